# Optimizing an MI355X kernel written in HIP

```python
import jax, jax.numpy as jnp
from jax import lax
import numpy as np

D_MODEL = 1024
BATCH = 8
SEQ = 4096
DEPTH = 2

GRID_W = 64
CTX_LEN = 256
EPS = 1e-6
MLA_HEADS = 8
Q_LORA = 256
KV_LORA = 128
QK_NOPE = 64
QK_ROPE = 32
V_HEAD = 64
QK_HEAD = QK_NOPE + QK_ROPE
ROPE_BASE = 10000.0
Q_BLOCK = 128
FNET_GROUPS = 4
FNET_GROUP_DIM = 64
FNET_C = FNET_GROUPS * FNET_GROUP_DIM
CONV_C = 256
CONV_W = 31
N_BRANCH = 3
PEER_HEADS = 8
N_KEYS = 128
N_EXPERTS = N_KEYS * N_KEYS
D_KEY = 128
PEER_TOPK = 16
PEER_CHUNK = 128
KV_IN = KV_LORA + QK_ROPE
REST_SPLITS = [Q_LORA, Q_LORA + FNET_C, Q_LORA + FNET_C + 2 * CONV_C]
IN_COLS = KV_IN + Q_LORA + FNET_C + 2 * CONV_C + N_BRANCH * D_MODEL

kernel_name = 'hybrid_mla_fnet_conformer_peer_dit'


def rmsnorm(x, g):
    xf = x.astype(jnp.float32)
    y = xf * lax.rsqrt(jnp.mean(xf * xf, axis=-1, keepdims=True) + EPS)
    return (y * g.astype(jnp.float32)).astype(x.dtype)


def layernorm(x, g, b):
    xf = x.astype(jnp.float32)
    mu = jnp.mean(xf, axis=-1, keepdims=True)
    var = jnp.mean(jnp.square(xf - mu), axis=-1, keepdims=True)
    y = (xf - mu) * lax.rsqrt(var + EPS)
    return (y * g.astype(jnp.float32) + b.astype(jnp.float32)).astype(x.dtype)


def adaln(cond, w_mod, b_mod):
    return jnp.split(jax.nn.silu(cond) @ w_mod + b_mod, 6, axis=-1)


def modulate(h, shift, scale):
    return h * (1.0 + scale[:, None, :]) + shift[:, None, :]


def axial_rope_tables(n, dtype):
    rows = n // GRID_W
    row = jnp.repeat(jnp.arange(rows, dtype=jnp.float32), GRID_W)
    col = jnp.tile(jnp.arange(GRID_W, dtype=jnp.float32), rows)
    half = QK_ROPE // 2
    inv = ROPE_BASE ** (-jnp.arange(0, half, 2, dtype=jnp.float32) / half)
    ar = row[:, None] * inv
    ac = col[:, None] * inv
    ang = jnp.concatenate([ar, ar, ac, ac], axis=-1)
    return jnp.cos(ang).astype(dtype), jnp.sin(ang).astype(dtype)


def _rotate_half(z):
    z1, z2 = jnp.split(z, 2, axis=-1)
    return jnp.concatenate([-z2, z1], axis=-1)


def apply_axial_rope(z, cos, sin):
    zr, zc = jnp.split(z, 2, axis=-1)
    rot = jnp.concatenate([_rotate_half(zr), _rotate_half(zc)], axis=-1)
    return z * cos[:, None, :] + rot * sin[:, None, :]


def mla_q(cq, lp, rope):
    b, t, _ = cq.shape
    q = (rmsnorm(cq, lp['g_cq']) @ lp['w_uq']).reshape(b, t, MLA_HEADS, QK_HEAD)
    q = rmsnorm(q, lp['g_qn'])
    if rope is not None:
        q = jnp.concatenate([q[..., :QK_NOPE], apply_axial_rope(q[..., QK_NOPE:], *rope)], axis=-1)
    return q


def mla_kv(z, lp, rope):
    b, t, _ = z.shape
    ckv, kr = jnp.split(z, [KV_LORA], axis=-1)
    kv = (rmsnorm(ckv, lp['g_ckv']) @ lp['w_ukv']).reshape(b, t, MLA_HEADS, QK_NOPE + V_HEAD)
    k_nope, v = kv[..., :QK_NOPE], kv[..., QK_NOPE:]
    k_rope = jnp.broadcast_to(kr[:, :, None, :], (b, t, MLA_HEADS, QK_ROPE))
    k = rmsnorm(jnp.concatenate([k_nope, k_rope], axis=-1), lp['g_kn'])
    if rope is not None:
        k = jnp.concatenate([k[..., :QK_NOPE], apply_axial_rope(k[..., QK_NOPE:], *rope)], axis=-1)
    return k, v


def softmax_attend(q, k, v):
    s = jnp.einsum('bqhd,bkhd->bhqk', q, k).astype(jnp.float32) * (QK_HEAD ** -0.5)
    p = jax.nn.softmax(s, axis=-1).astype(v.dtype)
    return jnp.einsum('bhqk,bkhd->bqhd', p, v)


def latent_attention(q, k, v):
    b, s, h, _ = q.shape
    nb = s // Q_BLOCK
    qb = q.reshape(b, nb, Q_BLOCK, h, QK_HEAD).transpose(1, 0, 2, 3, 4)
    o = lax.map(lambda qi: softmax_attend(qi, k, v), qb)
    return o.transpose(1, 0, 2, 3, 4).reshape(b, s, h * V_HEAD)


def fourier_mix(z):
    b, t, _ = z.shape
    zz = z.astype(jnp.float32).reshape(b, t, FNET_GROUPS, FNET_GROUP_DIM)
    f = jnp.fft.fft2(zz, axes=(1, 3), norm='ortho').real
    return f.reshape(b, t, FNET_C).astype(z.dtype)


def conformer_conv(z, lp):
    a, g = jnp.split(z, 2, axis=-1)
    u = a * jax.nn.sigmoid(g)
    u = lax.conv_general_dilated(u, lp['w_dw'], window_strides=(1,), padding=[(CONV_W // 2, CONV_W // 2)],
                                 dimension_numbers=('NWC', 'WIO', 'NWC'), feature_group_count=CONV_C) + lp['b_dw']
    return jax.nn.silu(layernorm(u, lp['g_cln'], lp['b_cln']))


def branch_merge(a_o, zf, zc, zg, lp):
    b, t, _ = zg.shape
    g = jax.nn.sigmoid(zg.astype(jnp.float32)).astype(zg.dtype).reshape(b, t, N_BRANCH, D_MODEL)
    m = (g[:, :, 0] * (a_o @ lp['wb_attn'])
         + g[:, :, 1] * (fourier_mix(zf) @ lp['wb_fnet'])
         + g[:, :, 2] * (conformer_conv(zc, lp) @ lp['wb_conv']))
    return m @ lp['w_out']


def mixer_sublayer(x, ctx, mod_x, mod_c, lp, rope, update_ctx):
    sh, sc, gt = mod_x
    csh, csc, cgt = mod_c
    hx = modulate(rmsnorm(x, lp['g_norm1']), sh, sc)
    hc = modulate(rmsnorm(ctx, lp['g_norm1']), csh, csc)
    k_c, v_c = mla_kv(hc @ lp['w_in'][:, :KV_IN], lp, None)
    k_x, v_x = mla_kv(hx @ lp['w_in'][:, :KV_IN], lp, rope)
    cq_x, zf_x, zc_x, zg_x = jnp.split(hx @ lp['w_in'][:, KV_IN:], REST_SPLITS, axis=-1)
    q_x = mla_q(cq_x, lp, rope)
    a_x = latent_attention(q_x, jnp.concatenate([k_c, k_x], axis=1), jnp.concatenate([v_c, v_x], axis=1))
    x = x + gt[:, None, :] * branch_merge(a_x, zf_x, zc_x, zg_x, lp)
    if update_ctx:
        b, l, _ = ctx.shape
        cq_c, zf_c, zc_c, zg_c = jnp.split(hc @ lp['w_in'][:, KV_IN:], REST_SPLITS, axis=-1)
        a_c = softmax_attend(mla_q(cq_c, lp, None), k_c, v_c).reshape(b, l, MLA_HEADS * V_HEAD)
        ctx = ctx + cgt[:, None, :] * branch_merge(a_c, zf_c, zc_c, zg_c, lp)
    return x, ctx


def peer_ffn(h, w_query, sub_keys, u_tab, v_tab):
    b, t, d = h.shape
    chunks = h.reshape(-1, PEER_CHUNK, d)

    def chunk(hc):
        q = (hc @ w_query).reshape(PEER_CHUNK, PEER_HEADS, 2, D_KEY // 2)
        s = jnp.einsum('chpd,hpnd->chpn', q, sub_keys).astype(jnp.float32)
        s_top, i_top = lax.top_k(s, PEER_TOPK)
        cand = (s_top[:, :, 0, :, None] + s_top[:, :, 1, None, :]).reshape(PEER_CHUNK, PEER_HEADS, PEER_TOPK * PEER_TOPK)
        cand_id = (i_top[:, :, 0, :, None] * N_KEYS + i_top[:, :, 1, None, :]).reshape(PEER_CHUNK, PEER_HEADS, PEER_TOPK * PEER_TOPK)
        best, pos = lax.top_k(cand, PEER_TOPK)
        eid = jnp.take_along_axis(cand_id, pos, axis=-1)
        gate = jax.nn.softmax(best, axis=-1).astype(hc.dtype)
        u = jnp.take(u_tab, eid, axis=0)
        act = jax.nn.gelu(jnp.einsum('chkd,cd->chk', u, hc)) * gate
        v = jnp.take(v_tab, eid, axis=0)
        return jnp.einsum('chk,chkd->cd', act, v)

    return lax.map(chunk, chunks).reshape(b, t, d)


def setup_inputs(seed: int = 0) -> dict:
    key = jax.random.key(seed)
    ks = jax.random.split(key, 28)
    f32 = jnp.float32

    def nrm(k, shape, scale):
        return jax.random.normal(k, shape, f32) * scale

    def gain(k, shape):
        return 1.0 + 0.02 * jax.random.normal(k, shape, f32)

    L = DEPTH
    return {
        'x': nrm(ks[0], (BATCH, SEQ, D_MODEL), 1.0),
        'c': nrm(ks[1], (BATCH, D_MODEL), 1.0),
        'ctx': nrm(ks[2], (BATCH, CTX_LEN, D_MODEL), 1.0),
        'c_ctx': nrm(ks[3], (D_MODEL,), 1.0),
        'w_mod': nrm(ks[4], (L, D_MODEL, 6 * D_MODEL), 0.5 * D_MODEL ** -0.5),
        'b_mod': nrm(ks[5], (L, 6 * D_MODEL), 0.02),
        'g_norm1': gain(ks[6], (L, D_MODEL)),
        'w_in': nrm(ks[7], (L, D_MODEL, IN_COLS), D_MODEL ** -0.5),
        'g_ckv': gain(ks[8], (L, KV_LORA)),
        'w_ukv': nrm(ks[9], (L, KV_LORA, MLA_HEADS * (QK_NOPE + V_HEAD)), KV_LORA ** -0.5),
        'g_cq': gain(ks[10], (L, Q_LORA)),
        'w_uq': nrm(ks[11], (L, Q_LORA, MLA_HEADS * QK_HEAD), Q_LORA ** -0.5),
        'g_qn': gain(ks[12], (L, QK_HEAD)),
        'g_kn': gain(ks[13], (L, QK_HEAD)),
        'w_dw': nrm(ks[14], (L, CONV_W, 1, CONV_C), CONV_W ** -0.5),
        'b_dw': nrm(ks[15], (L, CONV_C), 0.02),
        'g_cln': gain(ks[16], (L, CONV_C)),
        'b_cln': nrm(ks[17], (L, CONV_C), 0.02),
        'wb_attn': nrm(ks[18], (L, MLA_HEADS * V_HEAD, D_MODEL), (MLA_HEADS * V_HEAD) ** -0.5),
        'wb_fnet': nrm(ks[19], (L, FNET_C, D_MODEL), FNET_C ** -0.5),
        'wb_conv': nrm(ks[20], (L, CONV_C, D_MODEL), CONV_C ** -0.5),
        'w_out': nrm(ks[21], (L, D_MODEL, D_MODEL), D_MODEL ** -0.5),
        'g_norm2': gain(ks[22], (L, D_MODEL)),
        'w_query': nrm(ks[23], (L, D_MODEL, PEER_HEADS * D_KEY), D_MODEL ** -0.5),
        'sub_keys': nrm(ks[24], (L, PEER_HEADS, 2, N_KEYS, D_KEY // 2), (D_KEY // 2) ** -0.5),
        'u_tab': nrm(ks[25], (L, N_EXPERTS, D_MODEL), D_MODEL ** -0.5),
        'v_tab': nrm(ks[26], (L, N_EXPERTS, D_MODEL), PEER_HEADS ** -0.5),
    }


def reference(x, c, ctx, c_ctx, w_mod, b_mod, g_norm1, w_in, g_ckv, w_ukv, g_cq, w_uq, g_qn, g_kn,
              w_dw, b_dw, g_cln, b_cln, wb_attn, wb_fnet, wb_conv, w_out, g_norm2, w_query, sub_keys,
              u_tab, v_tab):
    rope = axial_rope_tables(x.shape[1], x.dtype)
    for i in range(DEPTH):
        lp = {'g_norm1': g_norm1[i], 'w_in': w_in[i], 'g_ckv': g_ckv[i], 'w_ukv': w_ukv[i],
              'g_cq': g_cq[i], 'w_uq': w_uq[i], 'g_qn': g_qn[i], 'g_kn': g_kn[i],
              'w_dw': w_dw[i], 'b_dw': b_dw[i], 'g_cln': g_cln[i], 'b_cln': b_cln[i],
              'wb_attn': wb_attn[i], 'wb_fnet': wb_fnet[i], 'wb_conv': wb_conv[i], 'w_out': w_out[i]}
        sh1, sc1, gt1, sh2, sc2, gt2 = adaln(c, w_mod[i], b_mod[i])
        csh1, csc1, cgt1, csh2, csc2, cgt2 = adaln(c_ctx[None, :], w_mod[i], b_mod[i])
        update_ctx = i < DEPTH - 1
        x, ctx = mixer_sublayer(x, ctx, (sh1, sc1, gt1), (csh1, csc1, cgt1), lp, rope, update_ctx)
        x = x + gt2[:, None, :] * peer_ffn(modulate(rmsnorm(x, g_norm2[i]), sh2, sc2),
                                           w_query[i], sub_keys[i], u_tab[i], v_tab[i])
        if update_ctx:
            ctx = ctx + cgt2[:, None, :] * peer_ffn(modulate(rmsnorm(ctx, g_norm2[i]), csh2, csc2),
                                                    w_query[i], sub_keys[i], u_tab[i], v_tab[i])
    return x
```

```cpp
#include <hip/hip_runtime.h>
#include <hip/hip_cooperative_groups.h>
#include <cstdio>
#include <cstdint>
namespace cg = cooperative_groups;

#ifndef ABL_PEER
#define ABL_PEER 1
#endif
#ifndef ABL_BR
#define ABL_BR 7
#endif
#ifndef PROBE_S
#define PROBE_S (-1)
#endif
#ifndef PROBE_REPS
#define PROBE_REPS 4
#endif
#ifndef CHECK_ATTN
#define CHECK_ATTN 0
#endif
#ifndef CHECK_MASK
#define CHECK_MASK 0xff
#endif
#ifndef ONE_LAUNCH
#define ONE_LAUNCH 1
#endif

typedef unsigned short u16;
typedef __attribute__((ext_vector_type(8))) __bf16 bf16x8;
typedef __attribute__((ext_vector_type(2))) __bf16 bf16x2;
typedef __attribute__((ext_vector_type(16))) float f32x16;
typedef __attribute__((ext_vector_type(2))) float f32x2;

#define NB 8
#define SEQ 4096
#define DM 1024
#define CTXL 256
#define TLAT (NB * SEQ)
#define TCTX (NB * CTXL)
#define RTOT (TLAT + TCTX)
#define SKEYS (CTXL + SEQ)
#define NH 8
#define QKD 96
#define N2 1280
#define NEXP 16384
#define EPSV 1e-6f

struct Params {
  const float *x, *c, *ctx, *c_ctx, *w_mod, *b_mod, *g_norm1, *w_in, *g_ckv, *w_ukv, *g_cq, *w_uq, *g_qn, *g_kn,
      *w_dw, *b_dw, *g_cln, *b_cln, *wb_attn, *wb_fnet, *wb_conv, *w_out, *g_norm2, *w_query, *sub_keys, *u_tab, *v_tab;
  float* out;
  unsigned* bar;
  float* mods;
  float* ropetab;
  u16 *W2T, *WgT, *WukvT, *WuqT, *WbaT, *WbfT, *WbcT, *WoutT, *WqT, *SubK;
  u16 *WA, *WC, *Dctx, *Wcs;
  float* tw;
  u16* GB;
  unsigned char *UT8, *VT8;
  unsigned* PD;
  u16* hx;
  u16 *cq, *zf, *zc, *ckv; float* kr;
  u16* m;
  u16 *Kb, *Vtb;
  int* eid; float* gate;
  u16 *Ytl, *Ytc, *Ob, *Fb, *cv;
  float* ctx1;
  int one; int pad_;
};

#define W2T_SZ (N2 * 1024)
#define WGT_SZ (3072 * 1024)
#define WUKV_SZ (1024 * 128)
#define WUQ_SZ (768 * 256)
#define WBA_SZ (1024 * 512)
#define WBF_SZ (1024 * 256)
#define WBC_SZ (1024 * 256)
#define WOUT_SZ (1024 * 1024)
#define WQ_SZ (1024 * 1024)
#define SUBK_SZ (8 * 2 * 128 * 64)

__device__ __forceinline__ unsigned pack2(float a, float b) {
  f32x2 v = {a, b};
  return __builtin_bit_cast(unsigned, __builtin_convertvector(v, bf16x2));
}
__device__ __forceinline__ u16 tobf(float a) { return (u16)(pack2(a, 0.f) & 0xffffu); }
__device__ __forceinline__ float bf_lo(unsigned u) { return __uint_as_float(u << 16); }
__device__ __forceinline__ float bf_hi(unsigned u) { return __uint_as_float(u & 0xffff0000u); }
__device__ __forceinline__ float bf1(u16 u) { return __uint_as_float(((unsigned)u) << 16); }
__device__ __forceinline__ f32x16 mfma32(uint4 a, uint4 b, f32x16 c) {
  return __builtin_amdgcn_mfma_f32_32x32x16_bf16(__builtin_bit_cast(bf16x8, a), __builtin_bit_cast(bf16x8, b), c, 0, 0, 0);
}
__device__ __forceinline__ uint4 ldg16(const void* p) { return *(const uint4*)p; }
__device__ __forceinline__ int opaque(int x) { asm volatile("" : "+v"(x)); return x; }
#define TIDX opaque((int)threadIdx.x)
__device__ __forceinline__ float wave_sum(float v) {
#pragma unroll
  for (int o = 32; o > 0; o >>= 1) v += __shfl_xor(v, o);
  return v;
}
__device__ __forceinline__ float half_sum(float v) {
#pragma unroll
  for (int o = 16; o > 0; o >>= 1) v += __shfl_xor(v, o);
  return v;
}
__device__ __forceinline__ float sigmoidf_(float x) { return 1.f / (1.f + __expf(-x)); }
__device__ __forceinline__ float siluf_(float x) { return x / (1.f + __expf(-x)); }
__device__ __forceinline__ float gelu_tanh(float x) {
  float u = 0.7978845608028654f * (x + 0.044715f * x * x * x);
  float t = 1.f - 2.f / (1.f + __expf(2.f * u));
  return 0.5f * x * (1.f + t);
}
__device__ __forceinline__ int row_mod(int r) { return r < TLAT ? (r >> 12) : 8; }

#define SMEM_BYTES 73728
#define LDT 72

#define LAS3 __attribute__((address_space(3)))
__device__ __forceinline__ void glds16(const u16* g, char* lds_wave_base) {
  __builtin_amdgcn_global_load_lds((const unsigned*)g, (LAS3 unsigned*)lds_wave_base, 16, 0, 0);
}
__device__ __forceinline__ void gemm128x(const u16* __restrict__ A, int lda, const u16* __restrict__ Bt, int ldb, int bs1, int bs2, int K,
                                         f32x16 (&acc)[2][2], char* smem) {
  char* As = smem;
  char* Bs = smem + 32768;
  const int tid = TIDX, lane = tid & 63, w = tid >> 6, wr = w >> 1, wc = w & 1;
  const int nk = K >> 6;
  const int srow = w * 8 + (lane >> 3);
  const int schunk = (lane & 7) ^ ((srow >> 1) & 7);
  const int aoff = srow * lda + schunk * 8, boff = srow * ldb + schunk * 8;
  const int a32 = 32 * lda;
  __syncthreads();
#pragma unroll
  for (int i = 0; i < 4; i++) {
    glds16(A + (aoff + i * a32), As + (i * 4 + w) * 1024);
    glds16(Bt + (boff + (i & 1) * bs1 + (i >> 1) * bs2), Bs + (i * 4 + w) * 1024);
  }
  __syncthreads();
  const int fr = lane & 31, hh = lane >> 5;
  const int sw = (fr >> 1) & 7;
  for (int kt = 0; kt < nk; kt++) {
    const int cur = kt & 1;
    if (kt + 1 < nk) {
      const int ko = (kt + 1) * 64;
      char* An = As + (cur ^ 1) * 16384;
      char* Bn = Bs + (cur ^ 1) * 16384;
#pragma unroll
      for (int i = 0; i < 4; i++) {
        glds16(A + (aoff + i * a32 + ko), An + (i * 4 + w) * 1024);
        glds16(Bt + (boff + (i & 1) * bs1 + (i >> 1) * bs2 + ko), Bn + (i * 4 + w) * 1024);
      }
    }
    const char* Ac = As + cur * 16384 + (wr * 64 + fr) * 128;
    const char* Bc = Bs + cur * 16384 + (wc * 64 + fr) * 128;
#pragma unroll
    for (int kk = 0; kk < 4; kk++) {
      const int so = ((2 * kk + hh) ^ sw) << 4;
      uint4 a0 = *(const uint4*)(Ac + so);
      uint4 a1 = *(const uint4*)(Ac + 32 * 128 + so);
      uint4 b0 = *(const uint4*)(Bc + so);
      uint4 b1 = *(const uint4*)(Bc + 32 * 128 + so);
      acc[0][0] = mfma32(a0, b0, acc[0][0]);
      acc[0][1] = mfma32(a0, b1, acc[0][1]);
      acc[1][0] = mfma32(a1, b0, acc[1][0]);
      acc[1][1] = mfma32(a1, b1, acc[1][1]);
    }
    __syncthreads();
  }
}
__device__ __forceinline__ void gemm128(const u16* __restrict__ A, int lda, const u16* __restrict__ Bt, int ldb, int K,
                                        f32x16 (&acc)[2][2], char* smem) {
  gemm128x(A, lda, Bt, ldb, 32 * ldb, 64 * ldb, K, acc, smem);
}
__device__ __forceinline__ void gemm128h(const u16* __restrict__ A, int lda, const u16* __restrict__ Bt, int ldb, int K, int jh,
                                         f32x16 (&acc)[2], char* smem) {
  char* As = smem;
  char* Bs = smem + 32768;
  const int tid = TIDX, lane = tid & 63, w = tid >> 6, wr = w >> 1, wc = w & 1;
  const int nk = K >> 6;
  const int srow = w * 8 + (lane >> 3);
  const int schunk = (lane & 7) ^ ((srow >> 1) & 7);
  const int aoff = srow * lda + schunk * 8;
  const int a32 = 32 * lda;
  const int boff = (jh * 32 + srow) * ldb + schunk * 8, b64 = 64 * ldb;
  __syncthreads();
#pragma unroll
  for (int i = 0; i < 4; i++) glds16(A + (aoff + i * a32), As + (i * 4 + w) * 1024);
#pragma unroll
  for (int i = 0; i < 2; i++) glds16(Bt + (boff + i * b64), Bs + (i * 4 + w) * 1024);
  __syncthreads();
  const int fr = lane & 31, hh = lane >> 5;
  const int sw = (fr >> 1) & 7;
  for (int kt = 0; kt < nk; kt++) {
    const int cur = kt & 1;
    if (kt + 1 < nk) {
      const int ko = (kt + 1) * 64;
      char* An = As + (cur ^ 1) * 16384;
      char* Bn = Bs + (cur ^ 1) * 8192;
#pragma unroll
      for (int i = 0; i < 4; i++) glds16(A + (aoff + i * a32 + ko), An + (i * 4 + w) * 1024);
#pragma unroll
      for (int i = 0; i < 2; i++) glds16(Bt + (boff + i * b64 + ko), Bn + (i * 4 + w) * 1024);
    }
    const char* Ac = As + cur * 16384 + (wr * 64 + fr) * 128;
    const char* Bc = Bs + cur * 8192 + (wc * 32 + fr) * 128;
#pragma unroll
    for (int kk = 0; kk < 4; kk++) {
      const int so = ((2 * kk + hh) ^ sw) << 4;
      uint4 a0 = *(const uint4*)(Ac + so);
      uint4 a1 = *(const uint4*)(Ac + 32 * 128 + so);
      uint4 b0 = *(const uint4*)(Bc + so);
      acc[0] = mfma32(a0, b0, acc[0]);
      acc[1] = mfma32(a1, b0, acc[1]);
    }
    __syncthreads();
  }
}
#define FOR_UNITS_XCD(NRT, NCT, RT, CT) \
  for (int _s = (int)(blockIdx.x >> 3), _per = (NRT) >> 3, _n = _per * (NCT); _s < _n; _s += (int)(gridDim.x >> 3)) { \
    const int RT = (int)(blockIdx.x & 7) * _per + _s / (NCT), CT = _s % (NCT);
#define ZERO_ACC(acc) { _Pragma("unroll") for (int _i = 0; _i < 2; _i++) _Pragma("unroll") for (int _j = 0; _j < 2; _j++) _Pragma("unroll") for (int _r = 0; _r < 16; _r++) acc[_i][_j][_r] = 0.f; }
#define ACC_ROW(wr, i, r, lane) ((wr) * 64 + (i) * 32 + ((r) & 3) + 8 * ((r) >> 2) + 4 * ((lane) >> 5))
#define ACC_COL(wc, j, lane) ((wc) * 64 + (j) * 32 + ((lane) & 31))

__device__ __forceinline__ void job_mods(const Params& p, int job, char* smem) {
  float* s = (float*)smem;
  float* red = s + 9 * 1024;
  const int L = job / 96, nt = job % 96;
  const int tid = TIDX, lane = tid & 63, w = tid >> 6;
  __syncthreads();
  for (int i = tid; i < 9 * 1024; i += 256) {
    const int j = i >> 10, k = i & 1023;
    const float cv = (j < 8) ? p.c[j * 1024 + k] : p.c_ctx[k];
    s[i] = siluf_(cv);
  }
  __syncthreads();
  const int n = nt * 64 + lane;
  float acc[9];
#pragma unroll
  for (int j = 0; j < 9; j++) acc[j] = 0.f;
  const float* wp = p.w_mod + (long)L * 1024 * 6144 + (long)(w * 256) * 6144 + n;
#pragma unroll 8
  for (int k = 0; k < 256; k++) {
    const float wv = wp[(long)k * 6144];
#pragma unroll
    for (int j = 0; j < 9; j++) acc[j] += s[j * 1024 + w * 256 + k] * wv;
  }
#pragma unroll
  for (int j = 0; j < 9; j++) red[(w * 9 + j) * 64 + lane] = acc[j];
  __syncthreads();
  for (int i = tid; i < 9 * 64; i += 256) {
    const int j = i >> 6, l = i & 63;
    const float v = ((red[(0 * 9 + j) * 64 + l] + red[(1 * 9 + j) * 64 + l]) + red[(2 * 9 + j) * 64 + l]) + red[(3 * 9 + j) * 64 + l];
    p.mods[(L * 9 + j) * 6144 + nt * 64 + l] = v + p.b_mod[L * 6144 + nt * 64 + l];
  }
}

__device__ __forceinline__ void job_convT(const float* src, int ldsrc, int c0, int k0, u16* dst, int K, int n0, const float* scale, char* smem) {
  float* t = (float*)smem;
  const int tid = TIDX;
  __syncthreads();
  const int nc = tid & 31, kr = tid >> 5;
#pragma unroll 4
  for (int kk = kr; kk < 128; kk += 8) {
    float v = 0.f;
    if (src) { v = src[(long)(k0 + kk) * ldsrc + c0 + nc]; if (scale) v *= scale[k0 + kk]; }
    t[nc * 129 + kk] = v;
  }
  __syncthreads();
  const int nr = tid >> 3, kc = (tid & 7) * 16;
  unsigned o[8];
#pragma unroll
  for (int q = 0; q < 8; q++) o[q] = pack2(t[nr * 129 + kc + 2 * q], t[nr * 129 + kc + 2 * q + 1]);
  uint4* dp = (uint4*)(dst + (long)(n0 + nr) * K + k0 + kc);
  dp[0] = make_uint4(o[0], o[1], o[2], o[3]);
  dp[1] = make_uint4(o[4], o[5], o[6], o[7]);
}

#define NJ_W2 (40 * 8)
#define NJ_WG (96 * 8)
#define NJ_UKV (32 * 1)
#define NJ_UQ (24 * 2)
#define NJ_BA (32 * 4)
#define NJ_BF (32 * 2)
#define NJ_BC (32 * 2)
#define NJ_OUT (32 * 8)
#define NJ_WQ (32 * 8)
#define NJ_CONV_LAYER (NJ_W2 + NJ_WG + NJ_UKV + NJ_UQ + NJ_BA + NJ_BF + NJ_BC + NJ_OUT + NJ_WQ)

__device__ __forceinline__ void job_conv_weights(const Params& p, int job, char* smem) {
  const int L = job / NJ_CONV_LAYER;
  int j = job % NJ_CONV_LAYER;
  const float* src; int ldsrc, c0, k0, K, n0; u16* dst; const float* scale = nullptr;
  if (j < NJ_W2) {
    const int nt = j >> 3, kt = j & 7; n0 = nt * 32;
    bool valid = true;
    if (n0 < 256) c0 = 160 + n0;
    else if (n0 < 512) c0 = 416 + (n0 - 256);
    else if (n0 < 1024) c0 = 672 + (n0 - 512);
    else if (n0 < 1152) c0 = n0 - 1024;
    else if (n0 < 1184) c0 = 128 + (n0 - 1152);
    else { c0 = 0; valid = false; }
    src = valid ? p.w_in + (long)L * 1024 * 4256 : nullptr; ldsrc = 4256; k0 = kt * 128; dst = p.W2T + (long)L * W2T_SZ; K = 1024;
  } else if ((j -= NJ_W2) < NJ_WG) {
    const int nt = j >> 3, kt = j & 7;
    src = p.w_in + (long)L * 1024 * 4256; ldsrc = 4256; c0 = 1184 + nt * 32; k0 = kt * 128; dst = p.WgT + (long)L * WGT_SZ; K = 1024; n0 = nt * 32;
  } else if ((j -= NJ_WG) < NJ_UKV) {
    src = p.w_ukv + (long)L * 128 * 1024; ldsrc = 1024; c0 = j * 32; k0 = 0; dst = p.WukvT + (long)L * WUKV_SZ; K = 128; n0 = j * 32; scale = p.g_ckv + L * 128;
  } else if ((j -= NJ_UKV) < NJ_UQ) {
    const int nt = j >> 1, kt = j & 1;
    src = p.w_uq + (long)L * 256 * 768; ldsrc = 768; c0 = nt * 32; k0 = kt * 128; dst = p.WuqT + (long)L * WUQ_SZ; K = 256; n0 = nt * 32; scale = p.g_cq + L * 256;
  } else if ((j -= NJ_UQ) < NJ_BA) {
    const int nt = j >> 2, kt = j & 3;
    src = p.wb_attn + (long)L * 512 * 1024; ldsrc = 1024; c0 = nt * 32; k0 = kt * 128; dst = p.WbaT + (long)L * WBA_SZ; K = 512; n0 = nt * 32;
  } else if ((j -= NJ_BA) < NJ_BF) {
    const int nt = j >> 1, kt = j & 1;
    src = p.wb_fnet + (long)L * 256 * 1024; ldsrc = 1024; c0 = nt * 32; k0 = kt * 128; dst = p.WbfT + (long)L * WBF_SZ; K = 256; n0 = nt * 32;
  } else if ((j -= NJ_BF) < NJ_BC) {
    const int nt = j >> 1, kt = j & 1;
    src = p.wb_conv + (long)L * 256 * 1024; ldsrc = 1024; c0 = nt * 32; k0 = kt * 128; dst = p.WbcT + (long)L * WBC_SZ; K = 256; n0 = nt * 32;
  } else if ((j -= NJ_BC) < NJ_OUT) {
    const int nt = j >> 3, kt = j & 7;
    src = p.w_out + (long)L * 1024 * 1024; ldsrc = 1024; c0 = nt * 32; k0 = kt * 128; dst = p.WoutT + (long)L * WOUT_SZ; K = 1024; n0 = nt * 32;
  } else {
    j -= NJ_OUT;
    const int nt = j >> 3, kt = j & 7;
    src = p.w_query + (long)L * 1024 * 1024; ldsrc = 1024; c0 = nt * 32; k0 = kt * 128; dst = p.WqT + (long)L * WQ_SZ; K = 1024; n0 = nt * 32;
  }
  job_convT(src, ldsrc, c0, k0, dst, K, n0, scale, smem);
}

__device__ __forceinline__ void job_cvt_straight(const float* src, u16* dst, long job) {
  const long base = job * 8192 + TIDX * 8;
#pragma unroll
  for (int i = 0; i < 4; i++) {
    const long o = base + i * 2048;
    float4 a = *(const float4*)(src + o), b = *(const float4*)(src + o + 4);
    *(uint4*)(dst + o) = make_uint4(pack2(a.x, a.y), pack2(a.z, a.w), pack2(b.x, b.y), pack2(b.z, b.w));
  }
}

__device__ __forceinline__ void job_misc(const Params& p) {
  const int tid = TIDX;
  for (int i = tid; i < 256 * 512; i += 256) {
    const int k = i >> 9, e = i & 511, part = e >> 8, t = e & 255;
    const int ph = (k * t) & 255;
    const float a = (float)ph * (1.0f / 128.0f);
    p.Dctx[i] = tobf((part == 0 ? cospif(a) : -sinpif(a)) * (1.0f / 16.0f));
  }
  for (int i = tid; i < 128 * 64; i += 256) {
    const int n = i >> 6, d = i & 63, pp = n >> 6, e = n & 63;
    const int ph = (e * d) & 63;
    const float a = (float)ph * (1.0f / 32.0f);
    p.Wcs[i] = tobf((pp == 0 ? cospif(a) : sinpif(a)) * 0.125f);
  }
  for (int i = tid; i < 128 * 128; i += 256) {
    const int R = i >> 7, kk = i & 127, k1 = (R >> 6) * 32 + (R & 31), pr = (R >> 5) & 1, part = kk >> 6, t1 = kk & 63;
    const float a = (float)((k1 * t1) & 63) * (1.0f / 32.0f);
    const float cs = cospif(a), sn = sinpif(a);
    const float v = (pr == 0) ? (part == 0 ? cs : -sn) : (part == 0 ? -sn : -cs);
    p.WA[i] = tobf(v * 0.125f);
  }
  for (int i = tid; i < 128 * 128; i += 256) {
    const int k2 = i >> 7, kk = i & 127, part = kk >> 6, t2 = kk & 63;
    const float a = (float)((k2 * t2) & 63) * (1.0f / 32.0f);
    p.WC[i] = (k2 < 64) ? tobf((part == 0 ? cospif(a) : sinpif(a)) * 0.125f) : (u16)0;
  }
  for (int i = tid; i < 4096; i += 256) {
    const float a = (float)i * (1.0f / 2048.0f);
    p.tw[2 * i] = cospif(a); p.tw[2 * i + 1] = sinpif(a);
  }
  for (int i = tid; i < 512; i += 256) {
    const int pos = i >> 3, mm = i & 7;
    const float inv = powf(10000.0f, -(float)(2 * mm) / 16.0f);
    const float ang = (float)pos * inv;
    p.ropetab[i * 2] = cosf(ang);
    p.ropetab[i * 2 + 1] = sinf(ang);
  }
}

#define NJ_MODS 192
#define NJ_CONVW (2 * NJ_CONV_LAYER)
#define NJ_SUBK 32
#define NJ_MISC 1
#define NJ_PREP (NJ_MODS + NJ_CONVW + NJ_SUBK + NJ_MISC)

__device__ __forceinline__ void phase_prep(const Params& p, char* smem) {
  for (int job = blockIdx.x; job < NJ_PREP; job += gridDim.x) {
    int j = job;
    if (j < NJ_MODS) { job_mods(p, j, smem); continue; }
    j -= NJ_MODS;
    if (j < NJ_CONVW) { job_conv_weights(p, j, smem); continue; }
    j -= NJ_CONVW;
    if (j < NJ_SUBK) { job_cvt_straight(p.sub_keys, p.SubK, j); continue; }
    job_misc(p);
  }
}

__device__ __forceinline__ void phase_norm(const Params& p, int L, int which, int nrows) {
  const int lane = TIDX & 63;
  const int gw = blockIdx.x * 4 + (TIDX >> 6), nw = gridDim.x * 4;
  const float* g = (which == 0 ? p.g_norm1 : p.g_norm2) + L * 1024;
  for (int r = gw; r < nrows; r += nw) {
    const float* src;
    if (which == 0 && L == 0) src = (r < TLAT) ? p.x + (long)r * 1024 : p.ctx + (long)(r - TLAT) * 1024;
    else src = (r < TLAT) ? p.out + (long)r * 1024 : p.ctx1 + (long)(r - TLAT) * 1024;
    const float* md = p.mods + (long)(L * 9 + row_mod(r)) * 6144 + (which == 0 ? 0 : 3072);
    float4 v[4];
    float ss = 0.f;
#pragma unroll
    for (int i = 0; i < 4; i++) {
      v[i] = *(const float4*)(src + i * 256 + lane * 4);
      ss += v[i].x * v[i].x + v[i].y * v[i].y + v[i].z * v[i].z + v[i].w * v[i].w;
    }
    ss = wave_sum(ss);
    const float rr = rsqrtf(ss * (1.0f / 1024.0f) + EPSV);
#pragma unroll
    for (int i = 0; i < 4; i++) {
      const int c = i * 256 + lane * 4;
      const float4 gg = *(const float4*)(g + c);
      const float4 sh = *(const float4*)(md + c);
      const float4 sc = *(const float4*)(md + 1024 + c);
      float o0 = v[i].x * rr * gg.x * (1.f + sc.x) + sh.x;
      float o1 = v[i].y * rr * gg.y * (1.f + sc.y) + sh.y;
      float o2 = v[i].z * rr * gg.z * (1.f + sc.z) + sh.z;
      float o3 = v[i].w * rr * gg.w * (1.f + sc.w) + sh.w;
      *(uint2*)(p.hx + (long)r * 1024 + c) = make_uint2(pack2(o0, o1), pack2(o2, o3));
    }
  }
}
#define U8_SCALE 32.0f
#define V8_SCALE 4.0f
__device__ __forceinline__ unsigned pack_fp8x4(float4 v, float s) {
  int w = 0;
  w = __builtin_amdgcn_cvt_pk_fp8_f32(v.x * s, v.y * s, w, false);
  w = __builtin_amdgcn_cvt_pk_fp8_f32(v.z * s, v.w * s, w, true);
  return (unsigned)w;
}
__device__ __forceinline__ void phase_tables(const Params& p, int L) {
  const int tid = TIDX;
  for (int job = blockIdx.x; job < 4096; job += gridDim.x) {
    const bool isu = job < 2048;
    const float* src = (isu ? p.u_tab : p.v_tab) + (long)L * NEXP * 1024;
    unsigned char* dst = isu ? p.UT8 : p.VT8;
    const float s = isu ? U8_SCALE : V8_SCALE;
    const long base = (long)(isu ? job : job - 2048) * 8192 + tid * 16;
#pragma unroll
    for (int i = 0; i < 2; i++) {
      const long o = base + i * 4096;
      const float4 a = *(const float4*)(src + o), b = *(const float4*)(src + o + 4);
      const float4 c = *(const float4*)(src + o + 8), d = *(const float4*)(src + o + 12);
      const long e = o >> 10; const int col = (int)(o & 1023), sl = col >> 7, cc = col & 127;
      *(uint4*)(dst + ((long)sl * NEXP + e) * 128 + cc) = make_uint4(pack_fp8x4(a, s), pack_fp8x4(b, s), pack_fp8x4(c, s), pack_fp8x4(d, s));
    }
  }
}

__device__ __forceinline__ void phase_s2(const Params& p, int L, char* smem) {
  const int lane = TIDX & 63, w = TIDX >> 6, wr = w >> 1, wc = w & 1;
  for (int pass = 0; pass < (L == 0 ? 1 : 2); pass++) {
  const int g_nrt = (L == 0) ? 272 : (pass == 0 ? 256 : 16), g_nct = (L == 0 || pass == 0) ? 10 : 2;
  FOR_UNITS_XCD(g_nrt, g_nct, rt_, ct_)
    const int rt = (L == 1 && pass == 1) ? 256 + rt_ : rt_, ct = (L == 1 && pass == 1) ? 8 + ct_ : ct_;
    f32x16 acc[2][2];
    ZERO_ACC(acc);
    gemm128(p.hx + (long)rt * 128 * 1024, 1024, p.W2T + (long)L * W2T_SZ + (long)ct * 128 * 1024, 1024, 1024, acc, smem);
    const int row0 = rt * 128;
#pragma unroll
    for (int i = 0; i < 2; i++)
#pragma unroll
      for (int j = 0; j < 2; j++)
#pragma unroll
        for (int r = 0; r < 16; r++) {
          const int row = row0 + ACC_ROW(wr, i, r, lane);
          const int col = ct * 128 + ACC_COL(wc, j, lane);
          const float v = acc[i][j][r];
          if (col < 256) p.cq[(long)row * 256 + col] = tobf(v);
          else if (col < 512) p.zf[(long)row * 256 + (col - 256)] = tobf(v);
          else if (col < 1024) p.zc[(long)row * 512 + (col - 512)] = tobf(v);
          else if (col < 1152) p.ckv[(long)row * 128 + (col - 1024)] = tobf(v);
          else if (col < 1184) p.kr[(long)row * 32 + (col - 1152)] = v;
        }
  }
  }
}

__device__ __forceinline__ void unit_kv(const Params& p, int L, int rt, int h, char* smem) {
  u16* As = (u16*)smem;
  u16* Ws = (u16*)(smem + 128 * 136 * 2);
  float* rrs = (float*)(smem + 2 * 128 * 136 * 2);
  const int tid = TIDX, lane = tid & 63, w = tid >> 6, hh = lane >> 5, c = lane & 31;
  const int row0 = rt * 128;
  __syncthreads();
  {
    const u16* ap = p.ckv + (long)row0 * 128;
    const u16* wp = p.WukvT + (long)L * WUKV_SZ + (long)h * 128 * 128;
#pragma unroll
    for (int i = 0; i < 8; i++) {
      const int idx = tid + 256 * i, rw = idx >> 4, ch = idx & 15;
      *(uint4*)(As + rw * 136 + ch * 8) = ldg16(ap + rw * 128 + ch * 8);
      *(uint4*)(Ws + rw * 136 + ch * 8) = ldg16(wp + rw * 128 + ch * 8);
    }
  }
  __syncthreads();
  {
    const int rw = tid >> 1, hf = tid & 1;
    float ss = 0.f;
#pragma unroll
    for (int q = 0; q < 8; q++) {
      uint4 v = *(const uint4*)(As + rw * 136 + hf * 64 + q * 8);
      float a;
      a = bf_lo(v.x); ss += a * a; a = bf_hi(v.x); ss += a * a;
      a = bf_lo(v.y); ss += a * a; a = bf_hi(v.y); ss += a * a;
      a = bf_lo(v.z); ss += a * a; a = bf_hi(v.z); ss += a * a;
      a = bf_lo(v.w); ss += a * a; a = bf_hi(v.w); ss += a * a;
    }
    ss += __shfl_xor(ss, 1);
    if (hf == 0) rrs[rw] = rsqrtf(ss * (1.0f / 128.0f) + EPSV);
  }
  __syncthreads();
  f32x16 aK[2], aV[2];
#pragma unroll
  for (int r = 0; r < 16; r++) { aK[0][r] = 0.f; aK[1][r] = 0.f; aV[0][r] = 0.f; aV[1][r] = 0.f; }
#pragma unroll
  for (int s = 0; s < 8; s++) {
    const int ko = s * 16 + hh * 8;
    uint4 tk = *(const uint4*)(As + (32 * w + c) * 136 + ko);
    uint4 w0 = *(const uint4*)(Ws + (c) * 136 + ko);
    uint4 w1 = *(const uint4*)(Ws + (32 + c) * 136 + ko);
    uint4 w2 = *(const uint4*)(Ws + (64 + c) * 136 + ko);
    uint4 w3 = *(const uint4*)(Ws + (96 + c) * 136 + ko);
    aK[0] = mfma32(tk, w0, aK[0]);
    aK[1] = mfma32(tk, w1, aK[1]);
    aV[0] = mfma32(w2, tk, aV[0]);
    aV[1] = mfma32(w3, tk, aV[1]);
  }
  const bool lat = row0 < TLAT;
  const int b = lat ? (row0 >> 12) : ((row0 - TLAT) >> 8);
  const int s0 = lat ? (row0 & 4095) : ((row0 - TLAT) & 255);
  const int kpos0 = lat ? (CTXL + s0) : s0;
  const float* gkn = p.g_kn + L * 96;
  const float gk0 = gkn[c], gk1 = gkn[32 + c], gk2 = gkn[64 + c];
  u16* Kdst = p.Kb + ((long)(b * 8 + h) * SKEYS + kpos0) * 96;
#pragma unroll
  for (int r = 0; r < 16; r++) {
    const int tl = 32 * w + (r & 3) + 8 * (r >> 2) + 4 * hh;
    const float rc = rrs[tl];
    const float v0 = aK[0][r] * rc, v1 = aK[1][r] * rc;
    const float kv = p.kr[(long)(row0 + tl) * 32 + c];
    const float ss = half_sum(v0 * v0 + v1 * v1 + kv * kv);
    const float rk = rsqrtf(ss * (1.0f / 96.0f) + EPSV);
    const float krn = kv * rk * gk2;
    const float partner = __shfl_xor(krn, 8);
    float o2 = krn;
    if (lat) {
      const int s = s0 + tl;
      const int pos = (c < 16) ? (s >> 6) : (s & 63);
      const float2 cs = *(const float2*)(p.ropetab + (pos * 8 + (c & 7)) * 2);
      const float rot = (c & 8) ? partner : -partner;
      o2 = krn * cs.x + rot * cs.y;
    }
    u16* kd = Kdst + (long)tl * 96;
    kd[c] = tobf(v0 * rk * gk0);
    kd[32 + c] = tobf(v1 * rk * gk1);
    kd[64 + c] = tobf(o2);
  }
  u16* Vdst = p.Vtb + (long)(b * 8 + h) * 64 * SKEYS + kpos0;
  const float rcv = rrs[32 * w + c];
#pragma unroll
  for (int i = 0; i < 2; i++)
#pragma unroll
    for (int r = 0; r < 16; r++) {
      const int d = 32 * i + (r & 3) + 8 * (r >> 2) + 4 * hh;
      Vdst[(long)d * SKEYS + 32 * w + c] = tobf(aV[i][r] * rcv);
    }
}

__device__ __forceinline__ void unit_chdft(const Params& p, int ut, int g, bool lat, char* smem) {
  const int lane = TIDX & 63, w = TIDX >> 6, wr = w >> 1, wc = w & 1;
  f32x16 acc[2][2];
  ZERO_ACC(acc);
  if (lat) {
    const int b = ut >> 5, j = ut & 31;
    gemm128x(p.Wcs, 64, p.zf + ((long)(b * SEQ + 2 * j) * 256 + g * 64), 64 * 256, 32 * 64 * 256, 256, 64, acc, smem);
    u16* dst = p.Ytl + ((long)(b * 256 + g * 64) * 64 + 2 * j) * 128;
#pragma unroll
    for (int i = 0; i < 2; i++)
#pragma unroll
      for (int jj = 0; jj < 2; jj++)
#pragma unroll
        for (int r = 0; r < 16; r++) {
          const int e = i * 32 + (r & 3) + 8 * (r >> 2) + 4 * (lane >> 5);
          dst[((long)e * 64 + wc) * 128 + wr * 64 + jj * 32 + (lane & 31)] = tobf(acc[i][jj][r]);
        }
  } else {
    const int row0 = TLAT + ut * 128;
    gemm128(p.Wcs, 64, p.zf + (long)row0 * 256 + g * 64, 256, 64, acc, smem);
    const int b = (row0 - TLAT) >> 8, s0 = (row0 - TLAT) & 255;
#pragma unroll
    for (int i = 0; i < 2; i++)
#pragma unroll
      for (int jj = 0; jj < 2; jj++)
#pragma unroll
        for (int r = 0; r < 16; r++) {
          const int n = ACC_ROW(wr, i, r, lane);
          const int t = s0 + ACC_COL(wc, jj, lane);
          p.Ytc[((long)(b * 256 + g * 64 + (n & 63))) * 512 + (n >> 6) * 256 + t] = tobf(acc[i][jj][r]);
        }
  }
}

__device__ __forceinline__ void unit_conv(const Params& p, int L, int ut, char* smem) {
  float* U = (float*)smem;
  const int tid = TIDX, lane = tid & 63, w = tid >> 6;
  const int row0 = ut * 32;
  const bool lat = row0 < TLAT;
  const int seqlen = lat ? SEQ : CTXL;
  const int s0 = lat ? (row0 & 4095) : ((row0 - TLAT) & 255);
  __syncthreads();
  for (int i = 0; i < 62; i++) {
    const int s = s0 - 15 + i;
    float u = 0.f;
    if (s >= 0 && s < seqlen) {
      const u16* zr = p.zc + (long)(row0 - 15 + i) * 512;
      const float a = bf1(zr[tid]), gg = bf1(zr[256 + tid]);
      u = a * sigmoidf_(gg);
    }
    U[i * 256 + tid] = u;
  }
  __syncthreads();
  float wv[31];
#pragma unroll
  for (int j = 0; j < 31; j++) wv[j] = p.w_dw[(long)L * 31 * 256 + j * 256 + tid];
  const float bias = p.b_dw[L * 256 + tid];
#pragma unroll 2
  for (int t = 0; t < 32; t++) {
    float acc = bias;
#pragma unroll
    for (int j = 0; j < 31; j++) acc += U[(t + j) * 256 + tid] * wv[j];
    U[t * 256 + tid] = acc;
  }
  __syncthreads();
  const float4 gg = *(const float4*)(p.g_cln + L * 256 + lane * 4);
  const float4 bb = *(const float4*)(p.b_cln + L * 256 + lane * 4);
#pragma unroll
  for (int q = 0; q < 8; q++) {
    const int t = w * 8 + q;
    const float4 v = *(const float4*)(U + t * 256 + lane * 4);
    const float mu = wave_sum(v.x + v.y + v.z + v.w) * (1.0f / 256.0f);
    const float d0 = v.x - mu, d1 = v.y - mu, d2 = v.z - mu, d3 = v.w - mu;
    const float var = wave_sum(d0 * d0 + d1 * d1 + d2 * d2 + d3 * d3) * (1.0f / 256.0f);
    const float rs = rsqrtf(var + EPSV);
    const float y0 = siluf_(d0 * rs * gg.x + bb.x), y1 = siluf_(d1 * rs * gg.y + bb.y);
    const float y2 = siluf_(d2 * rs * gg.z + bb.z), y3 = siluf_(d3 * rs * gg.w + bb.w);
    *(uint2*)(p.cv + (long)(row0 + t) * 256 + lane * 4) = make_uint2(pack2(y0, y1), pack2(y2, y3));
  }
}

__device__ __forceinline__ void phase_s3(const Params& p, int L, char* smem) {
  const int nrt_all = (L == 0) ? 272 : 256;
  const int n_kv = 272 * 8, n_dft = nrt_all * 4, n_cv = nrt_all * 4;
  for (int u = blockIdx.x; u < n_kv + n_dft + n_cv; u += gridDim.x) {
#ifndef S3_MASK
#define S3_MASK 7
#endif
    if (u < n_kv) { if (S3_MASK & 1) unit_kv(p, L, u >> 3, u & 7, smem); }
    else if (u < n_kv + n_dft) { const int v = u - n_kv; const int ut = v >> 2; if (S3_MASK & 2) unit_chdft(p, ut < 256 ? ut : ut - 256, v & 3, ut < 256, smem); }
    else { if (S3_MASK & 4) unit_conv(p, L, u - n_kv - n_dft, smem); }
  }
}

#define KLD 104
__device__ __forceinline__ void unit_attn(const Params& p, int L, int b, int h, int qt, bool isctx, char* smem) {
  const int tid = TIDX, lane = tid & 63, w = tid >> 6, hh = lane >> 5, c = lane & 31;
  const int qrow0 = isctx ? (TLAT + b * CTXL + qt * 128) : (b * SEQ + qt * 128);
  const int nkt = isctx ? (CTXL / 64) : (SKEYS / 64);
  u16* As = (u16*)smem;
  u16* Bs = (u16*)(smem + 128 * LDT * 2);
  u16* Qs = (u16*)(smem + (128 + 96) * LDT * 2);
  f32x16 aq[3];
#pragma unroll
  for (int r = 0; r < 16; r++) { aq[0][r] = 0.f; aq[1][r] = 0.f; aq[2][r] = 0.f; }
  float ssq = 0.f;
  const u16* cqp = p.cq + (long)qrow0 * 256;
  const u16* wqp = p.WuqT + (long)L * WUQ_SZ + (long)h * 96 * 256;
  for (int kc = 0; kc < 4; kc++) {
    __syncthreads();
#pragma unroll
    for (int i = 0; i < 4; i++) {
      const int idx = tid + 256 * i, rw = idx >> 3, ch = idx & 7;
      *(uint4*)(As + rw * LDT + ch * 8) = ldg16(cqp + rw * 256 + kc * 64 + ch * 8);
    }
#pragma unroll
    for (int i = 0; i < 3; i++) {
      const int idx = tid + 256 * i, rw = idx >> 3, ch = idx & 7;
      *(uint4*)(Bs + rw * LDT + ch * 8) = ldg16(wqp + rw * 256 + kc * 64 + ch * 8);
    }
    __syncthreads();
#pragma unroll
    for (int q = 0; q < 4; q++) {
      uint4 v = *(const uint4*)(As + (32 * w + c) * LDT + hh * 32 + q * 8);
      float a;
      a = bf_lo(v.x); ssq += a * a; a = bf_hi(v.x); ssq += a * a;
      a = bf_lo(v.y); ssq += a * a; a = bf_hi(v.y); ssq += a * a;
      a = bf_lo(v.z); ssq += a * a; a = bf_hi(v.z); ssq += a * a;
      a = bf_lo(v.w); ssq += a * a; a = bf_hi(v.w); ssq += a * a;
    }
#pragma unroll
    for (int kk = 0; kk < 4; kk++) {
      uint4 a = *(const uint4*)(As + (32 * w + c) * LDT + kk * 16 + hh * 8);
#pragma unroll
      for (int j = 0; j < 3; j++) {
        uint4 bq = *(const uint4*)(Bs + (32 * j + c) * LDT + kk * 16 + hh * 8);
        aq[j] = mfma32(a, bq, aq[j]);
      }
    }
  }
  ssq += __shfl_xor(ssq, 32);
  const float rr_lane = rsqrtf(ssq * (1.0f / 256.0f) + EPSV);
  {
    const float* gqn = p.g_qn + L * 96;
    const float g0 = gqn[c], g1 = gqn[32 + c], g2 = gqn[64 + c];
    const float qscale = 0.10206207261596577f * 1.4426950408889634f;
    u16* Qw = Qs + w * 32 * KLD;
#pragma unroll
    for (int r = 0; r < 16; r++) {
      const int rl = (r & 3) + 8 * (r >> 2) + 4 * hh;
      const float rc = __shfl(rr_lane, rl);
      const float q0 = aq[0][r] * rc, q1 = aq[1][r] * rc, q2 = aq[2][r] * rc;
      const float ss = half_sum(q0 * q0 + q1 * q1 + q2 * q2);
      const float rq = rsqrtf(ss * (1.0f / 96.0f) + EPSV);
      const float qn2 = q2 * rq * g2;
      const float partner = __shfl_xor(qn2, 8);
      float o2 = qn2;
      if (!isctx) {
        const int s = qt * 128 + 32 * w + rl;
        const int pos = (c < 16) ? (s >> 6) : (s & 63);
        const float2 cs = *(const float2*)(p.ropetab + (pos * 8 + (c & 7)) * 2);
        const float rot = (c & 8) ? partner : -partner;
        o2 = qn2 * cs.x + rot * cs.y;
      }
      Qw[rl * KLD + c] = tobf(q0 * rq * g0 * qscale);
      Qw[rl * KLD + 32 + c] = tobf(q1 * rq * g1 * qscale);
      Qw[rl * KLD + 64 + c] = tobf(o2 * qscale);
    }
  }
  __syncthreads();
  uint4 qf[6];
#pragma unroll
  for (int s = 0; s < 6; s++) qf[s] = *(const uint4*)(Qs + (w * 32 + c) * KLD + s * 16 + hh * 8);
  __syncthreads();
  u16* Ks = (u16*)smem;
  u16* Vs = (u16*)(smem + 2 * 64 * KLD * 2);
  const u16* kg = p.Kb + (long)(b * 8 + h) * SKEYS * 96;
  const u16* vg = p.Vtb + (long)(b * 8 + h) * 64 * SKEYS;
  uint4 rk[3], rv[2];
  int krow[3], kch[3];
#pragma unroll
  for (int i = 0; i < 3; i++) { const int idx = tid + 256 * i; krow[i] = idx / 12; kch[i] = idx % 12; }
  const int vrow = tid >> 3, vch = tid & 7;
#pragma unroll
  for (int i = 0; i < 3; i++) rk[i] = ldg16(kg + (long)(tid + 256 * i) * 8);
#pragma unroll
  for (int i = 0; i < 2; i++) rv[i] = ldg16(vg + (long)(vrow + 32 * i) * SKEYS + vch * 8);
#pragma unroll
  for (int i = 0; i < 3; i++) *(uint4*)(Ks + krow[i] * KLD + kch[i] * 8) = rk[i];
#pragma unroll
  for (int i = 0; i < 2; i++) *(uint4*)(Vs + (vrow + 32 * i) * LDT + vch * 8) = rv[i];
  __syncthreads();
  f32x16 aO[2];
#pragma unroll
  for (int r = 0; r < 16; r++) { aO[0][r] = 0.f; aO[1][r] = 0.f; }
  float mref = 0.f;
  f32x2 lsum2 = {0.f, 0.f};
  const int kperm = (c & ~12) | ((c & 4) << 1) | ((c & 8) >> 1);
  for (int kt = 0; kt < nkt; kt++) {
    const int cur = kt & 1;
    if (kt + 1 < nkt) {
#pragma unroll
      for (int i = 0; i < 3; i++) rk[i] = ldg16(kg + (long)(kt + 1) * 64 * 96 + (long)(tid + 256 * i) * 8);
#pragma unroll
      for (int i = 0; i < 2; i++) rv[i] = ldg16(vg + (long)(vrow + 32 * i) * SKEYS + (kt + 1) * 64 + vch * 8);
    }
    __builtin_amdgcn_sched_barrier(0);
    const u16* Kc = Ks + cur * 64 * KLD;
    const u16* Vc = Vs + cur * 64 * LDT;
    f32x16 aS[2];
    {
      const float nm = -mref;
#pragma unroll
      for (int r = 0; r < 16; r++) { aS[0][r] = nm; aS[1][r] = nm; }
    }
#pragma unroll
    for (int s = 0; s < 6; s++) {
      uint4 k0 = *(const uint4*)(Kc + (kperm) * KLD + s * 16 + hh * 8);
      uint4 k1 = *(const uint4*)(Kc + (32 + kperm) * KLD + s * 16 + hh * 8);
      aS[0] = mfma32(k0, qf[s], aS[0]);
      aS[1] = mfma32(k1, qf[s], aS[1]);
    }
    float mx = fmaxf(aS[0][0], aS[1][0]);
#pragma unroll
    for (int r = 1; r < 16; r++) mx = fmaxf(fmaxf(mx, aS[0][r]), aS[1][r]);
    if (__any(mx > 8.0f)) {
      const float mo = fmaxf(mx, __shfl_xor(mx, 32));
      const float delta = (mo > 8.0f) ? mo : 0.f;
      const float alpha = __builtin_amdgcn_exp2f(-delta);
      mref += delta;
      lsum2 *= alpha;
#pragma unroll
      for (int r = 0; r < 16; r++) {
        aO[0][r] *= alpha; aO[1][r] *= alpha;
        aS[0][r] -= delta; aS[1][r] -= delta;
      }
    }
#pragma unroll
    for (int r = 0; r < 16; r += 2) {
      aS[0][r] = __builtin_amdgcn_exp2f(aS[0][r]); aS[0][r + 1] = __builtin_amdgcn_exp2f(aS[0][r + 1]);
      aS[1][r] = __builtin_amdgcn_exp2f(aS[1][r]); aS[1][r + 1] = __builtin_amdgcn_exp2f(aS[1][r + 1]);
      const f32x2 p0 = {aS[0][r], aS[0][r + 1]}, p1 = {aS[1][r], aS[1][r + 1]};
      lsum2 += p0; lsum2 += p1;
    }
#pragma unroll
    for (int i = 0; i < 2; i++)
#pragma unroll
      for (int s2 = 0; s2 < 2; s2++) {
        uint4 pf = make_uint4(pack2(aS[i][8 * s2 + 0], aS[i][8 * s2 + 1]), pack2(aS[i][8 * s2 + 2], aS[i][8 * s2 + 3]),
                              pack2(aS[i][8 * s2 + 4], aS[i][8 * s2 + 5]), pack2(aS[i][8 * s2 + 6], aS[i][8 * s2 + 7]));
        uint4 v0 = *(const uint4*)(Vc + (c) * LDT + 32 * i + 16 * s2 + 8 * hh);
        uint4 v1 = *(const uint4*)(Vc + (32 + c) * LDT + 32 * i + 16 * s2 + 8 * hh);
        aO[0] = mfma32(v0, pf, aO[0]);
        aO[1] = mfma32(v1, pf, aO[1]);
      }
    if (kt + 1 < nkt) {
      const int nx = cur ^ 1;
#pragma unroll
      for (int i = 0; i < 3; i++) *(uint4*)(Ks + nx * 64 * KLD + krow[i] * KLD + kch[i] * 8) = rk[i];
#pragma unroll
      for (int i = 0; i < 2; i++) *(uint4*)(Vs + nx * 64 * LDT + (vrow + 32 * i) * LDT + vch * 8) = rv[i];
    }
    __syncthreads();
  }
  float lsum = lsum2.x + lsum2.y;
  lsum += __shfl_xor(lsum, 32);
  const float inv = 1.0f / lsum;
  u16* Os = (u16*)smem + w * 32 * LDT;
#pragma unroll
  for (int i = 0; i < 2; i++)
#pragma unroll
    for (int r = 0; r < 16; r++) {
      const int d = 32 * i + (r & 3) + 8 * (r >> 2) + 4 * hh;
      Os[c * LDT + d] = tobf(aO[i][r] * inv);
    }
  __syncthreads();
#pragma unroll
  for (int i = 0; i < 4; i++) {
    const int idx = lane + 64 * i, q = idx >> 3, ch = idx & 7;
    *(uint4*)(p.Ob + (long)(qrow0 + 32 * w + q) * 512 + h * 64 + ch * 8) = *(const uint4*)(Os + q * LDT + ch * 8);
  }
}

__device__ __forceinline__ void unit_dftA(const Params& p, int b, int np, char* smem) {
  const int lane = TIDX & 63, w = TIDX >> 6, wr = w >> 1, wc = w & 1, hh = lane >> 5, c = lane & 31;
  f32x16 acc[2][2];
  ZERO_ACC(acc);
  gemm128(p.WA, 128, p.Ytl + (long)(b * 256 + 2 * np) * 64 * 128, 128, 128, acc, smem);
  const int n = 2 * np + wc;
#pragma unroll
  for (int jj = 0; jj < 2; jj++) {
    const int t2 = jj * 32 + c;
#pragma unroll
    for (int r = 0; r < 16; r++) {
      const int k1 = wr * 32 + (r & 3) + 8 * (r >> 2) + 4 * hh;
      const float2 t = *(const float2*)(p.tw + 2 * ((k1 * t2) & 4095));
      const float gr = acc[0][jj][r], gi = acc[1][jj][r];
      u16* dst = p.GB + ((long)((b * 64 + k1) * 256 + n)) * 128 + t2;
      dst[0] = tobf(gr * t.x + gi * t.y);
      dst[64] = tobf(gi * t.x - gr * t.y);
    }
  }
}
__device__ __forceinline__ void unit_dftC(const Params& p, int b, int k1, int nt, char* smem) {
  const int lane = TIDX & 63, w = TIDX >> 6, wr = w >> 1, wc = w & 1, hh = lane >> 5, c = lane & 31;
  f32x16 acc[2][2];
  ZERO_ACC(acc);
  gemm128(p.WC, 128, p.GB + ((long)((b * 64 + k1) * 256 + nt * 128)) * 128, 128, 128, acc, smem);
  if (wr == 0) {
#pragma unroll
    for (int i = 0; i < 2; i++)
#pragma unroll
      for (int jj = 0; jj < 2; jj++)
#pragma unroll
        for (int r = 0; r < 16; r++) {
          const int k2 = i * 32 + (r & 3) + 8 * (r >> 2) + 4 * hh;
          p.Fb[((long)b * SEQ + k1 + 64 * k2) * 256 + nt * 128 + wc * 64 + jj * 32 + c] = tobf(acc[i][jj][r]);
        }
  }
}
__device__ __forceinline__ void unit_seqdft_ctx(const Params& p, int b, int mt, int nt, char* smem) {
  const int lane = TIDX & 63, w = TIDX >> 6, wr = w >> 1, wc = w & 1;
  f32x16 acc[2][2];
  ZERO_ACC(acc);
  gemm128(p.Dctx + (long)mt * 128 * 512, 512, p.Ytc + (long)(b * 256 + nt * 128) * 512, 512, 512, acc, smem);
  const long orow0 = (long)TLAT + b * CTXL + mt * 128;
#pragma unroll
  for (int i = 0; i < 2; i++)
#pragma unroll
    for (int j = 0; j < 2; j++)
#pragma unroll
      for (int r = 0; r < 16; r++)
        p.Fb[(orow0 + ACC_ROW(wr, i, r, lane)) * 256 + nt * 128 + ACC_COL(wc, j, lane)] = tobf(acc[i][j][r]);
}
__device__ __forceinline__ void phase_dftC(const Params& p, char* smem) {
  for (int u = blockIdx.x; u < 8 * 64 * 2; u += gridDim.x) unit_dftC(p, u >> 7, (u >> 1) & 63, u & 1, smem);
}

__device__ __forceinline__ void phase_s4(const Params& p, int L, char* smem) {
  const int n_at = 8 * 8 * 32, n_da = 8 * 128;
  const int n_dc = (L == 0) ? 8 * 2 * 2 : 0, n_ac = (L == 0) ? 8 * 8 * 2 : 0;
  for (int u = blockIdx.x; u < n_at + n_da + n_dc + n_ac; u += gridDim.x) {
    int v = u;
    if (v < n_at) { unit_attn(p, L, v >> 8, (v >> 5) & 7, v & 31, false, smem); continue; }
    v -= n_at;
    if (v < n_da) { unit_dftA(p, v >> 7, v & 127, smem); continue; }
    v -= n_da;
    if (v < n_dc) { unit_seqdft_ctx(p, v >> 2, (v >> 1) & 1, v & 1, smem); continue; }
    v -= n_dc;
    unit_attn(p, L, v >> 4, (v >> 1) & 7, v & 1, true, smem);
  }
}

__device__ __forceinline__ void phase_s7(const Params& p, int L, char* smem) {
  const int nrt = (L == 0) ? 272 : 256;
  FOR_UNITS_XCD(nrt, 8, rt, ct)
    const int row0 = rt * 128;
    f32x16 macc[2][2];
    ZERO_ACC(macc);
#pragma unroll 1
    for (int br = 0; br < 3; br++) {
      unsigned gp[2][2][8];
      {
      f32x16 acc[2][2];
      ZERO_ACC(acc);
      gemm128(p.hx + (long)row0 * 1024, 1024, p.WgT + (long)L * WGT_SZ + (long)(br * 1024 + ct * 128) * 1024, 1024, 1024, acc, smem);
#pragma unroll
      for (int i = 0; i < 2; i++)
#pragma unroll
        for (int j = 0; j < 2; j++)
#pragma unroll
          for (int r = 0; r < 8; r++) gp[i][j][r] = pack2(sigmoidf_(acc[i][j][2 * r]), sigmoidf_(acc[i][j][2 * r + 1]));
      }
      const u16* A2; const u16* B2; int K2;
      if (br == 0) { A2 = p.Ob + (long)row0 * 512; B2 = p.WbaT + (long)L * WBA_SZ + (long)ct * 128 * 512; K2 = 512; }
      else if (br == 1) { A2 = p.Fb + (long)row0 * 256; B2 = p.WbfT + (long)L * WBF_SZ + (long)ct * 128 * 256; K2 = 256; }
      else { A2 = p.cv + (long)row0 * 256; B2 = p.WbcT + (long)L * WBC_SZ + (long)ct * 128 * 256; K2 = 256; }
#pragma unroll
      for (int jh = 0; jh < 2; jh++) {
        f32x16 ah[2];
#pragma unroll
        for (int r = 0; r < 16; r++) { ah[0][r] = 0.f; ah[1][r] = 0.f; }
        gemm128h(A2, K2, B2, K2, K2, jh, ah, smem);
#pragma unroll
        for (int i = 0; i < 2; i++)
#pragma unroll
          for (int r = 0; r < 8; r++) {
            if ((ABL_BR >> br) & 1) {
            macc[i][jh][2 * r] += bf_lo(gp[i][jh][r]) * ah[i][2 * r];
            macc[i][jh][2 * r + 1] += bf_hi(gp[i][jh][r]) * ah[i][2 * r + 1];
            }
          }
      }
    }
    u16* mp = p.m + (long)row0 * 1024 + ct * 128;
    const int tid = TIDX, lane = tid & 63, w = tid >> 6, wr = w >> 1, wc = w & 1;
    const int tb = (wr * 64 + 4 * (lane >> 5)) * 1024 + wc * 64 + (lane & 31);
#pragma unroll
    for (int i = 0; i < 2; i++)
#pragma unroll
      for (int j = 0; j < 2; j++)
#pragma unroll
        for (int r = 0; r < 16; r++)
          mp[tb + (i * 32 + (r & 3) + 8 * (r >> 2)) * 1024 + j * 32] = tobf(macc[i][j][r]);
  }
}

__device__ __forceinline__ void phase_s8(const Params& p, int L, char* smem, bool dry = false) {
  const int lane = TIDX & 63, w = TIDX >> 6, wr = w >> 1, wc = w & 1;
  const int nrt = (L == 0) ? 272 : 256;
  FOR_UNITS_XCD(nrt, 8, rt, ct)
    const long row0 = (long)rt * 128;
    f32x16 acc[2][2];
    ZERO_ACC(acc);
    gemm128(p.m + row0 * 1024, 1024, p.WoutT + (long)L * WOUT_SZ + (long)ct * 128 * 1024, 1024, 1024, acc, smem);
    const int mr = row_mod((int)row0);
    const float* gt = p.mods + (long)(L * 9 + mr) * 6144 + 2048 + ct * 128;
    const float* src; float* dst;
    if (row0 < TLAT) { src = (L == 0 ? p.x : p.out) + row0 * 1024; dst = p.out + row0 * 1024; }
    else { src = (L == 0 ? p.ctx : p.ctx1) + (row0 - TLAT) * 1024; dst = p.ctx1 + (row0 - TLAT) * 1024; }
    src += ct * 128; dst += ct * 128;
    const int tb = opaque((wr * 64 + 4 * (lane >> 5)) * 1024 + wc * 64 + (lane & 31));
#pragma unroll
    for (int j = 0; j < 2; j++) {
      const float gv = gt[ACC_COL(wc, j, lane)];
#pragma unroll
      for (int i = 0; i < 2; i++)
#pragma unroll
        for (int r = 0; r < 16; r++) {
          const int o = tb + (i * 32 + (r & 3) + 8 * (r >> 2)) * 1024 + j * 32;
          const float nv = src[o] + gv * acc[i][j][r];
          if (!dry) dst[o] = nv;
        }
    }
  }
}

#define CE_DESC(a, b) { const float _x = fmaxf(a, b); const float _y = fminf(a, b); a = _x; b = _y; }
template <int N>
__device__ __forceinline__ void bitonic_sort_desc(float (&v)[N]) {
#pragma unroll
  for (int k = 2; k <= N; k <<= 1)
#pragma unroll
    for (int j = k >> 1; j > 0; j >>= 1)
#pragma unroll
      for (int i = 0; i < N; i++) {
        const int l = i ^ j;
        if (l > i) {
          if ((i & k) == 0) { CE_DESC(v[i], v[l]); } else { CE_DESC(v[l], v[i]); }
        }
      }
}
template <int N>
__device__ __forceinline__ void bitonic_merge_desc(float (&v)[N]) {
#pragma unroll
  for (int j = N >> 1; j > 0; j >>= 1)
#pragma unroll
    for (int i = 0; i < N; i++) {
      const int l = i ^ j;
      if (l > i) { CE_DESC(v[i], v[l]); }
    }
}
__device__ __forceinline__ void merge_top16(float (&a)[16], const float (&b)[16]) {
#pragma unroll
  for (int i = 0; i < 16; i++) a[i] = fmaxf(a[i], b[15 - i]);
  bitonic_merge_desc<16>(a);
}
__device__ __forceinline__ void top16_of_tiles(const f32x16 (&s)[4], int hh, float (&res)[16]) {
  float g[4][16];
#pragma unroll
  for (int t = 0; t < 4; t++) {
#pragma unroll
    for (int r = 0; r < 16; r++) {
      const unsigned key = (unsigned)(32 * t + (r & 3) + 8 * (r >> 2)) + (unsigned)(4 * hh);
      g[t][r] = __uint_as_float((__float_as_uint(s[t][r]) & 0xffffff80u) | key);
    }
    bitonic_sort_desc<16>(g[t]);
  }
  merge_top16(g[0], g[1]);
  merge_top16(g[2], g[3]);
  merge_top16(g[0], g[2]);
  float o[16];
#pragma unroll
  for (int i = 0; i < 16; i++) o[i] = __shfl_xor(g[0][i], 32);
  merge_top16(g[0], o);
#pragma unroll
  for (int i = 0; i < 16; i++) res[i] = g[0][i];
}

__device__ __forceinline__ void unit_peer_query(const Params& p, int L, int rt, int h, char* smem) {
  const int tid = TIDX, lane = tid & 63, w = tid >> 6, wr = w >> 1, wc = w & 1, hh = lane >> 5, c = lane & 31;
  const long row0 = (long)rt * 128;
  u16* Qs = (u16*)smem;
  u16* Ss = (u16*)(smem + 128 * 136 * 2);
  {
    f32x16 acc[2][2];
    ZERO_ACC(acc);
    gemm128(p.hx + row0 * 1024, 1024, p.WqT + (long)L * WQ_SZ + (long)h * 128 * 1024, 1024, 1024, acc, smem);
#pragma unroll
    for (int i = 0; i < 2; i++)
#pragma unroll
      for (int j = 0; j < 2; j++)
#pragma unroll
        for (int r = 0; r < 16; r++) Qs[ACC_ROW(wr, i, r, lane) * 136 + ACC_COL(wc, j, lane)] = tobf(acc[i][j][r]);
    const u16* sk = p.SubK + (long)L * SUBK_SZ + (long)h * 2 * 128 * 64;
#pragma unroll
    for (int i = 0; i < 8; i++) {
      const int idx = tid + 256 * i, rw = idx >> 3, ch = idx & 7;
      *(uint4*)(Ss + rw * LDT + ch * 8) = ldg16(sk + rw * 64 + ch * 8);
    }
  }
  __syncthreads();
  float top[2][16];
#pragma unroll
  for (int pp = 0; pp < 2; pp++) {
    f32x16 s[4];
#pragma unroll
    for (int t = 0; t < 4; t++)
#pragma unroll
      for (int r = 0; r < 16; r++) s[t][r] = 0.f;
#pragma unroll
    for (int kk = 0; kk < 4; kk++) {
      uint4 bq = *(const uint4*)(Qs + (32 * w + c) * 136 + pp * 64 + kk * 16 + hh * 8);
#pragma unroll
      for (int t = 0; t < 4; t++) {
        uint4 ak = *(const uint4*)(Ss + (pp * 128 + 32 * t + c) * LDT + kk * 16 + hh * 8);
        s[t] = mfma32(ak, bq, s[t]);
      }
    }
    top16_of_tiles(s, hh, top[pp]);
  }
  float cand[64];
#define CAND(q, a, b) cand[q] = __uint_as_float((__float_as_uint(top[0][a] + top[1][b]) & 0xffffff00u) | (unsigned)((a) * 16 + (b)));
  CAND(0, 0, 0)
  CAND(1, 0, 1)
  CAND(2, 0, 2)
  CAND(3, 0, 3)
  CAND(4, 0, 4)
  CAND(5, 0, 5)
  CAND(6, 0, 6)
  CAND(7, 0, 7)
  CAND(8, 0, 8)
  CAND(9, 0, 9)
  CAND(10, 0, 10)
  CAND(11, 0, 11)
  CAND(12, 0, 12)
  CAND(13, 0, 13)
  CAND(14, 0, 14)
  CAND(15, 0, 15)
  CAND(16, 1, 0)
  CAND(17, 1, 1)
  CAND(18, 1, 2)
  CAND(19, 1, 3)
  CAND(20, 1, 4)
  CAND(21, 1, 5)
  CAND(22, 1, 6)
  CAND(23, 1, 7)
  CAND(24, 2, 0)
  CAND(25, 2, 1)
  CAND(26, 2, 2)
  CAND(27, 2, 3)
  CAND(28, 2, 4)
  CAND(29, 3, 0)
  CAND(30, 3, 1)
  CAND(31, 3, 2)
  CAND(32, 3, 3)
  CAND(33, 4, 0)
  CAND(34, 4, 1)
  CAND(35, 4, 2)
  CAND(36, 5, 0)
  CAND(37, 5, 1)
  CAND(38, 6, 0)
  CAND(39, 6, 1)
  CAND(40, 7, 0)
  CAND(41, 7, 1)
  CAND(42, 8, 0)
  CAND(43, 9, 0)
  CAND(44, 10, 0)
  CAND(45, 11, 0)
  CAND(46, 12, 0)
  CAND(47, 13, 0)
  CAND(48, 14, 0)
  CAND(49, 15, 0)
#undef CAND
#pragma unroll
  for (int q = 50; q < 64; q++) cand[q] = -3.0e38f;
  float best[16];
  {
    float g[4][16];
#pragma unroll
    for (int t = 0; t < 4; t++) {
#pragma unroll
      for (int r = 0; r < 16; r++) g[t][r] = cand[t * 16 + r];
      bitonic_sort_desc<16>(g[t]);
    }
    merge_top16(g[0], g[1]);
    merge_top16(g[2], g[3]);
    merge_top16(g[0], g[2]);
#pragma unroll
    for (int i = 0; i < 16; i++) best[i] = g[0][i];
  }
  float e[16], es = 0.f;
#pragma unroll
  for (int i = 0; i < 16; i++) { e[i] = __expf(best[i] - best[0]); es += e[i]; }
  const float einv = 1.0f / es;
  __syncthreads();
  int* Ix = (int*)smem + w * 32 * 33;
  if (hh == 0) {
#pragma unroll
    for (int i = 0; i < 16; i++) {
      Ix[c * 33 + i] = (int)(__float_as_uint(top[0][i]) & 127u);
      Ix[c * 33 + 16 + i] = (int)(__float_as_uint(top[1][i]) & 127u);
    }
  }
  __syncthreads();
  const long orow = row0 + 32 * w + c;
  int* ed = p.eid + orow * 128 + h * 16 + hh * 8;
  float* gd = p.gate + orow * 128 + h * 16 + hh * 8;
  int ev[8]; float gv[8];
#pragma unroll
  for (int i = 0; i < 8; i++) {
    const unsigned hm = 0u - (unsigned)hh;
    const unsigned bselu = (__float_as_uint(best[8 + i]) & hm) | (__float_as_uint(best[i]) & ~hm);
    const float esel = __uint_as_float((__float_as_uint(e[8 + i]) & hm) | (__float_as_uint(e[i]) & ~hm));
    const unsigned id = bselu & 255u;
    const int ia = Ix[c * 33 + (id >> 4)], ib = Ix[c * 33 + 16 + (id & 15)];
    ev[i] = ia * 128 + ib;
    gv[i] = esel * einv;
  }
  *(int4*)(ed) = make_int4(ev[0], ev[1], ev[2], ev[3]);
  *(int4*)(ed + 4) = make_int4(ev[4], ev[5], ev[6], ev[7]);
  *(float4*)(gd) = make_float4(gv[0], gv[1], gv[2], gv[3]);
  *(float4*)(gd + 4) = make_float4(gv[4], gv[5], gv[6], gv[7]);
}

__device__ __forceinline__ void phase_s10(const Params& p, int L, char* smem) {
  const int nrt = (L == 0) ? 272 : 256;
  FOR_UNITS_XCD(nrt, 8, rt, hd) unit_peer_query(p, L, rt, hd, smem); }
}

#define CVT8(w, lo2, hi2) { lo2 = __builtin_amdgcn_cvt_pk_f32_fp8((int)(w), false); hi2 = __builtin_amdgcn_cvt_pk_f32_fp8((int)(w), true); }
#if CHECK_ATTN
#define NB11 1
#else
#define NB11 2
#endif
__device__ __forceinline__ void phase_s11a(const Params& p, int L) {
  const int lane = TIDX & 63, j = lane >> 3, cch = lane & 7;
  const int sl = blockIdx.x & 7;
  const int lw = (blockIdx.x >> 3) * 4 + (TIDX >> 6), nlw = (gridDim.x >> 3) * 4;
  const int nrows = (L == 0) ? RTOT : TLAT;
  const unsigned char* Us = p.UT8 + (long)sl * NEXP * 128 + cch * 16;
  for (int r0 = lw; r0 < nrows; r0 += NB11 * nlw) {
    int rr[NB11]; bool ok[NB11];
    uint4 ha[NB11], hb[NB11]; int e_lo[NB11], e_hi[NB11];
#pragma unroll
    for (int u = 0; u < NB11; u++) {
      const int r = r0 + u * nlw;
      ok[u] = r < nrows; rr[u] = ok[u] ? r : r0;
      ha[u] = ldg16(p.hx + (long)rr[u] * 1024 + sl * 128 + cch * 16);
      hb[u] = ldg16(p.hx + (long)rr[u] * 1024 + sl * 128 + cch * 16 + 8);
      e_lo[u] = p.eid[(long)rr[u] * 128 + lane]; e_hi[u] = p.eid[(long)rr[u] * 128 + 64 + lane];
    }
    uint4 uu[NB11][16];
#pragma unroll
    for (int u = 0; u < NB11; u++)
#pragma unroll
      for (int i = 0; i < 16; i++) {
        const int e = __shfl(i < 8 ? e_lo[u] : e_hi[u], 8 * (i & 7) + j);
        uu[u][i] = ldg16(Us + (long)e * 128);
      }
    __builtin_amdgcn_sched_barrier(0);
#pragma unroll
    for (int u = 0; u < NB11; u++) {
      f32x2 h2[8];
      h2[0] = f32x2{bf_lo(ha[u].x), bf_hi(ha[u].x)}; h2[1] = f32x2{bf_lo(ha[u].y), bf_hi(ha[u].y)};
      h2[2] = f32x2{bf_lo(ha[u].z), bf_hi(ha[u].z)}; h2[3] = f32x2{bf_lo(ha[u].w), bf_hi(ha[u].w)};
      h2[4] = f32x2{bf_lo(hb[u].x), bf_hi(hb[u].x)}; h2[5] = f32x2{bf_lo(hb[u].y), bf_hi(hb[u].y)};
      h2[6] = f32x2{bf_lo(hb[u].z), bf_hi(hb[u].z)}; h2[7] = f32x2{bf_lo(hb[u].w), bf_hi(hb[u].w)};
      float d[16];
#pragma unroll
      for (int i = 0; i < 16; i++) {
        f32x2 a0, a1, acc = {0.f, 0.f};
        CVT8(uu[u][i].x, a0, a1); acc += a0 * h2[0]; acc += a1 * h2[1];
        CVT8(uu[u][i].y, a0, a1); acc += a0 * h2[2]; acc += a1 * h2[3];
        CVT8(uu[u][i].z, a0, a1); acc += a0 * h2[4]; acc += a1 * h2[5];
        CVT8(uu[u][i].w, a0, a1); acc += a0 * h2[6]; acc += a1 * h2[7];
        d[i] = acc.x + acc.y;
      }
      float t8[8], t4[4], t2[2];
      { const bool up = (lane & 4) != 0;
#pragma unroll
        for (int k = 0; k < 8; k++) { const float send = up ? d[k] : d[k + 8], keep = up ? d[k + 8] : d[k]; t8[k] = keep + __shfl_xor(send, 4); } }
      { const bool up = (lane & 2) != 0;
#pragma unroll
        for (int k = 0; k < 4; k++) { const float send = up ? t8[k] : t8[k + 4], keep = up ? t8[k + 4] : t8[k]; t4[k] = keep + __shfl_xor(send, 2); } }
      { const bool up = (lane & 1) != 0;
#pragma unroll
        for (int k = 0; k < 2; k++) { const float send = up ? t4[k] : t4[k + 2], keep = up ? t4[k + 2] : t4[k]; t2[k] = keep + __shfl_xor(send, 1); } }
      if (ok[u]) p.PD[((long)sl * RTOT + rr[u]) * 64 + cch * 8 + j] = pack2(t2[0], t2[1]);
    }
  }
}
__device__ __forceinline__ void phase_s11b(const Params& p, int L, bool dry = false) {
  const int lane = TIDX & 63, j = lane >> 3, cch = lane & 7;
  const int sl = blockIdx.x & 7;
  const int lw = (blockIdx.x >> 3) * 4 + (TIDX >> 6), nlw = (gridDim.x >> 3) * 4;
  const int nrows = (L == 0) ? RTOT : TLAT;
  const unsigned char* Vs = p.VT8 + (long)sl * NEXP * 128 + cch * 16;
  const int P0 = 16 * (lane >> 3) + (lane & 7);
  const int col = sl * 128 + cch * 16 + 2 * j;
  for (int r0 = lw; r0 < nrows; r0 += NB11 * nlw) {
    int rr[NB11]; bool ok[NB11];
    unsigned pw[NB11][8]; float g0[NB11], g1[NB11]; int e_lo[NB11], e_hi[NB11];
#pragma unroll
    for (int u = 0; u < NB11; u++) {
      const int r = r0 + u * nlw;
      ok[u] = r < nrows; rr[u] = ok[u] ? r : r0;
#pragma unroll
      for (int s2 = 0; s2 < 8; s2++) pw[u][s2] = p.PD[((long)s2 * RTOT + rr[u]) * 64 + lane];
      g0[u] = p.gate[(long)rr[u] * 128 + P0]; g1[u] = p.gate[(long)rr[u] * 128 + P0 + 8];
      e_lo[u] = p.eid[(long)rr[u] * 128 + lane]; e_hi[u] = p.eid[(long)rr[u] * 128 + 64 + lane];
    }
    uint4 vv[NB11][16];
#pragma unroll
    for (int u = 0; u < NB11; u++)
#pragma unroll
      for (int i = 0; i < 16; i++) {
        const int e = __shfl(i < 8 ? e_lo[u] : e_hi[u], 8 * (i & 7) + j);
        vv[u][i] = ldg16(Vs + (long)e * 128);
      }
    __builtin_amdgcn_sched_barrier(0);
#pragma unroll
    for (int u = 0; u < NB11; u++) {
      float d0 = 0.f, d1 = 0.f;
#pragma unroll
      for (int s2 = 0; s2 < 8; s2++) { d0 += bf_lo(pw[u][s2]); d1 += bf_hi(pw[u][s2]); }
      const float act0 = gelu_tanh(d0 * (1.0f / U8_SCALE)) * g0[u] * (1.0f / V8_SCALE);
      const float act1 = gelu_tanh(d1 * (1.0f / U8_SCALE)) * g1[u] * (1.0f / V8_SCALE);
      f32x2 o2[8];
#pragma unroll
      for (int q = 0; q < 8; q++) o2[q] = f32x2{0.f, 0.f};
#pragma unroll
      for (int i = 0; i < 16; i++) {
        const float a = __shfl((i & 1) ? act1 : act0, (i >> 1) * 8 + j);
        const f32x2 aa = {a, a};
        f32x2 a0, a1;
        CVT8(vv[u][i].x, a0, a1); o2[0] += aa * a0; o2[1] += aa * a1;
        CVT8(vv[u][i].y, a0, a1); o2[2] += aa * a0; o2[3] += aa * a1;
        CVT8(vv[u][i].z, a0, a1); o2[4] += aa * a0; o2[5] += aa * a1;
        CVT8(vv[u][i].w, a0, a1); o2[6] += aa * a0; o2[7] += aa * a1;
      }
      float o[16];
#pragma unroll
      for (int q = 0; q < 8; q++) { o[2 * q] = o2[q].x; o[2 * q + 1] = o2[q].y; }
      float t8[8], t4[4], t2[2];
      { const bool up = (lane & 32) != 0;
#pragma unroll
        for (int k = 0; k < 8; k++) { const float send = up ? o[k] : o[k + 8], keep = up ? o[k + 8] : o[k]; t8[k] = keep + __shfl_xor(send, 32); } }
      { const bool up = (lane & 16) != 0;
#pragma unroll
        for (int k = 0; k < 4; k++) { const float send = up ? t8[k] : t8[k + 4], keep = up ? t8[k + 4] : t8[k]; t4[k] = keep + __shfl_xor(send, 16); } }
      { const bool up = (lane & 8) != 0;
#pragma unroll
        for (int k = 0; k < 2; k++) { const float send = up ? t4[k] : t4[k + 2], keep = up ? t4[k + 2] : t4[k]; t2[k] = keep + __shfl_xor(send, 8); } }
      if (!ABL_PEER || !ok[u]) continue;
      const int r = rr[u];
      float* xr = ((r < TLAT) ? p.out + (long)r * 1024 : p.ctx1 + (long)(r - TLAT) * 1024) + col;
      const float2 gt = *(const float2*)(p.mods + (long)(L * 9 + row_mod(r)) * 6144 + 5120 + col);
      float2 xv = *(const float2*)xr;
      xv.x += gt.x * t2[0]; xv.y += gt.y * t2[1];
      if (!dry) *(float2*)xr = xv;
    }
  }
}


#if CHECK_ATTN
__device__ __forceinline__ float blk_sum(float v, float* red) {
  v = wave_sum(v);
  __syncthreads();
  if ((TIDX & 63) == 0) red[TIDX >> 6] = v;
  __syncthreads();
  return red[0] + red[1] + red[2] + red[3];
}
__device__ __forceinline__ float blk_max(float v, float* red) {
#pragma unroll
  for (int o = 32; o > 0; o >>= 1) v = fmaxf(v, __shfl_xor(v, o));
  __syncthreads();
  if ((TIDX & 63) == 0) red[TIDX >> 6] = v;
  __syncthreads();
  return fmaxf(fmaxf(red[0], red[1]), fmaxf(red[2], red[3]));
}
__device__ __forceinline__ bool far(float got, float ref, float rel, float ab) { return !(fabsf(got - ref) <= rel * fabsf(ref) + ab); }
__device__ __forceinline__ void rope_ref(const float* z, float* o, int s) {
  for (int c = 0; c < 32; c++) {
    const int pos = (c < 16) ? (s / 64) : (s % 64);
    const float inv = powf(10000.0f, -(float)(2 * (c % 8)) / 16.0f);
    const float ang = (float)pos * inv;
    const int cb = c & 16, cc = c & 15;
    const float rot = (cc < 8) ? -z[cb + cc + 8] : z[cb + cc - 8];
    o[c] = z[c] * cosf(ang) + rot * sinf(ang);
  }
}
__device__ __forceinline__ void check_proj(const Params& p, int L, int r, char* smem) {
  float* hrow = (float*)smem;
  float* z = hrow + 1024;
  float* kvr = z + 416;
  float* red = kvr + 1024;
  float* kk = red + 8;
  const int tid = TIDX;
  __syncthreads();
  for (int k = tid; k < 1024; k += 256) hrow[k] = bf1(p.hx[(long)r * 1024 + k]);
  __syncthreads();
  for (int n = tid; n < 416; n += 256) {
    float a = 0.f;
    for (int k = 0; k < 1024; k++) a += hrow[k] * p.w_in[((long)L * 1024 + k) * 4256 + n];
    z[n] = a;
  }
  __syncthreads();
  unsigned bad = 0;
  if (L == 0 || r < TLAT)
  for (int n = tid; n < 256; n += 256) if (far(bf1(p.cq[(long)r * 256 + n]), z[160 + n], 0.02f, 0.03f)) bad |= 1u;
  for (int n = tid; n < 32; n += 256) if (far(p.kr[(long)r * 32 + n], z[128 + n], 0.02f, 0.03f)) bad |= 1u;
  const float ssc = blk_sum(tid < 128 ? z[tid] * z[tid] : 0.f, red);
  const float rc = rsqrtf(ssc / 128.0f + EPSV);
  for (int n = tid; n < 1024; n += 256) {
    float a = 0.f;
    for (int k = 0; k < 128; k++) a += z[k] * rc * p.g_ckv[L * 128 + k] * p.w_ukv[((long)L * 128 + k) * 1024 + n];
    kvr[n] = a;
  }
  __syncthreads();
  const bool lat = r < TLAT;
  const int b = lat ? (r >> 12) : ((r - TLAT) >> 8), s = lat ? (r & 4095) : ((r - TLAT) & 255), kpos = lat ? CTXL + s : s;
  for (int h = 0; h < 8; h++) {
    float sq = 0.f;
    if (tid < 64) sq = kvr[h * 128 + tid] * kvr[h * 128 + tid]; else if (tid < 96) sq = z[128 + tid - 64] * z[128 + tid - 64];
    const float ssk = blk_sum(sq, red);
    const float rk = rsqrtf(ssk / 96.0f + EPSV);
    if (tid == 0) {
      float* zr = kk + 96; float* zo = zr + 32;
      for (int c = 0; c < 32; c++) zr[c] = z[128 + c] * rk * p.g_kn[L * 96 + 64 + c];
      if (lat) rope_ref(zr, zo, s); else for (int c = 0; c < 32; c++) zo[c] = zr[c];
      for (int c = 0; c < 32; c++) kk[64 + c] = zo[c];
    }
    if (tid < 64) kk[tid] = kvr[h * 128 + tid] * rk * p.g_kn[L * 96 + tid];
    __syncthreads();
    if (tid < 96 && far(bf1(p.Kb[((long)(b * 8 + h) * SKEYS + kpos) * 96 + tid]), kk[tid], 0.03f, 0.03f)) bad |= 2u;
    if (tid < 64 && far(bf1(p.Vtb[((long)(b * 8 + h) * 64 + tid) * SKEYS + kpos]), kvr[h * 128 + 64 + tid], 0.03f, 0.03f)) bad |= 4u;
    __syncthreads();
  }
  if (bad & CHECK_MASK) atomicOr(&p.bar[0], bad & CHECK_MASK);
}
__device__ __forceinline__ void check_attn(const Params& p, int L, int r, int h, char* smem) {
  float* cqr = (float*)smem;
  float* q = cqr + 256;
  float* sc = q + 96;
  float* red = sc + 4352;
  const int tid = TIDX;
  const bool lat = r < TLAT;
  const int b = lat ? (r >> 12) : ((r - TLAT) >> 8), s = lat ? (r & 4095) : ((r - TLAT) & 255);
  const int nkeys = lat ? SKEYS : CTXL;
  __syncthreads();
  cqr[tid] = bf1(p.cq[(long)r * 256 + tid]);
  __syncthreads();
  const float rc = rsqrtf(blk_sum(cqr[tid] * cqr[tid], red) / 256.0f + EPSV);
  float qr = 0.f;
  if (tid < 96) for (int k = 0; k < 256; k++) qr += cqr[k] * rc * p.g_cq[L * 256 + k] * p.w_uq[((long)L * 256 + k) * 768 + h * 96 + tid];
  const float rq = rsqrtf(blk_sum(tid < 96 ? qr * qr : 0.f, red) / 96.0f + EPSV);
  if (tid < 96) q[tid] = qr * rq * p.g_qn[L * 96 + tid];
  __syncthreads();
  if (tid == 0 && lat) {
    float* zr = red + 8; float* zo = zr + 32;
    for (int c = 0; c < 32; c++) zr[c] = q[64 + c];
    rope_ref(zr, zo, s);
    for (int c = 0; c < 32; c++) q[64 + c] = zo[c];
  }
  __syncthreads();
  float mx = -1e30f;
  for (int key = tid; key < nkeys; key += 256) {
    float a = 0.f;
    for (int d = 0; d < 96; d++) a += q[d] * bf1(p.Kb[((long)(b * 8 + h) * SKEYS + key) * 96 + d]);
    a *= 0.10206207261596577f;
    sc[key] = a; mx = fmaxf(mx, a);
  }
  mx = blk_max(mx, red);
  float ps = 0.f;
  for (int key = tid; key < nkeys; key += 256) { const float e = expf(sc[key] - mx); sc[key] = e; ps += e; }
  const float tot = blk_sum(ps, red);
  unsigned bad = 0;
  if (tid < 64) {
    float a = 0.f;
    for (int key = 0; key < nkeys; key++) a += sc[key] * bf1(p.Vtb[((long)(b * 8 + h) * 64 + tid) * SKEYS + key]);
    a /= tot;
    if (far(bf1(p.Ob[(long)r * 512 + h * 64 + tid]), a, 0.04f, 1.5e-3f)) bad |= 8u;
  }
  if (bad & CHECK_MASK) atomicOr(&p.bar[0], bad & CHECK_MASK);
}
__device__ __forceinline__ void phase_check(const Params& p, int L, char* smem) {
  const int nq = (L == 0) ? 12 : 8;
  for (int u = blockIdx.x; u < 12 + nq * 8; u += gridDim.x) {
    const int si = (u < 12) ? u : ((u - 12) >> 3);
    int r;
    switch (si) {
      case 0: r = 0; break; case 1: r = 63; break; case 2: r = 64; break; case 3: r = 4095; break;
      case 4: r = 4096 + 777; break; case 5: r = 12345; break; case 6: r = 20000; break; case 7: r = 32767; break;
      case 8: r = TLAT; break; case 9: r = TLAT + 255; break; case 10: r = TLAT + 256 + 100; break; default: r = TLAT + 2047; break;
    }
    if (u < 12) check_proj(p, L, r, smem);
    else check_attn(p, L, r, (u - 12) & 7, smem);
  }
}
#endif

#define XB_TMO      128
#define XB_XCNT(j)  (256  + 64 * (j))
#define XB_XSUB(j)  (1280 + 64 * (j))
#define XB_XGEN(j)  (2304 + 64 * (j))
#define XB_TOP      3328
#define XB_TOPGEN   3392
#define XCD_BAR_WORDS 3456
#define XB_SPIN_CAP (1u << 22)
#define LAS __attribute__((address_space(3)))
__device__ __forceinline__ unsigned xb_ld(unsigned* p)              { return __hip_atomic_load(p, __ATOMIC_RELAXED, __HIP_MEMORY_SCOPE_AGENT); }
__device__ __forceinline__ unsigned xb_add(unsigned* p, unsigned v) { return __hip_atomic_fetch_add(p, v, __ATOMIC_RELAXED, __HIP_MEMORY_SCOPE_AGENT); }
__device__ __forceinline__ unsigned xb_xcc_id() { return (unsigned)__builtin_amdgcn_s_getreg((3 << 11) | 20) & 0xFu; }
#define XB_SPIN(cond, bar) do { unsigned _sp = 0; while (cond) { __builtin_amdgcn_s_sleep(1); \
    if ((++_sp & 255u) == 0u) { if (xb_ld(&(bar)[XB_TMO])) break; if (_sp > XB_SPIN_CAP) { atomicAdd(&(bar)[XB_TMO], 1u); break; } } } } while (0)
struct XcdBarrier { unsigned* bar; unsigned x; volatile LAS unsigned* st; };
__device__ __forceinline__ XcdBarrier xcd_barrier_post(unsigned* bar, volatile LAS unsigned* st) {
  XcdBarrier b; b.bar = bar; b.x = xb_xcc_id(); b.st = st;
  if (threadIdx.x == 0) (void)xb_add(&bar[XB_XCNT(b.x)], 1u);
  return b;
}
__device__ __forceinline__ void xcd_barrier_complete(unsigned* bar, unsigned x, unsigned& nloc, unsigned& nx) {
  const unsigned G = gridDim.x * gridDim.y * gridDim.z;
  unsigned sum, cnt, mine, sp = 0u;
  for (;;) {
    sum = 0u; cnt = 0u; mine = 0u;
#pragma unroll
    for (unsigned j = 0; j < 16; ++j) { const unsigned c = xb_ld(&bar[XB_XCNT(j)]); sum += c; cnt += (c > 0u) ? 1u : 0u; mine = (j == x) ? c : mine; }
    if (sum == G) break;
    __builtin_amdgcn_s_sleep(1);
    if ((++sp & 255u) == 0u) { if (xb_ld(&bar[XB_TMO])) break; if (sp > XB_SPIN_CAP) { atomicAdd(&bar[XB_TMO], 1u); break; } }
  }
  nloc = mine > 0u ? mine : 1u; nx = cnt > 0u ? cnt : 1u;
}
__device__ __forceinline__ void xcd_barrier(const XcdBarrier& b) {
  asm volatile("s_waitcnt vmcnt(0)" ::: "memory");
  __syncthreads();
  if (threadIdx.x == 0) {
    unsigned* bar = b.bar;
    asm volatile("" : "+s"(bar));
    __builtin_amdgcn_s_waitcnt(0);
    unsigned nloc = b.st[0], nx = b.st[1];
    if (nloc == 0u) { xcd_barrier_complete(bar, b.x, nloc, nx); b.st[0] = nloc; b.st[1] = nx; }
    const unsigned old = xb_add(&bar[XB_XSUB(b.x)], 1u);
    const unsigned gen = old / nloc;
    if (old + 1u == (gen + 1u) * nloc) {
      __builtin_amdgcn_fence(__ATOMIC_RELEASE, "agent");
      asm volatile("s_waitcnt vmcnt(0)" ::: "memory");
      const unsigned og = xb_add(&bar[XB_TOP], 1u);
      const unsigned tg = og / nx;
      if (og + 1u == (tg + 1u) * nx) xb_add(&bar[XB_TOPGEN], 1u);
      else XB_SPIN(xb_ld(&bar[XB_TOPGEN]) == tg, bar);
      __builtin_amdgcn_fence(__ATOMIC_ACQUIRE, "agent");
      xb_add(&bar[XB_XGEN(b.x)], 1u);
      asm volatile("s_waitcnt vmcnt(0)" ::: "memory");
    } else {
      XB_SPIN(xb_ld(&bar[XB_XGEN(b.x)]) == gen, bar);
      __builtin_amdgcn_fence(__ATOMIC_ACQUIRE, "agent");
      asm volatile("s_waitcnt vmcnt(0)" ::: "memory");
    }
  }
  __syncthreads();
}

#define NPHASE (23 + CHECK_ATTN)
#ifndef PH_LIMIT
#define PH_LIMIT NPHASE
#endif
__device__ __forceinline__ void run_phase(const Params& p, int ph, char* smem, bool dry = false) {
  if (ph == 0) { phase_prep(p, smem); return; }
#if CHECK_ATTN
  if (ph == 23) {
    if (blockIdx.x == 0 && threadIdx.x == 0 && __hip_atomic_load(&p.bar[0], __ATOMIC_RELAXED, __HIP_MEMORY_SCOPE_AGENT) != 0u) p.out[0] = __uint_as_float(0x7fc00000u);
    return;
  }
#endif
  const int L = (ph - 1) / 11, s = (ph - 1) % 11;
  if (s == 0 || s == 7) {
    phase_norm(p, L, s == 0 ? 0 : 1, (s == 0 || L == 0) ? RTOT : TLAT);
    if (s == 0) phase_tables(p, L);
    return;
  }
  switch (s) {
    case 1: phase_s2(p, L, smem); break;
    case 2: phase_s3(p, L, smem); break;
    case 3: phase_s4(p, L, smem); break;
    case 4: phase_dftC(p, smem);
#if CHECK_ATTN
      phase_check(p, L, smem);
#endif
      break;
    case 5: phase_s7(p, L, smem); break;
    case 6: phase_s8(p, L, smem, dry); break;
    case 8: phase_s10(p, L, smem); break;
    case 9: phase_s11a(p, L); break;
    case 10: phase_s11b(p, L, dry); break;
  }
}

__global__ void __launch_bounds__(256, 2) mega(Params p, int ph0, int ph1) {
  __shared__ __attribute__((aligned(16))) char smem[SMEM_BYTES];
  __shared__ uint4 xb_words;
  cg::grid_group grid = cg::this_grid();
  const bool multi = (ph1 - ph0) > 1;
  XcdBarrier xb;
  if (multi) {
    if (threadIdx.x == 0) xb_words = make_uint4(0u, 0u, 0u, 0u);
    __syncthreads();
    xb = xcd_barrier_post(p.bar, (volatile LAS unsigned*)&xb_words);
  }
  for (int ph = ph0; ph < ph1; ph++) {
    if (ph > ph0) {
      if (ph == ph0 + 1) grid.sync();
      else xcd_barrier(xb);
    }
#if PROBE_S >= 0
    {
      const int kind = (ph == 0) ? 11 : (ph - 1) % 11;
      const int reps = (kind == PROBE_S) ? PROBE_REPS * p.one : 0;
      for (int rep = 0; rep <= reps; rep++) {
        if (rep > 0) xcd_barrier(xb);
        const bool dry = (rep < reps);
        if (kind == PROBE_S) {
          if (kind == 6 || kind == 10) run_phase(p, ph, smem, dry); else run_phase(p, ph, smem, false);
        } else run_phase(p, ph, smem, false);
      }
    }
#else
    run_phase(p, ph, smem);
#endif
  }
}

static inline size_t al256(size_t x) { return (x + 255) & ~(size_t)255; }
extern "C" void kernel_launch(void* const* d_in, const int* in_sizes, int n_in, void* d_out, int out_size, void* d_ws,
                              size_t ws_size, hipStream_t stream) {
  Params p{};
  const float* const* in = (const float* const*)d_in;
  p.x = in[0]; p.c = in[1]; p.ctx = in[2]; p.c_ctx = in[3]; p.w_mod = in[4]; p.b_mod = in[5]; p.g_norm1 = in[6];
  p.w_in = in[7]; p.g_ckv = in[8]; p.w_ukv = in[9]; p.g_cq = in[10]; p.w_uq = in[11]; p.g_qn = in[12]; p.g_kn = in[13];
  p.w_dw = in[14]; p.b_dw = in[15]; p.g_cln = in[16]; p.b_cln = in[17]; p.wb_attn = in[18]; p.wb_fnet = in[19];
  p.wb_conv = in[20]; p.w_out = in[21]; p.g_norm2 = in[22]; p.w_query = in[23]; p.sub_keys = in[24]; p.u_tab = in[25];
  p.v_tab = in[26];
  p.out = (float*)d_out;
  p.one = 1; p.pad_ = 0;
  char* ws = (char*)d_ws;
  size_t off = 0;
  auto take = [&](size_t bytes) { char* q = ws + off; off += al256(bytes); return q; };
  p.bar = (unsigned*)take(XCD_BAR_WORDS * 4);
  const size_t mods_bytes = 2 * 9 * 6144 * 4;
  p.mods = (float*)take(mods_bytes);
  p.ropetab = (float*)take(64 * 8 * 2 * 4);
  p.W2T = (u16*)take(2ull * W2T_SZ * 2);
  p.WgT = (u16*)take(2ull * WGT_SZ * 2);
  p.WukvT = (u16*)take(2ull * WUKV_SZ * 2);
  p.WuqT = (u16*)take(2ull * WUQ_SZ * 2);
  p.WbaT = (u16*)take(2ull * WBA_SZ * 2);
  p.WbfT = (u16*)take(2ull * WBF_SZ * 2);
  p.WbcT = (u16*)take(2ull * WBC_SZ * 2);
  p.WoutT = (u16*)take(2ull * WOUT_SZ * 2);
  p.WqT = (u16*)take(2ull * WQ_SZ * 2);
  p.SubK = (u16*)take(2ull * SUBK_SZ * 2);
  p.WA = (u16*)take(128 * 128 * 2);
  p.WC = (u16*)take(128 * 128 * 2);
  p.tw = (float*)take(4096 * 2 * 4);
  p.GB = (u16*)take((size_t)NB * 256 * 8192 * 2);
  p.Dctx = (u16*)take(256ull * 512 * 2);
  p.Wcs = (u16*)take(128ull * 64 * 2);
  p.UT8 = (unsigned char*)take((size_t)NEXP * 1024);
  p.VT8 = (unsigned char*)take((size_t)NEXP * 1024);
  p.hx = (u16*)take((size_t)RTOT * 1024 * 2);
  {
    const size_t b0 = off;
    p.cq = (u16*)take((size_t)RTOT * 256 * 2);
    p.zf = (u16*)take((size_t)RTOT * 256 * 2);
    p.zc = (u16*)take((size_t)RTOT * 512 * 2);
    p.ckv = (u16*)take((size_t)RTOT * 128 * 2);
    p.kr = (float*)take((size_t)RTOT * 32 * 4);
    p.m = (u16*)(ws + b0);
    p.PD = (unsigned*)(ws + b0);
  }
  {
    const size_t c0 = off;
    p.Kb = (u16*)take((size_t)NB * NH * SKEYS * 96 * 2);
    p.Vtb = (u16*)take((size_t)NB * NH * 64 * SKEYS * 2);
    p.eid = (int*)(ws + c0);
    p.gate = (float*)(ws + c0 + al256((size_t)RTOT * 128 * 4));
  }
  p.Ytl = (u16*)take((size_t)NB * 256 * 8192 * 2);
  p.Ytc = (u16*)take((size_t)NB * 256 * 512 * 2);
  p.Ob = (u16*)take((size_t)RTOT * 512 * 2);
  p.Fb = (u16*)take((size_t)RTOT * 256 * 2);
  p.cv = (u16*)take((size_t)RTOT * 256 * 2);
  p.ctx1 = (float*)take((size_t)TCTX * 1024 * 4);
  if (off > ws_size) { fprintf(stderr, "workspace too small: need %zu have %zu\n", off, ws_size); return; }

  (void)hipMemsetAsync(p.bar, 0, XCD_BAR_WORDS * 4, stream);
  static int grid_blocks = 0;
  if (!grid_blocks) {
    int dev = 0, cus = 0, per_cu = 0;
    hipGetDevice(&dev);
    hipDeviceGetAttribute(&cus, hipDeviceAttributeMultiprocessorCount, dev);
    hipOccupancyMaxActiveBlocksPerMultiprocessor(&per_cu, mega, 256, 0);
    if (per_cu > 2) per_cu = 2;
    if (per_cu < 1) per_cu = 1;
    grid_blocks = cus * per_cu;
  }
#if ONE_LAUNCH
  int ph0 = 0, ph1 = NPHASE;
  void* args[] = {&p, &ph0, &ph1};
  hipError_t e = hipLaunchCooperativeKernel((void*)mega, dim3(grid_blocks), dim3(256), args, 0, stream);
  if (e != hipSuccess) fprintf(stderr, "cooperative launch failed: %s (grid %d)\n", hipGetErrorString(e), grid_blocks);
#else
  for (int ph = 0; ph < PH_LIMIT; ph++) mega<<<grid_blocks, 256, 0, stream>>>(p, ph, ph + 1);
#endif
}
```

```cpp
#include <hip/hip_runtime.h>
#include <hip/hip_cooperative_groups.h>
#include <cstdio>
#include <cstdint>
namespace cg = cooperative_groups;

#ifndef ABL_PEER
#define ABL_PEER 1
#endif
#ifndef ABL_BR
#define ABL_BR 7
#endif
#ifndef PROBE_S
#define PROBE_S (-1)
#endif
#ifndef PROBE_REPS
#define PROBE_REPS 4
#endif
#ifndef CHECK_ATTN
#define CHECK_ATTN 0
#endif
#ifndef CHECK_MASK
#define CHECK_MASK 0xff
#endif
#ifndef ONE_LAUNCH
#define ONE_LAUNCH 1
#endif

typedef unsigned short u16;
typedef __attribute__((ext_vector_type(8))) __bf16 bf16x8;
typedef __attribute__((ext_vector_type(2))) __bf16 bf16x2;
typedef __attribute__((ext_vector_type(16))) float f32x16;
typedef __attribute__((ext_vector_type(2))) float f32x2;

#define NB 8
#define SEQ 4096
#define DM 1024
#define CTXL 256
#define TLAT (NB * SEQ)
#define TCTX (NB * CTXL)
#define RTOT (TLAT + TCTX)
#define SKEYS (CTXL + SEQ)
#define NH 8
#define QKD 96
#define N2 1280
#define NEXP 16384
#define EPSV 1e-6f

struct Params {
  const float *x, *c, *ctx, *c_ctx, *w_mod, *b_mod, *g_norm1, *w_in, *g_ckv, *w_ukv, *g_cq, *w_uq, *g_qn, *g_kn,
      *w_dw, *b_dw, *g_cln, *b_cln, *wb_attn, *wb_fnet, *wb_conv, *w_out, *g_norm2, *w_query, *sub_keys, *u_tab, *v_tab;
  float* out;
  unsigned* bar;
  float* mods;
  float* ropetab;
  u16 *W2T, *WgT, *WukvT, *WuqT, *WbaT, *WbfT, *WbcT, *WoutT, *WqT, *SubK;
  u16 *WA, *WC, *Dctx, *Wcs;
  float* tw;
  u16* GB;
  unsigned char *UT8, *VT8;
  unsigned* PD;
  u16* hx;
  u16 *cq, *zf, *zc, *ckv; float* kr;
  u16* m;
  u16 *Kb, *Vtb;
  int* eid; float* gate;
  u16 *Ytl, *Ytc, *Ob, *Fb, *cv;
  float* ctx1;
  int one; int pad_;
};

#define W2T_SZ (N2 * 1024)
#define WGT_SZ (3072 * 1024)
#define WUKV_SZ (1024 * 128)
#define WUQ_SZ (768 * 256)
#define WBA_SZ (1024 * 512)
#define WBF_SZ (1024 * 256)
#define WBC_SZ (1024 * 256)
#define WOUT_SZ (1024 * 1024)
#define WQ_SZ (1024 * 1024)
#define SUBK_SZ (8 * 2 * 128 * 64)

__device__ __forceinline__ unsigned pack2(float a, float b) {
  f32x2 v = {a, b};
  return __builtin_bit_cast(unsigned, __builtin_convertvector(v, bf16x2));
}
__device__ __forceinline__ u16 tobf(float a) { return (u16)(pack2(a, 0.f) & 0xffffu); }
__device__ __forceinline__ float bf_lo(unsigned u) { return __uint_as_float(u << 16); }
__device__ __forceinline__ float bf_hi(unsigned u) { return __uint_as_float(u & 0xffff0000u); }
__device__ __forceinline__ float bf1(u16 u) { return __uint_as_float(((unsigned)u) << 16); }
__device__ __forceinline__ f32x16 mfma32(uint4 a, uint4 b, f32x16 c) {
  return __builtin_amdgcn_mfma_f32_32x32x16_bf16(__builtin_bit_cast(bf16x8, a), __builtin_bit_cast(bf16x8, b), c, 0, 0, 0);
}
__device__ __forceinline__ uint4 ldg16(const void* p) { return *(const uint4*)p; }
__device__ __forceinline__ int opaque(int x) { asm volatile("" : "+v"(x)); return x; }
#define TIDX opaque((int)threadIdx.x)
__device__ __forceinline__ float wave_sum(float v) {
#pragma unroll
  for (int o = 32; o > 0; o >>= 1) v += __shfl_xor(v, o);
  return v;
}
__device__ __forceinline__ float half_sum(float v) {
#pragma unroll
  for (int o = 16; o > 0; o >>= 1) v += __shfl_xor(v, o);
  return v;
}
__device__ __forceinline__ float sigmoidf_(float x) { return 1.f / (1.f + __expf(-x)); }
__device__ __forceinline__ float siluf_(float x) { return x / (1.f + __expf(-x)); }
__device__ __forceinline__ float gelu_tanh(float x) {
  float u = 0.7978845608028654f * (x + 0.044715f * x * x * x);
  float t = 1.f - 2.f / (1.f + __expf(2.f * u));
  return 0.5f * x * (1.f + t);
}
__device__ __forceinline__ int row_mod(int r) { return r < TLAT ? (r >> 12) : 8; }

#define SMEM_BYTES 73728
#define LDT 72

#define LAS3 __attribute__((address_space(3)))
__device__ __forceinline__ void glds16(const u16* g, char* lds_wave_base) {
  __builtin_amdgcn_global_load_lds((const unsigned*)g, (LAS3 unsigned*)lds_wave_base, 16, 0, 0);
}
__device__ __forceinline__ void gemm128x(const u16* __restrict__ A, int lda, const u16* __restrict__ Bt, int ldb, int bs1, int bs2, int K,
                                         f32x16 (&acc)[2][2], char* smem) {
  char* As = smem;
  char* Bs = smem + 32768;
  const int tid = TIDX, lane = tid & 63, w = tid >> 6, wr = w >> 1, wc = w & 1;
  const int nk = K >> 6;
  const int srow = w * 8 + (lane >> 3);
  const int schunk = (lane & 7) ^ ((srow >> 1) & 7);
  const int aoff = srow * lda + schunk * 8, boff = srow * ldb + schunk * 8;
  const int a32 = 32 * lda;
  __syncthreads();
#pragma unroll
  for (int i = 0; i < 4; i++) {
    glds16(A + (aoff + i * a32), As + (i * 4 + w) * 1024);
    glds16(Bt + (boff + (i & 1) * bs1 + (i >> 1) * bs2), Bs + (i * 4 + w) * 1024);
  }
  __syncthreads();
  const int fr = lane & 31, hh = lane >> 5;
  const int sw = (fr >> 1) & 7;
  for (int kt = 0; kt < nk; kt++) {
    const int cur = kt & 1;
    if (kt + 1 < nk) {
      const int ko = (kt + 1) * 64;
      char* An = As + (cur ^ 1) * 16384;
      char* Bn = Bs + (cur ^ 1) * 16384;
#pragma unroll
      for (int i = 0; i < 4; i++) {
        glds16(A + (aoff + i * a32 + ko), An + (i * 4 + w) * 1024);
        glds16(Bt + (boff + (i & 1) * bs1 + (i >> 1) * bs2 + ko), Bn + (i * 4 + w) * 1024);
      }
    }
    const char* Ac = As + cur * 16384 + (wr * 64 + fr) * 128;
    const char* Bc = Bs + cur * 16384 + (wc * 64 + fr) * 128;
#pragma unroll
    for (int kk = 0; kk < 4; kk++) {
      const int so = ((2 * kk + hh) ^ sw) << 4;
      uint4 a0 = *(const uint4*)(Ac + so);
      uint4 a1 = *(const uint4*)(Ac + 32 * 128 + so);
      uint4 b0 = *(const uint4*)(Bc + so);
      uint4 b1 = *(const uint4*)(Bc + 32 * 128 + so);
      acc[0][0] = mfma32(a0, b0, acc[0][0]);
      acc[0][1] = mfma32(a0, b1, acc[0][1]);
      acc[1][0] = mfma32(a1, b0, acc[1][0]);
      acc[1][1] = mfma32(a1, b1, acc[1][1]);
    }
    __syncthreads();
  }
}
__device__ __forceinline__ void gemm128(const u16* __restrict__ A, int lda, const u16* __restrict__ Bt, int ldb, int K,
                                        f32x16 (&acc)[2][2], char* smem) {
  gemm128x(A, lda, Bt, ldb, 32 * ldb, 64 * ldb, K, acc, smem);
}
__device__ __forceinline__ void gemm128h(const u16* __restrict__ A, int lda, const u16* __restrict__ Bt, int ldb, int K, int jh,
                                         f32x16 (&acc)[2], char* smem) {
  char* As = smem;
  char* Bs = smem + 32768;
  const int tid = TIDX, lane = tid & 63, w = tid >> 6, wr = w >> 1, wc = w & 1;
  const int nk = K >> 6;
  const int srow = w * 8 + (lane >> 3);
  const int schunk = (lane & 7) ^ ((srow >> 1) & 7);
  const int aoff = srow * lda + schunk * 8;
  const int a32 = 32 * lda;
  const int boff = (jh * 32 + srow) * ldb + schunk * 8, b64 = 64 * ldb;
  __syncthreads();
#pragma unroll
  for (int i = 0; i < 4; i++) glds16(A + (aoff + i * a32), As + (i * 4 + w) * 1024);
#pragma unroll
  for (int i = 0; i < 2; i++) glds16(Bt + (boff + i * b64), Bs + (i * 4 + w) * 1024);
  __syncthreads();
  const int fr = lane & 31, hh = lane >> 5;
  const int sw = (fr >> 1) & 7;
  for (int kt = 0; kt < nk; kt++) {
    const int cur = kt & 1;
    if (kt + 1 < nk) {
      const int ko = (kt + 1) * 64;
      char* An = As + (cur ^ 1) * 16384;
      char* Bn = Bs + (cur ^ 1) * 8192;
#pragma unroll
      for (int i = 0; i < 4; i++) glds16(A + (aoff + i * a32 + ko), An + (i * 4 + w) * 1024);
#pragma unroll
      for (int i = 0; i < 2; i++) glds16(Bt + (boff + i * b64 + ko), Bn + (i * 4 + w) * 1024);
    }
    const char* Ac = As + cur * 16384 + (wr * 64 + fr) * 128;
    const char* Bc = Bs + cur * 8192 + (wc * 32 + fr) * 128;
#pragma unroll
    for (int kk = 0; kk < 4; kk++) {
      const int so = ((2 * kk + hh) ^ sw) << 4;
      uint4 a0 = *(const uint4*)(Ac + so);
      uint4 a1 = *(const uint4*)(Ac + 32 * 128 + so);
      uint4 b0 = *(const uint4*)(Bc + so);
      acc[0] = mfma32(a0, b0, acc[0]);
      acc[1] = mfma32(a1, b0, acc[1]);
    }
    __syncthreads();
  }
}
#define FOR_UNITS_XCD(NRT, NCT, RT, CT) \
  for (int _s = (int)(blockIdx.x >> 3), _per = (NRT) >> 3, _n = _per * (NCT); _s < _n; _s += (int)(gridDim.x >> 3)) { \
    const int RT = (int)(blockIdx.x & 7) * _per + _s / (NCT), CT = _s % (NCT);
#define ZERO_ACC(acc) { _Pragma("unroll") for (int _i = 0; _i < 2; _i++) _Pragma("unroll") for (int _j = 0; _j < 2; _j++) _Pragma("unroll") for (int _r = 0; _r < 16; _r++) acc[_i][_j][_r] = 0.f; }
#define ACC_ROW(wr, i, r, lane) ((wr) * 64 + (i) * 32 + ((r) & 3) + 8 * ((r) >> 2) + 4 * ((lane) >> 5))
#define ACC_COL(wc, j, lane) ((wc) * 64 + (j) * 32 + ((lane) & 31))

__device__ __forceinline__ void job_mods(const Params& p, int job, char* smem) {
  float* s = (float*)smem;
  float* red = s + 9 * 1024;
  const int L = job / 96, nt = job % 96;
  const int tid = TIDX, lane = tid & 63, w = tid >> 6;
  __syncthreads();
  for (int i = tid; i < 9 * 1024; i += 256) {
    const int j = i >> 10, k = i & 1023;
    const float cv = (j < 8) ? p.c[j * 1024 + k] : p.c_ctx[k];
    s[i] = siluf_(cv);
  }
  __syncthreads();
  const int n = nt * 64 + lane;
  float acc[9];
#pragma unroll
  for (int j = 0; j < 9; j++) acc[j] = 0.f;
  const float* wp = p.w_mod + (long)L * 1024 * 6144 + (long)(w * 256) * 6144 + n;
#pragma unroll 8
  for (int k = 0; k < 256; k++) {
    const float wv = wp[(long)k * 6144];
#pragma unroll
    for (int j = 0; j < 9; j++) acc[j] += s[j * 1024 + w * 256 + k] * wv;
  }
#pragma unroll
  for (int j = 0; j < 9; j++) red[(w * 9 + j) * 64 + lane] = acc[j];
  __syncthreads();
  for (int i = tid; i < 9 * 64; i += 256) {
    const int j = i >> 6, l = i & 63;
    const float v = ((red[(0 * 9 + j) * 64 + l] + red[(1 * 9 + j) * 64 + l]) + red[(2 * 9 + j) * 64 + l]) + red[(3 * 9 + j) * 64 + l];
    p.mods[(L * 9 + j) * 6144 + nt * 64 + l] = v + p.b_mod[L * 6144 + nt * 64 + l];
  }
}

__device__ __forceinline__ void job_convT(const float* src, int ldsrc, int c0, int k0, u16* dst, int K, int n0, const float* scale, char* smem) {
  float* t = (float*)smem;
  const int tid = TIDX;
  __syncthreads();
  const int nc = tid & 31, kr = tid >> 5;
#pragma unroll 4
  for (int kk = kr; kk < 128; kk += 8) {
    float v = 0.f;
    if (src) { v = src[(long)(k0 + kk) * ldsrc + c0 + nc]; if (scale) v *= scale[k0 + kk]; }
    t[nc * 129 + kk] = v;
  }
  __syncthreads();
  const int nr = tid >> 3, kc = (tid & 7) * 16;
  unsigned o[8];
#pragma unroll
  for (int q = 0; q < 8; q++) o[q] = pack2(t[nr * 129 + kc + 2 * q], t[nr * 129 + kc + 2 * q + 1]);
  uint4* dp = (uint4*)(dst + (long)(n0 + nr) * K + k0 + kc);
  dp[0] = make_uint4(o[0], o[1], o[2], o[3]);
  dp[1] = make_uint4(o[4], o[5], o[6], o[7]);
}

#define NJ_W2 (40 * 8)
#define NJ_WG (96 * 8)
#define NJ_UKV (32 * 1)
#define NJ_UQ (24 * 2)
#define NJ_BA (32 * 4)
#define NJ_BF (32 * 2)
#define NJ_BC (32 * 2)
#define NJ_OUT (32 * 8)
#define NJ_WQ (32 * 8)
#define NJ_CONV_LAYER (NJ_W2 + NJ_WG + NJ_UKV + NJ_UQ + NJ_BA + NJ_BF + NJ_BC + NJ_OUT + NJ_WQ)

__device__ __forceinline__ void job_conv_weights(const Params& p, int job, char* smem) {
  const int L = job / NJ_CONV_LAYER;
  int j = job % NJ_CONV_LAYER;
  const float* src; int ldsrc, c0, k0, K, n0; u16* dst; const float* scale = nullptr;
  if (j < NJ_W2) {
    const int nt = j >> 3, kt = j & 7; n0 = nt * 32;
    bool valid = true;
    if (n0 < 256) c0 = 160 + n0;
    else if (n0 < 512) c0 = 416 + (n0 - 256);
    else if (n0 < 1024) c0 = 672 + (n0 - 512);
    else if (n0 < 1152) c0 = n0 - 1024;
    else if (n0 < 1184) c0 = 128 + (n0 - 1152);
    else { c0 = 0; valid = false; }
    src = valid ? p.w_in + (long)L * 1024 * 4256 : nullptr; ldsrc = 4256; k0 = kt * 128; dst = p.W2T + (long)L * W2T_SZ; K = 1024;
  } else if ((j -= NJ_W2) < NJ_WG) {
    const int nt = j >> 3, kt = j & 7;
    src = p.w_in + (long)L * 1024 * 4256; ldsrc = 4256; c0 = 1184 + nt * 32; k0 = kt * 128; dst = p.WgT + (long)L * WGT_SZ; K = 1024; n0 = nt * 32;
  } else if ((j -= NJ_WG) < NJ_UKV) {
    src = p.w_ukv + (long)L * 128 * 1024; ldsrc = 1024; c0 = j * 32; k0 = 0; dst = p.WukvT + (long)L * WUKV_SZ; K = 128; n0 = j * 32; scale = p.g_ckv + L * 128;
  } else if ((j -= NJ_UKV) < NJ_UQ) {
    const int nt = j >> 1, kt = j & 1;
    src = p.w_uq + (long)L * 256 * 768; ldsrc = 768; c0 = nt * 32; k0 = kt * 128; dst = p.WuqT + (long)L * WUQ_SZ; K = 256; n0 = nt * 32; scale = p.g_cq + L * 256;
  } else if ((j -= NJ_UQ) < NJ_BA) {
    const int nt = j >> 2, kt = j & 3;
    src = p.wb_attn + (long)L * 512 * 1024; ldsrc = 1024; c0 = nt * 32; k0 = kt * 128; dst = p.WbaT + (long)L * WBA_SZ; K = 512; n0 = nt * 32;
  } else if ((j -= NJ_BA) < NJ_BF) {
    const int nt = j >> 1, kt = j & 1;
    src = p.wb_fnet + (long)L * 256 * 1024; ldsrc = 1024; c0 = nt * 32; k0 = kt * 128; dst = p.WbfT + (long)L * WBF_SZ; K = 256; n0 = nt * 32;
  } else if ((j -= NJ_BF) < NJ_BC) {
    const int nt = j >> 1, kt = j & 1;
    src = p.wb_conv + (long)L * 256 * 1024; ldsrc = 1024; c0 = nt * 32; k0 = kt * 128; dst = p.WbcT + (long)L * WBC_SZ; K = 256; n0 = nt * 32;
  } else if ((j -= NJ_BC) < NJ_OUT) {
    const int nt = j >> 3, kt = j & 7;
    src = p.w_out + (long)L * 1024 * 1024; ldsrc = 1024; c0 = nt * 32; k0 = kt * 128; dst = p.WoutT + (long)L * WOUT_SZ; K = 1024; n0 = nt * 32;
  } else {
    j -= NJ_OUT;
    const int nt = j >> 3, kt = j & 7;
    src = p.w_query + (long)L * 1024 * 1024; ldsrc = 1024; c0 = nt * 32; k0 = kt * 128; dst = p.WqT + (long)L * WQ_SZ; K = 1024; n0 = nt * 32;
  }
  job_convT(src, ldsrc, c0, k0, dst, K, n0, scale, smem);
}

__device__ __forceinline__ void job_cvt_straight(const float* src, u16* dst, long job) {
  const long base = job * 8192 + TIDX * 8;
#pragma unroll
  for (int i = 0; i < 4; i++) {
    const long o = base + i * 2048;
    float4 a = *(const float4*)(src + o), b = *(const float4*)(src + o + 4);
    *(uint4*)(dst + o) = make_uint4(pack2(a.x, a.y), pack2(a.z, a.w), pack2(b.x, b.y), pack2(b.z, b.w));
  }
}

__device__ __forceinline__ void job_misc(const Params& p) {
  const int tid = TIDX;
  for (int i = tid; i < 256 * 512; i += 256) {
    const int k = i >> 9, e = i & 511, part = e >> 8, t = e & 255;
    const int ph = (k * t) & 255;
    const float a = (float)ph * (1.0f / 128.0f);
    p.Dctx[i] = tobf((part == 0 ? cospif(a) : -sinpif(a)) * (1.0f / 16.0f));
  }
  for (int i = tid; i < 128 * 64; i += 256) {
    const int n = i >> 6, d = i & 63, pp = n >> 6, e = n & 63;
    const int ph = (e * d) & 63;
    const float a = (float)ph * (1.0f / 32.0f);
    p.Wcs[i] = tobf((pp == 0 ? cospif(a) : sinpif(a)) * 0.125f);
  }
  for (int i = tid; i < 128 * 128; i += 256) {
    const int R = i >> 7, kk = i & 127, k1 = (R >> 6) * 32 + (R & 31), pr = (R >> 5) & 1, part = kk >> 6, t1 = kk & 63;
    const float a = (float)((k1 * t1) & 63) * (1.0f / 32.0f);
    const float cs = cospif(a), sn = sinpif(a);
    const float v = (pr == 0) ? (part == 0 ? cs : -sn) : (part == 0 ? -sn : -cs);
    p.WA[i] = tobf(v * 0.125f);
  }
  for (int i = tid; i < 128 * 128; i += 256) {
    const int k2 = i >> 7, kk = i & 127, part = kk >> 6, t2 = kk & 63;
    const float a = (float)((k2 * t2) & 63) * (1.0f / 32.0f);
    p.WC[i] = (k2 < 64) ? tobf((part == 0 ? cospif(a) : sinpif(a)) * 0.125f) : (u16)0;
  }
  for (int i = tid; i < 4096; i += 256) {
    const float a = (float)i * (1.0f / 2048.0f);
    p.tw[2 * i] = cospif(a); p.tw[2 * i + 1] = sinpif(a);
  }
  for (int i = tid; i < 512; i += 256) {
    const int pos = i >> 3, mm = i & 7;
    const float inv = powf(10000.0f, -(float)(2 * mm) / 16.0f);
    const float ang = (float)pos * inv;
    p.ropetab[i * 2] = cosf(ang);
    p.ropetab[i * 2 + 1] = sinf(ang);
  }
}

#define NJ_MODS 192
#define NJ_CONVW (2 * NJ_CONV_LAYER)
#define NJ_SUBK 32
#define NJ_MISC 1
#define NJ_PREP (NJ_MODS + NJ_CONVW + NJ_SUBK + NJ_MISC)

__device__ __forceinline__ void phase_prep(const Params& p, char* smem) {
  for (int job = blockIdx.x; job < NJ_PREP; job += gridDim.x) {
    int j = job;
    if (j < NJ_MODS) { job_mods(p, j, smem); continue; }
    j -= NJ_MODS;
    if (j < NJ_CONVW) { job_conv_weights(p, j, smem); continue; }
    j -= NJ_CONVW;
    if (j < NJ_SUBK) { job_cvt_straight(p.sub_keys, p.SubK, j); continue; }
    job_misc(p);
  }
}

__device__ __forceinline__ void phase_norm(const Params& p, int L, int which, int nrows) {
  const int lane = TIDX & 63;
  const int gw = blockIdx.x * 4 + (TIDX >> 6), nw = gridDim.x * 4;
  const float* g = (which == 0 ? p.g_norm1 : p.g_norm2) + L * 1024;
  for (int r0 = gw; r0 < nrows; r0 += 2 * nw) {
    float4 v[2][4];
    int rr[2]; bool ok[2];
#pragma unroll
    for (int u = 0; u < 2; u++) {
      const int r = r0 + u * nw;
      ok[u] = r < nrows; rr[u] = ok[u] ? r : r0;
      const float* src;
      if (which == 0 && L == 0) src = (rr[u] < TLAT) ? p.x + (long)rr[u] * 1024 : p.ctx + (long)(rr[u] - TLAT) * 1024;
      else src = (rr[u] < TLAT) ? p.out + (long)rr[u] * 1024 : p.ctx1 + (long)(rr[u] - TLAT) * 1024;
#pragma unroll
      for (int i = 0; i < 4; i++) v[u][i] = *(const float4*)(src + i * 256 + lane * 4);
    }
#pragma unroll
    for (int u = 0; u < 2; u++) {
      const int r = rr[u];
      const float* md = p.mods + (long)(L * 9 + row_mod(r)) * 6144 + (which == 0 ? 0 : 3072);
      float ss = 0.f;
#pragma unroll
      for (int i = 0; i < 4; i++) ss += v[u][i].x * v[u][i].x + v[u][i].y * v[u][i].y + v[u][i].z * v[u][i].z + v[u][i].w * v[u][i].w;
      ss = wave_sum(ss);
      const float rs = rsqrtf(ss * (1.0f / 1024.0f) + EPSV);
      if (!ok[u]) continue;
#pragma unroll
      for (int i = 0; i < 4; i++) {
        const int c = i * 256 + lane * 4;
        const float4 gg = *(const float4*)(g + c);
        const float4 sh = *(const float4*)(md + c);
        const float4 sc = *(const float4*)(md + 1024 + c);
        const float o0 = v[u][i].x * rs * gg.x * (1.f + sc.x) + sh.x;
        const float o1 = v[u][i].y * rs * gg.y * (1.f + sc.y) + sh.y;
        const float o2 = v[u][i].z * rs * gg.z * (1.f + sc.z) + sh.z;
        const float o3 = v[u][i].w * rs * gg.w * (1.f + sc.w) + sh.w;
        *(uint2*)(p.hx + (long)r * 1024 + c) = make_uint2(pack2(o0, o1), pack2(o2, o3));
      }
    }
  }
}
#define U8_SCALE 32.0f
#define V8_SCALE 4.0f
__device__ __forceinline__ unsigned pack_fp8x4(float4 v, float s) {
  int w = 0;
  w = __builtin_amdgcn_cvt_pk_fp8_f32(v.x * s, v.y * s, w, false);
  w = __builtin_amdgcn_cvt_pk_fp8_f32(v.z * s, v.w * s, w, true);
  return (unsigned)w;
}
__device__ __forceinline__ void phase_tables(const Params& p, int L) {
  const int tid = TIDX;
  for (int job = blockIdx.x; job < 4096; job += gridDim.x) {
    const bool isu = job < 2048;
    const float* src = (isu ? p.u_tab : p.v_tab) + (long)L * NEXP * 1024;
    unsigned char* dst = isu ? p.UT8 : p.VT8;
    const float s = isu ? U8_SCALE : V8_SCALE;
    const long base = (long)(isu ? job : job - 2048) * 8192 + tid * 16;
#pragma unroll
    for (int i = 0; i < 2; i++) {
      const long o = base + i * 4096;
      const float4 a = *(const float4*)(src + o), b = *(const float4*)(src + o + 4);
      const float4 c = *(const float4*)(src + o + 8), d = *(const float4*)(src + o + 12);
      const long e = o >> 10; const int col = (int)(o & 1023), sl = col >> 7, cc = col & 127;
      *(uint4*)(dst + ((long)sl * NEXP + e) * 128 + cc) = make_uint4(pack_fp8x4(a, s), pack_fp8x4(b, s), pack_fp8x4(c, s), pack_fp8x4(d, s));
    }
  }
}

__device__ __forceinline__ void phase_s2(const Params& p, int L, char* smem) {
  const int lane = TIDX & 63, w = TIDX >> 6, wr = w >> 1, wc = w & 1;
  for (int pass = 0; pass < (L == 0 ? 1 : 2); pass++) {
  const int g_nrt = (L == 0) ? 272 : (pass == 0 ? 256 : 16), g_nct = (L == 0 || pass == 0) ? 10 : 2;
  FOR_UNITS_XCD(g_nrt, g_nct, rt_, ct_)
    const int rt = (L == 1 && pass == 1) ? 256 + rt_ : rt_, ct = (L == 1 && pass == 1) ? 8 + ct_ : ct_;
    f32x16 acc[2][2];
    ZERO_ACC(acc);
    gemm128(p.hx + (long)rt * 128 * 1024, 1024, p.W2T + (long)L * W2T_SZ + (long)ct * 128 * 1024, 1024, 1024, acc, smem);
    const int row0 = rt * 128;
#define S2_STORE(DST, LDD, C0) { u16* dp = (DST) + (long)row0 * (LDD) + (C0); \
      const int tb = opaque((wr * 64 + 4 * (lane >> 5)) * (LDD) + wc * 64 + (lane & 31)); \
      _Pragma("unroll") for (int i = 0; i < 2; i++) _Pragma("unroll") for (int j = 0; j < 2; j++) _Pragma("unroll") for (int r = 0; r < 16; r++) \
        dp[tb + (i * 32 + (r & 3) + 8 * (r >> 2)) * (LDD) + j * 32] = tobf(acc[i][j][r]); }
    if (ct < 2) S2_STORE(p.cq, 256, ct * 128)
    else if (ct < 4) S2_STORE(p.zf, 256, (ct - 2) * 128)
    else if (ct < 8) S2_STORE(p.zc, 512, (ct - 4) * 128)
    else if (ct == 8) S2_STORE(p.ckv, 128, 0)
#undef S2_STORE
    else if (wc == 0) {
      float* dp = p.kr + (long)row0 * 32;
      const int tb = opaque((wr * 64 + 4 * (lane >> 5)) * 32 + (lane & 31));
#pragma unroll
      for (int i = 0; i < 2; i++)
#pragma unroll
        for (int r = 0; r < 16; r++)
          dp[tb + (i * 32 + (r & 3) + 8 * (r >> 2)) * 32] = acc[i][0][r];
    }
  }
  }
}

__device__ __forceinline__ void unit_kv(const Params& p, int L, int rt, int h, char* smem) {
  u16* As = (u16*)smem;
  u16* Ws = (u16*)(smem + 128 * 136 * 2);
  float* rrs = (float*)(smem + 2 * 128 * 136 * 2);
  const int tid = TIDX, lane = tid & 63, w = tid >> 6, hh = lane >> 5, c = lane & 31;
  const int row0 = rt * 128;
  __syncthreads();
  {
    const u16* ap = p.ckv + (long)row0 * 128;
    const u16* wp = p.WukvT + (long)L * WUKV_SZ + (long)h * 128 * 128;
#pragma unroll
    for (int i = 0; i < 8; i++) {
      const int idx = tid + 256 * i, rw = idx >> 4, ch = idx & 15;
      *(uint4*)(As + rw * 136 + ch * 8) = ldg16(ap + rw * 128 + ch * 8);
      *(uint4*)(Ws + rw * 136 + ch * 8) = ldg16(wp + rw * 128 + ch * 8);
    }
  }
  __syncthreads();
  {
    const int rw = tid >> 1, hf = tid & 1;
    float ss = 0.f;
#pragma unroll
    for (int q = 0; q < 8; q++) {
      uint4 v = *(const uint4*)(As + rw * 136 + hf * 64 + q * 8);
      float a;
      a = bf_lo(v.x); ss += a * a; a = bf_hi(v.x); ss += a * a;
      a = bf_lo(v.y); ss += a * a; a = bf_hi(v.y); ss += a * a;
      a = bf_lo(v.z); ss += a * a; a = bf_hi(v.z); ss += a * a;
      a = bf_lo(v.w); ss += a * a; a = bf_hi(v.w); ss += a * a;
    }
    ss += __shfl_xor(ss, 1);
    if (hf == 0) rrs[rw] = rsqrtf(ss * (1.0f / 128.0f) + EPSV);
  }
  __syncthreads();
  f32x16 aK[2], aV[2];
#pragma unroll
  for (int r = 0; r < 16; r++) { aK[0][r] = 0.f; aK[1][r] = 0.f; aV[0][r] = 0.f; aV[1][r] = 0.f; }
#pragma unroll
  for (int s = 0; s < 8; s++) {
    const int ko = s * 16 + hh * 8;
    uint4 tk = *(const uint4*)(As + (32 * w + c) * 136 + ko);
    uint4 w0 = *(const uint4*)(Ws + (c) * 136 + ko);
    uint4 w1 = *(const uint4*)(Ws + (32 + c) * 136 + ko);
    uint4 w2 = *(const uint4*)(Ws + (64 + c) * 136 + ko);
    uint4 w3 = *(const uint4*)(Ws + (96 + c) * 136 + ko);
    aK[0] = mfma32(tk, w0, aK[0]);
    aK[1] = mfma32(tk, w1, aK[1]);
    aV[0] = mfma32(w2, tk, aV[0]);
    aV[1] = mfma32(w3, tk, aV[1]);
  }
  const bool lat = row0 < TLAT;
  const int b = lat ? (row0 >> 12) : ((row0 - TLAT) >> 8);
  const int s0 = lat ? (row0 & 4095) : ((row0 - TLAT) & 255);
  const int kpos0 = lat ? (CTXL + s0) : s0;
  const float* gkn = p.g_kn + L * 96;
  const float gk0 = gkn[c], gk1 = gkn[32 + c], gk2 = gkn[64 + c];
  u16* Kdst = p.Kb + ((long)(b * 8 + h) * SKEYS + kpos0) * 96;
#pragma unroll
  for (int r = 0; r < 16; r++) {
    const int tl = 32 * w + (r & 3) + 8 * (r >> 2) + 4 * hh;
    const float rc = rrs[tl];
    const float v0 = aK[0][r] * rc, v1 = aK[1][r] * rc;
    const float kv = p.kr[(long)(row0 + tl) * 32 + c];
    const float ss = half_sum(v0 * v0 + v1 * v1 + kv * kv);
    const float rk = rsqrtf(ss * (1.0f / 96.0f) + EPSV);
    const float krn = kv * rk * gk2;
    const float partner = __shfl_xor(krn, 8);
    float o2 = krn;
    if (lat) {
      const int s = s0 + tl;
      const int pos = (c < 16) ? (s >> 6) : (s & 63);
      const float2 cs = *(const float2*)(p.ropetab + (pos * 8 + (c & 7)) * 2);
      const float rot = (c & 8) ? partner : -partner;
      o2 = krn * cs.x + rot * cs.y;
    }
    u16* kd = Kdst + (long)tl * 96;
    kd[c] = tobf(v0 * rk * gk0);
    kd[32 + c] = tobf(v1 * rk * gk1);
    kd[64 + c] = tobf(o2);
  }
  u16* Vdst = p.Vtb + (long)(b * 8 + h) * 64 * SKEYS + kpos0;
  const float rcv = rrs[32 * w + c];
#pragma unroll
  for (int i = 0; i < 2; i++)
#pragma unroll
    for (int r = 0; r < 16; r++) {
      const int d = 32 * i + (r & 3) + 8 * (r >> 2) + 4 * hh;
      Vdst[(long)d * SKEYS + 32 * w + c] = tobf(aV[i][r] * rcv);
    }
}

__device__ __forceinline__ void unit_chdft(const Params& p, int ut, int g, bool lat, char* smem) {
  const int lane = TIDX & 63, w = TIDX >> 6, wr = w >> 1, wc = w & 1;
  f32x16 acc[2][2];
  ZERO_ACC(acc);
  if (lat) {
    const int b = ut >> 5, j = ut & 31;
    gemm128x(p.Wcs, 64, p.zf + ((long)(b * SEQ + 2 * j) * 256 + g * 64), 64 * 256, 32 * 64 * 256, 256, 64, acc, smem);
    u16* dst = p.Ytl + ((long)(b * 256 + g * 64) * 64 + 2 * j) * 128;
#pragma unroll
    for (int i = 0; i < 2; i++)
#pragma unroll
      for (int jj = 0; jj < 2; jj++)
#pragma unroll
        for (int r = 0; r < 16; r++) {
          const int e = i * 32 + (r & 3) + 8 * (r >> 2) + 4 * (lane >> 5);
          dst[((long)e * 64 + wc) * 128 + wr * 64 + jj * 32 + (lane & 31)] = tobf(acc[i][jj][r]);
        }
  } else {
    const int row0 = TLAT + ut * 128;
    gemm128(p.Wcs, 64, p.zf + (long)row0 * 256 + g * 64, 256, 64, acc, smem);
    const int b = (row0 - TLAT) >> 8, s0 = (row0 - TLAT) & 255;
#pragma unroll
    for (int i = 0; i < 2; i++)
#pragma unroll
      for (int jj = 0; jj < 2; jj++)
#pragma unroll
        for (int r = 0; r < 16; r++) {
          const int n = ACC_ROW(wr, i, r, lane);
          const int t = s0 + ACC_COL(wc, jj, lane);
          p.Ytc[((long)(b * 256 + g * 64 + (n & 63))) * 512 + (n >> 6) * 256 + t] = tobf(acc[i][jj][r]);
        }
  }
}

__device__ __forceinline__ void unit_conv(const Params& p, int L, int ut, char* smem) {
  float* U = (float*)smem;
  const int tid = TIDX, lane = tid & 63, w = tid >> 6;
  const int row0 = ut * 32;
  const bool lat = row0 < TLAT;
  const int seqlen = lat ? SEQ : CTXL;
  const int s0 = lat ? (row0 & 4095) : ((row0 - TLAT) & 255);
  __syncthreads();
  {
    uint4 ca[8], cg[8];
#pragma unroll
    for (int q = 0; q < 8; q++) {
      const int id = tid + 256 * q, i = id >> 5, k = id & 31;
      const int s = s0 - 15 + i;
      ca[q] = make_uint4(0u, 0u, 0u, 0u); cg[q] = ca[q];
      if (i < 62 && s >= 0 && s < seqlen) {
        const u16* zr = p.zc + (long)(row0 - 15 + i) * 512 + k * 8;
        ca[q] = ldg16(zr); cg[q] = ldg16(zr + 256);
      }
    }
#pragma unroll
    for (int q = 0; q < 8; q++) {
      const int id = tid + 256 * q, i = id >> 5, k = id & 31;
      if (i < 62) {
        float4 u0, u1;
        u0.x = bf_lo(ca[q].x) * sigmoidf_(bf_lo(cg[q].x)); u0.y = bf_hi(ca[q].x) * sigmoidf_(bf_hi(cg[q].x));
        u0.z = bf_lo(ca[q].y) * sigmoidf_(bf_lo(cg[q].y)); u0.w = bf_hi(ca[q].y) * sigmoidf_(bf_hi(cg[q].y));
        u1.x = bf_lo(ca[q].z) * sigmoidf_(bf_lo(cg[q].z)); u1.y = bf_hi(ca[q].z) * sigmoidf_(bf_hi(cg[q].z));
        u1.z = bf_lo(ca[q].w) * sigmoidf_(bf_lo(cg[q].w)); u1.w = bf_hi(ca[q].w) * sigmoidf_(bf_hi(cg[q].w));
        *(float4*)(U + i * 256 + k * 8) = u0;
        *(float4*)(U + i * 256 + k * 8 + 4) = u1;
      }
    }
  }
  __syncthreads();
  float wv[31];
#pragma unroll
  for (int j = 0; j < 31; j++) wv[j] = p.w_dw[(long)L * 31 * 256 + j * 256 + tid];
  const float bias = p.b_dw[L * 256 + tid];
#pragma unroll 2
  for (int t = 0; t < 32; t++) {
    float acc = bias;
#pragma unroll
    for (int j = 0; j < 31; j++) acc += U[(t + j) * 256 + tid] * wv[j];
    U[t * 256 + tid] = acc;
  }
  __syncthreads();
  const float4 gg = *(const float4*)(p.g_cln + L * 256 + lane * 4);
  const float4 bb = *(const float4*)(p.b_cln + L * 256 + lane * 4);
#pragma unroll
  for (int q = 0; q < 8; q++) {
    const int t = w * 8 + q;
    const float4 v = *(const float4*)(U + t * 256 + lane * 4);
    const float mu = wave_sum(v.x + v.y + v.z + v.w) * (1.0f / 256.0f);
    const float d0 = v.x - mu, d1 = v.y - mu, d2 = v.z - mu, d3 = v.w - mu;
    const float var = wave_sum(d0 * d0 + d1 * d1 + d2 * d2 + d3 * d3) * (1.0f / 256.0f);
    const float rs = rsqrtf(var + EPSV);
    const float y0 = siluf_(d0 * rs * gg.x + bb.x), y1 = siluf_(d1 * rs * gg.y + bb.y);
    const float y2 = siluf_(d2 * rs * gg.z + bb.z), y3 = siluf_(d3 * rs * gg.w + bb.w);
    *(uint2*)(p.cv + (long)(row0 + t) * 256 + lane * 4) = make_uint2(pack2(y0, y1), pack2(y2, y3));
  }
}

#ifndef S3_REP_MASK
#define S3_REP_MASK 7
#endif
__device__ __forceinline__ void phase_s3(const Params& p, int L, char* smem, bool rep = false) {
  const int msk = rep ? S3_REP_MASK : 7;
  const int nrt_all = (L == 0) ? 272 : 256;
  const int n_kv = 272 * 8, n_dft = nrt_all * 4, n_cv = nrt_all * 4;
  for (int u = blockIdx.x; u < n_kv + n_dft + n_cv; u += gridDim.x) {
#ifndef S3_MASK
#define S3_MASK 7
#endif
    if (u < n_kv) { if (msk & 1) unit_kv(p, L, u >> 3, u & 7, smem); }
    else if (u < n_kv + n_dft) { const int v = u - n_kv; const int ut = v >> 2; if (msk & 2) unit_chdft(p, ut < 256 ? ut : ut - 256, v & 3, ut < 256, smem); }
    else { if (msk & 4) unit_conv(p, L, u - n_kv - n_dft, smem); }
  }
}

#define KLD 104
__device__ __forceinline__ void unit_attn(const Params& p, int L, int b, int h, int qt, bool isctx, char* smem) {
  const int tid = TIDX, lane = tid & 63, w = tid >> 6, hh = lane >> 5, c = lane & 31;
  const int qrow0 = isctx ? (TLAT + b * CTXL + qt * 128) : (b * SEQ + qt * 128);
  const int nkt = isctx ? (CTXL / 64) : (SKEYS / 64);
  u16* As = (u16*)smem;
  u16* Bs = (u16*)(smem + 128 * LDT * 2);
  u16* Qs = (u16*)(smem + (128 + 96) * LDT * 2);
  f32x16 aq[3];
#pragma unroll
  for (int r = 0; r < 16; r++) { aq[0][r] = 0.f; aq[1][r] = 0.f; aq[2][r] = 0.f; }
  float ssq = 0.f;
  const u16* cqp = p.cq + (long)qrow0 * 256;
  const u16* wqp = p.WuqT + (long)L * WUQ_SZ + (long)h * 96 * 256;
  for (int kc = 0; kc < 4; kc++) {
    __syncthreads();
#pragma unroll
    for (int i = 0; i < 4; i++) {
      const int idx = tid + 256 * i, rw = idx >> 3, ch = idx & 7;
      *(uint4*)(As + rw * LDT + ch * 8) = ldg16(cqp + rw * 256 + kc * 64 + ch * 8);
    }
#pragma unroll
    for (int i = 0; i < 3; i++) {
      const int idx = tid + 256 * i, rw = idx >> 3, ch = idx & 7;
      *(uint4*)(Bs + rw * LDT + ch * 8) = ldg16(wqp + rw * 256 + kc * 64 + ch * 8);
    }
    __syncthreads();
#pragma unroll
    for (int q = 0; q < 4; q++) {
      uint4 v = *(const uint4*)(As + (32 * w + c) * LDT + hh * 32 + q * 8);
      float a;
      a = bf_lo(v.x); ssq += a * a; a = bf_hi(v.x); ssq += a * a;
      a = bf_lo(v.y); ssq += a * a; a = bf_hi(v.y); ssq += a * a;
      a = bf_lo(v.z); ssq += a * a; a = bf_hi(v.z); ssq += a * a;
      a = bf_lo(v.w); ssq += a * a; a = bf_hi(v.w); ssq += a * a;
    }
#pragma unroll
    for (int kk = 0; kk < 4; kk++) {
      uint4 a = *(const uint4*)(As + (32 * w + c) * LDT + kk * 16 + hh * 8);
#pragma unroll
      for (int j = 0; j < 3; j++) {
        uint4 bq = *(const uint4*)(Bs + (32 * j + c) * LDT + kk * 16 + hh * 8);
        aq[j] = mfma32(a, bq, aq[j]);
      }
    }
  }
  ssq += __shfl_xor(ssq, 32);
  const float rr_lane = rsqrtf(ssq * (1.0f / 256.0f) + EPSV);
  {
    const float* gqn = p.g_qn + L * 96;
    const float g0 = gqn[c], g1 = gqn[32 + c], g2 = gqn[64 + c];
    const float qscale = 0.10206207261596577f * 1.4426950408889634f;
    u16* Qw = Qs + w * 32 * KLD;
#pragma unroll
    for (int r = 0; r < 16; r++) {
      const int rl = (r & 3) + 8 * (r >> 2) + 4 * hh;
      const float rc = __shfl(rr_lane, rl);
      const float q0 = aq[0][r] * rc, q1 = aq[1][r] * rc, q2 = aq[2][r] * rc;
      const float ss = half_sum(q0 * q0 + q1 * q1 + q2 * q2);
      const float rq = rsqrtf(ss * (1.0f / 96.0f) + EPSV);
      const float qn2 = q2 * rq * g2;
      const float partner = __shfl_xor(qn2, 8);
      float o2 = qn2;
      if (!isctx) {
        const int s = qt * 128 + 32 * w + rl;
        const int pos = (c < 16) ? (s >> 6) : (s & 63);
        const float2 cs = *(const float2*)(p.ropetab + (pos * 8 + (c & 7)) * 2);
        const float rot = (c & 8) ? partner : -partner;
        o2 = qn2 * cs.x + rot * cs.y;
      }
      Qw[rl * KLD + c] = tobf(q0 * rq * g0 * qscale);
      Qw[rl * KLD + 32 + c] = tobf(q1 * rq * g1 * qscale);
      Qw[rl * KLD + 64 + c] = tobf(o2 * qscale);
    }
  }
  __syncthreads();
  uint4 qf[6];
#pragma unroll
  for (int s = 0; s < 6; s++) qf[s] = *(const uint4*)(Qs + (w * 32 + c) * KLD + s * 16 + hh * 8);
  __syncthreads();
  u16* Ks = (u16*)smem;
  u16* Vs = (u16*)(smem + 2 * 64 * KLD * 2);
  const u16* kg = p.Kb + (long)(b * 8 + h) * SKEYS * 96;
  const u16* vg = p.Vtb + (long)(b * 8 + h) * 64 * SKEYS;
  uint4 rk[3], rv[2];
  int krow[3], kch[3];
#pragma unroll
  for (int i = 0; i < 3; i++) { const int idx = tid + 256 * i; krow[i] = idx / 12; kch[i] = idx % 12; }
  const int vrow = tid >> 3, vch = tid & 7;
#pragma unroll
  for (int i = 0; i < 3; i++) rk[i] = ldg16(kg + (long)(tid + 256 * i) * 8);
#pragma unroll
  for (int i = 0; i < 2; i++) rv[i] = ldg16(vg + (long)(vrow + 32 * i) * SKEYS + vch * 8);
#pragma unroll
  for (int i = 0; i < 3; i++) *(uint4*)(Ks + krow[i] * KLD + kch[i] * 8) = rk[i];
#pragma unroll
  for (int i = 0; i < 2; i++) *(uint4*)(Vs + (vrow + 32 * i) * LDT + vch * 8) = rv[i];
  __syncthreads();
  f32x16 aO[2];
#pragma unroll
  for (int r = 0; r < 16; r++) { aO[0][r] = 0.f; aO[1][r] = 0.f; }
  float mref = 0.f;
  f32x2 lsum2 = {0.f, 0.f};
  const int kperm = (c & ~12) | ((c & 4) << 1) | ((c & 8) >> 1);
  for (int kt = 0; kt < nkt; kt++) {
    const int cur = kt & 1;
    if (kt + 1 < nkt) {
#pragma unroll
      for (int i = 0; i < 3; i++) rk[i] = ldg16(kg + (long)(kt + 1) * 64 * 96 + (long)(tid + 256 * i) * 8);
#pragma unroll
      for (int i = 0; i < 2; i++) rv[i] = ldg16(vg + (long)(vrow + 32 * i) * SKEYS + (kt + 1) * 64 + vch * 8);
    }
    __builtin_amdgcn_sched_barrier(0);
    const u16* Kc = Ks + cur * 64 * KLD;
    const u16* Vc = Vs + cur * 64 * LDT;
    f32x16 aS[2];
    {
      const float nm = -mref;
#pragma unroll
      for (int r = 0; r < 16; r++) { aS[0][r] = nm; aS[1][r] = nm; }
    }
#pragma unroll
    for (int s = 0; s < 6; s++) {
      uint4 k0 = *(const uint4*)(Kc + (kperm) * KLD + s * 16 + hh * 8);
      uint4 k1 = *(const uint4*)(Kc + (32 + kperm) * KLD + s * 16 + hh * 8);
      aS[0] = mfma32(k0, qf[s], aS[0]);
      aS[1] = mfma32(k1, qf[s], aS[1]);
    }
    float mx = fmaxf(aS[0][0], aS[1][0]);
#pragma unroll
    for (int r = 1; r < 16; r++) mx = fmaxf(fmaxf(mx, aS[0][r]), aS[1][r]);
    if (__any(mx > 8.0f)) {
      const float mo = fmaxf(mx, __shfl_xor(mx, 32));
      const float delta = (mo > 8.0f) ? mo : 0.f;
      const float alpha = __builtin_amdgcn_exp2f(-delta);
      mref += delta;
      lsum2 *= alpha;
#pragma unroll
      for (int r = 0; r < 16; r++) {
        aO[0][r] *= alpha; aO[1][r] *= alpha;
        aS[0][r] -= delta; aS[1][r] -= delta;
      }
    }
#pragma unroll
    for (int r = 0; r < 16; r += 2) {
      aS[0][r] = __builtin_amdgcn_exp2f(aS[0][r]); aS[0][r + 1] = __builtin_amdgcn_exp2f(aS[0][r + 1]);
      aS[1][r] = __builtin_amdgcn_exp2f(aS[1][r]); aS[1][r + 1] = __builtin_amdgcn_exp2f(aS[1][r + 1]);
      const f32x2 p0 = {aS[0][r], aS[0][r + 1]}, p1 = {aS[1][r], aS[1][r + 1]};
      lsum2 += p0; lsum2 += p1;
    }
#pragma unroll
    for (int i = 0; i < 2; i++)
#pragma unroll
      for (int s2 = 0; s2 < 2; s2++) {
        uint4 pf = make_uint4(pack2(aS[i][8 * s2 + 0], aS[i][8 * s2 + 1]), pack2(aS[i][8 * s2 + 2], aS[i][8 * s2 + 3]),
                              pack2(aS[i][8 * s2 + 4], aS[i][8 * s2 + 5]), pack2(aS[i][8 * s2 + 6], aS[i][8 * s2 + 7]));
        uint4 v0 = *(const uint4*)(Vc + (c) * LDT + 32 * i + 16 * s2 + 8 * hh);
        uint4 v1 = *(const uint4*)(Vc + (32 + c) * LDT + 32 * i + 16 * s2 + 8 * hh);
        aO[0] = mfma32(v0, pf, aO[0]);
        aO[1] = mfma32(v1, pf, aO[1]);
      }
    if (kt + 1 < nkt) {
      const int nx = cur ^ 1;
#pragma unroll
      for (int i = 0; i < 3; i++) *(uint4*)(Ks + nx * 64 * KLD + krow[i] * KLD + kch[i] * 8) = rk[i];
#pragma unroll
      for (int i = 0; i < 2; i++) *(uint4*)(Vs + nx * 64 * LDT + (vrow + 32 * i) * LDT + vch * 8) = rv[i];
    }
    __syncthreads();
  }
  float lsum = lsum2.x + lsum2.y;
  lsum += __shfl_xor(lsum, 32);
  const float inv = 1.0f / lsum;
  u16* Os = (u16*)smem + w * 32 * LDT;
#pragma unroll
  for (int i = 0; i < 2; i++)
#pragma unroll
    for (int r = 0; r < 16; r++) {
      const int d = 32 * i + (r & 3) + 8 * (r >> 2) + 4 * hh;
      Os[c * LDT + d] = tobf(aO[i][r] * inv);
    }
  __syncthreads();
#pragma unroll
  for (int i = 0; i < 4; i++) {
    const int idx = lane + 64 * i, q = idx >> 3, ch = idx & 7;
    *(uint4*)(p.Ob + (long)(qrow0 + 32 * w + q) * 512 + h * 64 + ch * 8) = *(const uint4*)(Os + q * LDT + ch * 8);
  }
}

__device__ __forceinline__ void unit_dftA(const Params& p, int b, int np, char* smem) {
  const int lane = TIDX & 63, w = TIDX >> 6, wr = w >> 1, wc = w & 1, hh = lane >> 5, c = lane & 31;
  f32x16 acc[2][2];
  ZERO_ACC(acc);
  gemm128(p.WA, 128, p.Ytl + (long)(b * 256 + 2 * np) * 64 * 128, 128, 128, acc, smem);
  const int n = 2 * np + wc;
#pragma unroll
  for (int jj = 0; jj < 2; jj++) {
    const int t2 = jj * 32 + c;
#pragma unroll
    for (int r = 0; r < 16; r++) {
      const int k1 = wr * 32 + (r & 3) + 8 * (r >> 2) + 4 * hh;
      const float2 t = *(const float2*)(p.tw + 2 * ((k1 * t2) & 4095));
      const float gr = acc[0][jj][r], gi = acc[1][jj][r];
      u16* dst = p.GB + ((long)((b * 64 + k1) * 256 + n)) * 128 + t2;
      dst[0] = tobf(gr * t.x + gi * t.y);
      dst[64] = tobf(gi * t.x - gr * t.y);
    }
  }
}
__device__ __forceinline__ void unit_dftC(const Params& p, int b, int k1, int nt, char* smem) {
  const int lane = TIDX & 63, w = TIDX >> 6, wr = w >> 1, wc = w & 1, hh = lane >> 5, c = lane & 31;
  f32x16 acc[2][2];
  ZERO_ACC(acc);
  gemm128(p.WC, 128, p.GB + ((long)((b * 64 + k1) * 256 + nt * 128)) * 128, 128, 128, acc, smem);
  if (wr == 0) {
#pragma unroll
    for (int i = 0; i < 2; i++)
#pragma unroll
      for (int jj = 0; jj < 2; jj++)
#pragma unroll
        for (int r = 0; r < 16; r++) {
          const int k2 = i * 32 + (r & 3) + 8 * (r >> 2) + 4 * hh;
          p.Fb[((long)b * SEQ + k1 + 64 * k2) * 256 + nt * 128 + wc * 64 + jj * 32 + c] = tobf(acc[i][jj][r]);
        }
  }
}
__device__ __forceinline__ void unit_seqdft_ctx(const Params& p, int b, int mt, int nt, char* smem) {
  const int lane = TIDX & 63, w = TIDX >> 6, wr = w >> 1, wc = w & 1;
  f32x16 acc[2][2];
  ZERO_ACC(acc);
  gemm128(p.Dctx + (long)mt * 128 * 512, 512, p.Ytc + (long)(b * 256 + nt * 128) * 512, 512, 512, acc, smem);
  const long orow0 = (long)TLAT + b * CTXL + mt * 128;
#pragma unroll
  for (int i = 0; i < 2; i++)
#pragma unroll
    for (int j = 0; j < 2; j++)
#pragma unroll
      for (int r = 0; r < 16; r++)
        p.Fb[(orow0 + ACC_ROW(wr, i, r, lane)) * 256 + nt * 128 + ACC_COL(wc, j, lane)] = tobf(acc[i][j][r]);
}
__device__ __forceinline__ void phase_dftC(const Params& p, char* smem) {
  for (int u = blockIdx.x; u < 8 * 64 * 2; u += gridDim.x) unit_dftC(p, u >> 7, (u >> 1) & 63, u & 1, smem);
}

__device__ __forceinline__ void phase_s4(const Params& p, int L, char* smem) {
  {
    const int x = blockIdx.x & 7, l = blockIdx.x >> 3, nl = gridDim.x >> 3;
    for (int s = l; s < 256; s += nl) {
      const int bh = x * 8 + (s >> 5);
      unit_attn(p, L, bh >> 3, bh & 7, s & 31, false, smem);
    }
  }
  const int n_da = 8 * 128;
  const int n_dc = (L == 0) ? 8 * 2 * 2 : 0, n_ac = (L == 0) ? 8 * 8 * 2 : 0;
  for (int u = blockIdx.x; u < n_da + n_dc + n_ac; u += gridDim.x) {
    int v = u;
    if (v < n_da) { unit_dftA(p, v >> 7, v & 127, smem); continue; }
    v -= n_da;
    if (v < n_dc) { unit_seqdft_ctx(p, v >> 2, (v >> 1) & 1, v & 1, smem); continue; }
    v -= n_dc;
    unit_attn(p, L, v >> 4, (v >> 1) & 7, v & 1, true, smem);
  }
}

__device__ __forceinline__ void phase_s7(const Params& p, int L, char* smem) {
  const int nrt = (L == 0) ? 272 : 256;
  FOR_UNITS_XCD(nrt, 8, rt, ct)
    const int row0 = rt * 128;
    f32x16 macc[2][2];
    ZERO_ACC(macc);
#pragma unroll 1
    for (int br = 0; br < 3; br++) {
      unsigned gp[2][2][8];
      {
      f32x16 acc[2][2];
      ZERO_ACC(acc);
      gemm128(p.hx + (long)row0 * 1024, 1024, p.WgT + (long)L * WGT_SZ + (long)(br * 1024 + ct * 128) * 1024, 1024, 1024, acc, smem);
#pragma unroll
      for (int i = 0; i < 2; i++)
#pragma unroll
        for (int j = 0; j < 2; j++)
#pragma unroll
          for (int r = 0; r < 8; r++) gp[i][j][r] = pack2(sigmoidf_(acc[i][j][2 * r]), sigmoidf_(acc[i][j][2 * r + 1]));
      }
      const u16* A2; const u16* B2; int K2;
      if (br == 0) { A2 = p.Ob + (long)row0 * 512; B2 = p.WbaT + (long)L * WBA_SZ + (long)ct * 128 * 512; K2 = 512; }
      else if (br == 1) { A2 = p.Fb + (long)row0 * 256; B2 = p.WbfT + (long)L * WBF_SZ + (long)ct * 128 * 256; K2 = 256; }
      else { A2 = p.cv + (long)row0 * 256; B2 = p.WbcT + (long)L * WBC_SZ + (long)ct * 128 * 256; K2 = 256; }
#pragma unroll
      for (int jh = 0; jh < 2; jh++) {
        f32x16 ah[2];
#pragma unroll
        for (int r = 0; r < 16; r++) { ah[0][r] = 0.f; ah[1][r] = 0.f; }
        gemm128h(A2, K2, B2, K2, K2, jh, ah, smem);
#pragma unroll
        for (int i = 0; i < 2; i++)
#pragma unroll
          for (int r = 0; r < 8; r++) {
            if ((ABL_BR >> br) & 1) {
            macc[i][jh][2 * r] += bf_lo(gp[i][jh][r]) * ah[i][2 * r];
            macc[i][jh][2 * r + 1] += bf_hi(gp[i][jh][r]) * ah[i][2 * r + 1];
            }
          }
      }
    }
    u16* mp = p.m + (long)row0 * 1024 + ct * 128;
    const int tid = TIDX, lane = tid & 63, w = tid >> 6, wr = w >> 1, wc = w & 1;
    const int tb = (wr * 64 + 4 * (lane >> 5)) * 1024 + wc * 64 + (lane & 31);
#pragma unroll
    for (int i = 0; i < 2; i++)
#pragma unroll
      for (int j = 0; j < 2; j++)
#pragma unroll
        for (int r = 0; r < 16; r++)
          mp[tb + (i * 32 + (r & 3) + 8 * (r >> 2)) * 1024 + j * 32] = tobf(macc[i][j][r]);
  }
}

__device__ __forceinline__ void phase_s8(const Params& p, int L, char* smem, bool dry = false) {
  const int lane = TIDX & 63, w = TIDX >> 6, wr = w >> 1, wc = w & 1;
  const int nrt = (L == 0) ? 272 : 256;
  FOR_UNITS_XCD(nrt, 8, rt, ct)
    const long row0 = (long)rt * 128;
    f32x16 acc[2][2];
    ZERO_ACC(acc);
    gemm128(p.m + row0 * 1024, 1024, p.WoutT + (long)L * WOUT_SZ + (long)ct * 128 * 1024, 1024, 1024, acc, smem);
    const int mr = row_mod((int)row0);
    const float* gt = p.mods + (long)(L * 9 + mr) * 6144 + 2048 + ct * 128;
    const float* src; float* dst;
    if (row0 < TLAT) { src = (L == 0 ? p.x : p.out) + row0 * 1024; dst = p.out + row0 * 1024; }
    else { src = (L == 0 ? p.ctx : p.ctx1) + (row0 - TLAT) * 1024; dst = p.ctx1 + (row0 - TLAT) * 1024; }
    src += ct * 128; dst += ct * 128;
    const int tb = opaque((wr * 64 + 4 * (lane >> 5)) * 1024 + wc * 64 + (lane & 31));
#pragma unroll
    for (int j = 0; j < 2; j++) {
      const float gv = gt[ACC_COL(wc, j, lane)];
#pragma unroll
      for (int i = 0; i < 2; i++)
#pragma unroll
        for (int r = 0; r < 16; r++) {
          const int o = tb + (i * 32 + (r & 3) + 8 * (r >> 2)) * 1024 + j * 32;
          const float nv = src[o] + gv * acc[i][j][r];
          if (!dry) dst[o] = nv;
        }
    }
  }
}

#define CE_DESC(a, b) { const float _x = fmaxf(a, b); const float _y = fminf(a, b); a = _x; b = _y; }
template <int N>
__device__ __forceinline__ void bitonic_sort_desc(float (&v)[N]) {
#pragma unroll
  for (int k = 2; k <= N; k <<= 1)
#pragma unroll
    for (int j = k >> 1; j > 0; j >>= 1)
#pragma unroll
      for (int i = 0; i < N; i++) {
        const int l = i ^ j;
        if (l > i) {
          if ((i & k) == 0) { CE_DESC(v[i], v[l]); } else { CE_DESC(v[l], v[i]); }
        }
      }
}
template <int N>
__device__ __forceinline__ void bitonic_merge_desc(float (&v)[N]) {
#pragma unroll
  for (int j = N >> 1; j > 0; j >>= 1)
#pragma unroll
    for (int i = 0; i < N; i++) {
      const int l = i ^ j;
      if (l > i) { CE_DESC(v[i], v[l]); }
    }
}
__device__ __forceinline__ void merge_top16(float (&a)[16], const float (&b)[16]) {
#pragma unroll
  for (int i = 0; i < 16; i++) a[i] = fmaxf(a[i], b[15 - i]);
  bitonic_merge_desc<16>(a);
}
__device__ __forceinline__ void top16_of_tiles(const f32x16 (&s)[4], int hh, float (&res)[16]) {
  float g[4][16];
#pragma unroll
  for (int t = 0; t < 4; t++) {
#pragma unroll
    for (int r = 0; r < 16; r++) {
      const unsigned key = (unsigned)(32 * t + (r & 3) + 8 * (r >> 2)) + (unsigned)(4 * hh);
      g[t][r] = __uint_as_float((__float_as_uint(s[t][r]) & 0xffffff80u) | key);
    }
    bitonic_sort_desc<16>(g[t]);
  }
  merge_top16(g[0], g[1]);
  merge_top16(g[2], g[3]);
  merge_top16(g[0], g[2]);
  float o[16];
#pragma unroll
  for (int i = 0; i < 16; i++) o[i] = __shfl_xor(g[0][i], 32);
  merge_top16(g[0], o);
#pragma unroll
  for (int i = 0; i < 16; i++) res[i] = g[0][i];
}

__device__ __forceinline__ void unit_peer_query(const Params& p, int L, int rt, int h, char* smem) {
  const int tid = TIDX, lane = tid & 63, w = tid >> 6, wr = w >> 1, wc = w & 1, hh = lane >> 5, c = lane & 31;
  const long row0 = (long)rt * 128;
  u16* Qs = (u16*)smem;
  u16* Ss = (u16*)(smem + 128 * 136 * 2);
  {
    f32x16 acc[2][2];
    ZERO_ACC(acc);
    gemm128(p.hx + row0 * 1024, 1024, p.WqT + (long)L * WQ_SZ + (long)h * 128 * 1024, 1024, 1024, acc, smem);
#pragma unroll
    for (int i = 0; i < 2; i++)
#pragma unroll
      for (int j = 0; j < 2; j++)
#pragma unroll
        for (int r = 0; r < 16; r++) Qs[ACC_ROW(wr, i, r, lane) * 136 + ACC_COL(wc, j, lane)] = tobf(acc[i][j][r]);
    const u16* sk = p.SubK + (long)L * SUBK_SZ + (long)h * 2 * 128 * 64;
#pragma unroll
    for (int i = 0; i < 8; i++) {
      const int idx = tid + 256 * i, rw = idx >> 3, ch = idx & 7;
      *(uint4*)(Ss + rw * LDT + ch * 8) = ldg16(sk + rw * 64 + ch * 8);
    }
  }
  __syncthreads();
  float top[2][16];
#pragma unroll
  for (int pp = 0; pp < 2; pp++) {
    f32x16 s[4];
#pragma unroll
    for (int t = 0; t < 4; t++)
#pragma unroll
      for (int r = 0; r < 16; r++) s[t][r] = 0.f;
#pragma unroll
    for (int kk = 0; kk < 4; kk++) {
      uint4 bq = *(const uint4*)(Qs + (32 * w + c) * 136 + pp * 64 + kk * 16 + hh * 8);
#pragma unroll
      for (int t = 0; t < 4; t++) {
        uint4 ak = *(const uint4*)(Ss + (pp * 128 + 32 * t + c) * LDT + kk * 16 + hh * 8);
        s[t] = mfma32(ak, bq, s[t]);
      }
    }
    top16_of_tiles(s, hh, top[pp]);
  }
  float cand[64];
#define CAND(q, a, b) cand[q] = __uint_as_float((__float_as_uint(top[0][a] + top[1][b]) & 0xffffff00u) | (unsigned)((a) * 16 + (b)));
  CAND(0, 0, 0)
  CAND(1, 0, 1)
  CAND(2, 0, 2)
  CAND(3, 0, 3)
  CAND(4, 0, 4)
  CAND(5, 0, 5)
  CAND(6, 0, 6)
  CAND(7, 0, 7)
  CAND(8, 0, 8)
  CAND(9, 0, 9)
  CAND(10, 0, 10)
  CAND(11, 0, 11)
  CAND(12, 0, 12)
  CAND(13, 0, 13)
  CAND(14, 0, 14)
  CAND(15, 0, 15)
  CAND(16, 1, 0)
  CAND(17, 1, 1)
  CAND(18, 1, 2)
  CAND(19, 1, 3)
  CAND(20, 1, 4)
  CAND(21, 1, 5)
  CAND(22, 1, 6)
  CAND(23, 1, 7)
  CAND(24, 2, 0)
  CAND(25, 2, 1)
  CAND(26, 2, 2)
  CAND(27, 2, 3)
  CAND(28, 2, 4)
  CAND(29, 3, 0)
  CAND(30, 3, 1)
  CAND(31, 3, 2)
  CAND(32, 3, 3)
  CAND(33, 4, 0)
  CAND(34, 4, 1)
  CAND(35, 4, 2)
  CAND(36, 5, 0)
  CAND(37, 5, 1)
  CAND(38, 6, 0)
  CAND(39, 6, 1)
  CAND(40, 7, 0)
  CAND(41, 7, 1)
  CAND(42, 8, 0)
  CAND(43, 9, 0)
  CAND(44, 10, 0)
  CAND(45, 11, 0)
  CAND(46, 12, 0)
  CAND(47, 13, 0)
  CAND(48, 14, 0)
  CAND(49, 15, 0)
#undef CAND
#pragma unroll
  for (int q = 50; q < 64; q++) cand[q] = -3.0e38f;
  float best[16];
  {
    float g[4][16];
#pragma unroll
    for (int t = 0; t < 4; t++) {
#pragma unroll
      for (int r = 0; r < 16; r++) g[t][r] = cand[t * 16 + r];
      bitonic_sort_desc<16>(g[t]);
    }
    merge_top16(g[0], g[1]);
    merge_top16(g[2], g[3]);
    merge_top16(g[0], g[2]);
#pragma unroll
    for (int i = 0; i < 16; i++) best[i] = g[0][i];
  }
  float e[16], es = 0.f;
#pragma unroll
  for (int i = 0; i < 16; i++) { e[i] = __expf(best[i] - best[0]); es += e[i]; }
  const float einv = 1.0f / es;
  __syncthreads();
  int* Ix = (int*)smem + w * 32 * 33;
  if (hh == 0) {
#pragma unroll
    for (int i = 0; i < 16; i++) {
      Ix[c * 33 + i] = (int)(__float_as_uint(top[0][i]) & 127u);
      Ix[c * 33 + 16 + i] = (int)(__float_as_uint(top[1][i]) & 127u);
    }
  }
  __syncthreads();
  const long orow = row0 + 32 * w + c;
  int* ed = p.eid + orow * 128 + h * 16 + hh * 8;
  float* gd = p.gate + orow * 128 + h * 16 + hh * 8;
  int ev[8]; float gv[8];
#pragma unroll
  for (int i = 0; i < 8; i++) {
    const unsigned hm = 0u - (unsigned)hh;
    const unsigned bselu = (__float_as_uint(best[8 + i]) & hm) | (__float_as_uint(best[i]) & ~hm);
    const float esel = __uint_as_float((__float_as_uint(e[8 + i]) & hm) | (__float_as_uint(e[i]) & ~hm));
    const unsigned id = bselu & 255u;
    const int ia = Ix[c * 33 + (id >> 4)], ib = Ix[c * 33 + 16 + (id & 15)];
    ev[i] = ia * 128 + ib;
    gv[i] = esel * einv;
  }
  *(int4*)(ed) = make_int4(ev[0], ev[1], ev[2], ev[3]);
  *(int4*)(ed + 4) = make_int4(ev[4], ev[5], ev[6], ev[7]);
  *(float4*)(gd) = make_float4(gv[0], gv[1], gv[2], gv[3]);
  *(float4*)(gd + 4) = make_float4(gv[4], gv[5], gv[6], gv[7]);
}

__device__ __forceinline__ void phase_s10(const Params& p, int L, char* smem) {
  const int nrt = (L == 0) ? 272 : 256;
  FOR_UNITS_XCD(nrt, 8, rt, hd) unit_peer_query(p, L, rt, hd, smem); }
}

#define CVT8(w, lo2, hi2) { lo2 = __builtin_amdgcn_cvt_pk_f32_fp8((int)(w), false); hi2 = __builtin_amdgcn_cvt_pk_f32_fp8((int)(w), true); }
#if CHECK_ATTN
#define NB11 1
#else
#define NB11 2
#endif
__device__ __forceinline__ void phase_s11a(const Params& p, int L) {
  const int lane = TIDX & 63, j = lane >> 3, cch = lane & 7;
  const int sl = blockIdx.x & 7;
  const int lw = (blockIdx.x >> 3) * 4 + (TIDX >> 6), nlw = (gridDim.x >> 3) * 4;
  const int nrows = (L == 0) ? RTOT : TLAT;
  const unsigned char* Us = p.UT8 + (long)sl * NEXP * 128 + cch * 16;
  for (int r0 = lw; r0 < nrows; r0 += NB11 * nlw) {
    int rr[NB11]; bool ok[NB11];
    uint4 ha[NB11], hb[NB11]; int e_lo[NB11], e_hi[NB11];
#pragma unroll
    for (int u = 0; u < NB11; u++) {
      const int r = r0 + u * nlw;
      ok[u] = r < nrows; rr[u] = ok[u] ? r : r0;
      ha[u] = ldg16(p.hx + (long)rr[u] * 1024 + sl * 128 + cch * 16);
      hb[u] = ldg16(p.hx + (long)rr[u] * 1024 + sl * 128 + cch * 16 + 8);
      e_lo[u] = p.eid[(long)rr[u] * 128 + lane]; e_hi[u] = p.eid[(long)rr[u] * 128 + 64 + lane];
    }
    uint4 uu[NB11][16];
#pragma unroll
    for (int u = 0; u < NB11; u++)
#pragma unroll
      for (int i = 0; i < 16; i++) {
        const int e = __shfl(i < 8 ? e_lo[u] : e_hi[u], 8 * (i & 7) + j);
        uu[u][i] = ldg16(Us + (long)e * 128);
      }
    __builtin_amdgcn_sched_barrier(0);
#pragma unroll
    for (int u = 0; u < NB11; u++) {
      f32x2 h2[8];
      h2[0] = f32x2{bf_lo(ha[u].x), bf_hi(ha[u].x)}; h2[1] = f32x2{bf_lo(ha[u].y), bf_hi(ha[u].y)};
      h2[2] = f32x2{bf_lo(ha[u].z), bf_hi(ha[u].z)}; h2[3] = f32x2{bf_lo(ha[u].w), bf_hi(ha[u].w)};
      h2[4] = f32x2{bf_lo(hb[u].x), bf_hi(hb[u].x)}; h2[5] = f32x2{bf_lo(hb[u].y), bf_hi(hb[u].y)};
      h2[6] = f32x2{bf_lo(hb[u].z), bf_hi(hb[u].z)}; h2[7] = f32x2{bf_lo(hb[u].w), bf_hi(hb[u].w)};
      float d[16];
#pragma unroll
      for (int i = 0; i < 16; i++) {
        f32x2 a0, a1, acc = {0.f, 0.f};
        CVT8(uu[u][i].x, a0, a1); acc += a0 * h2[0]; acc += a1 * h2[1];
        CVT8(uu[u][i].y, a0, a1); acc += a0 * h2[2]; acc += a1 * h2[3];
        CVT8(uu[u][i].z, a0, a1); acc += a0 * h2[4]; acc += a1 * h2[5];
        CVT8(uu[u][i].w, a0, a1); acc += a0 * h2[6]; acc += a1 * h2[7];
        d[i] = acc.x + acc.y;
      }
      float t8[8], t4[4], t2[2];
      { const bool up = (lane & 4) != 0;
#pragma unroll
        for (int k = 0; k < 8; k++) { const float send = up ? d[k] : d[k + 8], keep = up ? d[k + 8] : d[k]; t8[k] = keep + __shfl_xor(send, 4); } }
      { const bool up = (lane & 2) != 0;
#pragma unroll
        for (int k = 0; k < 4; k++) { const float send = up ? t8[k] : t8[k + 4], keep = up ? t8[k + 4] : t8[k]; t4[k] = keep + __shfl_xor(send, 2); } }
      { const bool up = (lane & 1) != 0;
#pragma unroll
        for (int k = 0; k < 2; k++) { const float send = up ? t4[k] : t4[k + 2], keep = up ? t4[k + 2] : t4[k]; t2[k] = keep + __shfl_xor(send, 1); } }
      if (ok[u]) p.PD[((long)sl * RTOT + rr[u]) * 64 + cch * 8 + j] = pack2(t2[0], t2[1]);
    }
  }
}
__device__ __forceinline__ void phase_s11b(const Params& p, int L, bool dry = false) {
  const int lane = TIDX & 63, j = lane >> 3, cch = lane & 7;
  const int sl = blockIdx.x & 7;
  const int lw = (blockIdx.x >> 3) * 4 + (TIDX >> 6), nlw = (gridDim.x >> 3) * 4;
  const int nrows = (L == 0) ? RTOT : TLAT;
  const unsigned char* Vs = p.VT8 + (long)sl * NEXP * 128 + cch * 16;
  const int P0 = 16 * (lane >> 3) + (lane & 7);
  const int col = sl * 128 + cch * 16 + 2 * j;
  for (int r0 = lw; r0 < nrows; r0 += NB11 * nlw) {
    int rr[NB11]; bool ok[NB11];
    unsigned pw[NB11][8]; float g0[NB11], g1[NB11]; int e_lo[NB11], e_hi[NB11];
#pragma unroll
    for (int u = 0; u < NB11; u++) {
      const int r = r0 + u * nlw;
      ok[u] = r < nrows; rr[u] = ok[u] ? r : r0;
#pragma unroll
      for (int s2 = 0; s2 < 8; s2++) pw[u][s2] = p.PD[((long)s2 * RTOT + rr[u]) * 64 + lane];
      g0[u] = p.gate[(long)rr[u] * 128 + P0]; g1[u] = p.gate[(long)rr[u] * 128 + P0 + 8];
      e_lo[u] = p.eid[(long)rr[u] * 128 + lane]; e_hi[u] = p.eid[(long)rr[u] * 128 + 64 + lane];
    }
    uint4 vv[NB11][16];
#pragma unroll
    for (int u = 0; u < NB11; u++)
#pragma unroll
      for (int i = 0; i < 16; i++) {
        const int e = __shfl(i < 8 ? e_lo[u] : e_hi[u], 8 * (i & 7) + j);
        vv[u][i] = ldg16(Vs + (long)e * 128);
      }
    __builtin_amdgcn_sched_barrier(0);
#pragma unroll
    for (int u = 0; u < NB11; u++) {
      float d0 = 0.f, d1 = 0.f;
#pragma unroll
      for (int s2 = 0; s2 < 8; s2++) { d0 += bf_lo(pw[u][s2]); d1 += bf_hi(pw[u][s2]); }
      const float act0 = gelu_tanh(d0 * (1.0f / U8_SCALE)) * g0[u] * (1.0f / V8_SCALE);
      const float act1 = gelu_tanh(d1 * (1.0f / U8_SCALE)) * g1[u] * (1.0f / V8_SCALE);
      f32x2 o2[8];
#pragma unroll
      for (int q = 0; q < 8; q++) o2[q] = f32x2{0.f, 0.f};
#pragma unroll
      for (int i = 0; i < 16; i++) {
        const float a = __shfl((i & 1) ? act1 : act0, (i >> 1) * 8 + j);
        const f32x2 aa = {a, a};
        f32x2 a0, a1;
        CVT8(vv[u][i].x, a0, a1); o2[0] += aa * a0; o2[1] += aa * a1;
        CVT8(vv[u][i].y, a0, a1); o2[2] += aa * a0; o2[3] += aa * a1;
        CVT8(vv[u][i].z, a0, a1); o2[4] += aa * a0; o2[5] += aa * a1;
        CVT8(vv[u][i].w, a0, a1); o2[6] += aa * a0; o2[7] += aa * a1;
      }
      float o[16];
#pragma unroll
      for (int q = 0; q < 8; q++) { o[2 * q] = o2[q].x; o[2 * q + 1] = o2[q].y; }
      float t8[8], t4[4], t2[2];
      { const bool up = (lane & 32) != 0;
#pragma unroll
        for (int k = 0; k < 8; k++) { const float send = up ? o[k] : o[k + 8], keep = up ? o[k + 8] : o[k]; t8[k] = keep + __shfl_xor(send, 32); } }
      { const bool up = (lane & 16) != 0;
#pragma unroll
        for (int k = 0; k < 4; k++) { const float send = up ? t8[k] : t8[k + 4], keep = up ? t8[k + 4] : t8[k]; t4[k] = keep + __shfl_xor(send, 16); } }
      { const bool up = (lane & 8) != 0;
#pragma unroll
        for (int k = 0; k < 2; k++) { const float send = up ? t4[k] : t4[k + 2], keep = up ? t4[k + 2] : t4[k]; t2[k] = keep + __shfl_xor(send, 8); } }
      if (!ABL_PEER || !ok[u]) continue;
      const int r = rr[u];
      float* xr = ((r < TLAT) ? p.out + (long)r * 1024 : p.ctx1 + (long)(r - TLAT) * 1024) + col;
      const float2 gt = *(const float2*)(p.mods + (long)(L * 9 + row_mod(r)) * 6144 + 5120 + col);
      float2 xv = *(const float2*)xr;
      xv.x += gt.x * t2[0]; xv.y += gt.y * t2[1];
      if (!dry) *(float2*)xr = xv;
    }
  }
}


#if CHECK_ATTN
__device__ __forceinline__ float blk_sum(float v, float* red) {
  v = wave_sum(v);
  __syncthreads();
  if ((TIDX & 63) == 0) red[TIDX >> 6] = v;
  __syncthreads();
  return red[0] + red[1] + red[2] + red[3];
}
__device__ __forceinline__ float blk_max(float v, float* red) {
#pragma unroll
  for (int o = 32; o > 0; o >>= 1) v = fmaxf(v, __shfl_xor(v, o));
  __syncthreads();
  if ((TIDX & 63) == 0) red[TIDX >> 6] = v;
  __syncthreads();
  return fmaxf(fmaxf(red[0], red[1]), fmaxf(red[2], red[3]));
}
__device__ __forceinline__ bool far(float got, float ref, float rel, float ab) { return !(fabsf(got - ref) <= rel * fabsf(ref) + ab); }
__device__ __forceinline__ void rope_ref(const float* z, float* o, int s) {
  for (int c = 0; c < 32; c++) {
    const int pos = (c < 16) ? (s / 64) : (s % 64);
    const float inv = powf(10000.0f, -(float)(2 * (c % 8)) / 16.0f);
    const float ang = (float)pos * inv;
    const int cb = c & 16, cc = c & 15;
    const float rot = (cc < 8) ? -z[cb + cc + 8] : z[cb + cc - 8];
    o[c] = z[c] * cosf(ang) + rot * sinf(ang);
  }
}
__device__ __forceinline__ void check_proj(const Params& p, int L, int r, char* smem) {
  float* hrow = (float*)smem;
  float* z = hrow + 1024;
  float* kvr = z + 416;
  float* red = kvr + 1024;
  float* kk = red + 8;
  const int tid = TIDX;
  __syncthreads();
  for (int k = tid; k < 1024; k += 256) hrow[k] = bf1(p.hx[(long)r * 1024 + k]);
  __syncthreads();
  for (int n = tid; n < 416; n += 256) {
    float a = 0.f;
    for (int k = 0; k < 1024; k++) a += hrow[k] * p.w_in[((long)L * 1024 + k) * 4256 + n];
    z[n] = a;
  }
  __syncthreads();
  unsigned bad = 0;
  if (L == 0 || r < TLAT)
  for (int n = tid; n < 256; n += 256) if (far(bf1(p.cq[(long)r * 256 + n]), z[160 + n], 0.02f, 0.03f)) bad |= 1u;
  for (int n = tid; n < 32; n += 256) if (far(p.kr[(long)r * 32 + n], z[128 + n], 0.02f, 0.03f)) bad |= 1u;
  const float ssc = blk_sum(tid < 128 ? z[tid] * z[tid] : 0.f, red);
  const float rc = rsqrtf(ssc / 128.0f + EPSV);
  for (int n = tid; n < 1024; n += 256) {
    float a = 0.f;
    for (int k = 0; k < 128; k++) a += z[k] * rc * p.g_ckv[L * 128 + k] * p.w_ukv[((long)L * 128 + k) * 1024 + n];
    kvr[n] = a;
  }
  __syncthreads();
  const bool lat = r < TLAT;
  const int b = lat ? (r >> 12) : ((r - TLAT) >> 8), s = lat ? (r & 4095) : ((r - TLAT) & 255), kpos = lat ? CTXL + s : s;
  for (int h = 0; h < 8; h++) {
    float sq = 0.f;
    if (tid < 64) sq = kvr[h * 128 + tid] * kvr[h * 128 + tid]; else if (tid < 96) sq = z[128 + tid - 64] * z[128 + tid - 64];
    const float ssk = blk_sum(sq, red);
    const float rk = rsqrtf(ssk / 96.0f + EPSV);
    if (tid == 0) {
      float* zr = kk + 96; float* zo = zr + 32;
      for (int c = 0; c < 32; c++) zr[c] = z[128 + c] * rk * p.g_kn[L * 96 + 64 + c];
      if (lat) rope_ref(zr, zo, s); else for (int c = 0; c < 32; c++) zo[c] = zr[c];
      for (int c = 0; c < 32; c++) kk[64 + c] = zo[c];
    }
    if (tid < 64) kk[tid] = kvr[h * 128 + tid] * rk * p.g_kn[L * 96 + tid];
    __syncthreads();
    if (tid < 96 && far(bf1(p.Kb[((long)(b * 8 + h) * SKEYS + kpos) * 96 + tid]), kk[tid], 0.03f, 0.03f)) bad |= 2u;
    if (tid < 64 && far(bf1(p.Vtb[((long)(b * 8 + h) * 64 + tid) * SKEYS + kpos]), kvr[h * 128 + 64 + tid], 0.03f, 0.03f)) bad |= 4u;
    __syncthreads();
  }
  if (bad & CHECK_MASK) atomicOr(&p.bar[0], bad & CHECK_MASK);
}
__device__ __forceinline__ void check_attn(const Params& p, int L, int r, int h, char* smem) {
  float* cqr = (float*)smem;
  float* q = cqr + 256;
  float* sc = q + 96;
  float* red = sc + 4352;
  const int tid = TIDX;
  const bool lat = r < TLAT;
  const int b = lat ? (r >> 12) : ((r - TLAT) >> 8), s = lat ? (r & 4095) : ((r - TLAT) & 255);
  const int nkeys = lat ? SKEYS : CTXL;
  __syncthreads();
  cqr[tid] = bf1(p.cq[(long)r * 256 + tid]);
  __syncthreads();
  const float rc = rsqrtf(blk_sum(cqr[tid] * cqr[tid], red) / 256.0f + EPSV);
  float qr = 0.f;
  if (tid < 96) for (int k = 0; k < 256; k++) qr += cqr[k] * rc * p.g_cq[L * 256 + k] * p.w_uq[((long)L * 256 + k) * 768 + h * 96 + tid];
  const float rq = rsqrtf(blk_sum(tid < 96 ? qr * qr : 0.f, red) / 96.0f + EPSV);
  if (tid < 96) q[tid] = qr * rq * p.g_qn[L * 96 + tid];
  __syncthreads();
  if (tid == 0 && lat) {
    float* zr = red + 8; float* zo = zr + 32;
    for (int c = 0; c < 32; c++) zr[c] = q[64 + c];
    rope_ref(zr, zo, s);
    for (int c = 0; c < 32; c++) q[64 + c] = zo[c];
  }
  __syncthreads();
  float mx = -1e30f;
  for (int key = tid; key < nkeys; key += 256) {
    float a = 0.f;
    for (int d = 0; d < 96; d++) a += q[d] * bf1(p.Kb[((long)(b * 8 + h) * SKEYS + key) * 96 + d]);
    a *= 0.10206207261596577f;
    sc[key] = a; mx = fmaxf(mx, a);
  }
  mx = blk_max(mx, red);
  float ps = 0.f;
  for (int key = tid; key < nkeys; key += 256) { const float e = expf(sc[key] - mx); sc[key] = e; ps += e; }
  const float tot = blk_sum(ps, red);
  unsigned bad = 0;
  if (tid < 64) {
    float a = 0.f;
    for (int key = 0; key < nkeys; key++) a += sc[key] * bf1(p.Vtb[((long)(b * 8 + h) * 64 + tid) * SKEYS + key]);
    a /= tot;
    if (far(bf1(p.Ob[(long)r * 512 + h * 64 + tid]), a, 0.04f, 1.5e-3f)) bad |= 8u;
  }
  if (bad & CHECK_MASK) atomicOr(&p.bar[0], bad & CHECK_MASK);
}
__device__ __forceinline__ void phase_check(const Params& p, int L, char* smem) {
  const int nq = (L == 0) ? 12 : 8;
  for (int u = blockIdx.x; u < 12 + nq * 8; u += gridDim.x) {
    const int si = (u < 12) ? u : ((u - 12) >> 3);
    int r;
    switch (si) {
      case 0: r = 0; break; case 1: r = 63; break; case 2: r = 64; break; case 3: r = 4095; break;
      case 4: r = 4096 + 777; break; case 5: r = 12345; break; case 6: r = 20000; break; case 7: r = 32767; break;
      case 8: r = TLAT; break; case 9: r = TLAT + 255; break; case 10: r = TLAT + 256 + 100; break; default: r = TLAT + 2047; break;
    }
    if (u < 12) check_proj(p, L, r, smem);
    else check_attn(p, L, r, (u - 12) & 7, smem);
  }
}
#endif

#define XB_TMO      128
#define XB_XCNT(j)  (256  + 64 * (j))
#define XB_XSUB(j)  (1280 + 64 * (j))
#define XB_XGEN(j)  (2304 + 64 * (j))
#define XB_TOP      3328
#define XB_TOPGEN   3392
#define XCD_BAR_WORDS 3456
#define XB_SPIN_CAP (1u << 22)
#define LAS __attribute__((address_space(3)))
__device__ __forceinline__ unsigned xb_ld(unsigned* p)              { return __hip_atomic_load(p, __ATOMIC_RELAXED, __HIP_MEMORY_SCOPE_AGENT); }
__device__ __forceinline__ unsigned xb_add(unsigned* p, unsigned v) { return __hip_atomic_fetch_add(p, v, __ATOMIC_RELAXED, __HIP_MEMORY_SCOPE_AGENT); }
__device__ __forceinline__ unsigned xb_xcc_id() { return (unsigned)__builtin_amdgcn_s_getreg((3 << 11) | 20) & 0xFu; }
#define XB_SPIN(cond, bar) do { unsigned _sp = 0; while (cond) { __builtin_amdgcn_s_sleep(1); \
    if ((++_sp & 255u) == 0u) { if (xb_ld(&(bar)[XB_TMO])) break; if (_sp > XB_SPIN_CAP) { atomicAdd(&(bar)[XB_TMO], 1u); break; } } } } while (0)
struct XcdBarrier { unsigned* bar; unsigned x; volatile LAS unsigned* st; };
__device__ __forceinline__ XcdBarrier xcd_barrier_post(unsigned* bar, volatile LAS unsigned* st) {
  XcdBarrier b; b.bar = bar; b.x = xb_xcc_id(); b.st = st;
  if (threadIdx.x == 0) (void)xb_add(&bar[XB_XCNT(b.x)], 1u);
  return b;
}
__device__ __forceinline__ void xcd_barrier_complete(unsigned* bar, unsigned x, unsigned& nloc, unsigned& nx) {
  const unsigned G = gridDim.x * gridDim.y * gridDim.z;
  unsigned sum, cnt, mine, sp = 0u;
  for (;;) {
    sum = 0u; cnt = 0u; mine = 0u;
#pragma unroll
    for (unsigned j = 0; j < 16; ++j) { const unsigned c = xb_ld(&bar[XB_XCNT(j)]); sum += c; cnt += (c > 0u) ? 1u : 0u; mine = (j == x) ? c : mine; }
    if (sum == G) break;
    __builtin_amdgcn_s_sleep(1);
    if ((++sp & 255u) == 0u) { if (xb_ld(&bar[XB_TMO])) break; if (sp > XB_SPIN_CAP) { atomicAdd(&bar[XB_TMO], 1u); break; } }
  }
  nloc = mine > 0u ? mine : 1u; nx = cnt > 0u ? cnt : 1u;
}
__device__ __forceinline__ void xcd_barrier(const XcdBarrier& b) {
  asm volatile("s_waitcnt vmcnt(0)" ::: "memory");
  __syncthreads();
  if (threadIdx.x == 0) {
    unsigned* bar = b.bar;
    asm volatile("" : "+s"(bar));
    __builtin_amdgcn_s_waitcnt(0);
    unsigned nloc = b.st[0], nx = b.st[1];
    if (nloc == 0u) { xcd_barrier_complete(bar, b.x, nloc, nx); b.st[0] = nloc; b.st[1] = nx; }
    const unsigned old = xb_add(&bar[XB_XSUB(b.x)], 1u);
    const unsigned gen = old / nloc;
    if (old + 1u == (gen + 1u) * nloc) {
      __builtin_amdgcn_fence(__ATOMIC_RELEASE, "agent");
      asm volatile("s_waitcnt vmcnt(0)" ::: "memory");
      const unsigned og = xb_add(&bar[XB_TOP], 1u);
      const unsigned tg = og / nx;
      if (og + 1u == (tg + 1u) * nx) xb_add(&bar[XB_TOPGEN], 1u);
      else XB_SPIN(xb_ld(&bar[XB_TOPGEN]) == tg, bar);
      __builtin_amdgcn_fence(__ATOMIC_ACQUIRE, "agent");
      xb_add(&bar[XB_XGEN(b.x)], 1u);
      asm volatile("s_waitcnt vmcnt(0)" ::: "memory");
    } else {
      XB_SPIN(xb_ld(&bar[XB_XGEN(b.x)]) == gen, bar);
      __builtin_amdgcn_fence(__ATOMIC_ACQUIRE, "agent");
      asm volatile("s_waitcnt vmcnt(0)" ::: "memory");
    }
  }
  __syncthreads();
}

#define NPHASE (23 + CHECK_ATTN)
#ifndef PH_LIMIT
#define PH_LIMIT NPHASE
#endif
__device__ __forceinline__ void run_phase(const Params& p, int ph, char* smem, bool dry = false) {
  if (ph == 0) { phase_prep(p, smem); return; }
#if CHECK_ATTN
  if (ph == 23) {
    if (blockIdx.x == 0 && threadIdx.x == 0 && __hip_atomic_load(&p.bar[0], __ATOMIC_RELAXED, __HIP_MEMORY_SCOPE_AGENT) != 0u) p.out[0] = __uint_as_float(0x7fc00000u);
    return;
  }
#endif
  const int L = (ph - 1) / 11, s = (ph - 1) % 11;
  if (s == 0 || s == 7) {
    phase_norm(p, L, s == 0 ? 0 : 1, (s == 0 || L == 0) ? RTOT : TLAT);
    if (s == 0) phase_tables(p, L);
    return;
  }
  switch (s) {
    case 1: phase_s2(p, L, smem); break;
    case 2: phase_s3(p, L, smem, dry); break;
    case 3: phase_s4(p, L, smem); break;
    case 4: phase_dftC(p, smem);
#if CHECK_ATTN
      phase_check(p, L, smem);
#endif
      break;
    case 5: phase_s7(p, L, smem); break;
    case 6: phase_s8(p, L, smem, dry); break;
    case 8: phase_s10(p, L, smem); break;
    case 9: phase_s11a(p, L); break;
    case 10: phase_s11b(p, L, dry); break;
  }
}

__global__ void __launch_bounds__(256, 2) mega(Params p, int ph0, int ph1) {
  __shared__ __attribute__((aligned(16))) char smem[SMEM_BYTES];
  __shared__ uint4 xb_words;
  cg::grid_group grid = cg::this_grid();
  const bool multi = (ph1 - ph0) > 1;
  XcdBarrier xb;
  if (multi) {
    if (threadIdx.x == 0) xb_words = make_uint4(0u, 0u, 0u, 0u);
    __syncthreads();
    xb = xcd_barrier_post(p.bar, (volatile LAS unsigned*)&xb_words);
  }
  for (int ph = ph0; ph < ph1; ph++) {
    if (ph > ph0) {
      if (ph == ph0 + 1) grid.sync();
      else xcd_barrier(xb);
    }
#if PROBE_S >= 0
    {
      const int kind = (ph == 0) ? 11 : (ph - 1) % 11;
      const int reps = (kind == PROBE_S) ? PROBE_REPS * p.one : 0;
      for (int rep = 0; rep <= reps; rep++) {
        if (rep > 0) xcd_barrier(xb);
        const bool dry = (rep < reps);
        if (kind == PROBE_S) {
          if (kind == 6 || kind == 10 || kind == 2) run_phase(p, ph, smem, dry); else run_phase(p, ph, smem, false);
        } else run_phase(p, ph, smem, false);
      }
    }
#else
    run_phase(p, ph, smem);
#endif
  }
}

static inline size_t al256(size_t x) { return (x + 255) & ~(size_t)255; }
extern "C" void kernel_launch(void* const* d_in, const int* in_sizes, int n_in, void* d_out, int out_size, void* d_ws,
                              size_t ws_size, hipStream_t stream) {
  Params p{};
  const float* const* in = (const float* const*)d_in;
  p.x = in[0]; p.c = in[1]; p.ctx = in[2]; p.c_ctx = in[3]; p.w_mod = in[4]; p.b_mod = in[5]; p.g_norm1 = in[6];
  p.w_in = in[7]; p.g_ckv = in[8]; p.w_ukv = in[9]; p.g_cq = in[10]; p.w_uq = in[11]; p.g_qn = in[12]; p.g_kn = in[13];
  p.w_dw = in[14]; p.b_dw = in[15]; p.g_cln = in[16]; p.b_cln = in[17]; p.wb_attn = in[18]; p.wb_fnet = in[19];
  p.wb_conv = in[20]; p.w_out = in[21]; p.g_norm2 = in[22]; p.w_query = in[23]; p.sub_keys = in[24]; p.u_tab = in[25];
  p.v_tab = in[26];
  p.out = (float*)d_out;
  p.one = 1; p.pad_ = 0;
  char* ws = (char*)d_ws;
  size_t off = 0;
  auto take = [&](size_t bytes) { char* q = ws + off; off += al256(bytes); return q; };
  p.bar = (unsigned*)take(XCD_BAR_WORDS * 4);
  const size_t mods_bytes = 2 * 9 * 6144 * 4;
  p.mods = (float*)take(mods_bytes);
  p.ropetab = (float*)take(64 * 8 * 2 * 4);
  p.W2T = (u16*)take(2ull * W2T_SZ * 2);
  p.WgT = (u16*)take(2ull * WGT_SZ * 2);
  p.WukvT = (u16*)take(2ull * WUKV_SZ * 2);
  p.WuqT = (u16*)take(2ull * WUQ_SZ * 2);
  p.WbaT = (u16*)take(2ull * WBA_SZ * 2);
  p.WbfT = (u16*)take(2ull * WBF_SZ * 2);
  p.WbcT = (u16*)take(2ull * WBC_SZ * 2);
  p.WoutT = (u16*)take(2ull * WOUT_SZ * 2);
  p.WqT = (u16*)take(2ull * WQ_SZ * 2);
  p.SubK = (u16*)take(2ull * SUBK_SZ * 2);
  p.WA = (u16*)take(128 * 128 * 2);
  p.WC = (u16*)take(128 * 128 * 2);
  p.tw = (float*)take(4096 * 2 * 4);
  p.GB = (u16*)take((size_t)NB * 256 * 8192 * 2);
  p.Dctx = (u16*)take(256ull * 512 * 2);
  p.Wcs = (u16*)take(128ull * 64 * 2);
  p.UT8 = (unsigned char*)take((size_t)NEXP * 1024);
  p.VT8 = (unsigned char*)take((size_t)NEXP * 1024);
  p.hx = (u16*)take((size_t)RTOT * 1024 * 2);
  {
    const size_t b0 = off;
    p.cq = (u16*)take((size_t)RTOT * 256 * 2);
    p.zf = (u16*)take((size_t)RTOT * 256 * 2);
    p.zc = (u16*)take((size_t)RTOT * 512 * 2);
    p.ckv = (u16*)take((size_t)RTOT * 128 * 2);
    p.kr = (float*)take((size_t)RTOT * 32 * 4);
    p.m = (u16*)(ws + b0);
    p.PD = (unsigned*)(ws + b0);
  }
  {
    const size_t c0 = off;
    p.Kb = (u16*)take((size_t)NB * NH * SKEYS * 96 * 2);
    p.Vtb = (u16*)take((size_t)NB * NH * 64 * SKEYS * 2);
    p.eid = (int*)(ws + c0);
    p.gate = (float*)(ws + c0 + al256((size_t)RTOT * 128 * 4));
  }
  p.Ytl = (u16*)take((size_t)NB * 256 * 8192 * 2);
  p.Ytc = (u16*)take((size_t)NB * 256 * 512 * 2);
  p.Ob = (u16*)take((size_t)RTOT * 512 * 2);
  p.Fb = (u16*)take((size_t)RTOT * 256 * 2);
  p.cv = (u16*)take((size_t)RTOT * 256 * 2);
  p.ctx1 = (float*)take((size_t)TCTX * 1024 * 4);
  if (off > ws_size) { fprintf(stderr, "workspace too small: need %zu have %zu\n", off, ws_size); return; }

  (void)hipMemsetAsync(p.bar, 0, XCD_BAR_WORDS * 4, stream);
  static int grid_blocks = 0;
  if (!grid_blocks) {
    int dev = 0, cus = 0, per_cu = 0;
    hipGetDevice(&dev);
    hipDeviceGetAttribute(&cus, hipDeviceAttributeMultiprocessorCount, dev);
    hipOccupancyMaxActiveBlocksPerMultiprocessor(&per_cu, mega, 256, 0);
    if (per_cu > 2) per_cu = 2;
    if (per_cu < 1) per_cu = 1;
    grid_blocks = cus * per_cu;
  }
#if ONE_LAUNCH
  int ph0 = 0, ph1 = NPHASE;
  void* args[] = {&p, &ph0, &ph1};
  hipError_t e = hipLaunchCooperativeKernel((void*)mega, dim3(grid_blocks), dim3(256), args, 0, stream);
  if (e != hipSuccess) fprintf(stderr, "cooperative launch failed: %s (grid %d)\n", hipGetErrorString(e), grid_blocks);
#else
  for (int ph = 0; ph < PH_LIMIT; ph++) mega<<<grid_blocks, 256, 0, stream>>>(p, ph, ph + 1);
#endif
}
```

```cpp
#include <hip/hip_runtime.h>
#include <hip/hip_cooperative_groups.h>
#include <cstdio>
#include <cstdint>
namespace cg = cooperative_groups;

#ifndef ABL_PEER
#define ABL_PEER 1
#endif
#ifndef ABL_BR
#define ABL_BR 7
#endif
#ifndef PROBE_S
#define PROBE_S (-1)
#endif
#ifndef PROBE_REPS
#define PROBE_REPS 4
#endif
#ifndef CHECK_ATTN
#define CHECK_ATTN 0
#endif
#ifndef CHECK_MASK
#define CHECK_MASK 0xff
#endif
#ifndef ONE_LAUNCH
#define ONE_LAUNCH 1
#endif

typedef unsigned short u16;
typedef __attribute__((ext_vector_type(8))) __bf16 bf16x8;
typedef __attribute__((ext_vector_type(2))) __bf16 bf16x2;
typedef __attribute__((ext_vector_type(16))) float f32x16;
typedef __attribute__((ext_vector_type(2))) float f32x2;

#define NB 8
#define SEQ 4096
#define DM 1024
#define CTXL 256
#define TLAT (NB * SEQ)
#define TCTX (NB * CTXL)
#define RTOT (TLAT + TCTX)
#define SKEYS (CTXL + SEQ)
#define NH 8
#define QKD 96
#define N2 1280
#define NEXP 16384
#define EPSV 1e-6f

struct Params {
  const float *x, *c, *ctx, *c_ctx, *w_mod, *b_mod, *g_norm1, *w_in, *g_ckv, *w_ukv, *g_cq, *w_uq, *g_qn, *g_kn,
      *w_dw, *b_dw, *g_cln, *b_cln, *wb_attn, *wb_fnet, *wb_conv, *w_out, *g_norm2, *w_query, *sub_keys, *u_tab, *v_tab;
  float* out;
  unsigned* bar;
  float* mods;
  float* ropetab;
  u16 *W2T, *WgT, *WukvT, *WuqT, *WbaT, *WbfT, *WbcT, *WoutT, *WqT, *SubK;
  u16 *WA, *WC, *Dctx, *Wcs;
  float* tw;
  u16* GB;
  unsigned char *UT8, *VT8;
  unsigned* PD;
  u16* hx;
  u16 *cq, *zf, *zc, *ckv; float* kr;
  u16* m;
  u16 *Kb, *Vtb;
  int* eid; float* gate;
  u16 *Ytl, *Ytc, *Ob, *Fb, *cv;
  float* ctx1;
  int one; int pad_;
};

#define W2T_SZ (N2 * 1024)
#define WGT_SZ (3072 * 1024)
#define WUKV_SZ (1024 * 128)
#define WUQ_SZ (768 * 256)
#define WBA_SZ (1024 * 512)
#define WBF_SZ (1024 * 256)
#define WBC_SZ (1024 * 256)
#define WOUT_SZ (1024 * 1024)
#define WQ_SZ (1024 * 1024)
#define SUBK_SZ (8 * 2 * 128 * 64)

__device__ __forceinline__ unsigned pack2(float a, float b) {
  f32x2 v = {a, b};
  return __builtin_bit_cast(unsigned, __builtin_convertvector(v, bf16x2));
}
__device__ __forceinline__ u16 tobf(float a) { return (u16)(pack2(a, 0.f) & 0xffffu); }
__device__ __forceinline__ float bf_lo(unsigned u) { return __uint_as_float(u << 16); }
__device__ __forceinline__ float bf_hi(unsigned u) { return __uint_as_float(u & 0xffff0000u); }
__device__ __forceinline__ float bf1(u16 u) { return __uint_as_float(((unsigned)u) << 16); }
__device__ __forceinline__ f32x16 mfma32(uint4 a, uint4 b, f32x16 c) {
  return __builtin_amdgcn_mfma_f32_32x32x16_bf16(__builtin_bit_cast(bf16x8, a), __builtin_bit_cast(bf16x8, b), c, 0, 0, 0);
}
__device__ __forceinline__ uint4 ldg16(const void* p) { return *(const uint4*)p; }
__device__ __forceinline__ int opaque(int x) { asm volatile("" : "+v"(x)); return x; }
#define TIDX opaque((int)threadIdx.x)
#define HALF_ (opaque((int)threadIdx.x) >> 8)
#define TIDS (opaque((int)threadIdx.x) & 255)
#define VBID ((int)blockIdx.x + HALF_ * (int)gridDim.x)
#define NVB ((int)gridDim.x * (int)(blockDim.x >> 8))
#define FOR_PAIRED(N, U) for (int _b = (int)blockIdx.x, _g = (int)gridDim.x, _st = _g * (int)(blockDim.x >> 8); _b < (N); _b += _st) { \
    int U = _b + HALF_ * _g; if (U >= (N)) U = _b;
__device__ __forceinline__ float wave_sum(float v) {
#pragma unroll
  for (int o = 32; o > 0; o >>= 1) v += __shfl_xor(v, o);
  return v;
}
__device__ __forceinline__ float half_sum(float v) {
#pragma unroll
  for (int o = 16; o > 0; o >>= 1) v += __shfl_xor(v, o);
  return v;
}
__device__ __forceinline__ float sigmoidf_(float x) { return 1.f / (1.f + __expf(-x)); }
__device__ __forceinline__ float siluf_(float x) { return x / (1.f + __expf(-x)); }
__device__ __forceinline__ float gelu_tanh(float x) {
  float u = 0.7978845608028654f * (x + 0.044715f * x * x * x);
  float t = 1.f - 2.f / (1.f + __expf(2.f * u));
  return 0.5f * x * (1.f + t);
}
__device__ __forceinline__ int row_mod(int r) { return r < TLAT ? (r >> 12) : 8; }

#define SMEM_BYTES 73728
#define LDS_SMALL 73728
#define LDS_BIG 147456
#define LDT 72

#define LAS3 __attribute__((address_space(3)))
__device__ __forceinline__ void glds16(const u16* g, char* lds_wave_base) {
  __builtin_amdgcn_global_load_lds((const unsigned*)g, (LAS3 unsigned*)lds_wave_base, 16, 0, 0);
}
__device__ __forceinline__ void gemm128x(const u16* __restrict__ A, int lda, const u16* __restrict__ Bt, int ldb, int bs1, int bs2, int K,
                                         f32x16 (&acc)[2][2], char* smem) {
  char* As = smem;
  char* Bs = smem + 32768;
  const int tid = TIDS, lane = tid & 63, w = tid >> 6, wr = w >> 1, wc = w & 1;
  const int nk = K >> 6;
  const int srow = w * 8 + (lane >> 3);
  const int schunk = (lane & 7) ^ ((srow >> 1) & 7);
  const int aoff = srow * lda + schunk * 8, boff = srow * ldb + schunk * 8;
  const int a32 = 32 * lda;
  __syncthreads();
#pragma unroll
  for (int i = 0; i < 4; i++) {
    glds16(A + (aoff + i * a32), As + (i * 4 + w) * 1024);
    glds16(Bt + (boff + (i & 1) * bs1 + (i >> 1) * bs2), Bs + (i * 4 + w) * 1024);
  }
  __syncthreads();
  const int fr = lane & 31, hh = lane >> 5;
  const int sw = (fr >> 1) & 7;
  for (int kt = 0; kt < nk; kt++) {
    const int cur = kt & 1;
    if (kt + 1 < nk) {
      const int ko = (kt + 1) * 64;
      char* An = As + (cur ^ 1) * 16384;
      char* Bn = Bs + (cur ^ 1) * 16384;
#pragma unroll
      for (int i = 0; i < 4; i++) {
        glds16(A + (aoff + i * a32 + ko), An + (i * 4 + w) * 1024);
        glds16(Bt + (boff + (i & 1) * bs1 + (i >> 1) * bs2 + ko), Bn + (i * 4 + w) * 1024);
      }
    }
    const char* Ac = As + cur * 16384 + (wr * 64 + fr) * 128;
    const char* Bc = Bs + cur * 16384 + (wc * 64 + fr) * 128;
#pragma unroll
    for (int kk = 0; kk < 4; kk++) {
      const int so = ((2 * kk + hh) ^ sw) << 4;
      uint4 a0 = *(const uint4*)(Ac + so);
      uint4 a1 = *(const uint4*)(Ac + 32 * 128 + so);
      uint4 b0 = *(const uint4*)(Bc + so);
      uint4 b1 = *(const uint4*)(Bc + 32 * 128 + so);
      acc[0][0] = mfma32(a0, b0, acc[0][0]);
      acc[0][1] = mfma32(a0, b1, acc[0][1]);
      acc[1][0] = mfma32(a1, b0, acc[1][0]);
      acc[1][1] = mfma32(a1, b1, acc[1][1]);
    }
    __syncthreads();
  }
}
__device__ __forceinline__ void gemm128(const u16* __restrict__ A, int lda, const u16* __restrict__ Bt, int ldb, int K,
                                        f32x16 (&acc)[2][2], char* smem) {
  gemm128x(A, lda, Bt, ldb, 32 * ldb, 64 * ldb, K, acc, smem);
}
__device__ __forceinline__ void gemm128h(const u16* __restrict__ A, int lda, const u16* __restrict__ Bt, int ldb, int K, int jh,
                                         f32x16 (&acc)[2], char* smem) {
  char* As = smem;
  char* Bs = smem + 32768;
  const int tid = TIDS, lane = tid & 63, w = tid >> 6, wr = w >> 1, wc = w & 1;
  const int nk = K >> 6;
  const int srow = w * 8 + (lane >> 3);
  const int schunk = (lane & 7) ^ ((srow >> 1) & 7);
  const int aoff = srow * lda + schunk * 8;
  const int a32 = 32 * lda;
  const int boff = (jh * 32 + srow) * ldb + schunk * 8, b64 = 64 * ldb;
  __syncthreads();
#pragma unroll
  for (int i = 0; i < 4; i++) glds16(A + (aoff + i * a32), As + (i * 4 + w) * 1024);
#pragma unroll
  for (int i = 0; i < 2; i++) glds16(Bt + (boff + i * b64), Bs + (i * 4 + w) * 1024);
  __syncthreads();
  const int fr = lane & 31, hh = lane >> 5;
  const int sw = (fr >> 1) & 7;
  for (int kt = 0; kt < nk; kt++) {
    const int cur = kt & 1;
    if (kt + 1 < nk) {
      const int ko = (kt + 1) * 64;
      char* An = As + (cur ^ 1) * 16384;
      char* Bn = Bs + (cur ^ 1) * 8192;
#pragma unroll
      for (int i = 0; i < 4; i++) glds16(A + (aoff + i * a32 + ko), An + (i * 4 + w) * 1024);
#pragma unroll
      for (int i = 0; i < 2; i++) glds16(Bt + (boff + i * b64 + ko), Bn + (i * 4 + w) * 1024);
    }
    const char* Ac = As + cur * 16384 + (wr * 64 + fr) * 128;
    const char* Bc = Bs + cur * 8192 + (wc * 32 + fr) * 128;
#pragma unroll
    for (int kk = 0; kk < 4; kk++) {
      const int so = ((2 * kk + hh) ^ sw) << 4;
      uint4 a0 = *(const uint4*)(Ac + so);
      uint4 a1 = *(const uint4*)(Ac + 32 * 128 + so);
      uint4 b0 = *(const uint4*)(Bc + so);
      acc[0] = mfma32(a0, b0, acc[0]);
      acc[1] = mfma32(a1, b0, acc[1]);
    }
    __syncthreads();
  }
}
#define WAIT_VM(n) asm volatile("s_waitcnt vmcnt(%0)" ::"n"(n) : "memory")
#define G256_STAGE 49152
__device__ __forceinline__ void gemm256(const u16* __restrict__ A, int lda, const u16* __restrict__ Bt, int ldb, int K,
                                        f32x16 (&acc)[2][2], char* smem) {
  const int tid = TIDX, lane = tid & 63, w = tid >> 6, wr = w >> 1, wc = w & 1;
  const int nk = K >> 6;
  const int srow = w * 8 + (lane >> 3);
  const int schunk = (lane & 7) ^ ((srow >> 1) & 7);
  const int aoff = srow * lda + schunk * 8, boff = srow * ldb + schunk * 8;
  const int a64 = 64 * lda, b64 = 64 * ldb;
  auto issue = [&](int kt) __attribute__((always_inline)) {
    char* As = smem + (kt % 3) * G256_STAGE;
    char* Bs = As + 32768;
    const int ko = kt * 64;
#pragma unroll
    for (int i = 0; i < 4; i++) glds16(A + (aoff + i * a64 + ko), As + (w + 8 * i) * 1024);
#pragma unroll
    for (int i = 0; i < 2; i++) glds16(Bt + (boff + i * b64 + ko), Bs + (w + 8 * i) * 1024);
  };
  WAIT_VM(0);
  __syncthreads();
  issue(0);
  if (nk > 1) issue(1);
  const int fr = lane & 31, hh = lane >> 5;
  const int sw = (fr >> 1) & 7;
  const int rdA = (wr * 64 + fr) * 128, rdB = 32768 + (wc * 64 + fr) * 128;
  for (int kt = 0; kt < nk; kt++) {
    if (kt + 1 < nk) WAIT_VM(6); else WAIT_VM(0);
    __builtin_amdgcn_s_barrier();
    if (kt + 2 < nk) issue(kt + 2);
    const char* Sb = smem + (kt % 3) * G256_STAGE;
#pragma unroll
    for (int kk = 0; kk < 4; kk++) {
      const int so = ((2 * kk + hh) ^ sw) << 4;
      uint4 a0 = *(const uint4*)(Sb + rdA + so);
      uint4 a1 = *(const uint4*)(Sb + rdA + 32 * 128 + so);
      uint4 b0 = *(const uint4*)(Sb + rdB + so);
      uint4 b1 = *(const uint4*)(Sb + rdB + 32 * 128 + so);
      acc[0][0] = mfma32(a0, b0, acc[0][0]);
      acc[0][1] = mfma32(a0, b1, acc[0][1]);
      acc[1][0] = mfma32(a1, b0, acc[1][0]);
      acc[1][1] = mfma32(a1, b1, acc[1][1]);
    }
  }
  __syncthreads();
}
__device__ __forceinline__ void gemm256h(const u16* __restrict__ A, int lda, const u16* __restrict__ Bt, int ldb, int K, int jh,
                                         f32x16 (&acc)[2], char* smem) {
  const int tid = TIDX, lane = tid & 63, w = tid >> 6, wr = w >> 1, wc = w & 1;
  const int nk = K >> 6;
  const int srow = w * 8 + (lane >> 3);
  const int schunk = (lane & 7) ^ ((srow >> 1) & 7);
  const int aoff = srow * lda + schunk * 8;
  const int a64 = 64 * lda;
  const int boff = ((srow >> 5) * 64 + jh * 32 + (srow & 31)) * ldb + schunk * 8;
  auto issue = [&](int kt) __attribute__((always_inline)) {
    char* As = smem + (kt % 3) * G256_STAGE;
    char* Bs = As + 32768;
    const int ko = kt * 64;
#pragma unroll
    for (int i = 0; i < 4; i++) glds16(A + (aoff + i * a64 + ko), As + (w + 8 * i) * 1024);
    glds16(Bt + (boff + ko), Bs + w * 1024);
  };
  WAIT_VM(0);
  __syncthreads();
  issue(0);
  if (nk > 1) issue(1);
  const int fr = lane & 31, hh = lane >> 5;
  const int sw = (fr >> 1) & 7;
  const int rdA = (wr * 64 + fr) * 128, rdB = 32768 + (wc * 32 + fr) * 128;
  for (int kt = 0; kt < nk; kt++) {
    if (kt + 1 < nk) WAIT_VM(5); else WAIT_VM(0);
    __builtin_amdgcn_s_barrier();
    if (kt + 2 < nk) issue(kt + 2);
    const char* Sb = smem + (kt % 3) * G256_STAGE;
#pragma unroll
    for (int kk = 0; kk < 4; kk++) {
      const int so = ((2 * kk + hh) ^ sw) << 4;
      uint4 a0 = *(const uint4*)(Sb + rdA + so);
      uint4 a1 = *(const uint4*)(Sb + rdA + 32 * 128 + so);
      uint4 b0 = *(const uint4*)(Sb + rdB + so);
      acc[0] = mfma32(a0, b0, acc[0]);
      acc[1] = mfma32(a1, b0, acc[1]);
    }
  }
  __syncthreads();
}
#define FOR_UNITS_XCD(NRT, NCT, RT, CT) \
  for (int _s = (int)(blockIdx.x >> 3), _per = (NRT) >> 3, _n = _per * (NCT); _s < _n; _s += (int)(gridDim.x >> 3)) { \
    const int RT = (int)(blockIdx.x & 7) * _per + _s / (NCT), CT = _s % (NCT);
#define ZERO_ACC(acc) { _Pragma("unroll") for (int _i = 0; _i < 2; _i++) _Pragma("unroll") for (int _j = 0; _j < 2; _j++) _Pragma("unroll") for (int _r = 0; _r < 16; _r++) acc[_i][_j][_r] = 0.f; }
#define ACC_ROW(wr, i, r, lane) ((wr) * 64 + (i) * 32 + ((r) & 3) + 8 * ((r) >> 2) + 4 * ((lane) >> 5))
#define ACC_COL(wc, j, lane) ((wc) * 64 + (j) * 32 + ((lane) & 31))

__device__ __forceinline__ void job_mods(const Params& p, int job, char* smem) {
  float* s = (float*)smem;
  float* red = s + 9 * 1024;
  const int L = job / 96, nt = job % 96;
  const int tid = TIDS, lane = tid & 63, w = tid >> 6;
  __syncthreads();
  for (int i = tid; i < 9 * 1024; i += 256) {
    const int j = i >> 10, k = i & 1023;
    const float cv = (j < 8) ? p.c[j * 1024 + k] : p.c_ctx[k];
    s[i] = siluf_(cv);
  }
  __syncthreads();
  const int n = nt * 64 + lane;
  float acc[9];
#pragma unroll
  for (int j = 0; j < 9; j++) acc[j] = 0.f;
  const float* wp = p.w_mod + (long)L * 1024 * 6144 + (long)(w * 256) * 6144 + n;
#pragma unroll 8
  for (int k = 0; k < 256; k++) {
    const float wv = wp[(long)k * 6144];
#pragma unroll
    for (int j = 0; j < 9; j++) acc[j] += s[j * 1024 + w * 256 + k] * wv;
  }
#pragma unroll
  for (int j = 0; j < 9; j++) red[(w * 9 + j) * 64 + lane] = acc[j];
  __syncthreads();
  for (int i = tid; i < 9 * 64; i += 256) {
    const int j = i >> 6, l = i & 63;
    const float v = ((red[(0 * 9 + j) * 64 + l] + red[(1 * 9 + j) * 64 + l]) + red[(2 * 9 + j) * 64 + l]) + red[(3 * 9 + j) * 64 + l];
    p.mods[(L * 9 + j) * 6144 + nt * 64 + l] = v + p.b_mod[L * 6144 + nt * 64 + l];
  }
}

__device__ __forceinline__ void job_convT(const float* src, int ldsrc, int c0, int k0, u16* dst, int K, int n0, const float* scale, char* smem) {
  float* t = (float*)smem;
  const int tid = TIDS;
  __syncthreads();
  const int nc = tid & 31, kr = tid >> 5;
#pragma unroll 4
  for (int kk = kr; kk < 128; kk += 8) {
    float v = 0.f;
    if (src) { v = src[(long)(k0 + kk) * ldsrc + c0 + nc]; if (scale) v *= scale[k0 + kk]; }
    t[nc * 129 + kk] = v;
  }
  __syncthreads();
  const int nr = tid >> 3, kc = (tid & 7) * 16;
  unsigned o[8];
#pragma unroll
  for (int q = 0; q < 8; q++) o[q] = pack2(t[nr * 129 + kc + 2 * q], t[nr * 129 + kc + 2 * q + 1]);
  uint4* dp = (uint4*)(dst + (long)(n0 + nr) * K + k0 + kc);
  dp[0] = make_uint4(o[0], o[1], o[2], o[3]);
  dp[1] = make_uint4(o[4], o[5], o[6], o[7]);
}

#define NJ_W2 (40 * 8)
#define NJ_WG (96 * 8)
#define NJ_UKV (32 * 1)
#define NJ_UQ (24 * 2)
#define NJ_BA (32 * 4)
#define NJ_BF (32 * 2)
#define NJ_BC (32 * 2)
#define NJ_OUT (32 * 8)
#define NJ_WQ (32 * 8)
#define NJ_CONV_LAYER (NJ_W2 + NJ_WG + NJ_UKV + NJ_UQ + NJ_BA + NJ_BF + NJ_BC + NJ_OUT + NJ_WQ)

__device__ __forceinline__ void job_conv_weights(const Params& p, int job, char* smem) {
  const int L = job / NJ_CONV_LAYER;
  int j = job % NJ_CONV_LAYER;
  const float* src; int ldsrc, c0, k0, K, n0; u16* dst; const float* scale = nullptr;
  if (j < NJ_W2) {
    const int nt = j >> 3, kt = j & 7; n0 = nt * 32;
    bool valid = true;
    if (n0 < 256) c0 = 160 + n0;
    else if (n0 < 512) c0 = 416 + (n0 - 256);
    else if (n0 < 1024) c0 = 672 + (n0 - 512);
    else if (n0 < 1152) c0 = n0 - 1024;
    else if (n0 < 1184) c0 = 128 + (n0 - 1152);
    else { c0 = 0; valid = false; }
    src = valid ? p.w_in + (long)L * 1024 * 4256 : nullptr; ldsrc = 4256; k0 = kt * 128; dst = p.W2T + (long)L * W2T_SZ; K = 1024;
  } else if ((j -= NJ_W2) < NJ_WG) {
    const int nt = j >> 3, kt = j & 7;
    src = p.w_in + (long)L * 1024 * 4256; ldsrc = 4256; c0 = 1184 + nt * 32; k0 = kt * 128; dst = p.WgT + (long)L * WGT_SZ; K = 1024; n0 = nt * 32;
  } else if ((j -= NJ_WG) < NJ_UKV) {
    src = p.w_ukv + (long)L * 128 * 1024; ldsrc = 1024; c0 = j * 32; k0 = 0; dst = p.WukvT + (long)L * WUKV_SZ; K = 128; n0 = j * 32; scale = p.g_ckv + L * 128;
  } else if ((j -= NJ_UKV) < NJ_UQ) {
    const int nt = j >> 1, kt = j & 1;
    src = p.w_uq + (long)L * 256 * 768; ldsrc = 768; c0 = nt * 32; k0 = kt * 128; dst = p.WuqT + (long)L * WUQ_SZ; K = 256; n0 = nt * 32; scale = p.g_cq + L * 256;
  } else if ((j -= NJ_UQ) < NJ_BA) {
    const int nt = j >> 2, kt = j & 3;
    src = p.wb_attn + (long)L * 512 * 1024; ldsrc = 1024; c0 = nt * 32; k0 = kt * 128; dst = p.WbaT + (long)L * WBA_SZ; K = 512; n0 = nt * 32;
  } else if ((j -= NJ_BA) < NJ_BF) {
    const int nt = j >> 1, kt = j & 1;
    src = p.wb_fnet + (long)L * 256 * 1024; ldsrc = 1024; c0 = nt * 32; k0 = kt * 128; dst = p.WbfT + (long)L * WBF_SZ; K = 256; n0 = nt * 32;
  } else if ((j -= NJ_BF) < NJ_BC) {
    const int nt = j >> 1, kt = j & 1;
    src = p.wb_conv + (long)L * 256 * 1024; ldsrc = 1024; c0 = nt * 32; k0 = kt * 128; dst = p.WbcT + (long)L * WBC_SZ; K = 256; n0 = nt * 32;
  } else if ((j -= NJ_BC) < NJ_OUT) {
    const int nt = j >> 3, kt = j & 7;
    src = p.w_out + (long)L * 1024 * 1024; ldsrc = 1024; c0 = nt * 32; k0 = kt * 128; dst = p.WoutT + (long)L * WOUT_SZ; K = 1024; n0 = nt * 32;
  } else {
    j -= NJ_OUT;
    const int nt = j >> 3, kt = j & 7;
    src = p.w_query + (long)L * 1024 * 1024; ldsrc = 1024; c0 = nt * 32; k0 = kt * 128; dst = p.WqT + (long)L * WQ_SZ; K = 1024; n0 = nt * 32;
  }
  job_convT(src, ldsrc, c0, k0, dst, K, n0, scale, smem);
}

__device__ __forceinline__ void job_cvt_straight(const float* src, u16* dst, long job) {
  const long base = job * 8192 + TIDS * 8;
#pragma unroll
  for (int i = 0; i < 4; i++) {
    const long o = base + i * 2048;
    float4 a = *(const float4*)(src + o), b = *(const float4*)(src + o + 4);
    *(uint4*)(dst + o) = make_uint4(pack2(a.x, a.y), pack2(a.z, a.w), pack2(b.x, b.y), pack2(b.z, b.w));
  }
}

__device__ __forceinline__ void job_misc(const Params& p) {
  const int tid = TIDS;
  for (int i = tid; i < 256 * 512; i += 256) {
    const int k = i >> 9, e = i & 511, part = e >> 8, t = e & 255;
    const int ph = (k * t) & 255;
    const float a = (float)ph * (1.0f / 128.0f);
    p.Dctx[i] = tobf((part == 0 ? cospif(a) : -sinpif(a)) * (1.0f / 16.0f));
  }
  for (int i = tid; i < 128 * 64; i += 256) {
    const int n = i >> 6, d = i & 63, pp = n >> 6, e = n & 63;
    const int ph = (e * d) & 63;
    const float a = (float)ph * (1.0f / 32.0f);
    p.Wcs[i] = tobf((pp == 0 ? cospif(a) : sinpif(a)) * 0.125f);
  }
  for (int i = tid; i < 128 * 128; i += 256) {
    const int R = i >> 7, kk = i & 127, k1 = (R >> 6) * 32 + (R & 31), pr = (R >> 5) & 1, part = kk >> 6, t1 = kk & 63;
    const float a = (float)((k1 * t1) & 63) * (1.0f / 32.0f);
    const float cs = cospif(a), sn = sinpif(a);
    const float v = (pr == 0) ? (part == 0 ? cs : -sn) : (part == 0 ? -sn : -cs);
    p.WA[i] = tobf(v * 0.125f);
  }
  for (int i = tid; i < 128 * 128; i += 256) {
    const int k2 = i >> 7, kk = i & 127, part = kk >> 6, t2 = kk & 63;
    const float a = (float)((k2 * t2) & 63) * (1.0f / 32.0f);
    p.WC[i] = (k2 < 64) ? tobf((part == 0 ? cospif(a) : sinpif(a)) * 0.125f) : (u16)0;
  }
  for (int i = tid; i < 4096; i += 256) {
    const float a = (float)i * (1.0f / 2048.0f);
    p.tw[2 * i] = cospif(a); p.tw[2 * i + 1] = sinpif(a);
  }
  for (int i = tid; i < 512; i += 256) {
    const int pos = i >> 3, mm = i & 7;
    const float inv = powf(10000.0f, -(float)(2 * mm) / 16.0f);
    const float ang = (float)pos * inv;
    p.ropetab[i * 2] = cosf(ang);
    p.ropetab[i * 2 + 1] = sinf(ang);
  }
}

#define NJ_MODS 192
#define NJ_CONVW (2 * NJ_CONV_LAYER)
#define NJ_SUBK 32
#define NJ_MISC 1
#define NJ_PREP (NJ_MODS + NJ_CONVW + NJ_SUBK + NJ_MISC)

__device__ __forceinline__ void phase_prep(const Params& p, char* smem) {
  char* sm = smem + HALF_ * LDS_SMALL;
  FOR_PAIRED(NJ_MODS, j) job_mods(p, j, sm); }
  FOR_PAIRED(NJ_CONVW, j) job_conv_weights(p, j, sm); }
  for (int j = VBID; j < NJ_SUBK; j += NVB) job_cvt_straight(p.sub_keys, p.SubK, j);
  if (VBID == NVB - 1) job_misc(p);
}

__device__ __forceinline__ void phase_norm(const Params& p, int L, int which, int nrows) {
  const int lane = TIDS & 63;
  const int gw = VBID * 4 + (TIDS >> 6), nw = NVB * 4;
  const float* g = (which == 0 ? p.g_norm1 : p.g_norm2) + L * 1024;
  for (int r0 = gw; r0 < nrows; r0 += 2 * nw) {
    float4 v[2][4];
    int rr[2]; bool ok[2];
#pragma unroll
    for (int u = 0; u < 2; u++) {
      const int r = r0 + u * nw;
      ok[u] = r < nrows; rr[u] = ok[u] ? r : r0;
      const float* src;
      if (which == 0 && L == 0) src = (rr[u] < TLAT) ? p.x + (long)rr[u] * 1024 : p.ctx + (long)(rr[u] - TLAT) * 1024;
      else src = (rr[u] < TLAT) ? p.out + (long)rr[u] * 1024 : p.ctx1 + (long)(rr[u] - TLAT) * 1024;
#pragma unroll
      for (int i = 0; i < 4; i++) v[u][i] = *(const float4*)(src + i * 256 + lane * 4);
    }
#pragma unroll
    for (int u = 0; u < 2; u++) {
      const int r = rr[u];
      const float* md = p.mods + (long)(L * 9 + row_mod(r)) * 6144 + (which == 0 ? 0 : 3072);
      float ss = 0.f;
#pragma unroll
      for (int i = 0; i < 4; i++) ss += v[u][i].x * v[u][i].x + v[u][i].y * v[u][i].y + v[u][i].z * v[u][i].z + v[u][i].w * v[u][i].w;
      ss = wave_sum(ss);
      const float rs = rsqrtf(ss * (1.0f / 1024.0f) + EPSV);
      if (!ok[u]) continue;
#pragma unroll
      for (int i = 0; i < 4; i++) {
        const int c = i * 256 + lane * 4;
        const float4 gg = *(const float4*)(g + c);
        const float4 sh = *(const float4*)(md + c);
        const float4 sc = *(const float4*)(md + 1024 + c);
        const float o0 = v[u][i].x * rs * gg.x * (1.f + sc.x) + sh.x;
        const float o1 = v[u][i].y * rs * gg.y * (1.f + sc.y) + sh.y;
        const float o2 = v[u][i].z * rs * gg.z * (1.f + sc.z) + sh.z;
        const float o3 = v[u][i].w * rs * gg.w * (1.f + sc.w) + sh.w;
        *(uint2*)(p.hx + (long)r * 1024 + c) = make_uint2(pack2(o0, o1), pack2(o2, o3));
      }
    }
  }
}
#define U8_SCALE 32.0f
#define V8_SCALE 4.0f
__device__ __forceinline__ unsigned pack_fp8x4(float4 v, float s) {
  int w = 0;
  w = __builtin_amdgcn_cvt_pk_fp8_f32(v.x * s, v.y * s, w, false);
  w = __builtin_amdgcn_cvt_pk_fp8_f32(v.z * s, v.w * s, w, true);
  return (unsigned)w;
}
__device__ __forceinline__ void phase_tables(const Params& p, int L) {
  const int tid = TIDS;
  for (int job = VBID; job < 4096; job += NVB) {
    const bool isu = job < 2048;
    const float* src = (isu ? p.u_tab : p.v_tab) + (long)L * NEXP * 1024;
    unsigned char* dst = isu ? p.UT8 : p.VT8;
    const float s = isu ? U8_SCALE : V8_SCALE;
    const long base = (long)(isu ? job : job - 2048) * 8192 + tid * 16;
#pragma unroll
    for (int i = 0; i < 2; i++) {
      const long o = base + i * 4096;
      const float4 a = *(const float4*)(src + o), b = *(const float4*)(src + o + 4);
      const float4 c = *(const float4*)(src + o + 8), d = *(const float4*)(src + o + 12);
      const long e = o >> 10; const int col = (int)(o & 1023), sl = col >> 7, cc = col & 127;
      *(uint4*)(dst + ((long)sl * NEXP + e) * 128 + cc) = make_uint4(pack_fp8x4(a, s), pack_fp8x4(b, s), pack_fp8x4(c, s), pack_fp8x4(d, s));
    }
  }
}

template <bool BIG>
__device__ __forceinline__ void phase_s2(const Params& p, int L, char* smem) {
  constexpr int TM = BIG ? 256 : 128;
  const int lane = TIDX & 63, w = TIDX >> 6, wr = w >> 1, wc = w & 1;
  for (int pass = 0; pass < (L == 0 ? 1 : 2); pass++) {
  const int g_nrt = (L == 0) ? RTOT / TM : (pass == 0 ? TLAT / TM : TCTX / TM), g_nct = (L == 0 || pass == 0) ? 10 : 2;
  FOR_UNITS_XCD(g_nrt, g_nct, rt_, ct_)
    const int rt = (L == 1 && pass == 1) ? TLAT / TM + rt_ : rt_, ct = (L == 1 && pass == 1) ? 8 + ct_ : ct_;
    f32x16 acc[2][2];
    ZERO_ACC(acc);
    if constexpr (BIG) gemm256(p.hx + (long)rt * TM * 1024, 1024, p.W2T + (long)L * W2T_SZ + (long)ct * 128 * 1024, 1024, 1024, acc, smem);
    else gemm128(p.hx + (long)rt * TM * 1024, 1024, p.W2T + (long)L * W2T_SZ + (long)ct * 128 * 1024, 1024, 1024, acc, smem);
    const int row0 = rt * TM;
#define S2_STORE(DST, LDD, C0) { u16* dp = (DST) + (long)row0 * (LDD) + (C0); \
      const int tb = opaque((wr * 64 + 4 * (lane >> 5)) * (LDD) + wc * 64 + (lane & 31)); \
      _Pragma("unroll") for (int i = 0; i < 2; i++) _Pragma("unroll") for (int j = 0; j < 2; j++) _Pragma("unroll") for (int r = 0; r < 16; r++) \
        dp[tb + (i * 32 + (r & 3) + 8 * (r >> 2)) * (LDD) + j * 32] = tobf(acc[i][j][r]); }
    if (ct < 2) S2_STORE(p.cq, 256, ct * 128)
    else if (ct < 4) S2_STORE(p.zf, 256, (ct - 2) * 128)
    else if (ct < 8) S2_STORE(p.zc, 512, (ct - 4) * 128)
    else if (ct == 8) S2_STORE(p.ckv, 128, 0)
#undef S2_STORE
    else if (wc == 0) {
      float* dp = p.kr + (long)row0 * 32;
      const int tb = opaque((wr * 64 + 4 * (lane >> 5)) * 32 + (lane & 31));
#pragma unroll
      for (int i = 0; i < 2; i++)
#pragma unroll
        for (int r = 0; r < 16; r++)
          dp[tb + (i * 32 + (r & 3) + 8 * (r >> 2)) * 32] = acc[i][0][r];
    }
  }
  }
}

__device__ __forceinline__ void unit_kv(const Params& p, int L, int rt, int h, char* smem) {
  u16* As = (u16*)smem;
  u16* Ws = (u16*)(smem + 128 * 136 * 2);
  float* rrs = (float*)(smem + 2 * 128 * 136 * 2);
  const int tid = TIDS, lane = tid & 63, w = tid >> 6, hh = lane >> 5, c = lane & 31;
  const int row0 = rt * 128;
  __syncthreads();
  {
    const u16* ap = p.ckv + (long)row0 * 128;
    const u16* wp = p.WukvT + (long)L * WUKV_SZ + (long)h * 128 * 128;
#pragma unroll
    for (int i = 0; i < 8; i++) {
      const int idx = tid + 256 * i, rw = idx >> 4, ch = idx & 15;
      *(uint4*)(As + rw * 136 + ch * 8) = ldg16(ap + rw * 128 + ch * 8);
      *(uint4*)(Ws + rw * 136 + ch * 8) = ldg16(wp + rw * 128 + ch * 8);
    }
  }
  __syncthreads();
  {
    const int rw = tid >> 1, hf = tid & 1;
    float ss = 0.f;
#pragma unroll
    for (int q = 0; q < 8; q++) {
      uint4 v = *(const uint4*)(As + rw * 136 + hf * 64 + q * 8);
      float a;
      a = bf_lo(v.x); ss += a * a; a = bf_hi(v.x); ss += a * a;
      a = bf_lo(v.y); ss += a * a; a = bf_hi(v.y); ss += a * a;
      a = bf_lo(v.z); ss += a * a; a = bf_hi(v.z); ss += a * a;
      a = bf_lo(v.w); ss += a * a; a = bf_hi(v.w); ss += a * a;
    }
    ss += __shfl_xor(ss, 1);
    if (hf == 0) rrs[rw] = rsqrtf(ss * (1.0f / 128.0f) + EPSV);
  }
  __syncthreads();
  f32x16 aK[2], aV[2];
#pragma unroll
  for (int r = 0; r < 16; r++) { aK[0][r] = 0.f; aK[1][r] = 0.f; aV[0][r] = 0.f; aV[1][r] = 0.f; }
#pragma unroll
  for (int s = 0; s < 8; s++) {
    const int ko = s * 16 + hh * 8;
    uint4 tk = *(const uint4*)(As + (32 * w + c) * 136 + ko);
    uint4 w0 = *(const uint4*)(Ws + (c) * 136 + ko);
    uint4 w1 = *(const uint4*)(Ws + (32 + c) * 136 + ko);
    uint4 w2 = *(const uint4*)(Ws + (64 + c) * 136 + ko);
    uint4 w3 = *(const uint4*)(Ws + (96 + c) * 136 + ko);
    aK[0] = mfma32(tk, w0, aK[0]);
    aK[1] = mfma32(tk, w1, aK[1]);
    aV[0] = mfma32(w2, tk, aV[0]);
    aV[1] = mfma32(w3, tk, aV[1]);
  }
  const bool lat = row0 < TLAT;
  const int b = lat ? (row0 >> 12) : ((row0 - TLAT) >> 8);
  const int s0 = lat ? (row0 & 4095) : ((row0 - TLAT) & 255);
  const int kpos0 = lat ? (CTXL + s0) : s0;
  const float* gkn = p.g_kn + L * 96;
  const float gk0 = gkn[c], gk1 = gkn[32 + c], gk2 = gkn[64 + c];
  u16* Kdst = p.Kb + ((long)(b * 8 + h) * SKEYS + kpos0) * 96;
#pragma unroll
  for (int r = 0; r < 16; r++) {
    const int tl = 32 * w + (r & 3) + 8 * (r >> 2) + 4 * hh;
    const float rc = rrs[tl];
    const float v0 = aK[0][r] * rc, v1 = aK[1][r] * rc;
    const float kv = p.kr[(long)(row0 + tl) * 32 + c];
    const float ss = half_sum(v0 * v0 + v1 * v1 + kv * kv);
    const float rk = rsqrtf(ss * (1.0f / 96.0f) + EPSV);
    const float krn = kv * rk * gk2;
    const float partner = __shfl_xor(krn, 8);
    float o2 = krn;
    if (lat) {
      const int s = s0 + tl;
      const int pos = (c < 16) ? (s >> 6) : (s & 63);
      const float2 cs = *(const float2*)(p.ropetab + (pos * 8 + (c & 7)) * 2);
      const float rot = (c & 8) ? partner : -partner;
      o2 = krn * cs.x + rot * cs.y;
    }
    u16* kd = Kdst + (long)tl * 96;
    kd[c] = tobf(v0 * rk * gk0);
    kd[32 + c] = tobf(v1 * rk * gk1);
    kd[64 + c] = tobf(o2);
  }
  u16* Vdst = p.Vtb + (long)(b * 8 + h) * 64 * SKEYS + kpos0;
  const float rcv = rrs[32 * w + c];
#pragma unroll
  for (int i = 0; i < 2; i++)
#pragma unroll
    for (int r = 0; r < 16; r++) {
      const int d = 32 * i + (r & 3) + 8 * (r >> 2) + 4 * hh;
      Vdst[(long)d * SKEYS + 32 * w + c] = tobf(aV[i][r] * rcv);
    }
}

__device__ __forceinline__ void unit_chdft(const Params& p, int ut, int g, bool lat, char* smem) {
  const int lane = TIDS & 63, w = TIDS >> 6, wr = w >> 1, wc = w & 1;
  f32x16 acc[2][2];
  ZERO_ACC(acc);
  if (lat) {
    const int b = ut >> 5, j = ut & 31;
    gemm128x(p.Wcs, 64, p.zf + ((long)(b * SEQ + 2 * j) * 256 + g * 64), 64 * 256, 32 * 64 * 256, 256, 64, acc, smem);
    u16* dst = p.Ytl + ((long)(b * 256 + g * 64) * 64 + 2 * j) * 128;
#pragma unroll
    for (int i = 0; i < 2; i++)
#pragma unroll
      for (int jj = 0; jj < 2; jj++)
#pragma unroll
        for (int r = 0; r < 16; r++) {
          const int e = i * 32 + (r & 3) + 8 * (r >> 2) + 4 * (lane >> 5);
          dst[((long)e * 64 + wc) * 128 + wr * 64 + jj * 32 + (lane & 31)] = tobf(acc[i][jj][r]);
        }
  } else {
    const int row0 = TLAT + ut * 128;
    gemm128(p.Wcs, 64, p.zf + (long)row0 * 256 + g * 64, 256, 64, acc, smem);
    const int b = (row0 - TLAT) >> 8, s0 = (row0 - TLAT) & 255;
#pragma unroll
    for (int i = 0; i < 2; i++)
#pragma unroll
      for (int jj = 0; jj < 2; jj++)
#pragma unroll
        for (int r = 0; r < 16; r++) {
          const int n = ACC_ROW(wr, i, r, lane);
          const int t = s0 + ACC_COL(wc, jj, lane);
          p.Ytc[((long)(b * 256 + g * 64 + (n & 63))) * 512 + (n >> 6) * 256 + t] = tobf(acc[i][jj][r]);
        }
  }
}

__device__ __forceinline__ void unit_conv(const Params& p, int L, int ut, char* smem) {
  float* U = (float*)smem;
  const int tid = TIDS, lane = tid & 63, w = tid >> 6;
  const int row0 = ut * 32;
  const bool lat = row0 < TLAT;
  const int seqlen = lat ? SEQ : CTXL;
  const int s0 = lat ? (row0 & 4095) : ((row0 - TLAT) & 255);
  __syncthreads();
  {
    uint4 ca[8], cg[8];
#pragma unroll
    for (int q = 0; q < 8; q++) {
      const int id = tid + 256 * q, i = id >> 5, k = id & 31;
      const int s = s0 - 15 + i;
      ca[q] = make_uint4(0u, 0u, 0u, 0u); cg[q] = ca[q];
      if (i < 62 && s >= 0 && s < seqlen) {
        const u16* zr = p.zc + (long)(row0 - 15 + i) * 512 + k * 8;
        ca[q] = ldg16(zr); cg[q] = ldg16(zr + 256);
      }
    }
#pragma unroll
    for (int q = 0; q < 8; q++) {
      const int id = tid + 256 * q, i = id >> 5, k = id & 31;
      if (i < 62) {
        float4 u0, u1;
        u0.x = bf_lo(ca[q].x) * sigmoidf_(bf_lo(cg[q].x)); u0.y = bf_hi(ca[q].x) * sigmoidf_(bf_hi(cg[q].x));
        u0.z = bf_lo(ca[q].y) * sigmoidf_(bf_lo(cg[q].y)); u0.w = bf_hi(ca[q].y) * sigmoidf_(bf_hi(cg[q].y));
        u1.x = bf_lo(ca[q].z) * sigmoidf_(bf_lo(cg[q].z)); u1.y = bf_hi(ca[q].z) * sigmoidf_(bf_hi(cg[q].z));
        u1.z = bf_lo(ca[q].w) * sigmoidf_(bf_lo(cg[q].w)); u1.w = bf_hi(ca[q].w) * sigmoidf_(bf_hi(cg[q].w));
        *(float4*)(U + i * 256 + k * 8) = u0;
        *(float4*)(U + i * 256 + k * 8 + 4) = u1;
      }
    }
  }
  __syncthreads();
  float wv[31];
#pragma unroll
  for (int j = 0; j < 31; j++) wv[j] = p.w_dw[(long)L * 31 * 256 + j * 256 + tid];
  const float bias = p.b_dw[L * 256 + tid];
#pragma unroll 2
  for (int t = 0; t < 32; t++) {
    float acc = bias;
#pragma unroll
    for (int j = 0; j < 31; j++) acc += U[(t + j) * 256 + tid] * wv[j];
    U[t * 256 + tid] = acc;
  }
  __syncthreads();
  const float4 gg = *(const float4*)(p.g_cln + L * 256 + lane * 4);
  const float4 bb = *(const float4*)(p.b_cln + L * 256 + lane * 4);
#pragma unroll
  for (int q = 0; q < 8; q++) {
    const int t = w * 8 + q;
    const float4 v = *(const float4*)(U + t * 256 + lane * 4);
    const float mu = wave_sum(v.x + v.y + v.z + v.w) * (1.0f / 256.0f);
    const float d0 = v.x - mu, d1 = v.y - mu, d2 = v.z - mu, d3 = v.w - mu;
    const float var = wave_sum(d0 * d0 + d1 * d1 + d2 * d2 + d3 * d3) * (1.0f / 256.0f);
    const float rs = rsqrtf(var + EPSV);
    const float y0 = siluf_(d0 * rs * gg.x + bb.x), y1 = siluf_(d1 * rs * gg.y + bb.y);
    const float y2 = siluf_(d2 * rs * gg.z + bb.z), y3 = siluf_(d3 * rs * gg.w + bb.w);
    *(uint2*)(p.cv + (long)(row0 + t) * 256 + lane * 4) = make_uint2(pack2(y0, y1), pack2(y2, y3));
  }
}

#ifndef S3_REP_MASK
#define S3_REP_MASK 7
#endif
__device__ __forceinline__ void phase_s3(const Params& p, int L, char* smem, bool rep = false) {
  const int msk = rep ? S3_REP_MASK : 7;
  char* sm = smem + HALF_ * LDS_SMALL;
  const int nrt_all = (L == 0) ? 272 : 256;
  if (msk & 1) { FOR_PAIRED(272 * 8, u) unit_kv(p, L, u >> 3, u & 7, sm); } }
  if (msk & 2) { FOR_PAIRED(nrt_all * 4, v) const int ut = v >> 2; unit_chdft(p, ut < 256 ? ut : ut - 256, v & 3, ut < 256, sm); } }
  if (msk & 4) { FOR_PAIRED(nrt_all * 4, v) unit_conv(p, L, v, sm); } }
}

#define KLD 104
__device__ __forceinline__ void unit_attn(const Params& p, int L, int b, int h, int qt, bool isctx, char* smem) {
  const int tid = TIDS, lane = tid & 63, w = tid >> 6, hh = lane >> 5, c = lane & 31;
  const int qrow0 = isctx ? (TLAT + b * CTXL + qt * 128) : (b * SEQ + qt * 128);
  const int nkt = isctx ? (CTXL / 64) : (SKEYS / 64);
  u16* As = (u16*)smem;
  u16* Bs = (u16*)(smem + 128 * LDT * 2);
  u16* Qs = (u16*)(smem + (128 + 96) * LDT * 2);
  f32x16 aq[3];
#pragma unroll
  for (int r = 0; r < 16; r++) { aq[0][r] = 0.f; aq[1][r] = 0.f; aq[2][r] = 0.f; }
  float ssq = 0.f;
  const u16* cqp = p.cq + (long)qrow0 * 256;
  const u16* wqp = p.WuqT + (long)L * WUQ_SZ + (long)h * 96 * 256;
  for (int kc = 0; kc < 4; kc++) {
    __syncthreads();
#pragma unroll
    for (int i = 0; i < 4; i++) {
      const int idx = tid + 256 * i, rw = idx >> 3, ch = idx & 7;
      *(uint4*)(As + rw * LDT + ch * 8) = ldg16(cqp + rw * 256 + kc * 64 + ch * 8);
    }
#pragma unroll
    for (int i = 0; i < 3; i++) {
      const int idx = tid + 256 * i, rw = idx >> 3, ch = idx & 7;
      *(uint4*)(Bs + rw * LDT + ch * 8) = ldg16(wqp + rw * 256 + kc * 64 + ch * 8);
    }
    __syncthreads();
#pragma unroll
    for (int q = 0; q < 4; q++) {
      uint4 v = *(const uint4*)(As + (32 * w + c) * LDT + hh * 32 + q * 8);
      float a;
      a = bf_lo(v.x); ssq += a * a; a = bf_hi(v.x); ssq += a * a;
      a = bf_lo(v.y); ssq += a * a; a = bf_hi(v.y); ssq += a * a;
      a = bf_lo(v.z); ssq += a * a; a = bf_hi(v.z); ssq += a * a;
      a = bf_lo(v.w); ssq += a * a; a = bf_hi(v.w); ssq += a * a;
    }
#pragma unroll
    for (int kk = 0; kk < 4; kk++) {
      uint4 a = *(const uint4*)(As + (32 * w + c) * LDT + kk * 16 + hh * 8);
#pragma unroll
      for (int j = 0; j < 3; j++) {
        uint4 bq = *(const uint4*)(Bs + (32 * j + c) * LDT + kk * 16 + hh * 8);
        aq[j] = mfma32(a, bq, aq[j]);
      }
    }
  }
  ssq += __shfl_xor(ssq, 32);
  const float rr_lane = rsqrtf(ssq * (1.0f / 256.0f) + EPSV);
  {
    const float* gqn = p.g_qn + L * 96;
    const float g0 = gqn[c], g1 = gqn[32 + c], g2 = gqn[64 + c];
    const float qscale = 0.10206207261596577f * 1.4426950408889634f;
    u16* Qw = Qs + w * 32 * KLD;
#pragma unroll
    for (int r = 0; r < 16; r++) {
      const int rl = (r & 3) + 8 * (r >> 2) + 4 * hh;
      const float rc = __shfl(rr_lane, rl);
      const float q0 = aq[0][r] * rc, q1 = aq[1][r] * rc, q2 = aq[2][r] * rc;
      const float ss = half_sum(q0 * q0 + q1 * q1 + q2 * q2);
      const float rq = rsqrtf(ss * (1.0f / 96.0f) + EPSV);
      const float qn2 = q2 * rq * g2;
      const float partner = __shfl_xor(qn2, 8);
      float o2 = qn2;
      if (!isctx) {
        const int s = qt * 128 + 32 * w + rl;
        const int pos = (c < 16) ? (s >> 6) : (s & 63);
        const float2 cs = *(const float2*)(p.ropetab + (pos * 8 + (c & 7)) * 2);
        const float rot = (c & 8) ? partner : -partner;
        o2 = qn2 * cs.x + rot * cs.y;
      }
      Qw[rl * KLD + c] = tobf(q0 * rq * g0 * qscale);
      Qw[rl * KLD + 32 + c] = tobf(q1 * rq * g1 * qscale);
      Qw[rl * KLD + 64 + c] = tobf(o2 * qscale);
    }
  }
  __syncthreads();
  uint4 qf[6];
#pragma unroll
  for (int s = 0; s < 6; s++) qf[s] = *(const uint4*)(Qs + (w * 32 + c) * KLD + s * 16 + hh * 8);
  __syncthreads();
  u16* Ks = (u16*)smem;
  u16* Vs = (u16*)(smem + 2 * 64 * KLD * 2);
  const u16* kg = p.Kb + (long)(b * 8 + h) * SKEYS * 96;
  const u16* vg = p.Vtb + (long)(b * 8 + h) * 64 * SKEYS;
  uint4 rk[3], rv[2];
  int krow[3], kch[3];
#pragma unroll
  for (int i = 0; i < 3; i++) { const int idx = tid + 256 * i; krow[i] = idx / 12; kch[i] = idx % 12; }
  const int vrow = tid >> 3, vch = tid & 7;
#pragma unroll
  for (int i = 0; i < 3; i++) rk[i] = ldg16(kg + (long)(tid + 256 * i) * 8);
#pragma unroll
  for (int i = 0; i < 2; i++) rv[i] = ldg16(vg + (long)(vrow + 32 * i) * SKEYS + vch * 8);
#pragma unroll
  for (int i = 0; i < 3; i++) *(uint4*)(Ks + krow[i] * KLD + kch[i] * 8) = rk[i];
#pragma unroll
  for (int i = 0; i < 2; i++) *(uint4*)(Vs + (vrow + 32 * i) * LDT + vch * 8) = rv[i];
  __syncthreads();
  f32x16 aO[2];
#pragma unroll
  for (int r = 0; r < 16; r++) { aO[0][r] = 0.f; aO[1][r] = 0.f; }
  float mref = 0.f;
  f32x2 lsum2 = {0.f, 0.f};
  const int kperm = (c & ~12) | ((c & 4) << 1) | ((c & 8) >> 1);
  for (int kt = 0; kt < nkt; kt++) {
    const int cur = kt & 1;
    if (kt + 1 < nkt) {
#pragma unroll
      for (int i = 0; i < 3; i++) rk[i] = ldg16(kg + (long)(kt + 1) * 64 * 96 + (long)(tid + 256 * i) * 8);
#pragma unroll
      for (int i = 0; i < 2; i++) rv[i] = ldg16(vg + (long)(vrow + 32 * i) * SKEYS + (kt + 1) * 64 + vch * 8);
    }
    __builtin_amdgcn_sched_barrier(0);
    const u16* Kc = Ks + cur * 64 * KLD;
    const u16* Vc = Vs + cur * 64 * LDT;
    f32x16 aS[2];
    {
      const float nm = -mref;
#pragma unroll
      for (int r = 0; r < 16; r++) { aS[0][r] = nm; aS[1][r] = nm; }
    }
#pragma unroll
    for (int s = 0; s < 6; s++) {
      uint4 k0 = *(const uint4*)(Kc + (kperm) * KLD + s * 16 + hh * 8);
      uint4 k1 = *(const uint4*)(Kc + (32 + kperm) * KLD + s * 16 + hh * 8);
      aS[0] = mfma32(k0, qf[s], aS[0]);
      aS[1] = mfma32(k1, qf[s], aS[1]);
    }
    float mx = fmaxf(aS[0][0], aS[1][0]);
#pragma unroll
    for (int r = 1; r < 16; r++) mx = fmaxf(fmaxf(mx, aS[0][r]), aS[1][r]);
    if (__any(mx > 8.0f)) {
      const float mo = fmaxf(mx, __shfl_xor(mx, 32));
      const float delta = (mo > 8.0f) ? mo : 0.f;
      const float alpha = __builtin_amdgcn_exp2f(-delta);
      mref += delta;
      lsum2 *= alpha;
#pragma unroll
      for (int r = 0; r < 16; r++) {
        aO[0][r] *= alpha; aO[1][r] *= alpha;
        aS[0][r] -= delta; aS[1][r] -= delta;
      }
    }
#pragma unroll
    for (int r = 0; r < 16; r += 2) {
      aS[0][r] = __builtin_amdgcn_exp2f(aS[0][r]); aS[0][r + 1] = __builtin_amdgcn_exp2f(aS[0][r + 1]);
      aS[1][r] = __builtin_amdgcn_exp2f(aS[1][r]); aS[1][r + 1] = __builtin_amdgcn_exp2f(aS[1][r + 1]);
      const f32x2 p0 = {aS[0][r], aS[0][r + 1]}, p1 = {aS[1][r], aS[1][r + 1]};
      lsum2 += p0; lsum2 += p1;
    }
#pragma unroll
    for (int i = 0; i < 2; i++)
#pragma unroll
      for (int s2 = 0; s2 < 2; s2++) {
        uint4 pf = make_uint4(pack2(aS[i][8 * s2 + 0], aS[i][8 * s2 + 1]), pack2(aS[i][8 * s2 + 2], aS[i][8 * s2 + 3]),
                              pack2(aS[i][8 * s2 + 4], aS[i][8 * s2 + 5]), pack2(aS[i][8 * s2 + 6], aS[i][8 * s2 + 7]));
        uint4 v0 = *(const uint4*)(Vc + (c) * LDT + 32 * i + 16 * s2 + 8 * hh);
        uint4 v1 = *(const uint4*)(Vc + (32 + c) * LDT + 32 * i + 16 * s2 + 8 * hh);
        aO[0] = mfma32(v0, pf, aO[0]);
        aO[1] = mfma32(v1, pf, aO[1]);
      }
    if (kt + 1 < nkt) {
      const int nx = cur ^ 1;
#pragma unroll
      for (int i = 0; i < 3; i++) *(uint4*)(Ks + nx * 64 * KLD + krow[i] * KLD + kch[i] * 8) = rk[i];
#pragma unroll
      for (int i = 0; i < 2; i++) *(uint4*)(Vs + nx * 64 * LDT + (vrow + 32 * i) * LDT + vch * 8) = rv[i];
    }
    __syncthreads();
  }
  float lsum = lsum2.x + lsum2.y;
  lsum += __shfl_xor(lsum, 32);
  const float inv = 1.0f / lsum;
  u16* Os = (u16*)smem + w * 32 * LDT;
#pragma unroll
  for (int i = 0; i < 2; i++)
#pragma unroll
    for (int r = 0; r < 16; r++) {
      const int d = 32 * i + (r & 3) + 8 * (r >> 2) + 4 * hh;
      Os[c * LDT + d] = tobf(aO[i][r] * inv);
    }
  __syncthreads();
#pragma unroll
  for (int i = 0; i < 4; i++) {
    const int idx = lane + 64 * i, q = idx >> 3, ch = idx & 7;
    *(uint4*)(p.Ob + (long)(qrow0 + 32 * w + q) * 512 + h * 64 + ch * 8) = *(const uint4*)(Os + q * LDT + ch * 8);
  }
}

__device__ __forceinline__ void unit_dftA(const Params& p, int b, int np, char* smem) {
  const int lane = TIDS & 63, w = TIDS >> 6, wr = w >> 1, wc = w & 1, hh = lane >> 5, c = lane & 31;
  f32x16 acc[2][2];
  ZERO_ACC(acc);
  gemm128(p.WA, 128, p.Ytl + (long)(b * 256 + 2 * np) * 64 * 128, 128, 128, acc, smem);
  const int n = 2 * np + wc;
#pragma unroll
  for (int jj = 0; jj < 2; jj++) {
    const int t2 = jj * 32 + c;
#pragma unroll
    for (int r = 0; r < 16; r++) {
      const int k1 = wr * 32 + (r & 3) + 8 * (r >> 2) + 4 * hh;
      const float2 t = *(const float2*)(p.tw + 2 * ((k1 * t2) & 4095));
      const float gr = acc[0][jj][r], gi = acc[1][jj][r];
      u16* dst = p.GB + ((long)((b * 64 + k1) * 256 + n)) * 128 + t2;
      dst[0] = tobf(gr * t.x + gi * t.y);
      dst[64] = tobf(gi * t.x - gr * t.y);
    }
  }
}
__device__ __forceinline__ void unit_dftC(const Params& p, int b, int k1, int nt, char* smem) {
  const int lane = TIDS & 63, w = TIDS >> 6, wr = w >> 1, wc = w & 1, hh = lane >> 5, c = lane & 31;
  f32x16 acc[2][2];
  ZERO_ACC(acc);
  gemm128(p.WC, 128, p.GB + ((long)((b * 64 + k1) * 256 + nt * 128)) * 128, 128, 128, acc, smem);
  if (wr == 0) {
#pragma unroll
    for (int i = 0; i < 2; i++)
#pragma unroll
      for (int jj = 0; jj < 2; jj++)
#pragma unroll
        for (int r = 0; r < 16; r++) {
          const int k2 = i * 32 + (r & 3) + 8 * (r >> 2) + 4 * hh;
          p.Fb[((long)b * SEQ + k1 + 64 * k2) * 256 + nt * 128 + wc * 64 + jj * 32 + c] = tobf(acc[i][jj][r]);
        }
  }
}
__device__ __forceinline__ void unit_seqdft_ctx(const Params& p, int b, int mt, int nt, char* smem) {
  const int lane = TIDS & 63, w = TIDS >> 6, wr = w >> 1, wc = w & 1;
  f32x16 acc[2][2];
  ZERO_ACC(acc);
  gemm128(p.Dctx + (long)mt * 128 * 512, 512, p.Ytc + (long)(b * 256 + nt * 128) * 512, 512, 512, acc, smem);
  const long orow0 = (long)TLAT + b * CTXL + mt * 128;
#pragma unroll
  for (int i = 0; i < 2; i++)
#pragma unroll
    for (int j = 0; j < 2; j++)
#pragma unroll
      for (int r = 0; r < 16; r++)
        p.Fb[(orow0 + ACC_ROW(wr, i, r, lane)) * 256 + nt * 128 + ACC_COL(wc, j, lane)] = tobf(acc[i][j][r]);
}
__device__ __forceinline__ void phase_dftC(const Params& p, char* smem) {
  char* sm = smem + HALF_ * LDS_SMALL;
  FOR_PAIRED(8 * 64 * 2, u) unit_dftC(p, u >> 7, (u >> 1) & 63, u & 1, sm); }
}

__device__ __forceinline__ void phase_s4(const Params& p, int L, char* smem) {
  char* sm = smem + HALF_ * LDS_SMALL;
  {
    const int x = VBID & 7, l = VBID >> 3, nl = NVB >> 3;
    for (int s = l; s < 256; s += nl) {
      const int bh = x * 8 + (s >> 5);
      unit_attn(p, L, bh >> 3, bh & 7, s & 31, false, sm);
    }
  }
  FOR_PAIRED(8 * 128, v) unit_dftA(p, v >> 7, v & 127, sm); }
  if (L == 0) {
    FOR_PAIRED(8 * 2 * 2, v) unit_seqdft_ctx(p, v >> 2, (v >> 1) & 1, v & 1, sm); }
    FOR_PAIRED(8 * 8 * 2, v) unit_attn(p, L, v >> 4, (v >> 1) & 7, v & 1, true, sm); }
  }
}

template <bool BIG>
__device__ __forceinline__ void phase_s7(const Params& p, int L, char* smem) {
  constexpr int TM = BIG ? 256 : 128;
  const int nrt = ((L == 0) ? RTOT : TLAT) / TM;
  FOR_UNITS_XCD(nrt, 8, rt, ct)
    const int row0 = rt * TM;
    f32x16 macc[2][2];
    ZERO_ACC(macc);
#pragma unroll 1
    for (int br = 0; br < 3; br++) {
      unsigned gp[2][2][8];
      {
      f32x16 acc[2][2];
      ZERO_ACC(acc);
      if constexpr (BIG) gemm256(p.hx + (long)row0 * 1024, 1024, p.WgT + (long)L * WGT_SZ + (long)(br * 1024 + ct * 128) * 1024, 1024, 1024, acc, smem);
      else gemm128(p.hx + (long)row0 * 1024, 1024, p.WgT + (long)L * WGT_SZ + (long)(br * 1024 + ct * 128) * 1024, 1024, 1024, acc, smem);
#pragma unroll
      for (int i = 0; i < 2; i++)
#pragma unroll
        for (int j = 0; j < 2; j++)
#pragma unroll
          for (int r = 0; r < 8; r++) gp[i][j][r] = pack2(sigmoidf_(acc[i][j][2 * r]), sigmoidf_(acc[i][j][2 * r + 1]));
      }
      const u16* A2; const u16* B2; int K2;
      if (br == 0) { A2 = p.Ob + (long)row0 * 512; B2 = p.WbaT + (long)L * WBA_SZ + (long)ct * 128 * 512; K2 = 512; }
      else if (br == 1) { A2 = p.Fb + (long)row0 * 256; B2 = p.WbfT + (long)L * WBF_SZ + (long)ct * 128 * 256; K2 = 256; }
      else { A2 = p.cv + (long)row0 * 256; B2 = p.WbcT + (long)L * WBC_SZ + (long)ct * 128 * 256; K2 = 256; }
#pragma unroll
      for (int jh = 0; jh < 2; jh++) {
        f32x16 ah[2];
#pragma unroll
        for (int r = 0; r < 16; r++) { ah[0][r] = 0.f; ah[1][r] = 0.f; }
        if constexpr (BIG) gemm256h(A2, K2, B2, K2, K2, jh, ah, smem); else gemm128h(A2, K2, B2, K2, K2, jh, ah, smem);
#pragma unroll
        for (int i = 0; i < 2; i++)
#pragma unroll
          for (int r = 0; r < 8; r++) {
            if ((ABL_BR >> br) & 1) {
            macc[i][jh][2 * r] += bf_lo(gp[i][jh][r]) * ah[i][2 * r];
            macc[i][jh][2 * r + 1] += bf_hi(gp[i][jh][r]) * ah[i][2 * r + 1];
            }
          }
      }
    }
    u16* mp = p.m + (long)row0 * 1024 + ct * 128;
    const int tid = TIDX, lane = tid & 63, w = tid >> 6, wr = w >> 1, wc = w & 1;
    const int tb = (wr * 64 + 4 * (lane >> 5)) * 1024 + wc * 64 + (lane & 31);
#pragma unroll
    for (int i = 0; i < 2; i++)
#pragma unroll
      for (int j = 0; j < 2; j++)
#pragma unroll
        for (int r = 0; r < 16; r++)
          mp[tb + (i * 32 + (r & 3) + 8 * (r >> 2)) * 1024 + j * 32] = tobf(macc[i][j][r]);
  }
}

template <bool BIG>
__device__ __forceinline__ void phase_s8(const Params& p, int L, char* smem, bool dry = false) {
  constexpr int TM = BIG ? 256 : 128;
  const int lane = TIDX & 63, w = TIDX >> 6, wr = w >> 1, wc = w & 1;
  const int nrt = ((L == 0) ? RTOT : TLAT) / TM;
  FOR_UNITS_XCD(nrt, 8, rt, ct)
    const long row0 = (long)rt * TM;
    f32x16 acc[2][2];
    ZERO_ACC(acc);
    if constexpr (BIG) gemm256(p.m + row0 * 1024, 1024, p.WoutT + (long)L * WOUT_SZ + (long)ct * 128 * 1024, 1024, 1024, acc, smem);
    else gemm128(p.m + row0 * 1024, 1024, p.WoutT + (long)L * WOUT_SZ + (long)ct * 128 * 1024, 1024, 1024, acc, smem);
    const int mr = row_mod((int)row0);
    const float* gt = p.mods + (long)(L * 9 + mr) * 6144 + 2048 + ct * 128;
    const float* src; float* dst;
    if (row0 < TLAT) { src = (L == 0 ? p.x : p.out) + row0 * 1024; dst = p.out + row0 * 1024; }
    else { src = (L == 0 ? p.ctx : p.ctx1) + (row0 - TLAT) * 1024; dst = p.ctx1 + (row0 - TLAT) * 1024; }
    src += ct * 128; dst += ct * 128;
    const int tb = opaque((wr * 64 + 4 * (lane >> 5)) * 1024 + wc * 64 + (lane & 31));
#pragma unroll
    for (int j = 0; j < 2; j++) {
      const float gv = gt[ACC_COL(wc, j, lane)];
#pragma unroll
      for (int i = 0; i < 2; i++)
#pragma unroll
        for (int r = 0; r < 16; r++) {
          const int o = tb + (i * 32 + (r & 3) + 8 * (r >> 2)) * 1024 + j * 32;
          const float nv = src[o] + gv * acc[i][j][r];
          if (!dry) dst[o] = nv;
        }
    }
  }
}

#define CE_DESC(a, b) { const float _x = fmaxf(a, b); const float _y = fminf(a, b); a = _x; b = _y; }
template <int N>
__device__ __forceinline__ void bitonic_sort_desc(float (&v)[N]) {
#pragma unroll
  for (int k = 2; k <= N; k <<= 1)
#pragma unroll
    for (int j = k >> 1; j > 0; j >>= 1)
#pragma unroll
      for (int i = 0; i < N; i++) {
        const int l = i ^ j;
        if (l > i) {
          if ((i & k) == 0) { CE_DESC(v[i], v[l]); } else { CE_DESC(v[l], v[i]); }
        }
      }
}
template <int N>
__device__ __forceinline__ void bitonic_merge_desc(float (&v)[N]) {
#pragma unroll
  for (int j = N >> 1; j > 0; j >>= 1)
#pragma unroll
    for (int i = 0; i < N; i++) {
      const int l = i ^ j;
      if (l > i) { CE_DESC(v[i], v[l]); }
    }
}
__device__ __forceinline__ void merge_top16(float (&a)[16], const float (&b)[16]) {
#pragma unroll
  for (int i = 0; i < 16; i++) a[i] = fmaxf(a[i], b[15 - i]);
  bitonic_merge_desc<16>(a);
}
__device__ __forceinline__ void top16_of_tiles(const f32x16 (&s)[4], int hh, float (&res)[16]) {
  float g[4][16];
#pragma unroll
  for (int t = 0; t < 4; t++) {
#pragma unroll
    for (int r = 0; r < 16; r++) {
      const unsigned key = (unsigned)(32 * t + (r & 3) + 8 * (r >> 2)) + (unsigned)(4 * hh);
      g[t][r] = __uint_as_float((__float_as_uint(s[t][r]) & 0xffffff80u) | key);
    }
    bitonic_sort_desc<16>(g[t]);
  }
  merge_top16(g[0], g[1]);
  merge_top16(g[2], g[3]);
  merge_top16(g[0], g[2]);
  float o[16];
#pragma unroll
  for (int i = 0; i < 16; i++) o[i] = __shfl_xor(g[0][i], 32);
  merge_top16(g[0], o);
#pragma unroll
  for (int i = 0; i < 16; i++) res[i] = g[0][i];
}

template <bool BIG>
__device__ __forceinline__ void unit_peer_query(const Params& p, int L, int rt, int h, char* smem) {
  constexpr int TM = BIG ? 256 : 128, NT = BIG ? 512 : 256;
  const int tid = TIDX, lane = tid & 63, w = tid >> 6, wr = w >> 1, wc = w & 1, hh = lane >> 5, c = lane & 31;
  const long row0 = (long)rt * TM;
  u16* Qs = (u16*)smem;
  u16* Ss = (u16*)(smem + TM * 136 * 2);
  {
    f32x16 acc[2][2];
    ZERO_ACC(acc);
    if constexpr (BIG) gemm256(p.hx + row0 * 1024, 1024, p.WqT + (long)L * WQ_SZ + (long)h * 128 * 1024, 1024, 1024, acc, smem);
    else gemm128(p.hx + row0 * 1024, 1024, p.WqT + (long)L * WQ_SZ + (long)h * 128 * 1024, 1024, 1024, acc, smem);
#pragma unroll
    for (int i = 0; i < 2; i++)
#pragma unroll
      for (int j = 0; j < 2; j++)
#pragma unroll
        for (int r = 0; r < 16; r++) Qs[ACC_ROW(wr, i, r, lane) * 136 + ACC_COL(wc, j, lane)] = tobf(acc[i][j][r]);
    const u16* sk = p.SubK + (long)L * SUBK_SZ + (long)h * 2 * 128 * 64;
#pragma unroll
    for (int i = 0; i < 2048 / NT; i++) {
      const int idx = tid + NT * i, rw = idx >> 3, ch = idx & 7;
      *(uint4*)(Ss + rw * LDT + ch * 8) = ldg16(sk + rw * 64 + ch * 8);
    }
  }
  __syncthreads();
  float top[2][16];
#pragma unroll
  for (int pp = 0; pp < 2; pp++) {
    f32x16 s[4];
#pragma unroll
    for (int t = 0; t < 4; t++)
#pragma unroll
      for (int r = 0; r < 16; r++) s[t][r] = 0.f;
#pragma unroll
    for (int kk = 0; kk < 4; kk++) {
      uint4 bq = *(const uint4*)(Qs + (32 * w + c) * 136 + pp * 64 + kk * 16 + hh * 8);
#pragma unroll
      for (int t = 0; t < 4; t++) {
        uint4 ak = *(const uint4*)(Ss + (pp * 128 + 32 * t + c) * LDT + kk * 16 + hh * 8);
        s[t] = mfma32(ak, bq, s[t]);
      }
    }
    top16_of_tiles(s, hh, top[pp]);
  }
  float cand[64];
#define CAND(q, a, b) cand[q] = __uint_as_float((__float_as_uint(top[0][a] + top[1][b]) & 0xffffff00u) | (unsigned)((a) * 16 + (b)));
  CAND(0, 0, 0)
  CAND(1, 0, 1)
  CAND(2, 0, 2)
  CAND(3, 0, 3)
  CAND(4, 0, 4)
  CAND(5, 0, 5)
  CAND(6, 0, 6)
  CAND(7, 0, 7)
  CAND(8, 0, 8)
  CAND(9, 0, 9)
  CAND(10, 0, 10)
  CAND(11, 0, 11)
  CAND(12, 0, 12)
  CAND(13, 0, 13)
  CAND(14, 0, 14)
  CAND(15, 0, 15)
  CAND(16, 1, 0)
  CAND(17, 1, 1)
  CAND(18, 1, 2)
  CAND(19, 1, 3)
  CAND(20, 1, 4)
  CAND(21, 1, 5)
  CAND(22, 1, 6)
  CAND(23, 1, 7)
  CAND(24, 2, 0)
  CAND(25, 2, 1)
  CAND(26, 2, 2)
  CAND(27, 2, 3)
  CAND(28, 2, 4)
  CAND(29, 3, 0)
  CAND(30, 3, 1)
  CAND(31, 3, 2)
  CAND(32, 3, 3)
  CAND(33, 4, 0)
  CAND(34, 4, 1)
  CAND(35, 4, 2)
  CAND(36, 5, 0)
  CAND(37, 5, 1)
  CAND(38, 6, 0)
  CAND(39, 6, 1)
  CAND(40, 7, 0)
  CAND(41, 7, 1)
  CAND(42, 8, 0)
  CAND(43, 9, 0)
  CAND(44, 10, 0)
  CAND(45, 11, 0)
  CAND(46, 12, 0)
  CAND(47, 13, 0)
  CAND(48, 14, 0)
  CAND(49, 15, 0)
#undef CAND
#pragma unroll
  for (int q = 50; q < 64; q++) cand[q] = -3.0e38f;
  float best[16];
  {
    float g[4][16];
#pragma unroll
    for (int t = 0; t < 4; t++) {
#pragma unroll
      for (int r = 0; r < 16; r++) g[t][r] = cand[t * 16 + r];
      bitonic_sort_desc<16>(g[t]);
    }
    merge_top16(g[0], g[1]);
    merge_top16(g[2], g[3]);
    merge_top16(g[0], g[2]);
#pragma unroll
    for (int i = 0; i < 16; i++) best[i] = g[0][i];
  }
  float e[16], es = 0.f;
#pragma unroll
  for (int i = 0; i < 16; i++) { e[i] = __expf(best[i] - best[0]); es += e[i]; }
  const float einv = 1.0f / es;
  __syncthreads();
  int* Ix = (int*)smem + w * 32 * 33;
  if (hh == 0) {
#pragma unroll
    for (int i = 0; i < 16; i++) {
      Ix[c * 33 + i] = (int)(__float_as_uint(top[0][i]) & 127u);
      Ix[c * 33 + 16 + i] = (int)(__float_as_uint(top[1][i]) & 127u);
    }
  }
  __syncthreads();
  const long orow = row0 + 32 * w + c;
  int* ed = p.eid + orow * 128 + h * 16 + hh * 8;
  float* gd = p.gate + orow * 128 + h * 16 + hh * 8;
  int ev[8]; float gv[8];
#pragma unroll
  for (int i = 0; i < 8; i++) {
    const unsigned hm = 0u - (unsigned)hh;
    const unsigned bselu = (__float_as_uint(best[8 + i]) & hm) | (__float_as_uint(best[i]) & ~hm);
    const float esel = __uint_as_float((__float_as_uint(e[8 + i]) & hm) | (__float_as_uint(e[i]) & ~hm));
    const unsigned id = bselu & 255u;
    const int ia = Ix[c * 33 + (id >> 4)], ib = Ix[c * 33 + 16 + (id & 15)];
    ev[i] = ia * 128 + ib;
    gv[i] = esel * einv;
  }
  *(int4*)(ed) = make_int4(ev[0], ev[1], ev[2], ev[3]);
  *(int4*)(ed + 4) = make_int4(ev[4], ev[5], ev[6], ev[7]);
  *(float4*)(gd) = make_float4(gv[0], gv[1], gv[2], gv[3]);
  *(float4*)(gd + 4) = make_float4(gv[4], gv[5], gv[6], gv[7]);
}

template <bool BIG>
__device__ __forceinline__ void phase_s10(const Params& p, int L, char* smem) {
  const int nrt = ((L == 0) ? RTOT : TLAT) / (BIG ? 256 : 128);
  FOR_UNITS_XCD(nrt, 8, rt, hd) unit_peer_query<BIG>(p, L, rt, hd, smem); }
}

#define CVT8(w, lo2, hi2) { lo2 = __builtin_amdgcn_cvt_pk_f32_fp8((int)(w), false); hi2 = __builtin_amdgcn_cvt_pk_f32_fp8((int)(w), true); }
#if CHECK_ATTN
#define NB11 1
#else
#define NB11 2
#endif
__device__ __forceinline__ void phase_s11a(const Params& p, int L) {
  const int lane = TIDS & 63, j = lane >> 3, cch = lane & 7;
  const int sl = VBID & 7;
  const int lw = (VBID >> 3) * 4 + (TIDS >> 6), nlw = (NVB >> 3) * 4;
  const int nrows = (L == 0) ? RTOT : TLAT;
  const unsigned char* Us = p.UT8 + (long)sl * NEXP * 128 + cch * 16;
  for (int r0 = lw; r0 < nrows; r0 += NB11 * nlw) {
    int rr[NB11]; bool ok[NB11];
    uint4 ha[NB11], hb[NB11]; int e_lo[NB11], e_hi[NB11];
#pragma unroll
    for (int u = 0; u < NB11; u++) {
      const int r = r0 + u * nlw;
      ok[u] = r < nrows; rr[u] = ok[u] ? r : r0;
      ha[u] = ldg16(p.hx + (long)rr[u] * 1024 + sl * 128 + cch * 16);
      hb[u] = ldg16(p.hx + (long)rr[u] * 1024 + sl * 128 + cch * 16 + 8);
      e_lo[u] = p.eid[(long)rr[u] * 128 + lane]; e_hi[u] = p.eid[(long)rr[u] * 128 + 64 + lane];
    }
    uint4 uu[NB11][16];
#pragma unroll
    for (int u = 0; u < NB11; u++)
#pragma unroll
      for (int i = 0; i < 16; i++) {
        const int e = __shfl(i < 8 ? e_lo[u] : e_hi[u], 8 * (i & 7) + j);
        uu[u][i] = ldg16(Us + (long)e * 128);
      }
    __builtin_amdgcn_sched_barrier(0);
#pragma unroll
    for (int u = 0; u < NB11; u++) {
      f32x2 h2[8];
      h2[0] = f32x2{bf_lo(ha[u].x), bf_hi(ha[u].x)}; h2[1] = f32x2{bf_lo(ha[u].y), bf_hi(ha[u].y)};
      h2[2] = f32x2{bf_lo(ha[u].z), bf_hi(ha[u].z)}; h2[3] = f32x2{bf_lo(ha[u].w), bf_hi(ha[u].w)};
      h2[4] = f32x2{bf_lo(hb[u].x), bf_hi(hb[u].x)}; h2[5] = f32x2{bf_lo(hb[u].y), bf_hi(hb[u].y)};
      h2[6] = f32x2{bf_lo(hb[u].z), bf_hi(hb[u].z)}; h2[7] = f32x2{bf_lo(hb[u].w), bf_hi(hb[u].w)};
      float d[16];
#pragma unroll
      for (int i = 0; i < 16; i++) {
        f32x2 a0, a1, acc = {0.f, 0.f};
        CVT8(uu[u][i].x, a0, a1); acc += a0 * h2[0]; acc += a1 * h2[1];
        CVT8(uu[u][i].y, a0, a1); acc += a0 * h2[2]; acc += a1 * h2[3];
        CVT8(uu[u][i].z, a0, a1); acc += a0 * h2[4]; acc += a1 * h2[5];
        CVT8(uu[u][i].w, a0, a1); acc += a0 * h2[6]; acc += a1 * h2[7];
        d[i] = acc.x + acc.y;
      }
      float t8[8], t4[4], t2[2];
      { const bool up = (lane & 4) != 0;
#pragma unroll
        for (int k = 0; k < 8; k++) { const float send = up ? d[k] : d[k + 8], keep = up ? d[k + 8] : d[k]; t8[k] = keep + __shfl_xor(send, 4); } }
      { const bool up = (lane & 2) != 0;
#pragma unroll
        for (int k = 0; k < 4; k++) { const float send = up ? t8[k] : t8[k + 4], keep = up ? t8[k + 4] : t8[k]; t4[k] = keep + __shfl_xor(send, 2); } }
      { const bool up = (lane & 1) != 0;
#pragma unroll
        for (int k = 0; k < 2; k++) { const float send = up ? t4[k] : t4[k + 2], keep = up ? t4[k + 2] : t4[k]; t2[k] = keep + __shfl_xor(send, 1); } }
      if (ok[u]) p.PD[((long)sl * RTOT + rr[u]) * 64 + cch * 8 + j] = pack2(t2[0], t2[1]);
    }
  }
}
__device__ __forceinline__ void phase_s11b(const Params& p, int L, bool dry = false) {
  const int lane = TIDS & 63, j = lane >> 3, cch = lane & 7;
  const int sl = VBID & 7;
  const int lw = (VBID >> 3) * 4 + (TIDS >> 6), nlw = (NVB >> 3) * 4;
  const int nrows = (L == 0) ? RTOT : TLAT;
  const unsigned char* Vs = p.VT8 + (long)sl * NEXP * 128 + cch * 16;
  const int P0 = 16 * (lane >> 3) + (lane & 7);
  const int col = sl * 128 + cch * 16 + 2 * j;
  for (int r0 = lw; r0 < nrows; r0 += NB11 * nlw) {
    int rr[NB11]; bool ok[NB11];
    unsigned pw[NB11][8]; float g0[NB11], g1[NB11]; int e_lo[NB11], e_hi[NB11];
#pragma unroll
    for (int u = 0; u < NB11; u++) {
      const int r = r0 + u * nlw;
      ok[u] = r < nrows; rr[u] = ok[u] ? r : r0;
#pragma unroll
      for (int s2 = 0; s2 < 8; s2++) pw[u][s2] = p.PD[((long)s2 * RTOT + rr[u]) * 64 + lane];
      g0[u] = p.gate[(long)rr[u] * 128 + P0]; g1[u] = p.gate[(long)rr[u] * 128 + P0 + 8];
      e_lo[u] = p.eid[(long)rr[u] * 128 + lane]; e_hi[u] = p.eid[(long)rr[u] * 128 + 64 + lane];
    }
    uint4 vv[NB11][16];
#pragma unroll
    for (int u = 0; u < NB11; u++)
#pragma unroll
      for (int i = 0; i < 16; i++) {
        const int e = __shfl(i < 8 ? e_lo[u] : e_hi[u], 8 * (i & 7) + j);
        vv[u][i] = ldg16(Vs + (long)e * 128);
      }
    __builtin_amdgcn_sched_barrier(0);
#pragma unroll
    for (int u = 0; u < NB11; u++) {
      float d0 = 0.f, d1 = 0.f;
#pragma unroll
      for (int s2 = 0; s2 < 8; s2++) { d0 += bf_lo(pw[u][s2]); d1 += bf_hi(pw[u][s2]); }
      const float act0 = gelu_tanh(d0 * (1.0f / U8_SCALE)) * g0[u] * (1.0f / V8_SCALE);
      const float act1 = gelu_tanh(d1 * (1.0f / U8_SCALE)) * g1[u] * (1.0f / V8_SCALE);
      f32x2 o2[8];
#pragma unroll
      for (int q = 0; q < 8; q++) o2[q] = f32x2{0.f, 0.f};
#pragma unroll
      for (int i = 0; i < 16; i++) {
        const float a = __shfl((i & 1) ? act1 : act0, (i >> 1) * 8 + j);
        const f32x2 aa = {a, a};
        f32x2 a0, a1;
        CVT8(vv[u][i].x, a0, a1); o2[0] += aa * a0; o2[1] += aa * a1;
        CVT8(vv[u][i].y, a0, a1); o2[2] += aa * a0; o2[3] += aa * a1;
        CVT8(vv[u][i].z, a0, a1); o2[4] += aa * a0; o2[5] += aa * a1;
        CVT8(vv[u][i].w, a0, a1); o2[6] += aa * a0; o2[7] += aa * a1;
      }
      float o[16];
#pragma unroll
      for (int q = 0; q < 8; q++) { o[2 * q] = o2[q].x; o[2 * q + 1] = o2[q].y; }
      float t8[8], t4[4], t2[2];
      { const bool up = (lane & 32) != 0;
#pragma unroll
        for (int k = 0; k < 8; k++) { const float send = up ? o[k] : o[k + 8], keep = up ? o[k + 8] : o[k]; t8[k] = keep + __shfl_xor(send, 32); } }
      { const bool up = (lane & 16) != 0;
#pragma unroll
        for (int k = 0; k < 4; k++) { const float send = up ? t8[k] : t8[k + 4], keep = up ? t8[k + 4] : t8[k]; t4[k] = keep + __shfl_xor(send, 16); } }
      { const bool up = (lane & 8) != 0;
#pragma unroll
        for (int k = 0; k < 2; k++) { const float send = up ? t4[k] : t4[k + 2], keep = up ? t4[k + 2] : t4[k]; t2[k] = keep + __shfl_xor(send, 8); } }
      if (!ABL_PEER || !ok[u]) continue;
      const int r = rr[u];
      float* xr = ((r < TLAT) ? p.out + (long)r * 1024 : p.ctx1 + (long)(r - TLAT) * 1024) + col;
      const float2 gt = *(const float2*)(p.mods + (long)(L * 9 + row_mod(r)) * 6144 + 5120 + col);
      float2 xv = *(const float2*)xr;
      xv.x += gt.x * t2[0]; xv.y += gt.y * t2[1];
      if (!dry) *(float2*)xr = xv;
    }
  }
}


#if CHECK_ATTN
__device__ __forceinline__ float blk_sum(float v, float* red) {
  v = wave_sum(v);
  __syncthreads();
  if ((TIDS & 63) == 0) red[TIDS >> 6] = v;
  __syncthreads();
  return red[0] + red[1] + red[2] + red[3];
}
__device__ __forceinline__ float blk_max(float v, float* red) {
#pragma unroll
  for (int o = 32; o > 0; o >>= 1) v = fmaxf(v, __shfl_xor(v, o));
  __syncthreads();
  if ((TIDS & 63) == 0) red[TIDS >> 6] = v;
  __syncthreads();
  return fmaxf(fmaxf(red[0], red[1]), fmaxf(red[2], red[3]));
}
__device__ __forceinline__ bool far(float got, float ref, float rel, float ab) { return !(fabsf(got - ref) <= rel * fabsf(ref) + ab); }
__device__ __forceinline__ void rope_ref(const float* z, float* o, int s) {
  for (int c = 0; c < 32; c++) {
    const int pos = (c < 16) ? (s / 64) : (s % 64);
    const float inv = powf(10000.0f, -(float)(2 * (c % 8)) / 16.0f);
    const float ang = (float)pos * inv;
    const int cb = c & 16, cc = c & 15;
    const float rot = (cc < 8) ? -z[cb + cc + 8] : z[cb + cc - 8];
    o[c] = z[c] * cosf(ang) + rot * sinf(ang);
  }
}
__device__ __forceinline__ void check_proj(const Params& p, int L, int r, char* smem) {
  float* hrow = (float*)smem;
  float* z = hrow + 1024;
  float* kvr = z + 416;
  float* red = kvr + 1024;
  float* kk = red + 8;
  const int tid = TIDS;
  __syncthreads();
  for (int k = tid; k < 1024; k += 256) hrow[k] = bf1(p.hx[(long)r * 1024 + k]);
  __syncthreads();
  for (int n = tid; n < 416; n += 256) {
    float a = 0.f;
    for (int k = 0; k < 1024; k++) a += hrow[k] * p.w_in[((long)L * 1024 + k) * 4256 + n];
    z[n] = a;
  }
  __syncthreads();
  unsigned bad = 0;
  if (L == 0 || r < TLAT)
  for (int n = tid; n < 256; n += 256) if (far(bf1(p.cq[(long)r * 256 + n]), z[160 + n], 0.02f, 0.03f)) bad |= 1u;
  for (int n = tid; n < 32; n += 256) if (far(p.kr[(long)r * 32 + n], z[128 + n], 0.02f, 0.03f)) bad |= 1u;
  const float ssc = blk_sum(tid < 128 ? z[tid] * z[tid] : 0.f, red);
  const float rc = rsqrtf(ssc / 128.0f + EPSV);
  for (int n = tid; n < 1024; n += 256) {
    float a = 0.f;
    for (int k = 0; k < 128; k++) a += z[k] * rc * p.g_ckv[L * 128 + k] * p.w_ukv[((long)L * 128 + k) * 1024 + n];
    kvr[n] = a;
  }
  __syncthreads();
  const bool lat = r < TLAT;
  const int b = lat ? (r >> 12) : ((r - TLAT) >> 8), s = lat ? (r & 4095) : ((r - TLAT) & 255), kpos = lat ? CTXL + s : s;
  for (int h = 0; h < 8; h++) {
    float sq = 0.f;
    if (tid < 64) sq = kvr[h * 128 + tid] * kvr[h * 128 + tid]; else if (tid < 96) sq = z[128 + tid - 64] * z[128 + tid - 64];
    const float ssk = blk_sum(sq, red);
    const float rk = rsqrtf(ssk / 96.0f + EPSV);
    if (tid == 0) {
      float* zr = kk + 96; float* zo = zr + 32;
      for (int c = 0; c < 32; c++) zr[c] = z[128 + c] * rk * p.g_kn[L * 96 + 64 + c];
      if (lat) rope_ref(zr, zo, s); else for (int c = 0; c < 32; c++) zo[c] = zr[c];
      for (int c = 0; c < 32; c++) kk[64 + c] = zo[c];
    }
    if (tid < 64) kk[tid] = kvr[h * 128 + tid] * rk * p.g_kn[L * 96 + tid];
    __syncthreads();
    if (tid < 96 && far(bf1(p.Kb[((long)(b * 8 + h) * SKEYS + kpos) * 96 + tid]), kk[tid], 0.03f, 0.03f)) bad |= 2u;
    if (tid < 64 && far(bf1(p.Vtb[((long)(b * 8 + h) * 64 + tid) * SKEYS + kpos]), kvr[h * 128 + 64 + tid], 0.03f, 0.03f)) bad |= 4u;
    __syncthreads();
  }
  if (bad & CHECK_MASK) atomicOr(&p.bar[0], bad & CHECK_MASK);
}
__device__ __forceinline__ void check_attn(const Params& p, int L, int r, int h, char* smem) {
  float* cqr = (float*)smem;
  float* q = cqr + 256;
  float* sc = q + 96;
  float* red = sc + 4352;
  const int tid = TIDS;
  const bool lat = r < TLAT;
  const int b = lat ? (r >> 12) : ((r - TLAT) >> 8), s = lat ? (r & 4095) : ((r - TLAT) & 255);
  const int nkeys = lat ? SKEYS : CTXL;
  __syncthreads();
  cqr[tid] = bf1(p.cq[(long)r * 256 + tid]);
  __syncthreads();
  const float rc = rsqrtf(blk_sum(cqr[tid] * cqr[tid], red) / 256.0f + EPSV);
  float qr = 0.f;
  if (tid < 96) for (int k = 0; k < 256; k++) qr += cqr[k] * rc * p.g_cq[L * 256 + k] * p.w_uq[((long)L * 256 + k) * 768 + h * 96 + tid];
  const float rq = rsqrtf(blk_sum(tid < 96 ? qr * qr : 0.f, red) / 96.0f + EPSV);
  if (tid < 96) q[tid] = qr * rq * p.g_qn[L * 96 + tid];
  __syncthreads();
  if (tid == 0 && lat) {
    float* zr = red + 8; float* zo = zr + 32;
    for (int c = 0; c < 32; c++) zr[c] = q[64 + c];
    rope_ref(zr, zo, s);
    for (int c = 0; c < 32; c++) q[64 + c] = zo[c];
  }
  __syncthreads();
  float mx = -1e30f;
  for (int key = tid; key < nkeys; key += 256) {
    float a = 0.f;
    for (int d = 0; d < 96; d++) a += q[d] * bf1(p.Kb[((long)(b * 8 + h) * SKEYS + key) * 96 + d]);
    a *= 0.10206207261596577f;
    sc[key] = a; mx = fmaxf(mx, a);
  }
  mx = blk_max(mx, red);
  float ps = 0.f;
  for (int key = tid; key < nkeys; key += 256) { const float e = expf(sc[key] - mx); sc[key] = e; ps += e; }
  const float tot = blk_sum(ps, red);
  unsigned bad = 0;
  if (tid < 64) {
    float a = 0.f;
    for (int key = 0; key < nkeys; key++) a += sc[key] * bf1(p.Vtb[((long)(b * 8 + h) * 64 + tid) * SKEYS + key]);
    a /= tot;
    if (far(bf1(p.Ob[(long)r * 512 + h * 64 + tid]), a, 0.04f, 1.5e-3f)) bad |= 8u;
  }
  if (bad & CHECK_MASK) atomicOr(&p.bar[0], bad & CHECK_MASK);
}
__device__ __forceinline__ void phase_check(const Params& p, int L, char* smem) {
  const int nq = (L == 0) ? 12 : 8;
  char* sm = smem + HALF_ * LDS_SMALL;
  for (int pass = 0; pass < 2; pass++) {
  FOR_PAIRED(pass == 0 ? 12 : nq * 8, uu)
    const int u = (pass == 0) ? uu : uu + 12;
    const int si = (u < 12) ? u : ((u - 12) >> 3);
    int r;
    switch (si) {
      case 0: r = 0; break; case 1: r = 63; break; case 2: r = 64; break; case 3: r = 4095; break;
      case 4: r = 4096 + 777; break; case 5: r = 12345; break; case 6: r = 20000; break; case 7: r = 32767; break;
      case 8: r = TLAT; break; case 9: r = TLAT + 255; break; case 10: r = TLAT + 256 + 100; break; default: r = TLAT + 2047; break;
    }
    if (u < 12) check_proj(p, L, r, sm);
    else check_attn(p, L, r, (u - 12) & 7, sm);
  }
  }
}
#endif

#define XB_TMO      128
#define XB_XCNT(j)  (256  + 64 * (j))
#define XB_XSUB(j)  (1280 + 64 * (j))
#define XB_XGEN(j)  (2304 + 64 * (j))
#define XB_TOP      3328
#define XB_TOPGEN   3392
#define XCD_BAR_WORDS 3456
#define XB_SPIN_CAP (1u << 22)
#define LAS __attribute__((address_space(3)))
__device__ __forceinline__ unsigned xb_ld(unsigned* p)              { return __hip_atomic_load(p, __ATOMIC_RELAXED, __HIP_MEMORY_SCOPE_AGENT); }
__device__ __forceinline__ unsigned xb_add(unsigned* p, unsigned v) { return __hip_atomic_fetch_add(p, v, __ATOMIC_RELAXED, __HIP_MEMORY_SCOPE_AGENT); }
__device__ __forceinline__ unsigned xb_xcc_id() { return (unsigned)__builtin_amdgcn_s_getreg((3 << 11) | 20) & 0xFu; }
#define XB_SPIN(cond, bar) do { unsigned _sp = 0; while (cond) { __builtin_amdgcn_s_sleep(1); \
    if ((++_sp & 255u) == 0u) { if (xb_ld(&(bar)[XB_TMO])) break; if (_sp > XB_SPIN_CAP) { atomicAdd(&(bar)[XB_TMO], 1u); break; } } } } while (0)
struct XcdBarrier { unsigned* bar; unsigned x; volatile LAS unsigned* st; };
__device__ __forceinline__ XcdBarrier xcd_barrier_post(unsigned* bar, volatile LAS unsigned* st) {
  XcdBarrier b; b.bar = bar; b.x = xb_xcc_id(); b.st = st;
  if (threadIdx.x == 0) (void)xb_add(&bar[XB_XCNT(b.x)], 1u);
  return b;
}
__device__ __forceinline__ void xcd_barrier_complete(unsigned* bar, unsigned x, unsigned& nloc, unsigned& nx) {
  const unsigned G = gridDim.x * gridDim.y * gridDim.z;
  unsigned sum, cnt, mine, sp = 0u;
  for (;;) {
    sum = 0u; cnt = 0u; mine = 0u;
#pragma unroll
    for (unsigned j = 0; j < 16; ++j) { const unsigned c = xb_ld(&bar[XB_XCNT(j)]); sum += c; cnt += (c > 0u) ? 1u : 0u; mine = (j == x) ? c : mine; }
    if (sum == G) break;
    __builtin_amdgcn_s_sleep(1);
    if ((++sp & 255u) == 0u) { if (xb_ld(&bar[XB_TMO])) break; if (sp > XB_SPIN_CAP) { atomicAdd(&bar[XB_TMO], 1u); break; } }
  }
  nloc = mine > 0u ? mine : 1u; nx = cnt > 0u ? cnt : 1u;
}
__device__ __forceinline__ void xcd_barrier(const XcdBarrier& b) {
  asm volatile("s_waitcnt vmcnt(0)" ::: "memory");
  __syncthreads();
  if (threadIdx.x == 0) {
    unsigned* bar = b.bar;
    asm volatile("" : "+s"(bar));
    __builtin_amdgcn_s_waitcnt(0);
    unsigned nloc = b.st[0], nx = b.st[1];
    if (nloc == 0u) { xcd_barrier_complete(bar, b.x, nloc, nx); b.st[0] = nloc; b.st[1] = nx; }
    const unsigned old = xb_add(&bar[XB_XSUB(b.x)], 1u);
    const unsigned gen = old / nloc;
    if (old + 1u == (gen + 1u) * nloc) {
      __builtin_amdgcn_fence(__ATOMIC_RELEASE, "agent");
      asm volatile("s_waitcnt vmcnt(0)" ::: "memory");
      const unsigned og = xb_add(&bar[XB_TOP], 1u);
      const unsigned tg = og / nx;
      if (og + 1u == (tg + 1u) * nx) xb_add(&bar[XB_TOPGEN], 1u);
      else XB_SPIN(xb_ld(&bar[XB_TOPGEN]) == tg, bar);
      __builtin_amdgcn_fence(__ATOMIC_ACQUIRE, "agent");
      xb_add(&bar[XB_XGEN(b.x)], 1u);
      asm volatile("s_waitcnt vmcnt(0)" ::: "memory");
    } else {
      XB_SPIN(xb_ld(&bar[XB_XGEN(b.x)]) == gen, bar);
      __builtin_amdgcn_fence(__ATOMIC_ACQUIRE, "agent");
      asm volatile("s_waitcnt vmcnt(0)" ::: "memory");
    }
  }
  __syncthreads();
}

#define NPHASE (23 + CHECK_ATTN)
#ifndef PH_LIMIT
#define PH_LIMIT NPHASE
#endif
__device__ __forceinline__ void run_phase(const Params& p, int ph, char* smem, bool dry = false, bool big = false) {
  if (ph == 0) { phase_prep(p, smem); return; }
#if CHECK_ATTN
  if (ph == 23) {
    if (blockIdx.x == 0 && threadIdx.x == 0 && __hip_atomic_load(&p.bar[0], __ATOMIC_RELAXED, __HIP_MEMORY_SCOPE_AGENT) != 0u) p.out[0] = __uint_as_float(0x7fc00000u);
    return;
  }
#endif
  const int L = (ph - 1) / 11, s = (ph - 1) % 11;
  if (s == 0 || s == 7) {
    phase_norm(p, L, s == 0 ? 0 : 1, (s == 0 || L == 0) ? RTOT : TLAT);
    if (s == 0) phase_tables(p, L);
    return;
  }
  switch (s) {
    case 1: phase_s2<true>(p, L, smem); break;
    case 2: phase_s3(p, L, smem, dry); break;
    case 3: phase_s4(p, L, smem); break;
    case 4: phase_dftC(p, smem);
#if CHECK_ATTN
      phase_check(p, L, smem);
#endif
      break;
    case 5: phase_s7<true>(p, L, smem); break;
    case 6: phase_s8<true>(p, L, smem, dry); break;
    case 8: phase_s10<true>(p, L, smem); break;
    case 9: phase_s11a(p, L); break;
    case 10: phase_s11b(p, L, dry); break;
  }
}

__global__ void __launch_bounds__(512, 2) mega(Params p, int ph0, int ph1) {
  extern __shared__ __attribute__((aligned(16))) char smem[];
  __shared__ uint4 xb_words;
  cg::grid_group grid = cg::this_grid();
  const bool multi = (ph1 - ph0) > 1;
  const bool big = blockDim.x == 512;
  XcdBarrier xb;
  if (multi) {
    if (threadIdx.x == 0) xb_words = make_uint4(0u, 0u, 0u, 0u);
    __syncthreads();
    xb = xcd_barrier_post(p.bar, (volatile LAS unsigned*)&xb_words);
  }
  for (int ph = ph0; ph < ph1; ph++) {
    if (ph > ph0) {
      if (ph == ph0 + 1) grid.sync();
      else xcd_barrier(xb);
    }
    run_phase(p, ph, smem, false, big);
  }
}

static inline size_t al256(size_t x) { return (x + 255) & ~(size_t)255; }
extern "C" void kernel_launch(void* const* d_in, const int* in_sizes, int n_in, void* d_out, int out_size, void* d_ws,
                              size_t ws_size, hipStream_t stream) {
  Params p{};
  const float* const* in = (const float* const*)d_in;
  p.x = in[0]; p.c = in[1]; p.ctx = in[2]; p.c_ctx = in[3]; p.w_mod = in[4]; p.b_mod = in[5]; p.g_norm1 = in[6];
  p.w_in = in[7]; p.g_ckv = in[8]; p.w_ukv = in[9]; p.g_cq = in[10]; p.w_uq = in[11]; p.g_qn = in[12]; p.g_kn = in[13];
  p.w_dw = in[14]; p.b_dw = in[15]; p.g_cln = in[16]; p.b_cln = in[17]; p.wb_attn = in[18]; p.wb_fnet = in[19];
  p.wb_conv = in[20]; p.w_out = in[21]; p.g_norm2 = in[22]; p.w_query = in[23]; p.sub_keys = in[24]; p.u_tab = in[25];
  p.v_tab = in[26];
  p.out = (float*)d_out;
  p.one = 1; p.pad_ = 0;
  char* ws = (char*)d_ws;
  size_t off = 0;
  auto take = [&](size_t bytes) { char* q = ws + off; off += al256(bytes); return q; };
  p.bar = (unsigned*)take(XCD_BAR_WORDS * 4);
  const size_t mods_bytes = 2 * 9 * 6144 * 4;
  p.mods = (float*)take(mods_bytes);
  p.ropetab = (float*)take(64 * 8 * 2 * 4);
  p.W2T = (u16*)take(2ull * W2T_SZ * 2);
  p.WgT = (u16*)take(2ull * WGT_SZ * 2);
  p.WukvT = (u16*)take(2ull * WUKV_SZ * 2);
  p.WuqT = (u16*)take(2ull * WUQ_SZ * 2);
  p.WbaT = (u16*)take(2ull * WBA_SZ * 2);
  p.WbfT = (u16*)take(2ull * WBF_SZ * 2);
  p.WbcT = (u16*)take(2ull * WBC_SZ * 2);
  p.WoutT = (u16*)take(2ull * WOUT_SZ * 2);
  p.WqT = (u16*)take(2ull * WQ_SZ * 2);
  p.SubK = (u16*)take(2ull * SUBK_SZ * 2);
  p.WA = (u16*)take(128 * 128 * 2);
  p.WC = (u16*)take(128 * 128 * 2);
  p.tw = (float*)take(4096 * 2 * 4);
  p.GB = (u16*)take((size_t)NB * 256 * 8192 * 2);
  p.Dctx = (u16*)take(256ull * 512 * 2);
  p.Wcs = (u16*)take(128ull * 64 * 2);
  p.UT8 = (unsigned char*)take((size_t)NEXP * 1024);
  p.VT8 = (unsigned char*)take((size_t)NEXP * 1024);
  p.hx = (u16*)take((size_t)RTOT * 1024 * 2);
  {
    const size_t b0 = off;
    p.cq = (u16*)take((size_t)RTOT * 256 * 2);
    p.zf = (u16*)take((size_t)RTOT * 256 * 2);
    p.zc = (u16*)take((size_t)RTOT * 512 * 2);
    p.ckv = (u16*)take((size_t)RTOT * 128 * 2);
    p.kr = (float*)take((size_t)RTOT * 32 * 4);
    p.m = (u16*)(ws + b0);
    p.PD = (unsigned*)(ws + b0);
  }
  {
    const size_t c0 = off;
    p.Kb = (u16*)take((size_t)NB * NH * SKEYS * 96 * 2);
    p.Vtb = (u16*)take((size_t)NB * NH * 64 * SKEYS * 2);
    p.eid = (int*)(ws + c0);
    p.gate = (float*)(ws + c0 + al256((size_t)RTOT * 128 * 4));
  }
  p.Ytl = (u16*)take((size_t)NB * 256 * 8192 * 2);
  p.Ytc = (u16*)take((size_t)NB * 256 * 512 * 2);
  p.Ob = (u16*)take((size_t)RTOT * 512 * 2);
  p.Fb = (u16*)take((size_t)RTOT * 256 * 2);
  p.cv = (u16*)take((size_t)RTOT * 256 * 2);
  p.ctx1 = (float*)take((size_t)TCTX * 1024 * 4);
  if (off > ws_size) { fprintf(stderr, "workspace too small: need %zu have %zu\n", off, ws_size); return; }

  (void)hipMemsetAsync(p.bar, 0, XCD_BAR_WORDS * 4, stream);
  static int cus = 0;
  if (!cus) {
    int dev = 0;
    (void)hipGetDevice(&dev);
    (void)hipDeviceGetAttribute(&cus, hipDeviceAttributeMultiprocessorCount, dev);
    (void)hipFuncSetAttribute((const void*)mega, hipFuncAttributeMaxDynamicSharedMemorySize, LDS_BIG);
  }
#if ONE_LAUNCH
  int ph0 = 0, ph1 = NPHASE;
  void* args[] = {&p, &ph0, &ph1};
  hipError_t e = hipLaunchCooperativeKernel((void*)mega, dim3(cus), dim3(512), args, LDS_BIG, stream);
  if (e != hipSuccess) fprintf(stderr, "cooperative launch failed: %s (grid %d)\n", hipGetErrorString(e), cus);
#else
  for (int ph = 0; ph < PH_LIMIT; ph++) {
    const int kind = (ph == 0) ? 11 : (ph - 1) % 11;
    const bool bigp = (kind == 1 || kind == 5 || kind == 6 || kind == 8);
    if (bigp) mega<<<cus, 512, LDS_BIG, stream>>>(p, ph, ph + 1);
    else mega<<<cus * 2, 256, LDS_SMALL, stream>>>(p, ph, ph + 1);
  }
#endif
}
```

```cpp
#include <hip/hip_runtime.h>
#include <hip/hip_cooperative_groups.h>
#include <cstdio>
#include <cstdint>
namespace cg = cooperative_groups;

#ifndef ABL_PEER
#define ABL_PEER 1
#endif
#ifndef ABL_BR
#define ABL_BR 7
#endif
#ifndef PROBE_S
#define PROBE_S (-1)
#endif
#ifndef PROBE_REPS
#define PROBE_REPS 4
#endif
#ifndef CHECK_ATTN
#define CHECK_ATTN 0
#endif
#ifndef CHECK_MASK
#define CHECK_MASK 0xff
#endif
#ifndef ONE_LAUNCH
#define ONE_LAUNCH 1
#endif

typedef unsigned short u16;
typedef __attribute__((ext_vector_type(8))) __bf16 bf16x8;
typedef __attribute__((ext_vector_type(2))) __bf16 bf16x2;
typedef __attribute__((ext_vector_type(16))) float f32x16;
typedef __attribute__((ext_vector_type(2))) float f32x2;

#define NB 8
#define SEQ 4096
#define DM 1024
#define CTXL 256
#define TLAT (NB * SEQ)
#define TCTX (NB * CTXL)
#define RTOT (TLAT + TCTX)
#define SKEYS (CTXL + SEQ)
#define NH 8
#define QKD 96
#define N2 1280
#define NEXP 16384
#define EPSV 1e-6f

struct Params {
  const float *x, *c, *ctx, *c_ctx, *w_mod, *b_mod, *g_norm1, *w_in, *g_ckv, *w_ukv, *g_cq, *w_uq, *g_qn, *g_kn,
      *w_dw, *b_dw, *g_cln, *b_cln, *wb_attn, *wb_fnet, *wb_conv, *w_out, *g_norm2, *w_query, *sub_keys, *u_tab, *v_tab;
  float* out;
  unsigned* bar;
  float* mods;
  float* ropetab;
  u16 *W2T, *WgT, *WukvT, *WuqT, *WbaT, *WbfT, *WbcT, *WoutT, *WqT, *SubK;
  u16 *WA, *WC, *Dctx, *Wcs;
  float* tw;
  u16* GB;
  unsigned char *UT8, *VT8;
  unsigned* PD;
  u16* hx;
  u16 *cq, *zf, *zc, *ckv; float* kr;
  u16* m;
  u16 *Kb, *Vtb;
  int* eid; float* gate;
  u16 *Ytl, *Ytc, *Ob, *Fb, *cv;
  float* ctx1;
  int one; int pad_;
};

#define W2T_SZ (N2 * 1024)
#define WGT_SZ (3072 * 1024)
#define WUKV_SZ (1024 * 128)
#define WUQ_SZ (768 * 256)
#define WBA_SZ (1024 * 512)
#define WBF_SZ (1024 * 256)
#define WBC_SZ (1024 * 256)
#define WOUT_SZ (1024 * 1024)
#define WQ_SZ (1024 * 1024)
#define SUBK_SZ (8 * 2 * 128 * 64)

__device__ __forceinline__ unsigned pack2(float a, float b) {
  f32x2 v = {a, b};
  return __builtin_bit_cast(unsigned, __builtin_convertvector(v, bf16x2));
}
__device__ __forceinline__ u16 tobf(float a) { return (u16)(pack2(a, 0.f) & 0xffffu); }
__device__ __forceinline__ float bf_lo(unsigned u) { return __uint_as_float(u << 16); }
__device__ __forceinline__ float bf_hi(unsigned u) { return __uint_as_float(u & 0xffff0000u); }
__device__ __forceinline__ float bf1(u16 u) { return __uint_as_float(((unsigned)u) << 16); }
__device__ __forceinline__ f32x16 mfma32(uint4 a, uint4 b, f32x16 c) {
  return __builtin_amdgcn_mfma_f32_32x32x16_bf16(__builtin_bit_cast(bf16x8, a), __builtin_bit_cast(bf16x8, b), c, 0, 0, 0);
}
__device__ __forceinline__ uint4 ldg16(const void* p) { return *(const uint4*)p; }
__device__ __forceinline__ int opaque(int x) { asm volatile("" : "+v"(x)); return x; }
#define TIDX opaque((int)threadIdx.x)
#define HALF_ (opaque((int)threadIdx.x) >> 8)
#define TIDS (opaque((int)threadIdx.x) & 255)
#define VBID ((int)blockIdx.x + HALF_ * (int)gridDim.x)
#define NVB ((int)gridDim.x * (int)(blockDim.x >> 8))
#define FOR_PAIRED(N, U) for (int _b = (int)blockIdx.x, _g = (int)gridDim.x, _st = _g * (int)(blockDim.x >> 8); _b < (N); _b += _st) { \
    int U = _b + HALF_ * _g; if (U >= (N)) U = _b;
__device__ __forceinline__ float wave_sum(float v) {
#pragma unroll
  for (int o = 32; o > 0; o >>= 1) v += __shfl_xor(v, o);
  return v;
}
__device__ __forceinline__ float half_sum(float v) {
#pragma unroll
  for (int o = 16; o > 0; o >>= 1) v += __shfl_xor(v, o);
  return v;
}
__device__ __forceinline__ float sigmoidf_(float x) { return 1.f / (1.f + __expf(-x)); }
__device__ __forceinline__ float siluf_(float x) { return x / (1.f + __expf(-x)); }
__device__ __forceinline__ float gelu_tanh(float x) {
  float u = 0.7978845608028654f * (x + 0.044715f * x * x * x);
  float t = 1.f - 2.f / (1.f + __expf(2.f * u));
  return 0.5f * x * (1.f + t);
}
__device__ __forceinline__ int row_mod(int r) { return r < TLAT ? (r >> 12) : 8; }

#define SMEM_BYTES 73728
#define LDS_SMALL 73728
#define LDS_BIG 147456
#define LDT 72

#define LAS3 __attribute__((address_space(3)))
__device__ __forceinline__ void glds16(const u16* g, char* lds_wave_base) {
  __builtin_amdgcn_global_load_lds((const unsigned*)g, (LAS3 unsigned*)lds_wave_base, 16, 0, 0);
}
__device__ __forceinline__ void gemm128x(const u16* __restrict__ A, int lda, const u16* __restrict__ Bt, int ldb, int bs1, int bs2, int K,
                                         f32x16 (&acc)[2][2], char* smem) {
  char* As = smem;
  char* Bs = smem + 32768;
  const int tid = TIDS, lane = tid & 63, w = tid >> 6, wr = w >> 1, wc = w & 1;
  const int nk = K >> 6;
  const int srow = w * 8 + (lane >> 3);
  const int schunk = (lane & 7) ^ ((srow >> 1) & 7);
  const int aoff = srow * lda + schunk * 8, boff = srow * ldb + schunk * 8;
  const int a32 = 32 * lda;
  __syncthreads();
#pragma unroll
  for (int i = 0; i < 4; i++) {
    glds16(A + (aoff + i * a32), As + (i * 4 + w) * 1024);
    glds16(Bt + (boff + (i & 1) * bs1 + (i >> 1) * bs2), Bs + (i * 4 + w) * 1024);
  }
  __syncthreads();
  const int fr = lane & 31, hh = lane >> 5;
  const int sw = (fr >> 1) & 7;
  for (int kt = 0; kt < nk; kt++) {
    const int cur = kt & 1;
    if (kt + 1 < nk) {
      const int ko = (kt + 1) * 64;
      char* An = As + (cur ^ 1) * 16384;
      char* Bn = Bs + (cur ^ 1) * 16384;
#pragma unroll
      for (int i = 0; i < 4; i++) {
        glds16(A + (aoff + i * a32 + ko), An + (i * 4 + w) * 1024);
        glds16(Bt + (boff + (i & 1) * bs1 + (i >> 1) * bs2 + ko), Bn + (i * 4 + w) * 1024);
      }
    }
    const char* Ac = As + cur * 16384 + (wr * 64 + fr) * 128;
    const char* Bc = Bs + cur * 16384 + (wc * 64 + fr) * 128;
#pragma unroll
    for (int kk = 0; kk < 4; kk++) {
      const int so = ((2 * kk + hh) ^ sw) << 4;
      uint4 a0 = *(const uint4*)(Ac + so);
      uint4 a1 = *(const uint4*)(Ac + 32 * 128 + so);
      uint4 b0 = *(const uint4*)(Bc + so);
      uint4 b1 = *(const uint4*)(Bc + 32 * 128 + so);
      acc[0][0] = mfma32(a0, b0, acc[0][0]);
      acc[0][1] = mfma32(a0, b1, acc[0][1]);
      acc[1][0] = mfma32(a1, b0, acc[1][0]);
      acc[1][1] = mfma32(a1, b1, acc[1][1]);
    }
    __syncthreads();
  }
}
__device__ __forceinline__ void gemm128(const u16* __restrict__ A, int lda, const u16* __restrict__ Bt, int ldb, int K,
                                        f32x16 (&acc)[2][2], char* smem) {
  gemm128x(A, lda, Bt, ldb, 32 * ldb, 64 * ldb, K, acc, smem);
}
__device__ __forceinline__ void gemm128h(const u16* __restrict__ A, int lda, const u16* __restrict__ Bt, int ldb, int K, int jh,
                                         f32x16 (&acc)[2], char* smem) {
  char* As = smem;
  char* Bs = smem + 32768;
  const int tid = TIDS, lane = tid & 63, w = tid >> 6, wr = w >> 1, wc = w & 1;
  const int nk = K >> 6;
  const int srow = w * 8 + (lane >> 3);
  const int schunk = (lane & 7) ^ ((srow >> 1) & 7);
  const int aoff = srow * lda + schunk * 8;
  const int a32 = 32 * lda;
  const int boff = (jh * 32 + srow) * ldb + schunk * 8, b64 = 64 * ldb;
  __syncthreads();
#pragma unroll
  for (int i = 0; i < 4; i++) glds16(A + (aoff + i * a32), As + (i * 4 + w) * 1024);
#pragma unroll
  for (int i = 0; i < 2; i++) glds16(Bt + (boff + i * b64), Bs + (i * 4 + w) * 1024);
  __syncthreads();
  const int fr = lane & 31, hh = lane >> 5;
  const int sw = (fr >> 1) & 7;
  for (int kt = 0; kt < nk; kt++) {
    const int cur = kt & 1;
    if (kt + 1 < nk) {
      const int ko = (kt + 1) * 64;
      char* An = As + (cur ^ 1) * 16384;
      char* Bn = Bs + (cur ^ 1) * 8192;
#pragma unroll
      for (int i = 0; i < 4; i++) glds16(A + (aoff + i * a32 + ko), An + (i * 4 + w) * 1024);
#pragma unroll
      for (int i = 0; i < 2; i++) glds16(Bt + (boff + i * b64 + ko), Bn + (i * 4 + w) * 1024);
    }
    const char* Ac = As + cur * 16384 + (wr * 64 + fr) * 128;
    const char* Bc = Bs + cur * 8192 + (wc * 32 + fr) * 128;
#pragma unroll
    for (int kk = 0; kk < 4; kk++) {
      const int so = ((2 * kk + hh) ^ sw) << 4;
      uint4 a0 = *(const uint4*)(Ac + so);
      uint4 a1 = *(const uint4*)(Ac + 32 * 128 + so);
      uint4 b0 = *(const uint4*)(Bc + so);
      acc[0] = mfma32(a0, b0, acc[0]);
      acc[1] = mfma32(a1, b0, acc[1]);
    }
    __syncthreads();
  }
}
#define WAIT_VM(n) asm volatile("s_waitcnt vmcnt(%0)" ::"n"(n) : "memory")
#define G256_STAGE 49152
__device__ __forceinline__ void gemm256(const u16* __restrict__ A, int lda, const u16* __restrict__ Bt, int ldb, int K,
                                        f32x16 (&acc)[2][2], char* smem) {
  const int tid = TIDX, lane = tid & 63, w = tid >> 6, wr = w >> 1, wc = w & 1;
  const int nk = K >> 6;
  const int srow = w * 8 + (lane >> 3);
  const int schunk = (lane & 7) ^ ((srow >> 1) & 7);
  const int aoff = srow * lda + schunk * 8, boff = srow * ldb + schunk * 8;
  const int a64 = 64 * lda, b64 = 64 * ldb;
  auto issue = [&](int kt) __attribute__((always_inline)) {
    char* As = smem + (kt % 3) * G256_STAGE;
    char* Bs = As + 32768;
    const int ko = kt * 64;
#pragma unroll
    for (int i = 0; i < 4; i++) glds16(A + (aoff + i * a64 + ko), As + (w + 8 * i) * 1024);
#pragma unroll
    for (int i = 0; i < 2; i++) glds16(Bt + (boff + i * b64 + ko), Bs + (w + 8 * i) * 1024);
  };
  WAIT_VM(0);
  __syncthreads();
  issue(0);
  if (nk > 1) issue(1);
  const int fr = lane & 31, hh = lane >> 5;
  const int sw = (fr >> 1) & 7;
  const int rdA = (wr * 64 + fr) * 128, rdB = 32768 + (wc * 64 + fr) * 128;
  for (int kt = 0; kt < nk; kt++) {
    if (kt + 1 < nk) WAIT_VM(6); else WAIT_VM(0);
    __builtin_amdgcn_s_barrier();
    if (kt + 2 < nk) issue(kt + 2);
    const char* Sb = smem + (kt % 3) * G256_STAGE;
#pragma unroll
    for (int kk = 0; kk < 4; kk++) {
      const int so = ((2 * kk + hh) ^ sw) << 4;
      uint4 a0 = *(const uint4*)(Sb + rdA + so);
      uint4 a1 = *(const uint4*)(Sb + rdA + 32 * 128 + so);
      uint4 b0 = *(const uint4*)(Sb + rdB + so);
      uint4 b1 = *(const uint4*)(Sb + rdB + 32 * 128 + so);
      acc[0][0] = mfma32(a0, b0, acc[0][0]);
      acc[0][1] = mfma32(a0, b1, acc[0][1]);
      acc[1][0] = mfma32(a1, b0, acc[1][0]);
      acc[1][1] = mfma32(a1, b1, acc[1][1]);
    }
  }
  __syncthreads();
}
__device__ __forceinline__ void gemm256h(const u16* __restrict__ A, int lda, const u16* __restrict__ Bt, int ldb, int K, int jh,
                                         f32x16 (&acc)[2], char* smem) {
  const int tid = TIDX, lane = tid & 63, w = tid >> 6, wr = w >> 1, wc = w & 1;
  const int nk = K >> 6;
  const int srow = w * 8 + (lane >> 3);
  const int schunk = (lane & 7) ^ ((srow >> 1) & 7);
  const int aoff = srow * lda + schunk * 8;
  const int a64 = 64 * lda;
  const int boff = ((srow >> 5) * 64 + jh * 32 + (srow & 31)) * ldb + schunk * 8;
  auto issue = [&](int kt) __attribute__((always_inline)) {
    char* As = smem + (kt % 3) * G256_STAGE;
    char* Bs = As + 32768;
    const int ko = kt * 64;
#pragma unroll
    for (int i = 0; i < 4; i++) glds16(A + (aoff + i * a64 + ko), As + (w + 8 * i) * 1024);
    glds16(Bt + (boff + ko), Bs + w * 1024);
  };
  WAIT_VM(0);
  __syncthreads();
  issue(0);
  if (nk > 1) issue(1);
  const int fr = lane & 31, hh = lane >> 5;
  const int sw = (fr >> 1) & 7;
  const int rdA = (wr * 64 + fr) * 128, rdB = 32768 + (wc * 32 + fr) * 128;
  for (int kt = 0; kt < nk; kt++) {
    if (kt + 1 < nk) WAIT_VM(5); else WAIT_VM(0);
    __builtin_amdgcn_s_barrier();
    if (kt + 2 < nk) issue(kt + 2);
    const char* Sb = smem + (kt % 3) * G256_STAGE;
#pragma unroll
    for (int kk = 0; kk < 4; kk++) {
      const int so = ((2 * kk + hh) ^ sw) << 4;
      uint4 a0 = *(const uint4*)(Sb + rdA + so);
      uint4 a1 = *(const uint4*)(Sb + rdA + 32 * 128 + so);
      uint4 b0 = *(const uint4*)(Sb + rdB + so);
      acc[0] = mfma32(a0, b0, acc[0]);
      acc[1] = mfma32(a1, b0, acc[1]);
    }
  }
  __syncthreads();
}
#define FOR_UNITS_XCD(NRT, NCT, RT, CT) \
  for (int _s = (int)(blockIdx.x >> 3), _per = (NRT) >> 3, _n = _per * (NCT); _s < _n; _s += (int)(gridDim.x >> 3)) { \
    const int RT = (int)(blockIdx.x & 7) * _per + _s / (NCT), CT = _s % (NCT);
#define ZERO_ACC(acc) { _Pragma("unroll") for (int _i = 0; _i < 2; _i++) _Pragma("unroll") for (int _j = 0; _j < 2; _j++) _Pragma("unroll") for (int _r = 0; _r < 16; _r++) acc[_i][_j][_r] = 0.f; }
#define ACC_ROW(wr, i, r, lane) ((wr) * 64 + (i) * 32 + ((r) & 3) + 8 * ((r) >> 2) + 4 * ((lane) >> 5))
#define ACC_COL(wc, j, lane) ((wc) * 64 + (j) * 32 + ((lane) & 31))

__device__ __forceinline__ void job_mods(const Params& p, int job, char* smem) {
  float* s = (float*)smem;
  float* red = s + 9 * 1024;
  const int L = job / 96, nt = job % 96;
  const int tid = TIDS, lane = tid & 63, w = tid >> 6;
  __syncthreads();
  for (int i = tid; i < 9 * 1024; i += 256) {
    const int j = i >> 10, k = i & 1023;
    const float cv = (j < 8) ? p.c[j * 1024 + k] : p.c_ctx[k];
    s[i] = siluf_(cv);
  }
  __syncthreads();
  const int n = nt * 64 + lane;
  float acc[9];
#pragma unroll
  for (int j = 0; j < 9; j++) acc[j] = 0.f;
  const float* wp = p.w_mod + (long)L * 1024 * 6144 + (long)(w * 256) * 6144 + n;
#pragma unroll 8
  for (int k = 0; k < 256; k++) {
    const float wv = wp[(long)k * 6144];
#pragma unroll
    for (int j = 0; j < 9; j++) acc[j] += s[j * 1024 + w * 256 + k] * wv;
  }
#pragma unroll
  for (int j = 0; j < 9; j++) red[(w * 9 + j) * 64 + lane] = acc[j];
  __syncthreads();
  for (int i = tid; i < 9 * 64; i += 256) {
    const int j = i >> 6, l = i & 63;
    const float v = ((red[(0 * 9 + j) * 64 + l] + red[(1 * 9 + j) * 64 + l]) + red[(2 * 9 + j) * 64 + l]) + red[(3 * 9 + j) * 64 + l];
    p.mods[(L * 9 + j) * 6144 + nt * 64 + l] = v + p.b_mod[L * 6144 + nt * 64 + l];
  }
}

__device__ __forceinline__ void job_convT(const float* src, int ldsrc, int c0, int k0, u16* dst, int K, int n0, const float* scale, char* smem) {
  float* t = (float*)smem;
  const int tid = TIDS;
  __syncthreads();
  const int nc = tid & 31, kr = tid >> 5;
#pragma unroll 4
  for (int kk = kr; kk < 128; kk += 8) {
    float v = 0.f;
    if (src) { v = src[(long)(k0 + kk) * ldsrc + c0 + nc]; if (scale) v *= scale[k0 + kk]; }
    t[nc * 129 + kk] = v;
  }
  __syncthreads();
  const int nr = tid >> 3, kc = (tid & 7) * 16;
  unsigned o[8];
#pragma unroll
  for (int q = 0; q < 8; q++) o[q] = pack2(t[nr * 129 + kc + 2 * q], t[nr * 129 + kc + 2 * q + 1]);
  uint4* dp = (uint4*)(dst + (long)(n0 + nr) * K + k0 + kc);
  dp[0] = make_uint4(o[0], o[1], o[2], o[3]);
  dp[1] = make_uint4(o[4], o[5], o[6], o[7]);
}

#define NJ_W2 (40 * 8)
#define NJ_WG (96 * 8)
#define NJ_UKV (32 * 1)
#define NJ_UQ (24 * 2)
#define NJ_BA (32 * 4)
#define NJ_BF (32 * 2)
#define NJ_BC (32 * 2)
#define NJ_OUT (32 * 8)
#define NJ_WQ (32 * 8)
#define NJ_CONV_LAYER (NJ_W2 + NJ_WG + NJ_UKV + NJ_UQ + NJ_BA + NJ_BF + NJ_BC + NJ_OUT + NJ_WQ)

__device__ __forceinline__ void job_conv_weights(const Params& p, int job, char* smem) {
  const int L = job / NJ_CONV_LAYER;
  int j = job % NJ_CONV_LAYER;
  const float* src; int ldsrc, c0, k0, K, n0; u16* dst; const float* scale = nullptr;
  if (j < NJ_W2) {
    const int nt = j >> 3, kt = j & 7; n0 = nt * 32;
    bool valid = true;
    if (n0 < 256) c0 = 160 + n0;
    else if (n0 < 512) c0 = 416 + (n0 - 256);
    else if (n0 < 1024) c0 = 672 + (n0 - 512);
    else if (n0 < 1152) c0 = n0 - 1024;
    else if (n0 < 1184) c0 = 128 + (n0 - 1152);
    else { c0 = 0; valid = false; }
    src = valid ? p.w_in + (long)L * 1024 * 4256 : nullptr; ldsrc = 4256; k0 = kt * 128; dst = p.W2T + (long)L * W2T_SZ; K = 1024;
  } else if ((j -= NJ_W2) < NJ_WG) {
    const int nt = j >> 3, kt = j & 7;
    src = p.w_in + (long)L * 1024 * 4256; ldsrc = 4256; c0 = 1184 + nt * 32; k0 = kt * 128; dst = p.WgT + (long)L * WGT_SZ; K = 1024; n0 = nt * 32;
  } else if ((j -= NJ_WG) < NJ_UKV) {
    src = p.w_ukv + (long)L * 128 * 1024; ldsrc = 1024; c0 = j * 32; k0 = 0; dst = p.WukvT + (long)L * WUKV_SZ; K = 128; n0 = j * 32; scale = p.g_ckv + L * 128;
  } else if ((j -= NJ_UKV) < NJ_UQ) {
    const int nt = j >> 1, kt = j & 1;
    src = p.w_uq + (long)L * 256 * 768; ldsrc = 768; c0 = nt * 32; k0 = kt * 128; dst = p.WuqT + (long)L * WUQ_SZ; K = 256; n0 = nt * 32; scale = p.g_cq + L * 256;
  } else if ((j -= NJ_UQ) < NJ_BA) {
    const int nt = j >> 2, kt = j & 3;
    src = p.wb_attn + (long)L * 512 * 1024; ldsrc = 1024; c0 = nt * 32; k0 = kt * 128; dst = p.WbaT + (long)L * WBA_SZ; K = 512; n0 = nt * 32;
  } else if ((j -= NJ_BA) < NJ_BF) {
    const int nt = j >> 1, kt = j & 1;
    src = p.wb_fnet + (long)L * 256 * 1024; ldsrc = 1024; c0 = nt * 32; k0 = kt * 128; dst = p.WbfT + (long)L * WBF_SZ; K = 256; n0 = nt * 32;
  } else if ((j -= NJ_BF) < NJ_BC) {
    const int nt = j >> 1, kt = j & 1;
    src = p.wb_conv + (long)L * 256 * 1024; ldsrc = 1024; c0 = nt * 32; k0 = kt * 128; dst = p.WbcT + (long)L * WBC_SZ; K = 256; n0 = nt * 32;
  } else if ((j -= NJ_BC) < NJ_OUT) {
    const int nt = j >> 3, kt = j & 7;
    src = p.w_out + (long)L * 1024 * 1024; ldsrc = 1024; c0 = nt * 32; k0 = kt * 128; dst = p.WoutT + (long)L * WOUT_SZ; K = 1024; n0 = nt * 32;
  } else {
    j -= NJ_OUT;
    const int nt = j >> 3, kt = j & 7;
    src = p.w_query + (long)L * 1024 * 1024; ldsrc = 1024; c0 = nt * 32; k0 = kt * 128; dst = p.WqT + (long)L * WQ_SZ; K = 1024; n0 = nt * 32;
  }
  job_convT(src, ldsrc, c0, k0, dst, K, n0, scale, smem);
}

__device__ __forceinline__ void job_cvt_straight(const float* src, u16* dst, long job) {
  const long base = job * 8192 + TIDS * 8;
#pragma unroll
  for (int i = 0; i < 4; i++) {
    const long o = base + i * 2048;
    float4 a = *(const float4*)(src + o), b = *(const float4*)(src + o + 4);
    *(uint4*)(dst + o) = make_uint4(pack2(a.x, a.y), pack2(a.z, a.w), pack2(b.x, b.y), pack2(b.z, b.w));
  }
}

#define NJ_MISC 87
__device__ __forceinline__ void job_misc(const Params& p, int job) {
  const int tid = TIDS;
#pragma unroll 1
  for (int q = 0; q < 8; q++) {
    const int e = tid + 256 * q;
    if (job < 64) {
      const int i = job * 2048 + e;
      const int k = i >> 9, ee = i & 511, part = ee >> 8, t = ee & 255;
      const float a = (float)((k * t) & 255) * (1.0f / 128.0f);
      p.Dctx[i] = tobf((part == 0 ? cospif(a) : -sinpif(a)) * (1.0f / 16.0f));
    } else if (job < 72) {
      const int i = (job - 64) * 2048 + e;
      const int R = i >> 7, kk = i & 127, k1 = (R >> 6) * 32 + (R & 31), pr = (R >> 5) & 1, part = kk >> 6, t1 = kk & 63;
      const float a = (float)((k1 * t1) & 63) * (1.0f / 32.0f);
      const float cs = cospif(a), sn = sinpif(a);
      const float v = (pr == 0) ? (part == 0 ? cs : -sn) : (part == 0 ? -sn : -cs);
      p.WA[i] = tobf(v * 0.125f);
    } else if (job < 80) {
      const int i = (job - 72) * 2048 + e;
      const int k2 = i >> 7, kk = i & 127, part = kk >> 6, t2 = kk & 63;
      const float a = (float)((k2 * t2) & 63) * (1.0f / 32.0f);
      p.WC[i] = (k2 < 64) ? tobf((part == 0 ? cospif(a) : sinpif(a)) * 0.125f) : (u16)0;
    } else if (job < 84) {
      const int i = (job - 80) * 2048 + e;
      const int n = i >> 6, d = i & 63, pp = n >> 6, en = n & 63;
      const float a = (float)((en * d) & 63) * (1.0f / 32.0f);
      p.Wcs[i] = tobf((pp == 0 ? cospif(a) : sinpif(a)) * 0.125f);
    } else if (job < 86) {
      const int i = (job - 84) * 2048 + e;
      const float a = (float)i * (1.0f / 2048.0f);
      p.tw[2 * i] = cospif(a); p.tw[2 * i + 1] = sinpif(a);
    } else if (e < 512) {
      const int pos = e >> 3, mm = e & 7;
      const float inv = powf(10000.0f, -(float)(2 * mm) / 16.0f);
      const float ang = (float)pos * inv;
      p.ropetab[e * 2] = cosf(ang);
      p.ropetab[e * 2 + 1] = sinf(ang);
    }
  }
}

#define NJ_MODS 192
#define NJ_CONVW (2 * NJ_CONV_LAYER)
#define NJ_SUBK 32
#define NJ_PREP (NJ_MODS + NJ_CONVW + NJ_SUBK + NJ_MISC)

__device__ __forceinline__ void phase_prep(const Params& p, char* smem) {
  char* sm = smem + HALF_ * LDS_SMALL;
  FOR_PAIRED(NJ_MODS, j) job_mods(p, j, sm); }
  FOR_PAIRED(NJ_CONVW, j) job_conv_weights(p, j, sm); }
  for (int j = VBID; j < NJ_SUBK; j += NVB) job_cvt_straight(p.sub_keys, p.SubK, j);
  for (int j = NVB - 1 - VBID; j < NJ_MISC; j += NVB) job_misc(p, j);
}

__device__ __forceinline__ void phase_norm(const Params& p, int L, int which, int nrows) {
  const int lane = TIDS & 63;
  const int gw = VBID * 4 + (TIDS >> 6), nw = NVB * 4;
  const float* g = (which == 0 ? p.g_norm1 : p.g_norm2) + L * 1024;
  for (int r0 = gw; r0 < nrows; r0 += 2 * nw) {
    float4 v[2][4];
    int rr[2]; bool ok[2];
#pragma unroll
    for (int u = 0; u < 2; u++) {
      const int r = r0 + u * nw;
      ok[u] = r < nrows; rr[u] = ok[u] ? r : r0;
      const float* src;
      if (which == 0 && L == 0) src = (rr[u] < TLAT) ? p.x + (long)rr[u] * 1024 : p.ctx + (long)(rr[u] - TLAT) * 1024;
      else src = (rr[u] < TLAT) ? p.out + (long)rr[u] * 1024 : p.ctx1 + (long)(rr[u] - TLAT) * 1024;
#pragma unroll
      for (int i = 0; i < 4; i++) v[u][i] = *(const float4*)(src + i * 256 + lane * 4);
    }
#pragma unroll
    for (int u = 0; u < 2; u++) {
      const int r = rr[u];
      const float* md = p.mods + (long)(L * 9 + row_mod(r)) * 6144 + (which == 0 ? 0 : 3072);
      float ss = 0.f;
#pragma unroll
      for (int i = 0; i < 4; i++) ss += v[u][i].x * v[u][i].x + v[u][i].y * v[u][i].y + v[u][i].z * v[u][i].z + v[u][i].w * v[u][i].w;
      ss = wave_sum(ss);
      const float rs = rsqrtf(ss * (1.0f / 1024.0f) + EPSV);
      if (!ok[u]) continue;
#pragma unroll
      for (int i = 0; i < 4; i++) {
        const int c = i * 256 + lane * 4;
        const float4 gg = *(const float4*)(g + c);
        const float4 sh = *(const float4*)(md + c);
        const float4 sc = *(const float4*)(md + 1024 + c);
        const float o0 = v[u][i].x * rs * gg.x * (1.f + sc.x) + sh.x;
        const float o1 = v[u][i].y * rs * gg.y * (1.f + sc.y) + sh.y;
        const float o2 = v[u][i].z * rs * gg.z * (1.f + sc.z) + sh.z;
        const float o3 = v[u][i].w * rs * gg.w * (1.f + sc.w) + sh.w;
        *(uint2*)(p.hx + (long)r * 1024 + c) = make_uint2(pack2(o0, o1), pack2(o2, o3));
      }
    }
  }
}
#define U8_SCALE 32.0f
#define V8_SCALE 4.0f
__device__ __forceinline__ unsigned pack_fp8x4(float4 v, float s) {
  int w = 0;
  w = __builtin_amdgcn_cvt_pk_fp8_f32(v.x * s, v.y * s, w, false);
  w = __builtin_amdgcn_cvt_pk_fp8_f32(v.z * s, v.w * s, w, true);
  return (unsigned)w;
}
__device__ __forceinline__ void phase_tables(const Params& p, int L) {
  const int tid = TIDS;
  for (int job = VBID; job < 4096; job += NVB) {
    const bool isu = job < 2048;
    const float* src = (isu ? p.u_tab : p.v_tab) + (long)L * NEXP * 1024;
    unsigned char* dst = isu ? p.UT8 : p.VT8;
    const float s = isu ? U8_SCALE : V8_SCALE;
    const long base = (long)(isu ? job : job - 2048) * 8192 + tid * 16;
#pragma unroll
    for (int i = 0; i < 2; i++) {
      const long o = base + i * 4096;
      const float4 a = *(const float4*)(src + o), b = *(const float4*)(src + o + 4);
      const float4 c = *(const float4*)(src + o + 8), d = *(const float4*)(src + o + 12);
      const long e = o >> 10; const int col = (int)(o & 1023), sl = col >> 7, cc = col & 127;
      *(uint4*)(dst + ((long)sl * NEXP + e) * 128 + cc) = make_uint4(pack_fp8x4(a, s), pack_fp8x4(b, s), pack_fp8x4(c, s), pack_fp8x4(d, s));
    }
  }
}

template <bool BIG>
__device__ __forceinline__ void phase_s2(const Params& p, int L, char* smem) {
  constexpr int TM = BIG ? 256 : 128;
  const int lane = TIDX & 63, w = TIDX >> 6, wr = w >> 1, wc = w & 1;
  for (int pass = 0; pass < (L == 0 ? 1 : 2); pass++) {
  const int g_nrt = (L == 0) ? RTOT / TM : (pass == 0 ? TLAT / TM : TCTX / TM), g_nct = (L == 0 || pass == 0) ? 10 : 2;
  FOR_UNITS_XCD(g_nrt, g_nct, rt_, ct_)
    const int rt = (L == 1 && pass == 1) ? TLAT / TM + rt_ : rt_, ct = (L == 1 && pass == 1) ? 8 + ct_ : ct_;
    f32x16 acc[2][2];
    ZERO_ACC(acc);
    if constexpr (BIG) gemm256(p.hx + (long)rt * TM * 1024, 1024, p.W2T + (long)L * W2T_SZ + (long)ct * 128 * 1024, 1024, 1024, acc, smem);
    else gemm128(p.hx + (long)rt * TM * 1024, 1024, p.W2T + (long)L * W2T_SZ + (long)ct * 128 * 1024, 1024, 1024, acc, smem);
    const int row0 = rt * TM;
#define S2_STORE(DST, LDD, C0) { u16* dp = (DST) + (long)row0 * (LDD) + (C0); \
      const int tb = opaque((wr * 64 + 4 * (lane >> 5)) * (LDD) + wc * 64 + (lane & 31)); \
      _Pragma("unroll") for (int i = 0; i < 2; i++) _Pragma("unroll") for (int j = 0; j < 2; j++) _Pragma("unroll") for (int r = 0; r < 16; r++) \
        dp[tb + (i * 32 + (r & 3) + 8 * (r >> 2)) * (LDD) + j * 32] = tobf(acc[i][j][r]); }
    if (ct < 2) S2_STORE(p.cq, 256, ct * 128)
    else if (ct < 4) S2_STORE(p.zf, 256, (ct - 2) * 128)
    else if (ct < 8) S2_STORE(p.zc, 512, (ct - 4) * 128)
    else if (ct == 8) S2_STORE(p.ckv, 128, 0)
#undef S2_STORE
    else if (wc == 0) {
      float* dp = p.kr + (long)row0 * 32;
      const int tb = opaque((wr * 64 + 4 * (lane >> 5)) * 32 + (lane & 31));
#pragma unroll
      for (int i = 0; i < 2; i++)
#pragma unroll
        for (int r = 0; r < 16; r++)
          dp[tb + (i * 32 + (r & 3) + 8 * (r >> 2)) * 32] = acc[i][0][r];
    }
  }
  }
}

__device__ __forceinline__ void unit_kv(const Params& p, int L, int rt, int h, char* smem) {
  u16* As = (u16*)smem;
  u16* Ws = (u16*)(smem + 128 * 136 * 2);
  float* rrs = (float*)(smem + 2 * 128 * 136 * 2);
  const int tid = TIDS, lane = tid & 63, w = tid >> 6, hh = lane >> 5, c = lane & 31;
  const int row0 = rt * 128;
  __syncthreads();
  {
    const u16* ap = p.ckv + (long)row0 * 128;
    const u16* wp = p.WukvT + (long)L * WUKV_SZ + (long)h * 128 * 128;
#pragma unroll
    for (int i = 0; i < 8; i++) {
      const int idx = tid + 256 * i, rw = idx >> 4, ch = idx & 15;
      *(uint4*)(As + rw * 136 + ch * 8) = ldg16(ap + rw * 128 + ch * 8);
      *(uint4*)(Ws + rw * 136 + ch * 8) = ldg16(wp + rw * 128 + ch * 8);
    }
  }
  __syncthreads();
  {
    const int rw = tid >> 1, hf = tid & 1;
    float ss = 0.f;
#pragma unroll
    for (int q = 0; q < 8; q++) {
      uint4 v = *(const uint4*)(As + rw * 136 + hf * 64 + q * 8);
      float a;
      a = bf_lo(v.x); ss += a * a; a = bf_hi(v.x); ss += a * a;
      a = bf_lo(v.y); ss += a * a; a = bf_hi(v.y); ss += a * a;
      a = bf_lo(v.z); ss += a * a; a = bf_hi(v.z); ss += a * a;
      a = bf_lo(v.w); ss += a * a; a = bf_hi(v.w); ss += a * a;
    }
    ss += __shfl_xor(ss, 1);
    if (hf == 0) rrs[rw] = rsqrtf(ss * (1.0f / 128.0f) + EPSV);
  }
  __syncthreads();
  f32x16 aK[2], aV[2];
#pragma unroll
  for (int r = 0; r < 16; r++) { aK[0][r] = 0.f; aK[1][r] = 0.f; aV[0][r] = 0.f; aV[1][r] = 0.f; }
#pragma unroll
  for (int s = 0; s < 8; s++) {
    const int ko = s * 16 + hh * 8;
    uint4 tk = *(const uint4*)(As + (32 * w + c) * 136 + ko);
    uint4 w0 = *(const uint4*)(Ws + (c) * 136 + ko);
    uint4 w1 = *(const uint4*)(Ws + (32 + c) * 136 + ko);
    uint4 w2 = *(const uint4*)(Ws + (64 + c) * 136 + ko);
    uint4 w3 = *(const uint4*)(Ws + (96 + c) * 136 + ko);
    aK[0] = mfma32(tk, w0, aK[0]);
    aK[1] = mfma32(tk, w1, aK[1]);
    aV[0] = mfma32(w2, tk, aV[0]);
    aV[1] = mfma32(w3, tk, aV[1]);
  }
  const bool lat = row0 < TLAT;
  const int b = lat ? (row0 >> 12) : ((row0 - TLAT) >> 8);
  const int s0 = lat ? (row0 & 4095) : ((row0 - TLAT) & 255);
  const int kpos0 = lat ? (CTXL + s0) : s0;
  const float* gkn = p.g_kn + L * 96;
  const float gk0 = gkn[c], gk1 = gkn[32 + c], gk2 = gkn[64 + c];
  u16* Kdst = p.Kb + ((long)(b * 8 + h) * SKEYS + kpos0) * 96;
#pragma unroll
  for (int r = 0; r < 16; r++) {
    const int tl = 32 * w + (r & 3) + 8 * (r >> 2) + 4 * hh;
    const float rc = rrs[tl];
    const float v0 = aK[0][r] * rc, v1 = aK[1][r] * rc;
    const float kv = p.kr[(long)(row0 + tl) * 32 + c];
    const float ss = half_sum(v0 * v0 + v1 * v1 + kv * kv);
    const float rk = rsqrtf(ss * (1.0f / 96.0f) + EPSV);
    const float krn = kv * rk * gk2;
    const float partner = __shfl_xor(krn, 8);
    float o2 = krn;
    if (lat) {
      const int s = s0 + tl;
      const int pos = (c < 16) ? (s >> 6) : (s & 63);
      const float2 cs = *(const float2*)(p.ropetab + (pos * 8 + (c & 7)) * 2);
      const float rot = (c & 8) ? partner : -partner;
      o2 = krn * cs.x + rot * cs.y;
    }
    u16* kd = Kdst + (long)tl * 96;
    kd[c] = tobf(v0 * rk * gk0);
    kd[32 + c] = tobf(v1 * rk * gk1);
    kd[64 + c] = tobf(o2);
  }
  u16* Vdst = p.Vtb + (long)(b * 8 + h) * 64 * SKEYS + kpos0;
  const float rcv = rrs[32 * w + c];
#pragma unroll
  for (int i = 0; i < 2; i++)
#pragma unroll
    for (int r = 0; r < 16; r++) {
      const int d = 32 * i + (r & 3) + 8 * (r >> 2) + 4 * hh;
      Vdst[(long)d * SKEYS + 32 * w + c] = tobf(aV[i][r] * rcv);
    }
}

__device__ __forceinline__ void unit_chdft(const Params& p, int ut, int g, bool lat, char* smem) {
  const int lane = TIDS & 63, w = TIDS >> 6, wr = w >> 1, wc = w & 1;
  f32x16 acc[2][2];
  ZERO_ACC(acc);
  if (lat) {
    const int b = ut >> 5, j = ut & 31;
    gemm128x(p.Wcs, 64, p.zf + ((long)(b * SEQ + 2 * j) * 256 + g * 64), 64 * 256, 32 * 64 * 256, 256, 64, acc, smem);
    u16* dst = p.Ytl + ((long)(b * 256 + g * 64) * 64 + 2 * j) * 128;
#pragma unroll
    for (int i = 0; i < 2; i++)
#pragma unroll
      for (int jj = 0; jj < 2; jj++)
#pragma unroll
        for (int r = 0; r < 16; r++) {
          const int e = i * 32 + (r & 3) + 8 * (r >> 2) + 4 * (lane >> 5);
          dst[((long)e * 64 + wc) * 128 + wr * 64 + jj * 32 + (lane & 31)] = tobf(acc[i][jj][r]);
        }
  } else {
    const int row0 = TLAT + ut * 128;
    gemm128(p.Wcs, 64, p.zf + (long)row0 * 256 + g * 64, 256, 64, acc, smem);
    const int b = (row0 - TLAT) >> 8, s0 = (row0 - TLAT) & 255;
#pragma unroll
    for (int i = 0; i < 2; i++)
#pragma unroll
      for (int jj = 0; jj < 2; jj++)
#pragma unroll
        for (int r = 0; r < 16; r++) {
          const int n = ACC_ROW(wr, i, r, lane);
          const int t = s0 + ACC_COL(wc, jj, lane);
          p.Ytc[((long)(b * 256 + g * 64 + (n & 63))) * 512 + (n >> 6) * 256 + t] = tobf(acc[i][jj][r]);
        }
  }
}

__device__ __forceinline__ void unit_conv(const Params& p, int L, int ut, char* smem) {
  float* U = (float*)smem;
  const int tid = TIDS, lane = tid & 63, w = tid >> 6;
  const int row0 = ut * 32;
  const bool lat = row0 < TLAT;
  const int seqlen = lat ? SEQ : CTXL;
  const int s0 = lat ? (row0 & 4095) : ((row0 - TLAT) & 255);
  __syncthreads();
  {
    uint4 ca[8], cg[8];
#pragma unroll
    for (int q = 0; q < 8; q++) {
      const int id = tid + 256 * q, i = id >> 5, k = id & 31;
      const int s = s0 - 15 + i;
      ca[q] = make_uint4(0u, 0u, 0u, 0u); cg[q] = ca[q];
      if (i < 62 && s >= 0 && s < seqlen) {
        const u16* zr = p.zc + (long)(row0 - 15 + i) * 512 + k * 8;
        ca[q] = ldg16(zr); cg[q] = ldg16(zr + 256);
      }
    }
#pragma unroll
    for (int q = 0; q < 8; q++) {
      const int id = tid + 256 * q, i = id >> 5, k = id & 31;
      if (i < 62) {
        float4 u0, u1;
        u0.x = bf_lo(ca[q].x) * sigmoidf_(bf_lo(cg[q].x)); u0.y = bf_hi(ca[q].x) * sigmoidf_(bf_hi(cg[q].x));
        u0.z = bf_lo(ca[q].y) * sigmoidf_(bf_lo(cg[q].y)); u0.w = bf_hi(ca[q].y) * sigmoidf_(bf_hi(cg[q].y));
        u1.x = bf_lo(ca[q].z) * sigmoidf_(bf_lo(cg[q].z)); u1.y = bf_hi(ca[q].z) * sigmoidf_(bf_hi(cg[q].z));
        u1.z = bf_lo(ca[q].w) * sigmoidf_(bf_lo(cg[q].w)); u1.w = bf_hi(ca[q].w) * sigmoidf_(bf_hi(cg[q].w));
        *(float4*)(U + i * 256 + k * 8) = u0;
        *(float4*)(U + i * 256 + k * 8 + 4) = u1;
      }
    }
  }
  __syncthreads();
  float wv[31];
#pragma unroll
  for (int j = 0; j < 31; j++) wv[j] = p.w_dw[(long)L * 31 * 256 + j * 256 + tid];
  const float bias = p.b_dw[L * 256 + tid];
#pragma unroll 2
  for (int t = 0; t < 32; t++) {
    float acc = bias;
#pragma unroll
    for (int j = 0; j < 31; j++) acc += U[(t + j) * 256 + tid] * wv[j];
    U[t * 256 + tid] = acc;
  }
  __syncthreads();
  const float4 gg = *(const float4*)(p.g_cln + L * 256 + lane * 4);
  const float4 bb = *(const float4*)(p.b_cln + L * 256 + lane * 4);
#pragma unroll
  for (int q = 0; q < 8; q++) {
    const int t = w * 8 + q;
    const float4 v = *(const float4*)(U + t * 256 + lane * 4);
    const float mu = wave_sum(v.x + v.y + v.z + v.w) * (1.0f / 256.0f);
    const float d0 = v.x - mu, d1 = v.y - mu, d2 = v.z - mu, d3 = v.w - mu;
    const float var = wave_sum(d0 * d0 + d1 * d1 + d2 * d2 + d3 * d3) * (1.0f / 256.0f);
    const float rs = rsqrtf(var + EPSV);
    const float y0 = siluf_(d0 * rs * gg.x + bb.x), y1 = siluf_(d1 * rs * gg.y + bb.y);
    const float y2 = siluf_(d2 * rs * gg.z + bb.z), y3 = siluf_(d3 * rs * gg.w + bb.w);
    *(uint2*)(p.cv + (long)(row0 + t) * 256 + lane * 4) = make_uint2(pack2(y0, y1), pack2(y2, y3));
  }
}

#ifndef S3_REP_MASK
#define S3_REP_MASK 7
#endif
__device__ __forceinline__ void phase_s3(const Params& p, int L, char* smem, bool rep = false) {
  const int msk = rep ? S3_REP_MASK : 7;
  char* sm = smem + HALF_ * LDS_SMALL;
  const int nrt_all = (L == 0) ? 272 : 256;
  if (msk & 1) { FOR_PAIRED(272 * 8, u) unit_kv(p, L, u >> 3, u & 7, sm); } }
  if (msk & 2) { FOR_PAIRED(nrt_all * 4, v) const int ut = v >> 2; unit_chdft(p, ut < 256 ? ut : ut - 256, v & 3, ut < 256, sm); } }
  if (msk & 4) { FOR_PAIRED(nrt_all * 4, v) unit_conv(p, L, v, sm); } }
}

#define KLD 104
__device__ __forceinline__ void unit_attn(const Params& p, int L, int b, int h, int qt, bool isctx, char* smem) {
  const int tid = TIDS, lane = tid & 63, w = tid >> 6, hh = lane >> 5, c = lane & 31;
  const int qrow0 = isctx ? (TLAT + b * CTXL + qt * 128) : (b * SEQ + qt * 128);
  const int nkt = isctx ? (CTXL / 64) : (SKEYS / 64);
  u16* As = (u16*)smem;
  u16* Bs = (u16*)(smem + 128 * LDT * 2);
  u16* Qs = (u16*)(smem + (128 + 96) * LDT * 2);
  f32x16 aq[3];
#pragma unroll
  for (int r = 0; r < 16; r++) { aq[0][r] = 0.f; aq[1][r] = 0.f; aq[2][r] = 0.f; }
  float ssq = 0.f;
  const u16* cqp = p.cq + (long)qrow0 * 256;
  const u16* wqp = p.WuqT + (long)L * WUQ_SZ + (long)h * 96 * 256;
  for (int kc = 0; kc < 4; kc++) {
    __syncthreads();
#pragma unroll
    for (int i = 0; i < 4; i++) {
      const int idx = tid + 256 * i, rw = idx >> 3, ch = idx & 7;
      *(uint4*)(As + rw * LDT + ch * 8) = ldg16(cqp + rw * 256 + kc * 64 + ch * 8);
    }
#pragma unroll
    for (int i = 0; i < 3; i++) {
      const int idx = tid + 256 * i, rw = idx >> 3, ch = idx & 7;
      *(uint4*)(Bs + rw * LDT + ch * 8) = ldg16(wqp + rw * 256 + kc * 64 + ch * 8);
    }
    __syncthreads();
#pragma unroll
    for (int q = 0; q < 4; q++) {
      uint4 v = *(const uint4*)(As + (32 * w + c) * LDT + hh * 32 + q * 8);
      float a;
      a = bf_lo(v.x); ssq += a * a; a = bf_hi(v.x); ssq += a * a;
      a = bf_lo(v.y); ssq += a * a; a = bf_hi(v.y); ssq += a * a;
      a = bf_lo(v.z); ssq += a * a; a = bf_hi(v.z); ssq += a * a;
      a = bf_lo(v.w); ssq += a * a; a = bf_hi(v.w); ssq += a * a;
    }
#pragma unroll
    for (int kk = 0; kk < 4; kk++) {
      uint4 a = *(const uint4*)(As + (32 * w + c) * LDT + kk * 16 + hh * 8);
#pragma unroll
      for (int j = 0; j < 3; j++) {
        uint4 bq = *(const uint4*)(Bs + (32 * j + c) * LDT + kk * 16 + hh * 8);
        aq[j] = mfma32(a, bq, aq[j]);
      }
    }
  }
  ssq += __shfl_xor(ssq, 32);
  const float rr_lane = rsqrtf(ssq * (1.0f / 256.0f) + EPSV);
  {
    const float* gqn = p.g_qn + L * 96;
    const float g0 = gqn[c], g1 = gqn[32 + c], g2 = gqn[64 + c];
    const float qscale = 0.10206207261596577f * 1.4426950408889634f;
    u16* Qw = Qs + w * 32 * KLD;
#pragma unroll
    for (int r = 0; r < 16; r++) {
      const int rl = (r & 3) + 8 * (r >> 2) + 4 * hh;
      const float rc = __shfl(rr_lane, rl);
      const float q0 = aq[0][r] * rc, q1 = aq[1][r] * rc, q2 = aq[2][r] * rc;
      const float ss = half_sum(q0 * q0 + q1 * q1 + q2 * q2);
      const float rq = rsqrtf(ss * (1.0f / 96.0f) + EPSV);
      const float qn2 = q2 * rq * g2;
      const float partner = __shfl_xor(qn2, 8);
      float o2 = qn2;
      if (!isctx) {
        const int s = qt * 128 + 32 * w + rl;
        const int pos = (c < 16) ? (s >> 6) : (s & 63);
        const float2 cs = *(const float2*)(p.ropetab + (pos * 8 + (c & 7)) * 2);
        const float rot = (c & 8) ? partner : -partner;
        o2 = qn2 * cs.x + rot * cs.y;
      }
      Qw[rl * KLD + c] = tobf(q0 * rq * g0 * qscale);
      Qw[rl * KLD + 32 + c] = tobf(q1 * rq * g1 * qscale);
      Qw[rl * KLD + 64 + c] = tobf(o2 * qscale);
    }
  }
  __syncthreads();
  uint4 qf[6];
#pragma unroll
  for (int s = 0; s < 6; s++) qf[s] = *(const uint4*)(Qs + (w * 32 + c) * KLD + s * 16 + hh * 8);
  __syncthreads();
  u16* Ks = (u16*)smem;
  u16* Vs = (u16*)(smem + 2 * 64 * KLD * 2);
  const u16* kg = p.Kb + (long)(b * 8 + h) * SKEYS * 96;
  const u16* vg = p.Vtb + (long)(b * 8 + h) * 64 * SKEYS;
  uint4 rk[3], rv[2];
  int krow[3], kch[3];
#pragma unroll
  for (int i = 0; i < 3; i++) { const int idx = tid + 256 * i; krow[i] = idx / 12; kch[i] = idx % 12; }
  const int vrow = tid >> 3, vch = tid & 7;
#pragma unroll
  for (int i = 0; i < 3; i++) rk[i] = ldg16(kg + (long)(tid + 256 * i) * 8);
#pragma unroll
  for (int i = 0; i < 2; i++) rv[i] = ldg16(vg + (long)(vrow + 32 * i) * SKEYS + vch * 8);
#pragma unroll
  for (int i = 0; i < 3; i++) *(uint4*)(Ks + krow[i] * KLD + kch[i] * 8) = rk[i];
#pragma unroll
  for (int i = 0; i < 2; i++) *(uint4*)(Vs + (vrow + 32 * i) * LDT + vch * 8) = rv[i];
  __syncthreads();
  f32x16 aO[2];
#pragma unroll
  for (int r = 0; r < 16; r++) { aO[0][r] = 0.f; aO[1][r] = 0.f; }
  float mref = 0.f;
  f32x2 lsum2 = {0.f, 0.f};
  const int kperm = (c & ~12) | ((c & 4) << 1) | ((c & 8) >> 1);
  for (int kt = 0; kt < nkt; kt++) {
    const int cur = kt & 1;
    if (kt + 1 < nkt) {
#pragma unroll
      for (int i = 0; i < 3; i++) rk[i] = ldg16(kg + (long)(kt + 1) * 64 * 96 + (long)(tid + 256 * i) * 8);
#pragma unroll
      for (int i = 0; i < 2; i++) rv[i] = ldg16(vg + (long)(vrow + 32 * i) * SKEYS + (kt + 1) * 64 + vch * 8);
    }
    __builtin_amdgcn_sched_barrier(0);
    const u16* Kc = Ks + cur * 64 * KLD;
    const u16* Vc = Vs + cur * 64 * LDT;
    f32x16 aS[2];
    {
      const float nm = -mref;
#pragma unroll
      for (int r = 0; r < 16; r++) { aS[0][r] = nm; aS[1][r] = nm; }
    }
#pragma unroll
    for (int s = 0; s < 6; s++) {
      uint4 k0 = *(const uint4*)(Kc + (kperm) * KLD + s * 16 + hh * 8);
      uint4 k1 = *(const uint4*)(Kc + (32 + kperm) * KLD + s * 16 + hh * 8);
      aS[0] = mfma32(k0, qf[s], aS[0]);
      aS[1] = mfma32(k1, qf[s], aS[1]);
    }
    float mx = fmaxf(aS[0][0], aS[1][0]);
#pragma unroll
    for (int r = 1; r < 16; r++) mx = fmaxf(fmaxf(mx, aS[0][r]), aS[1][r]);
    if (__any(mx > 8.0f)) {
      const float mo = fmaxf(mx, __shfl_xor(mx, 32));
      const float delta = (mo > 8.0f) ? mo : 0.f;
      const float alpha = __builtin_amdgcn_exp2f(-delta);
      mref += delta;
      lsum2 *= alpha;
#pragma unroll
      for (int r = 0; r < 16; r++) {
        aO[0][r] *= alpha; aO[1][r] *= alpha;
        aS[0][r] -= delta; aS[1][r] -= delta;
      }
    }
#pragma unroll
    for (int r = 0; r < 16; r += 2) {
      aS[0][r] = __builtin_amdgcn_exp2f(aS[0][r]); aS[0][r + 1] = __builtin_amdgcn_exp2f(aS[0][r + 1]);
      aS[1][r] = __builtin_amdgcn_exp2f(aS[1][r]); aS[1][r + 1] = __builtin_amdgcn_exp2f(aS[1][r + 1]);
      const f32x2 p0 = {aS[0][r], aS[0][r + 1]}, p1 = {aS[1][r], aS[1][r + 1]};
      lsum2 += p0; lsum2 += p1;
    }
#pragma unroll
    for (int i = 0; i < 2; i++)
#pragma unroll
      for (int s2 = 0; s2 < 2; s2++) {
        uint4 pf = make_uint4(pack2(aS[i][8 * s2 + 0], aS[i][8 * s2 + 1]), pack2(aS[i][8 * s2 + 2], aS[i][8 * s2 + 3]),
                              pack2(aS[i][8 * s2 + 4], aS[i][8 * s2 + 5]), pack2(aS[i][8 * s2 + 6], aS[i][8 * s2 + 7]));
        uint4 v0 = *(const uint4*)(Vc + (c) * LDT + 32 * i + 16 * s2 + 8 * hh);
        uint4 v1 = *(const uint4*)(Vc + (32 + c) * LDT + 32 * i + 16 * s2 + 8 * hh);
        aO[0] = mfma32(v0, pf, aO[0]);
        aO[1] = mfma32(v1, pf, aO[1]);
      }
    if (kt + 1 < nkt) {
      const int nx = cur ^ 1;
#pragma unroll
      for (int i = 0; i < 3; i++) *(uint4*)(Ks + nx * 64 * KLD + krow[i] * KLD + kch[i] * 8) = rk[i];
#pragma unroll
      for (int i = 0; i < 2; i++) *(uint4*)(Vs + nx * 64 * LDT + (vrow + 32 * i) * LDT + vch * 8) = rv[i];
    }
    __syncthreads();
  }
  float lsum = lsum2.x + lsum2.y;
  lsum += __shfl_xor(lsum, 32);
  const float inv = 1.0f / lsum;
  u16* Os = (u16*)smem + w * 32 * LDT;
#pragma unroll
  for (int i = 0; i < 2; i++)
#pragma unroll
    for (int r = 0; r < 16; r++) {
      const int d = 32 * i + (r & 3) + 8 * (r >> 2) + 4 * hh;
      Os[c * LDT + d] = tobf(aO[i][r] * inv);
    }
  __syncthreads();
#pragma unroll
  for (int i = 0; i < 4; i++) {
    const int idx = lane + 64 * i, q = idx >> 3, ch = idx & 7;
    *(uint4*)(p.Ob + (long)(qrow0 + 32 * w + q) * 512 + h * 64 + ch * 8) = *(const uint4*)(Os + q * LDT + ch * 8);
  }
}

__device__ __forceinline__ void unit_dftA(const Params& p, int b, int np, char* smem) {
  const int lane = TIDS & 63, w = TIDS >> 6, wr = w >> 1, wc = w & 1, hh = lane >> 5, c = lane & 31;
  f32x16 acc[2][2];
  ZERO_ACC(acc);
  gemm128(p.WA, 128, p.Ytl + (long)(b * 256 + 2 * np) * 64 * 128, 128, 128, acc, smem);
  const int n = 2 * np + wc;
#pragma unroll
  for (int jj = 0; jj < 2; jj++) {
    const int t2 = jj * 32 + c;
#pragma unroll
    for (int r = 0; r < 16; r++) {
      const int k1 = wr * 32 + (r & 3) + 8 * (r >> 2) + 4 * hh;
      const float2 t = *(const float2*)(p.tw + 2 * ((k1 * t2) & 4095));
      const float gr = acc[0][jj][r], gi = acc[1][jj][r];
      u16* dst = p.GB + ((long)((b * 64 + k1) * 256 + n)) * 128 + t2;
      dst[0] = tobf(gr * t.x + gi * t.y);
      dst[64] = tobf(gi * t.x - gr * t.y);
    }
  }
}
__device__ __forceinline__ void unit_dftC(const Params& p, int b, int k1, int nt, char* smem) {
  const int lane = TIDS & 63, w = TIDS >> 6, wr = w >> 1, wc = w & 1, hh = lane >> 5, c = lane & 31;
  f32x16 acc[2][2];
  ZERO_ACC(acc);
  gemm128(p.WC, 128, p.GB + ((long)((b * 64 + k1) * 256 + nt * 128)) * 128, 128, 128, acc, smem);
  if (wr == 0) {
#pragma unroll
    for (int i = 0; i < 2; i++)
#pragma unroll
      for (int jj = 0; jj < 2; jj++)
#pragma unroll
        for (int r = 0; r < 16; r++) {
          const int k2 = i * 32 + (r & 3) + 8 * (r >> 2) + 4 * hh;
          p.Fb[((long)b * SEQ + k1 + 64 * k2) * 256 + nt * 128 + wc * 64 + jj * 32 + c] = tobf(acc[i][jj][r]);
        }
  }
}
__device__ __forceinline__ void unit_seqdft_ctx(const Params& p, int b, int mt, int nt, char* smem) {
  const int lane = TIDS & 63, w = TIDS >> 6, wr = w >> 1, wc = w & 1;
  f32x16 acc[2][2];
  ZERO_ACC(acc);
  gemm128(p.Dctx + (long)mt * 128 * 512, 512, p.Ytc + (long)(b * 256 + nt * 128) * 512, 512, 512, acc, smem);
  const long orow0 = (long)TLAT + b * CTXL + mt * 128;
#pragma unroll
  for (int i = 0; i < 2; i++)
#pragma unroll
    for (int j = 0; j < 2; j++)
#pragma unroll
      for (int r = 0; r < 16; r++)
        p.Fb[(orow0 + ACC_ROW(wr, i, r, lane)) * 256 + nt * 128 + ACC_COL(wc, j, lane)] = tobf(acc[i][j][r]);
}
__device__ __forceinline__ void phase_dftC(const Params& p, char* smem) {
  char* sm = smem + HALF_ * LDS_SMALL;
  FOR_PAIRED(8 * 64 * 2, u) unit_dftC(p, u >> 7, (u >> 1) & 63, u & 1, sm); }
}

__device__ __forceinline__ void phase_s4(const Params& p, int L, char* smem) {
  char* sm = smem + HALF_ * LDS_SMALL;
  {
    const int x = VBID & 7, l = VBID >> 3, nl = NVB >> 3;
    for (int s = l; s < 256; s += nl) {
      const int bh = x * 8 + (s >> 5);
      unit_attn(p, L, bh >> 3, bh & 7, s & 31, false, sm);
    }
  }
  FOR_PAIRED(8 * 128, v) unit_dftA(p, v >> 7, v & 127, sm); }
  if (L == 0) {
    FOR_PAIRED(8 * 2 * 2, v) unit_seqdft_ctx(p, v >> 2, (v >> 1) & 1, v & 1, sm); }
    FOR_PAIRED(8 * 8 * 2, v) unit_attn(p, L, v >> 4, (v >> 1) & 7, v & 1, true, sm); }
  }
}

template <bool BIG>
__device__ __forceinline__ void phase_s7(const Params& p, int L, char* smem) {
  constexpr int TM = BIG ? 256 : 128;
  const int nrt = ((L == 0) ? RTOT : TLAT) / TM;
  FOR_UNITS_XCD(nrt, 8, rt, ct)
    const int row0 = rt * TM;
    f32x16 macc[2][2];
    ZERO_ACC(macc);
#pragma unroll 1
    for (int br = 0; br < 3; br++) {
      unsigned gp[2][2][8];
      {
      f32x16 acc[2][2];
      ZERO_ACC(acc);
      if constexpr (BIG) gemm256(p.hx + (long)row0 * 1024, 1024, p.WgT + (long)L * WGT_SZ + (long)(br * 1024 + ct * 128) * 1024, 1024, 1024, acc, smem);
      else gemm128(p.hx + (long)row0 * 1024, 1024, p.WgT + (long)L * WGT_SZ + (long)(br * 1024 + ct * 128) * 1024, 1024, 1024, acc, smem);
#pragma unroll
      for (int i = 0; i < 2; i++)
#pragma unroll
        for (int j = 0; j < 2; j++)
#pragma unroll
          for (int r = 0; r < 8; r++) gp[i][j][r] = pack2(sigmoidf_(acc[i][j][2 * r]), sigmoidf_(acc[i][j][2 * r + 1]));
      }
      const u16* A2; const u16* B2; int K2;
      if (br == 0) { A2 = p.Ob + (long)row0 * 512; B2 = p.WbaT + (long)L * WBA_SZ + (long)ct * 128 * 512; K2 = 512; }
      else if (br == 1) { A2 = p.Fb + (long)row0 * 256; B2 = p.WbfT + (long)L * WBF_SZ + (long)ct * 128 * 256; K2 = 256; }
      else { A2 = p.cv + (long)row0 * 256; B2 = p.WbcT + (long)L * WBC_SZ + (long)ct * 128 * 256; K2 = 256; }
      {
        f32x16 ab[2][2];
        ZERO_ACC(ab);
        if constexpr (BIG) gemm256(A2, K2, B2, K2, K2, ab, smem); else gemm128(A2, K2, B2, K2, K2, ab, smem);
#pragma unroll
        for (int i = 0; i < 2; i++)
#pragma unroll
          for (int j = 0; j < 2; j++)
#pragma unroll
            for (int r = 0; r < 8; r++) {
              if ((ABL_BR >> br) & 1) {
              macc[i][j][2 * r] += bf_lo(gp[i][j][r]) * ab[i][j][2 * r];
              macc[i][j][2 * r + 1] += bf_hi(gp[i][j][r]) * ab[i][j][2 * r + 1];
              }
            }
      }
    }
    u16* mp = p.m + (long)row0 * 1024 + ct * 128;
    const int tid = TIDX, lane = tid & 63, w = tid >> 6, wr = w >> 1, wc = w & 1;
    const int tb = (wr * 64 + 4 * (lane >> 5)) * 1024 + wc * 64 + (lane & 31);
#pragma unroll
    for (int i = 0; i < 2; i++)
#pragma unroll
      for (int j = 0; j < 2; j++)
#pragma unroll
        for (int r = 0; r < 16; r++)
          mp[tb + (i * 32 + (r & 3) + 8 * (r >> 2)) * 1024 + j * 32] = tobf(macc[i][j][r]);
  }
}

template <bool BIG>
__device__ __forceinline__ void phase_s8(const Params& p, int L, char* smem, bool dry = false) {
  constexpr int TM = BIG ? 256 : 128;
  const int lane = TIDX & 63, w = TIDX >> 6, wr = w >> 1, wc = w & 1;
  const int nrt = ((L == 0) ? RTOT : TLAT) / TM;
  FOR_UNITS_XCD(nrt, 8, rt, ct)
    const long row0 = (long)rt * TM;
    f32x16 acc[2][2];
    ZERO_ACC(acc);
    if constexpr (BIG) gemm256(p.m + row0 * 1024, 1024, p.WoutT + (long)L * WOUT_SZ + (long)ct * 128 * 1024, 1024, 1024, acc, smem);
    else gemm128(p.m + row0 * 1024, 1024, p.WoutT + (long)L * WOUT_SZ + (long)ct * 128 * 1024, 1024, 1024, acc, smem);
    const int mr = row_mod((int)row0);
    const float* gt = p.mods + (long)(L * 9 + mr) * 6144 + 2048 + ct * 128;
    const float* src; float* dst;
    if (row0 < TLAT) { src = (L == 0 ? p.x : p.out) + row0 * 1024; dst = p.out + row0 * 1024; }
    else { src = (L == 0 ? p.ctx : p.ctx1) + (row0 - TLAT) * 1024; dst = p.ctx1 + (row0 - TLAT) * 1024; }
    src += ct * 128; dst += ct * 128;
    const int tb = opaque((wr * 64 + 4 * (lane >> 5)) * 1024 + wc * 64 + (lane & 31));
#pragma unroll
    for (int j = 0; j < 2; j++) {
      const float gv = gt[ACC_COL(wc, j, lane)];
#pragma unroll
      for (int i = 0; i < 2; i++)
#pragma unroll
        for (int r = 0; r < 16; r++) {
          const int o = tb + (i * 32 + (r & 3) + 8 * (r >> 2)) * 1024 + j * 32;
          const float nv = src[o] + gv * acc[i][j][r];
          if (!dry) dst[o] = nv;
        }
    }
  }
}

#define CE_DESC(a, b) { const float _x = fmaxf(a, b); const float _y = fminf(a, b); a = _x; b = _y; }
template <int N>
__device__ __forceinline__ void bitonic_sort_desc(float (&v)[N]) {
#pragma unroll
  for (int k = 2; k <= N; k <<= 1)
#pragma unroll
    for (int j = k >> 1; j > 0; j >>= 1)
#pragma unroll
      for (int i = 0; i < N; i++) {
        const int l = i ^ j;
        if (l > i) {
          if ((i & k) == 0) { CE_DESC(v[i], v[l]); } else { CE_DESC(v[l], v[i]); }
        }
      }
}
template <int N>
__device__ __forceinline__ void bitonic_merge_desc(float (&v)[N]) {
#pragma unroll
  for (int j = N >> 1; j > 0; j >>= 1)
#pragma unroll
    for (int i = 0; i < N; i++) {
      const int l = i ^ j;
      if (l > i) { CE_DESC(v[i], v[l]); }
    }
}
__device__ __forceinline__ void merge_top16(float (&a)[16], const float (&b)[16]) {
#pragma unroll
  for (int i = 0; i < 16; i++) a[i] = fmaxf(a[i], b[15 - i]);
  bitonic_merge_desc<16>(a);
}
__device__ __forceinline__ void top16_of_tiles(const f32x16 (&s)[4], int hh, float (&res)[16]) {
  float g[4][16];
#pragma unroll
  for (int t = 0; t < 4; t++) {
#pragma unroll
    for (int r = 0; r < 16; r++) {
      const unsigned key = (unsigned)(32 * t + (r & 3) + 8 * (r >> 2)) + (unsigned)(4 * hh);
      g[t][r] = __uint_as_float((__float_as_uint(s[t][r]) & 0xffffff80u) | key);
    }
    bitonic_sort_desc<16>(g[t]);
  }
  merge_top16(g[0], g[1]);
  merge_top16(g[2], g[3]);
  merge_top16(g[0], g[2]);
  float o[16];
#pragma unroll
  for (int i = 0; i < 16; i++) o[i] = __shfl_xor(g[0][i], 32);
  merge_top16(g[0], o);
#pragma unroll
  for (int i = 0; i < 16; i++) res[i] = g[0][i];
}

template <bool BIG>
__device__ __forceinline__ void unit_peer_query(const Params& p, int L, int rt, int h, char* smem) {
  constexpr int TM = BIG ? 256 : 128, NT = BIG ? 512 : 256;
  const int tid = TIDX, lane = tid & 63, w = tid >> 6, wr = w >> 1, wc = w & 1, hh = lane >> 5, c = lane & 31;
  const long row0 = (long)rt * TM;
  u16* Qs = (u16*)smem;
  u16* Ss = (u16*)(smem + TM * 136 * 2);
  {
    f32x16 acc[2][2];
    ZERO_ACC(acc);
    if constexpr (BIG) gemm256(p.hx + row0 * 1024, 1024, p.WqT + (long)L * WQ_SZ + (long)h * 128 * 1024, 1024, 1024, acc, smem);
    else gemm128(p.hx + row0 * 1024, 1024, p.WqT + (long)L * WQ_SZ + (long)h * 128 * 1024, 1024, 1024, acc, smem);
#pragma unroll
    for (int i = 0; i < 2; i++)
#pragma unroll
      for (int j = 0; j < 2; j++)
#pragma unroll
        for (int r = 0; r < 16; r++) Qs[ACC_ROW(wr, i, r, lane) * 136 + ACC_COL(wc, j, lane)] = tobf(acc[i][j][r]);
    const u16* sk = p.SubK + (long)L * SUBK_SZ + (long)h * 2 * 128 * 64;
#pragma unroll
    for (int i = 0; i < 2048 / NT; i++) {
      const int idx = tid + NT * i, rw = idx >> 3, ch = idx & 7;
      *(uint4*)(Ss + rw * LDT + ch * 8) = ldg16(sk + rw * 64 + ch * 8);
    }
  }
  __syncthreads();
  float top[2][16];
#pragma unroll
  for (int pp = 0; pp < 2; pp++) {
    f32x16 s[4];
#pragma unroll
    for (int t = 0; t < 4; t++)
#pragma unroll
      for (int r = 0; r < 16; r++) s[t][r] = 0.f;
#pragma unroll
    for (int kk = 0; kk < 4; kk++) {
      uint4 bq = *(const uint4*)(Qs + (32 * w + c) * 136 + pp * 64 + kk * 16 + hh * 8);
#pragma unroll
      for (int t = 0; t < 4; t++) {
        uint4 ak = *(const uint4*)(Ss + (pp * 128 + 32 * t + c) * LDT + kk * 16 + hh * 8);
        s[t] = mfma32(ak, bq, s[t]);
      }
    }
    top16_of_tiles(s, hh, top[pp]);
  }
  float cand[64];
#define CAND(q, a, b) cand[q] = __uint_as_float((__float_as_uint(top[0][a] + top[1][b]) & 0xffffff00u) | (unsigned)((a) * 16 + (b)));
  CAND(0, 0, 0)
  CAND(1, 0, 1)
  CAND(2, 0, 2)
  CAND(3, 0, 3)
  CAND(4, 0, 4)
  CAND(5, 0, 5)
  CAND(6, 0, 6)
  CAND(7, 0, 7)
  CAND(8, 0, 8)
  CAND(9, 0, 9)
  CAND(10, 0, 10)
  CAND(11, 0, 11)
  CAND(12, 0, 12)
  CAND(13, 0, 13)
  CAND(14, 0, 14)
  CAND(15, 0, 15)
  CAND(16, 1, 0)
  CAND(17, 1, 1)
  CAND(18, 1, 2)
  CAND(19, 1, 3)
  CAND(20, 1, 4)
  CAND(21, 1, 5)
  CAND(22, 1, 6)
  CAND(23, 1, 7)
  CAND(24, 2, 0)
  CAND(25, 2, 1)
  CAND(26, 2, 2)
  CAND(27, 2, 3)
  CAND(28, 2, 4)
  CAND(29, 3, 0)
  CAND(30, 3, 1)
  CAND(31, 3, 2)
  CAND(32, 3, 3)
  CAND(33, 4, 0)
  CAND(34, 4, 1)
  CAND(35, 4, 2)
  CAND(36, 5, 0)
  CAND(37, 5, 1)
  CAND(38, 6, 0)
  CAND(39, 6, 1)
  CAND(40, 7, 0)
  CAND(41, 7, 1)
  CAND(42, 8, 0)
  CAND(43, 9, 0)
  CAND(44, 10, 0)
  CAND(45, 11, 0)
  CAND(46, 12, 0)
  CAND(47, 13, 0)
  CAND(48, 14, 0)
  CAND(49, 15, 0)
#undef CAND
#pragma unroll
  for (int q = 50; q < 64; q++) cand[q] = -3.0e38f;
  float best[16];
  {
    float g[4][16];
#pragma unroll
    for (int t = 0; t < 4; t++) {
#pragma unroll
      for (int r = 0; r < 16; r++) g[t][r] = cand[t * 16 + r];
      bitonic_sort_desc<16>(g[t]);
    }
    merge_top16(g[0], g[1]);
    merge_top16(g[2], g[3]);
    merge_top16(g[0], g[2]);
#pragma unroll
    for (int i = 0; i < 16; i++) best[i] = g[0][i];
  }
  float e[16], es = 0.f;
#pragma unroll
  for (int i = 0; i < 16; i++) { e[i] = __expf(best[i] - best[0]); es += e[i]; }
  const float einv = 1.0f / es;
  __syncthreads();
  int* Ix = (int*)smem + w * 32 * 33;
  if (hh == 0) {
#pragma unroll
    for (int i = 0; i < 16; i++) {
      Ix[c * 33 + i] = (int)(__float_as_uint(top[0][i]) & 127u);
      Ix[c * 33 + 16 + i] = (int)(__float_as_uint(top[1][i]) & 127u);
    }
  }
  __syncthreads();
  const long orow = row0 + 32 * w + c;
  int* ed = p.eid + orow * 128 + h * 16 + hh * 8;
  float* gd = p.gate + orow * 128 + h * 16 + hh * 8;
  int ev[8]; float gv[8];
#pragma unroll
  for (int i = 0; i < 8; i++) {
    const unsigned hm = 0u - (unsigned)hh;
    const unsigned bselu = (__float_as_uint(best[8 + i]) & hm) | (__float_as_uint(best[i]) & ~hm);
    const float esel = __uint_as_float((__float_as_uint(e[8 + i]) & hm) | (__float_as_uint(e[i]) & ~hm));
    const unsigned id = bselu & 255u;
    const int ia = Ix[c * 33 + (id >> 4)], ib = Ix[c * 33 + 16 + (id & 15)];
    ev[i] = ia * 128 + ib;
    gv[i] = esel * einv;
  }
  *(int4*)(ed) = make_int4(ev[0], ev[1], ev[2], ev[3]);
  *(int4*)(ed + 4) = make_int4(ev[4], ev[5], ev[6], ev[7]);
  *(float4*)(gd) = make_float4(gv[0], gv[1], gv[2], gv[3]);
  *(float4*)(gd + 4) = make_float4(gv[4], gv[5], gv[6], gv[7]);
}

template <bool BIG>
__device__ __forceinline__ void phase_s10(const Params& p, int L, char* smem) {
  const int nrt = ((L == 0) ? RTOT : TLAT) / (BIG ? 256 : 128);
  FOR_UNITS_XCD(nrt, 8, rt, hd) unit_peer_query<BIG>(p, L, rt, hd, smem); }
}

#define CVT8(w, lo2, hi2) { lo2 = __builtin_amdgcn_cvt_pk_f32_fp8((int)(w), false); hi2 = __builtin_amdgcn_cvt_pk_f32_fp8((int)(w), true); }
#if CHECK_ATTN
#define NB11 1
#else
#define NB11 2
#endif
__device__ __forceinline__ void phase_s11a(const Params& p, int L) {
  const int lane = TIDS & 63, j = lane >> 3, cch = lane & 7;
  const int sl = VBID & 7;
  const int lw = (VBID >> 3) * 4 + (TIDS >> 6), nlw = (NVB >> 3) * 4;
  const int nrows = (L == 0) ? RTOT : TLAT;
  const unsigned char* Us = p.UT8 + (long)sl * NEXP * 128 + cch * 16;
  for (int r0 = lw; r0 < nrows; r0 += NB11 * nlw) {
    int rr[NB11]; bool ok[NB11];
    uint4 ha[NB11], hb[NB11]; int e_lo[NB11], e_hi[NB11];
#pragma unroll
    for (int u = 0; u < NB11; u++) {
      const int r = r0 + u * nlw;
      ok[u] = r < nrows; rr[u] = ok[u] ? r : r0;
      ha[u] = ldg16(p.hx + (long)rr[u] * 1024 + sl * 128 + cch * 16);
      hb[u] = ldg16(p.hx + (long)rr[u] * 1024 + sl * 128 + cch * 16 + 8);
      e_lo[u] = p.eid[(long)rr[u] * 128 + lane]; e_hi[u] = p.eid[(long)rr[u] * 128 + 64 + lane];
    }
    uint4 uu[NB11][16];
#pragma unroll
    for (int u = 0; u < NB11; u++)
#pragma unroll
      for (int i = 0; i < 16; i++) {
        const int e = __shfl(i < 8 ? e_lo[u] : e_hi[u], 8 * (i & 7) + j);
        uu[u][i] = ldg16(Us + (long)e * 128);
      }
    __builtin_amdgcn_sched_barrier(0);
#pragma unroll
    for (int u = 0; u < NB11; u++) {
      f32x2 h2[8];
      h2[0] = f32x2{bf_lo(ha[u].x), bf_hi(ha[u].x)}; h2[1] = f32x2{bf_lo(ha[u].y), bf_hi(ha[u].y)};
      h2[2] = f32x2{bf_lo(ha[u].z), bf_hi(ha[u].z)}; h2[3] = f32x2{bf_lo(ha[u].w), bf_hi(ha[u].w)};
      h2[4] = f32x2{bf_lo(hb[u].x), bf_hi(hb[u].x)}; h2[5] = f32x2{bf_lo(hb[u].y), bf_hi(hb[u].y)};
      h2[6] = f32x2{bf_lo(hb[u].z), bf_hi(hb[u].z)}; h2[7] = f32x2{bf_lo(hb[u].w), bf_hi(hb[u].w)};
      float d[16];
#pragma unroll
      for (int i = 0; i < 16; i++) {
        f32x2 a0, a1, acc = {0.f, 0.f};
        CVT8(uu[u][i].x, a0, a1); acc += a0 * h2[0]; acc += a1 * h2[1];
        CVT8(uu[u][i].y, a0, a1); acc += a0 * h2[2]; acc += a1 * h2[3];
        CVT8(uu[u][i].z, a0, a1); acc += a0 * h2[4]; acc += a1 * h2[5];
        CVT8(uu[u][i].w, a0, a1); acc += a0 * h2[6]; acc += a1 * h2[7];
        d[i] = acc.x + acc.y;
      }
      float t8[8], t4[4], t2[2];
      { const bool up = (lane & 4) != 0;
#pragma unroll
        for (int k = 0; k < 8; k++) { const float send = up ? d[k] : d[k + 8], keep = up ? d[k + 8] : d[k]; t8[k] = keep + __shfl_xor(send, 4); } }
      { const bool up = (lane & 2) != 0;
#pragma unroll
        for (int k = 0; k < 4; k++) { const float send = up ? t8[k] : t8[k + 4], keep = up ? t8[k + 4] : t8[k]; t4[k] = keep + __shfl_xor(send, 2); } }
      { const bool up = (lane & 1) != 0;
#pragma unroll
        for (int k = 0; k < 2; k++) { const float send = up ? t4[k] : t4[k + 2], keep = up ? t4[k + 2] : t4[k]; t2[k] = keep + __shfl_xor(send, 1); } }
      if (ok[u]) p.PD[((long)sl * RTOT + rr[u]) * 64 + cch * 8 + j] = pack2(t2[0], t2[1]);
    }
  }
}
__device__ __forceinline__ void phase_s11b(const Params& p, int L, bool dry = false) {
  const int lane = TIDS & 63, j = lane >> 3, cch = lane & 7;
  const int sl = VBID & 7;
  const int lw = (VBID >> 3) * 4 + (TIDS >> 6), nlw = (NVB >> 3) * 4;
  const int nrows = (L == 0) ? RTOT : TLAT;
  const unsigned char* Vs = p.VT8 + (long)sl * NEXP * 128 + cch * 16;
  const int P0 = 16 * (lane >> 3) + (lane & 7);
  const int col = sl * 128 + cch * 16 + 2 * j;
  for (int r0 = lw; r0 < nrows; r0 += NB11 * nlw) {
    int rr[NB11]; bool ok[NB11];
    unsigned pw[NB11][8]; float g0[NB11], g1[NB11]; int e_lo[NB11], e_hi[NB11];
#pragma unroll
    for (int u = 0; u < NB11; u++) {
      const int r = r0 + u * nlw;
      ok[u] = r < nrows; rr[u] = ok[u] ? r : r0;
#pragma unroll
      for (int s2 = 0; s2 < 8; s2++) pw[u][s2] = p.PD[((long)s2 * RTOT + rr[u]) * 64 + lane];
      g0[u] = p.gate[(long)rr[u] * 128 + P0]; g1[u] = p.gate[(long)rr[u] * 128 + P0 + 8];
      e_lo[u] = p.eid[(long)rr[u] * 128 + lane]; e_hi[u] = p.eid[(long)rr[u] * 128 + 64 + lane];
    }
    uint4 vv[NB11][16];
#pragma unroll
    for (int u = 0; u < NB11; u++)
#pragma unroll
      for (int i = 0; i < 16; i++) {
        const int e = __shfl(i < 8 ? e_lo[u] : e_hi[u], 8 * (i & 7) + j);
        vv[u][i] = ldg16(Vs + (long)e * 128);
      }
    __builtin_amdgcn_sched_barrier(0);
#pragma unroll
    for (int u = 0; u < NB11; u++) {
      float d0 = 0.f, d1 = 0.f;
#pragma unroll
      for (int s2 = 0; s2 < 8; s2++) { d0 += bf_lo(pw[u][s2]); d1 += bf_hi(pw[u][s2]); }
      const float act0 = gelu_tanh(d0 * (1.0f / U8_SCALE)) * g0[u] * (1.0f / V8_SCALE);
      const float act1 = gelu_tanh(d1 * (1.0f / U8_SCALE)) * g1[u] * (1.0f / V8_SCALE);
      f32x2 o2[8];
#pragma unroll
      for (int q = 0; q < 8; q++) o2[q] = f32x2{0.f, 0.f};
#pragma unroll
      for (int i = 0; i < 16; i++) {
        const float a = __shfl((i & 1) ? act1 : act0, (i >> 1) * 8 + j);
        const f32x2 aa = {a, a};
        f32x2 a0, a1;
        CVT8(vv[u][i].x, a0, a1); o2[0] += aa * a0; o2[1] += aa * a1;
        CVT8(vv[u][i].y, a0, a1); o2[2] += aa * a0; o2[3] += aa * a1;
        CVT8(vv[u][i].z, a0, a1); o2[4] += aa * a0; o2[5] += aa * a1;
        CVT8(vv[u][i].w, a0, a1); o2[6] += aa * a0; o2[7] += aa * a1;
      }
      float o[16];
#pragma unroll
      for (int q = 0; q < 8; q++) { o[2 * q] = o2[q].x; o[2 * q + 1] = o2[q].y; }
      float t8[8], t4[4], t2[2];
      { const bool up = (lane & 32) != 0;
#pragma unroll
        for (int k = 0; k < 8; k++) { const float send = up ? o[k] : o[k + 8], keep = up ? o[k + 8] : o[k]; t8[k] = keep + __shfl_xor(send, 32); } }
      { const bool up = (lane & 16) != 0;
#pragma unroll
        for (int k = 0; k < 4; k++) { const float send = up ? t8[k] : t8[k + 4], keep = up ? t8[k + 4] : t8[k]; t4[k] = keep + __shfl_xor(send, 16); } }
      { const bool up = (lane & 8) != 0;
#pragma unroll
        for (int k = 0; k < 2; k++) { const float send = up ? t4[k] : t4[k + 2], keep = up ? t4[k + 2] : t4[k]; t2[k] = keep + __shfl_xor(send, 8); } }
      if (!ABL_PEER || !ok[u]) continue;
      const int r = rr[u];
      float* xr = ((r < TLAT) ? p.out + (long)r * 1024 : p.ctx1 + (long)(r - TLAT) * 1024) + col;
      const float2 gt = *(const float2*)(p.mods + (long)(L * 9 + row_mod(r)) * 6144 + 5120 + col);
      float2 xv = *(const float2*)xr;
      xv.x += gt.x * t2[0]; xv.y += gt.y * t2[1];
      if (!dry) *(float2*)xr = xv;
    }
  }
}


#if CHECK_ATTN
__device__ __forceinline__ float blk_sum(float v, float* red) {
  v = wave_sum(v);
  __syncthreads();
  if ((TIDS & 63) == 0) red[TIDS >> 6] = v;
  __syncthreads();
  return red[0] + red[1] + red[2] + red[3];
}
__device__ __forceinline__ float blk_max(float v, float* red) {
#pragma unroll
  for (int o = 32; o > 0; o >>= 1) v = fmaxf(v, __shfl_xor(v, o));
  __syncthreads();
  if ((TIDS & 63) == 0) red[TIDS >> 6] = v;
  __syncthreads();
  return fmaxf(fmaxf(red[0], red[1]), fmaxf(red[2], red[3]));
}
__device__ __forceinline__ bool far(float got, float ref, float rel, float ab) { return !(fabsf(got - ref) <= rel * fabsf(ref) + ab); }
__device__ __forceinline__ void rope_ref(const float* z, float* o, int s) {
  for (int c = 0; c < 32; c++) {
    const int pos = (c < 16) ? (s / 64) : (s % 64);
    const float inv = powf(10000.0f, -(float)(2 * (c % 8)) / 16.0f);
    const float ang = (float)pos * inv;
    const int cb = c & 16, cc = c & 15;
    const float rot = (cc < 8) ? -z[cb + cc + 8] : z[cb + cc - 8];
    o[c] = z[c] * cosf(ang) + rot * sinf(ang);
  }
}
__device__ __forceinline__ void check_proj(const Params& p, int L, int r, char* smem) {
  float* hrow = (float*)smem;
  float* z = hrow + 1024;
  float* kvr = z + 416;
  float* red = kvr + 1024;
  float* kk = red + 8;
  const int tid = TIDS;
  __syncthreads();
  for (int k = tid; k < 1024; k += 256) hrow[k] = bf1(p.hx[(long)r * 1024 + k]);
  __syncthreads();
  for (int n = tid; n < 416; n += 256) {
    float a = 0.f;
    for (int k = 0; k < 1024; k++) a += hrow[k] * p.w_in[((long)L * 1024 + k) * 4256 + n];
    z[n] = a;
  }
  __syncthreads();
  unsigned bad = 0;
  if (L == 0 || r < TLAT)
  for (int n = tid; n < 256; n += 256) if (far(bf1(p.cq[(long)r * 256 + n]), z[160 + n], 0.02f, 0.03f)) bad |= 1u;
  for (int n = tid; n < 32; n += 256) if (far(p.kr[(long)r * 32 + n], z[128 + n], 0.02f, 0.03f)) bad |= 1u;
  const float ssc = blk_sum(tid < 128 ? z[tid] * z[tid] : 0.f, red);
  const float rc = rsqrtf(ssc / 128.0f + EPSV);
  for (int n = tid; n < 1024; n += 256) {
    float a = 0.f;
    for (int k = 0; k < 128; k++) a += z[k] * rc * p.g_ckv[L * 128 + k] * p.w_ukv[((long)L * 128 + k) * 1024 + n];
    kvr[n] = a;
  }
  __syncthreads();
  const bool lat = r < TLAT;
  const int b = lat ? (r >> 12) : ((r - TLAT) >> 8), s = lat ? (r & 4095) : ((r - TLAT) & 255), kpos = lat ? CTXL + s : s;
  for (int h = 0; h < 8; h++) {
    float sq = 0.f;
    if (tid < 64) sq = kvr[h * 128 + tid] * kvr[h * 128 + tid]; else if (tid < 96) sq = z[128 + tid - 64] * z[128 + tid - 64];
    const float ssk = blk_sum(sq, red);
    const float rk = rsqrtf(ssk / 96.0f + EPSV);
    if (tid == 0) {
      float* zr = kk + 96; float* zo = zr + 32;
      for (int c = 0; c < 32; c++) zr[c] = z[128 + c] * rk * p.g_kn[L * 96 + 64 + c];
      if (lat) rope_ref(zr, zo, s); else for (int c = 0; c < 32; c++) zo[c] = zr[c];
      for (int c = 0; c < 32; c++) kk[64 + c] = zo[c];
    }
    if (tid < 64) kk[tid] = kvr[h * 128 + tid] * rk * p.g_kn[L * 96 + tid];
    __syncthreads();
    if (tid < 96 && far(bf1(p.Kb[((long)(b * 8 + h) * SKEYS + kpos) * 96 + tid]), kk[tid], 0.03f, 0.03f)) bad |= 2u;
    if (tid < 64 && far(bf1(p.Vtb[((long)(b * 8 + h) * 64 + tid) * SKEYS + kpos]), kvr[h * 128 + 64 + tid], 0.03f, 0.03f)) bad |= 4u;
    __syncthreads();
  }
  if (bad & CHECK_MASK) atomicOr(&p.bar[0], bad & CHECK_MASK);
}
__device__ __forceinline__ void check_attn(const Params& p, int L, int r, int h, char* smem) {
  float* cqr = (float*)smem;
  float* q = cqr + 256;
  float* sc = q + 96;
  float* red = sc + 4352;
  const int tid = TIDS;
  const bool lat = r < TLAT;
  const int b = lat ? (r >> 12) : ((r - TLAT) >> 8), s = lat ? (r & 4095) : ((r - TLAT) & 255);
  const int nkeys = lat ? SKEYS : CTXL;
  __syncthreads();
  cqr[tid] = bf1(p.cq[(long)r * 256 + tid]);
  __syncthreads();
  const float rc = rsqrtf(blk_sum(cqr[tid] * cqr[tid], red) / 256.0f + EPSV);
  float qr = 0.f;
  if (tid < 96) for (int k = 0; k < 256; k++) qr += cqr[k] * rc * p.g_cq[L * 256 + k] * p.w_uq[((long)L * 256 + k) * 768 + h * 96 + tid];
  const float rq = rsqrtf(blk_sum(tid < 96 ? qr * qr : 0.f, red) / 96.0f + EPSV);
  if (tid < 96) q[tid] = qr * rq * p.g_qn[L * 96 + tid];
  __syncthreads();
  if (tid == 0 && lat) {
    float* zr = red + 8; float* zo = zr + 32;
    for (int c = 0; c < 32; c++) zr[c] = q[64 + c];
    rope_ref(zr, zo, s);
    for (int c = 0; c < 32; c++) q[64 + c] = zo[c];
  }
  __syncthreads();
  float mx = -1e30f;
  for (int key = tid; key < nkeys; key += 256) {
    float a = 0.f;
    for (int d = 0; d < 96; d++) a += q[d] * bf1(p.Kb[((long)(b * 8 + h) * SKEYS + key) * 96 + d]);
    a *= 0.10206207261596577f;
    sc[key] = a; mx = fmaxf(mx, a);
  }
  mx = blk_max(mx, red);
  float ps = 0.f;
  for (int key = tid; key < nkeys; key += 256) { const float e = expf(sc[key] - mx); sc[key] = e; ps += e; }
  const float tot = blk_sum(ps, red);
  unsigned bad = 0;
  if (tid < 64) {
    float a = 0.f;
    for (int key = 0; key < nkeys; key++) a += sc[key] * bf1(p.Vtb[((long)(b * 8 + h) * 64 + tid) * SKEYS + key]);
    a /= tot;
    if (far(bf1(p.Ob[(long)r * 512 + h * 64 + tid]), a, 0.04f, 1.5e-3f)) bad |= 8u;
  }
  if (bad & CHECK_MASK) atomicOr(&p.bar[0], bad & CHECK_MASK);
}
__device__ __forceinline__ void phase_check(const Params& p, int L, char* smem) {
  const int nq = (L == 0) ? 12 : 8;
  char* sm = smem + HALF_ * LDS_SMALL;
  for (int pass = 0; pass < 2; pass++) {
  FOR_PAIRED(pass == 0 ? 12 : nq * 8, uu)
    const int u = (pass == 0) ? uu : uu + 12;
    const int si = (u < 12) ? u : ((u - 12) >> 3);
    int r;
    switch (si) {
      case 0: r = 0; break; case 1: r = 63; break; case 2: r = 64; break; case 3: r = 4095; break;
      case 4: r = 4096 + 777; break; case 5: r = 12345; break; case 6: r = 20000; break; case 7: r = 32767; break;
      case 8: r = TLAT; break; case 9: r = TLAT + 255; break; case 10: r = TLAT + 256 + 100; break; default: r = TLAT + 2047; break;
    }
    if (u < 12) check_proj(p, L, r, sm);
    else check_attn(p, L, r, (u - 12) & 7, sm);
  }
  }
}
#endif

#define XB_TMO      128
#define XB_XCNT(j)  (256  + 64 * (j))
#define XB_XSUB(j)  (1280 + 64 * (j))
#define XB_XGEN(j)  (2304 + 64 * (j))
#define XB_TOP      3328
#define XB_TOPGEN   3392
#define XCD_BAR_WORDS 3456
#define XB_SPIN_CAP (1u << 22)
#define LAS __attribute__((address_space(3)))
__device__ __forceinline__ unsigned xb_ld(unsigned* p)              { return __hip_atomic_load(p, __ATOMIC_RELAXED, __HIP_MEMORY_SCOPE_AGENT); }
__device__ __forceinline__ unsigned xb_add(unsigned* p, unsigned v) { return __hip_atomic_fetch_add(p, v, __ATOMIC_RELAXED, __HIP_MEMORY_SCOPE_AGENT); }
__device__ __forceinline__ unsigned xb_xcc_id() { return (unsigned)__builtin_amdgcn_s_getreg((3 << 11) | 20) & 0xFu; }
#define XB_SPIN(cond, bar) do { unsigned _sp = 0; while (cond) { __builtin_amdgcn_s_sleep(1); \
    if ((++_sp & 255u) == 0u) { if (xb_ld(&(bar)[XB_TMO])) break; if (_sp > XB_SPIN_CAP) { atomicAdd(&(bar)[XB_TMO], 1u); break; } } } } while (0)
struct XcdBarrier { unsigned* bar; unsigned x; volatile LAS unsigned* st; };
__device__ __forceinline__ XcdBarrier xcd_barrier_post(unsigned* bar, volatile LAS unsigned* st) {
  XcdBarrier b; b.bar = bar; b.x = xb_xcc_id(); b.st = st;
  if (threadIdx.x == 0) (void)xb_add(&bar[XB_XCNT(b.x)], 1u);
  return b;
}
__device__ __forceinline__ void xcd_barrier_complete(unsigned* bar, unsigned x, unsigned& nloc, unsigned& nx) {
  const unsigned G = gridDim.x * gridDim.y * gridDim.z;
  unsigned sum, cnt, mine, sp = 0u;
  for (;;) {
    sum = 0u; cnt = 0u; mine = 0u;
#pragma unroll
    for (unsigned j = 0; j < 16; ++j) { const unsigned c = xb_ld(&bar[XB_XCNT(j)]); sum += c; cnt += (c > 0u) ? 1u : 0u; mine = (j == x) ? c : mine; }
    if (sum == G) break;
    __builtin_amdgcn_s_sleep(1);
    if ((++sp & 255u) == 0u) { if (xb_ld(&bar[XB_TMO])) break; if (sp > XB_SPIN_CAP) { atomicAdd(&bar[XB_TMO], 1u); break; } }
  }
  nloc = mine > 0u ? mine : 1u; nx = cnt > 0u ? cnt : 1u;
}
__device__ __forceinline__ void xcd_barrier(const XcdBarrier& b) {
  asm volatile("s_waitcnt vmcnt(0)" ::: "memory");
  __syncthreads();
  if (threadIdx.x == 0) {
    unsigned* bar = b.bar;
    asm volatile("" : "+s"(bar));
    __builtin_amdgcn_s_waitcnt(0);
    unsigned nloc = b.st[0], nx = b.st[1];
    if (nloc == 0u) { xcd_barrier_complete(bar, b.x, nloc, nx); b.st[0] = nloc; b.st[1] = nx; }
    const unsigned old = xb_add(&bar[XB_XSUB(b.x)], 1u);
    const unsigned gen = old / nloc;
    if (old + 1u == (gen + 1u) * nloc) {
      __builtin_amdgcn_fence(__ATOMIC_RELEASE, "agent");
      asm volatile("s_waitcnt vmcnt(0)" ::: "memory");
      const unsigned og = xb_add(&bar[XB_TOP], 1u);
      const unsigned tg = og / nx;
      if (og + 1u == (tg + 1u) * nx) xb_add(&bar[XB_TOPGEN], 1u);
      else XB_SPIN(xb_ld(&bar[XB_TOPGEN]) == tg, bar);
      __builtin_amdgcn_fence(__ATOMIC_ACQUIRE, "agent");
      xb_add(&bar[XB_XGEN(b.x)], 1u);
      asm volatile("s_waitcnt vmcnt(0)" ::: "memory");
    } else {
      XB_SPIN(xb_ld(&bar[XB_XGEN(b.x)]) == gen, bar);
      __builtin_amdgcn_fence(__ATOMIC_ACQUIRE, "agent");
      asm volatile("s_waitcnt vmcnt(0)" ::: "memory");
    }
  }
  __syncthreads();
}

#define NPHASE (23 + CHECK_ATTN)
#ifndef PH_LIMIT
#define PH_LIMIT NPHASE
#endif
__device__ __forceinline__ void run_phase(const Params& p, int ph, char* smem, bool dry = false, bool big = false) {
  if (ph == 0) { phase_prep(p, smem); return; }
#if CHECK_ATTN
  if (ph == 23) {
    if (blockIdx.x == 0 && threadIdx.x == 0 && __hip_atomic_load(&p.bar[0], __ATOMIC_RELAXED, __HIP_MEMORY_SCOPE_AGENT) != 0u) p.out[0] = __uint_as_float(0x7fc00000u);
    return;
  }
#endif
  const int L = (ph - 1) / 11, s = (ph - 1) % 11;
  if (s == 0 || s == 7) {
    phase_norm(p, L, s == 0 ? 0 : 1, (s == 0 || L == 0) ? RTOT : TLAT);
    if (s == 0) phase_tables(p, L);
    return;
  }
  switch (s) {
    case 1: phase_s2<true>(p, L, smem); break;
    case 2: phase_s3(p, L, smem, dry); break;
    case 3: phase_s4(p, L, smem); break;
    case 4: phase_dftC(p, smem);
#if CHECK_ATTN
      phase_check(p, L, smem);
#endif
      break;
    case 5: phase_s7<true>(p, L, smem); break;
    case 6: phase_s8<true>(p, L, smem, dry); break;
    case 8: phase_s10<true>(p, L, smem); break;
    case 9: phase_s11a(p, L); break;
    case 10: phase_s11b(p, L, dry); break;
  }
}

__global__ void __launch_bounds__(512, 2) mega(Params p, int ph0, int ph1) {
  extern __shared__ __attribute__((aligned(16))) char smem[];
  __shared__ uint4 xb_words;
  cg::grid_group grid = cg::this_grid();
  const bool multi = (ph1 - ph0) > 1;
  const bool big = blockDim.x == 512;
  XcdBarrier xb;
  if (multi) {
    if (threadIdx.x == 0) xb_words = make_uint4(0u, 0u, 0u, 0u);
    __syncthreads();
    xb = xcd_barrier_post(p.bar, (volatile LAS unsigned*)&xb_words);
  }
  for (int ph = ph0; ph < ph1; ph++) {
    if (ph > ph0) {
      if (ph == ph0 + 1) grid.sync();
      else xcd_barrier(xb);
    }
#if PROBE_S >= 0
    {
      const int kind = (ph == 0) ? 11 : (ph - 1) % 11;
      const int reps = (kind == PROBE_S) ? PROBE_REPS * p.one : 0;
      for (int rep = 0; rep <= reps; rep++) {
        if (rep > 0) xcd_barrier(xb);
        const bool dry = (rep < reps);
        if (kind == PROBE_S && (kind == 6 || kind == 10 || kind == 2)) run_phase(p, ph, smem, dry, big);
        else run_phase(p, ph, smem, false, big);
      }
    }
#else
    run_phase(p, ph, smem, false, big);
#endif
  }
}

static inline size_t al256(size_t x) { return (x + 255) & ~(size_t)255; }
extern "C" void kernel_launch(void* const* d_in, const int* in_sizes, int n_in, void* d_out, int out_size, void* d_ws,
                              size_t ws_size, hipStream_t stream) {
  Params p{};
  const float* const* in = (const float* const*)d_in;
  p.x = in[0]; p.c = in[1]; p.ctx = in[2]; p.c_ctx = in[3]; p.w_mod = in[4]; p.b_mod = in[5]; p.g_norm1 = in[6];
  p.w_in = in[7]; p.g_ckv = in[8]; p.w_ukv = in[9]; p.g_cq = in[10]; p.w_uq = in[11]; p.g_qn = in[12]; p.g_kn = in[13];
  p.w_dw = in[14]; p.b_dw = in[15]; p.g_cln = in[16]; p.b_cln = in[17]; p.wb_attn = in[18]; p.wb_fnet = in[19];
  p.wb_conv = in[20]; p.w_out = in[21]; p.g_norm2 = in[22]; p.w_query = in[23]; p.sub_keys = in[24]; p.u_tab = in[25];
  p.v_tab = in[26];
  p.out = (float*)d_out;
  p.one = 1; p.pad_ = 0;
  char* ws = (char*)d_ws;
  size_t off = 0;
  auto take = [&](size_t bytes) { char* q = ws + off; off += al256(bytes); return q; };
  p.bar = (unsigned*)take(XCD_BAR_WORDS * 4);
  const size_t mods_bytes = 2 * 9 * 6144 * 4;
  p.mods = (float*)take(mods_bytes);
  p.ropetab = (float*)take(64 * 8 * 2 * 4);
  p.W2T = (u16*)take(2ull * W2T_SZ * 2);
  p.WgT = (u16*)take(2ull * WGT_SZ * 2);
  p.WukvT = (u16*)take(2ull * WUKV_SZ * 2);
  p.WuqT = (u16*)take(2ull * WUQ_SZ * 2);
  p.WbaT = (u16*)take(2ull * WBA_SZ * 2);
  p.WbfT = (u16*)take(2ull * WBF_SZ * 2);
  p.WbcT = (u16*)take(2ull * WBC_SZ * 2);
  p.WoutT = (u16*)take(2ull * WOUT_SZ * 2);
  p.WqT = (u16*)take(2ull * WQ_SZ * 2);
  p.SubK = (u16*)take(2ull * SUBK_SZ * 2);
  p.WA = (u16*)take(128 * 128 * 2);
  p.WC = (u16*)take(128 * 128 * 2);
  p.tw = (float*)take(4096 * 2 * 4);
  p.GB = (u16*)take((size_t)NB * 256 * 8192 * 2);
  p.Dctx = (u16*)take(256ull * 512 * 2);
  p.Wcs = (u16*)take(128ull * 64 * 2);
  p.UT8 = (unsigned char*)take((size_t)NEXP * 1024);
  p.VT8 = (unsigned char*)take((size_t)NEXP * 1024);
  p.hx = (u16*)take((size_t)RTOT * 1024 * 2);
  {
    const size_t b0 = off;
    p.cq = (u16*)take((size_t)RTOT * 256 * 2);
    p.zf = (u16*)take((size_t)RTOT * 256 * 2);
    p.zc = (u16*)take((size_t)RTOT * 512 * 2);
    p.ckv = (u16*)take((size_t)RTOT * 128 * 2);
    p.kr = (float*)take((size_t)RTOT * 32 * 4);
    p.m = (u16*)(ws + b0);
    p.PD = (unsigned*)(ws + b0);
  }
  {
    const size_t c0 = off;
    p.Kb = (u16*)take((size_t)NB * NH * SKEYS * 96 * 2);
    p.Vtb = (u16*)take((size_t)NB * NH * 64 * SKEYS * 2);
    p.eid = (int*)(ws + c0);
    p.gate = (float*)(ws + c0 + al256((size_t)RTOT * 128 * 4));
  }
  p.Ytl = (u16*)take((size_t)NB * 256 * 8192 * 2);
  p.Ytc = (u16*)take((size_t)NB * 256 * 512 * 2);
  p.Ob = (u16*)take((size_t)RTOT * 512 * 2);
  p.Fb = (u16*)take((size_t)RTOT * 256 * 2);
  p.cv = (u16*)take((size_t)RTOT * 256 * 2);
  p.ctx1 = (float*)take((size_t)TCTX * 1024 * 4);
  if (off > ws_size) { fprintf(stderr, "workspace too small: need %zu have %zu\n", off, ws_size); return; }

  (void)hipMemsetAsync(p.bar, 0, XCD_BAR_WORDS * 4, stream);
  static int cus = 0;
  if (!cus) {
    int dev = 0;
    (void)hipGetDevice(&dev);
    (void)hipDeviceGetAttribute(&cus, hipDeviceAttributeMultiprocessorCount, dev);
    (void)hipFuncSetAttribute((const void*)mega, hipFuncAttributeMaxDynamicSharedMemorySize, LDS_BIG);
  }
#if ONE_LAUNCH
  int ph0 = 0, ph1 = NPHASE;
  void* args[] = {&p, &ph0, &ph1};
  hipError_t e = hipLaunchCooperativeKernel((void*)mega, dim3(cus), dim3(512), args, LDS_BIG, stream);
  if (e != hipSuccess) fprintf(stderr, "cooperative launch failed: %s (grid %d)\n", hipGetErrorString(e), cus);
#else
  for (int ph = 0; ph < PH_LIMIT; ph++) {
    const int kind = (ph == 0) ? 11 : (ph - 1) % 11;
    const bool bigp = (kind == 1 || kind == 5 || kind == 6 || kind == 8);
    if (bigp) mega<<<cus, 512, LDS_BIG, stream>>>(p, ph, ph + 1);
    else mega<<<cus * 2, 256, LDS_SMALL, stream>>>(p, ph, ph + 1);
  }
#endif
}
```

```cpp
#include <hip/hip_runtime.h>
#include <hip/hip_cooperative_groups.h>
#include <cstdio>
#include <cstdint>
namespace cg = cooperative_groups;

#ifndef ABL_PEER
#define ABL_PEER 1
#endif
#ifndef ABL_BR
#define ABL_BR 7
#endif
#ifndef PROBE_S
#define PROBE_S (-1)
#endif
#ifndef PROBE_REPS
#define PROBE_REPS 4
#endif
#ifndef CHECK_ATTN
#define CHECK_ATTN 0
#endif
#ifndef CHECK_MASK
#define CHECK_MASK 0xff
#endif
#ifndef ONE_LAUNCH
#define ONE_LAUNCH 1
#endif

typedef unsigned short u16;
typedef __attribute__((ext_vector_type(8))) __bf16 bf16x8;
typedef __attribute__((ext_vector_type(2))) __bf16 bf16x2;
typedef __attribute__((ext_vector_type(16))) float f32x16;
typedef __attribute__((ext_vector_type(2))) float f32x2;

#define NB 8
#define SEQ 4096
#define DM 1024
#define CTXL 256
#define TLAT (NB * SEQ)
#define TCTX (NB * CTXL)
#define RTOT (TLAT + TCTX)
#define SKEYS (CTXL + SEQ)
#define NH 8
#define QKD 96
#define N2 1280
#define NEXP 16384
#define EPSV 1e-6f

struct Params {
  const float *x, *c, *ctx, *c_ctx, *w_mod, *b_mod, *g_norm1, *w_in, *g_ckv, *w_ukv, *g_cq, *w_uq, *g_qn, *g_kn,
      *w_dw, *b_dw, *g_cln, *b_cln, *wb_attn, *wb_fnet, *wb_conv, *w_out, *g_norm2, *w_query, *sub_keys, *u_tab, *v_tab;
  float* out;
  unsigned* bar;
  float* mods;
  float* ropetab;
  u16 *W2T, *WgT, *WukvT, *WuqT, *WbaT, *WbfT, *WbcT, *WoutT, *WqT, *SubK;
  u16 *WA, *WC, *Dctx, *Wcs;
  float* tw;
  u16* GB;
  unsigned char *UT8, *VT8;
  unsigned* PD;
  u16* hx;
  u16 *cq, *zf, *zc, *ckv; float* kr;
  u16* m;
  u16 *Kb, *Vtb;
  int* eid; float* gate;
  u16 *Ytl, *Ytc, *Ob, *Fb, *cv;
  float* ctx1;
  int one; int pad_;
};

#define W2T_SZ (N2 * 1024)
#define WGT_SZ (3072 * 1024)
#define WUKV_SZ (1024 * 128)
#define WUQ_SZ (768 * 256)
#define WBA_SZ (1024 * 512)
#define WBF_SZ (1024 * 256)
#define WBC_SZ (1024 * 256)
#define WOUT_SZ (1024 * 1024)
#define WQ_SZ (1024 * 1024)
#define SUBK_SZ (8 * 2 * 128 * 64)

__device__ __forceinline__ unsigned pack2(float a, float b) {
  f32x2 v = {a, b};
  return __builtin_bit_cast(unsigned, __builtin_convertvector(v, bf16x2));
}
__device__ __forceinline__ u16 tobf(float a) { return (u16)(pack2(a, 0.f) & 0xffffu); }
__device__ __forceinline__ float bf_lo(unsigned u) { return __uint_as_float(u << 16); }
__device__ __forceinline__ float bf_hi(unsigned u) { return __uint_as_float(u & 0xffff0000u); }
__device__ __forceinline__ float bf1(u16 u) { return __uint_as_float(((unsigned)u) << 16); }
__device__ __forceinline__ f32x16 mfma32(uint4 a, uint4 b, f32x16 c) {
  return __builtin_amdgcn_mfma_f32_32x32x16_bf16(__builtin_bit_cast(bf16x8, a), __builtin_bit_cast(bf16x8, b), c, 0, 0, 0);
}
__device__ __forceinline__ uint4 ldg16(const void* p) { return *(const uint4*)p; }
__device__ __forceinline__ int opaque(int x) { asm volatile("" : "+v"(x)); return x; }
#define TIDX opaque((int)threadIdx.x)
#define HALF_ (opaque((int)threadIdx.x) >> 8)
#define TIDS (opaque((int)threadIdx.x) & 255)
#define VBID ((int)blockIdx.x + HALF_ * (int)gridDim.x)
#define NVB ((int)gridDim.x * (int)(blockDim.x >> 8))
#define FOR_PAIRED(N, U) for (int _b = (int)blockIdx.x, _g = (int)gridDim.x, _st = _g * (int)(blockDim.x >> 8); _b < (N); _b += _st) { \
    int U = _b + HALF_ * _g; if (U >= (N)) U = _b;
__device__ __forceinline__ float wave_sum(float v) {
#pragma unroll
  for (int o = 32; o > 0; o >>= 1) v += __shfl_xor(v, o);
  return v;
}
__device__ __forceinline__ float half_sum(float v) {
#pragma unroll
  for (int o = 16; o > 0; o >>= 1) v += __shfl_xor(v, o);
  return v;
}
__device__ __forceinline__ float sigmoidf_(float x) { return 1.f / (1.f + __expf(-x)); }
__device__ __forceinline__ float siluf_(float x) { return x / (1.f + __expf(-x)); }
__device__ __forceinline__ float gelu_tanh(float x) {
  float u = 0.7978845608028654f * (x + 0.044715f * x * x * x);
  float t = 1.f - 2.f / (1.f + __expf(2.f * u));
  return 0.5f * x * (1.f + t);
}
__device__ __forceinline__ int row_mod(int r) { return r < TLAT ? (r >> 12) : 8; }

#define SMEM_BYTES 73728
#define LDS_SMALL 73728
#define LDS_BIG 147456
#define LDT 72

#define LAS3 __attribute__((address_space(3)))
__device__ __forceinline__ void glds16(const u16* g, char* lds_wave_base) {
  __builtin_amdgcn_global_load_lds((const unsigned*)g, (LAS3 unsigned*)lds_wave_base, 16, 0, 0);
}
__device__ __forceinline__ void gemm128x(const u16* __restrict__ A, int lda, const u16* __restrict__ Bt, int ldb, int bs1, int bs2, int K,
                                         f32x16 (&acc)[2][2], char* smem) {
  char* As = smem;
  char* Bs = smem + 32768;
  const int tid = TIDS, lane = tid & 63, w = tid >> 6, wr = w >> 1, wc = w & 1;
  const int nk = K >> 6;
  const int srow = w * 8 + (lane >> 3);
  const int schunk = (lane & 7) ^ ((srow >> 1) & 7);
  const int aoff = srow * lda + schunk * 8, boff = srow * ldb + schunk * 8;
  const int a32 = 32 * lda;
  __syncthreads();
#pragma unroll
  for (int i = 0; i < 4; i++) {
    glds16(A + (aoff + i * a32), As + (i * 4 + w) * 1024);
    glds16(Bt + (boff + (i & 1) * bs1 + (i >> 1) * bs2), Bs + (i * 4 + w) * 1024);
  }
  __syncthreads();
  const int fr = lane & 31, hh = lane >> 5;
  const int sw = (fr >> 1) & 7;
  for (int kt = 0; kt < nk; kt++) {
    const int cur = kt & 1;
    if (kt + 1 < nk) {
      const int ko = (kt + 1) * 64;
      char* An = As + (cur ^ 1) * 16384;
      char* Bn = Bs + (cur ^ 1) * 16384;
#pragma unroll
      for (int i = 0; i < 4; i++) {
        glds16(A + (aoff + i * a32 + ko), An + (i * 4 + w) * 1024);
        glds16(Bt + (boff + (i & 1) * bs1 + (i >> 1) * bs2 + ko), Bn + (i * 4 + w) * 1024);
      }
    }
    const char* Ac = As + cur * 16384 + (wr * 64 + fr) * 128;
    const char* Bc = Bs + cur * 16384 + (wc * 64 + fr) * 128;
#pragma unroll
    for (int kk = 0; kk < 4; kk++) {
      const int so = ((2 * kk + hh) ^ sw) << 4;
      uint4 a0 = *(const uint4*)(Ac + so);
      uint4 a1 = *(const uint4*)(Ac + 32 * 128 + so);
      uint4 b0 = *(const uint4*)(Bc + so);
      uint4 b1 = *(const uint4*)(Bc + 32 * 128 + so);
      acc[0][0] = mfma32(a0, b0, acc[0][0]);
      acc[0][1] = mfma32(a0, b1, acc[0][1]);
      acc[1][0] = mfma32(a1, b0, acc[1][0]);
      acc[1][1] = mfma32(a1, b1, acc[1][1]);
    }
    __syncthreads();
  }
}
__device__ __forceinline__ void gemm128(const u16* __restrict__ A, int lda, const u16* __restrict__ Bt, int ldb, int K,
                                        f32x16 (&acc)[2][2], char* smem) {
  gemm128x(A, lda, Bt, ldb, 32 * ldb, 64 * ldb, K, acc, smem);
}
__device__ __forceinline__ void gemm128h(const u16* __restrict__ A, int lda, const u16* __restrict__ Bt, int ldb, int K, int jh,
                                         f32x16 (&acc)[2], char* smem) {
  char* As = smem;
  char* Bs = smem + 32768;
  const int tid = TIDS, lane = tid & 63, w = tid >> 6, wr = w >> 1, wc = w & 1;
  const int nk = K >> 6;
  const int srow = w * 8 + (lane >> 3);
  const int schunk = (lane & 7) ^ ((srow >> 1) & 7);
  const int aoff = srow * lda + schunk * 8;
  const int a32 = 32 * lda;
  const int boff = (jh * 32 + srow) * ldb + schunk * 8, b64 = 64 * ldb;
  __syncthreads();
#pragma unroll
  for (int i = 0; i < 4; i++) glds16(A + (aoff + i * a32), As + (i * 4 + w) * 1024);
#pragma unroll
  for (int i = 0; i < 2; i++) glds16(Bt + (boff + i * b64), Bs + (i * 4 + w) * 1024);
  __syncthreads();
  const int fr = lane & 31, hh = lane >> 5;
  const int sw = (fr >> 1) & 7;
  for (int kt = 0; kt < nk; kt++) {
    const int cur = kt & 1;
    if (kt + 1 < nk) {
      const int ko = (kt + 1) * 64;
      char* An = As + (cur ^ 1) * 16384;
      char* Bn = Bs + (cur ^ 1) * 8192;
#pragma unroll
      for (int i = 0; i < 4; i++) glds16(A + (aoff + i * a32 + ko), An + (i * 4 + w) * 1024);
#pragma unroll
      for (int i = 0; i < 2; i++) glds16(Bt + (boff + i * b64 + ko), Bn + (i * 4 + w) * 1024);
    }
    const char* Ac = As + cur * 16384 + (wr * 64 + fr) * 128;
    const char* Bc = Bs + cur * 8192 + (wc * 32 + fr) * 128;
#pragma unroll
    for (int kk = 0; kk < 4; kk++) {
      const int so = ((2 * kk + hh) ^ sw) << 4;
      uint4 a0 = *(const uint4*)(Ac + so);
      uint4 a1 = *(const uint4*)(Ac + 32 * 128 + so);
      uint4 b0 = *(const uint4*)(Bc + so);
      acc[0] = mfma32(a0, b0, acc[0]);
      acc[1] = mfma32(a1, b0, acc[1]);
    }
    __syncthreads();
  }
}
#define WAIT_VM(n) asm volatile("s_waitcnt vmcnt(%0)" ::"n"(n) : "memory")
#define G256_STAGE 49152
__device__ __forceinline__ void gemm256(const u16* __restrict__ A, int lda, const u16* __restrict__ Bt, int ldb, int K,
                                        f32x16 (&acc)[2][2], char* smem) {
  const int tid = TIDX, lane = tid & 63, w = tid >> 6, wr = w >> 1, wc = w & 1;
  const int nk = K >> 6;
  const int srow = w * 8 + (lane >> 3);
  const int schunk = (lane & 7) ^ ((srow >> 1) & 7);
  const int aoff = srow * lda + schunk * 8, boff = srow * ldb + schunk * 8;
  const int a64 = 64 * lda, b64 = 64 * ldb;
  auto issue = [&](int kt) __attribute__((always_inline)) {
    char* As = smem + (kt % 3) * G256_STAGE;
    char* Bs = As + 32768;
    const int ko = kt * 64;
#pragma unroll
    for (int i = 0; i < 4; i++) glds16(A + (aoff + i * a64 + ko), As + (w + 8 * i) * 1024);
#pragma unroll
    for (int i = 0; i < 2; i++) glds16(Bt + (boff + i * b64 + ko), Bs + (w + 8 * i) * 1024);
  };
  WAIT_VM(0);
  __syncthreads();
  issue(0);
  if (nk > 1) issue(1);
  const int fr = lane & 31, hh = lane >> 5;
  const int sw = (fr >> 1) & 7;
  const int rdA = (wr * 64 + fr) * 128, rdB = 32768 + (wc * 64 + fr) * 128;
  for (int kt = 0; kt < nk; kt++) {
    if (kt + 1 < nk) WAIT_VM(6); else WAIT_VM(0);
    __builtin_amdgcn_s_barrier();
    if (kt + 2 < nk) issue(kt + 2);
    const char* Sb = smem + (kt % 3) * G256_STAGE;
#pragma unroll
    for (int kk = 0; kk < 4; kk++) {
      const int so = ((2 * kk + hh) ^ sw) << 4;
      uint4 a0 = *(const uint4*)(Sb + rdA + so);
      uint4 a1 = *(const uint4*)(Sb + rdA + 32 * 128 + so);
      uint4 b0 = *(const uint4*)(Sb + rdB + so);
      uint4 b1 = *(const uint4*)(Sb + rdB + 32 * 128 + so);
      acc[0][0] = mfma32(a0, b0, acc[0][0]);
      acc[0][1] = mfma32(a0, b1, acc[0][1]);
      acc[1][0] = mfma32(a1, b0, acc[1][0]);
      acc[1][1] = mfma32(a1, b1, acc[1][1]);
    }
  }
  __syncthreads();
}
__device__ __forceinline__ void gemm256h(const u16* __restrict__ A, int lda, const u16* __restrict__ Bt, int ldb, int K, int jh,
                                         f32x16 (&acc)[2], char* smem) {
  const int tid = TIDX, lane = tid & 63, w = tid >> 6, wr = w >> 1, wc = w & 1;
  const int nk = K >> 6;
  const int srow = w * 8 + (lane >> 3);
  const int schunk = (lane & 7) ^ ((srow >> 1) & 7);
  const int aoff = srow * lda + schunk * 8;
  const int a64 = 64 * lda;
  const int boff = ((srow >> 5) * 64 + jh * 32 + (srow & 31)) * ldb + schunk * 8;
  auto issue = [&](int kt) __attribute__((always_inline)) {
    char* As = smem + (kt % 3) * G256_STAGE;
    char* Bs = As + 32768;
    const int ko = kt * 64;
#pragma unroll
    for (int i = 0; i < 4; i++) glds16(A + (aoff + i * a64 + ko), As + (w + 8 * i) * 1024);
    glds16(Bt + (boff + ko), Bs + w * 1024);
  };
  WAIT_VM(0);
  __syncthreads();
  issue(0);
  if (nk > 1) issue(1);
  const int fr = lane & 31, hh = lane >> 5;
  const int sw = (fr >> 1) & 7;
  const int rdA = (wr * 64 + fr) * 128, rdB = 32768 + (wc * 32 + fr) * 128;
  for (int kt = 0; kt < nk; kt++) {
    if (kt + 1 < nk) WAIT_VM(5); else WAIT_VM(0);
    __builtin_amdgcn_s_barrier();
    if (kt + 2 < nk) issue(kt + 2);
    const char* Sb = smem + (kt % 3) * G256_STAGE;
#pragma unroll
    for (int kk = 0; kk < 4; kk++) {
      const int so = ((2 * kk + hh) ^ sw) << 4;
      uint4 a0 = *(const uint4*)(Sb + rdA + so);
      uint4 a1 = *(const uint4*)(Sb + rdA + 32 * 128 + so);
      uint4 b0 = *(const uint4*)(Sb + rdB + so);
      acc[0] = mfma32(a0, b0, acc[0]);
      acc[1] = mfma32(a1, b0, acc[1]);
    }
  }
  __syncthreads();
}
#define FOR_UNITS_XCD(NRT, NCT, RT, CT) \
  for (int _s = (int)(blockIdx.x >> 3), _per = (NRT) >> 3, _n = _per * (NCT); _s < _n; _s += (int)(gridDim.x >> 3)) { \
    const int RT = (int)(blockIdx.x & 7) * _per + _s / (NCT), CT = _s % (NCT);
#define ZERO_ACC(acc) { _Pragma("unroll") for (int _i = 0; _i < 2; _i++) _Pragma("unroll") for (int _j = 0; _j < 2; _j++) _Pragma("unroll") for (int _r = 0; _r < 16; _r++) acc[_i][_j][_r] = 0.f; }
#define ACC_ROW(wr, i, r, lane) ((wr) * 64 + (i) * 32 + ((r) & 3) + 8 * ((r) >> 2) + 4 * ((lane) >> 5))
#define ACC_COL(wc, j, lane) ((wc) * 64 + (j) * 32 + ((lane) & 31))

__device__ __forceinline__ void job_mods(const Params& p, int job, char* smem) {
  float* s = (float*)smem;
  float* red = s + 9 * 1024;
  const int L = job / 96, nt = job % 96;
  const int tid = TIDS, lane = tid & 63, w = tid >> 6;
  __syncthreads();
  for (int i = tid; i < 9 * 1024; i += 256) {
    const int j = i >> 10, k = i & 1023;
    const float cv = (j < 8) ? p.c[j * 1024 + k] : p.c_ctx[k];
    s[i] = siluf_(cv);
  }
  __syncthreads();
  const int n = nt * 64 + lane;
  float acc[9];
#pragma unroll
  for (int j = 0; j < 9; j++) acc[j] = 0.f;
  const float* wp = p.w_mod + (long)L * 1024 * 6144 + (long)(w * 256) * 6144 + n;
#pragma unroll 8
  for (int k = 0; k < 256; k++) {
    const float wv = wp[(long)k * 6144];
#pragma unroll
    for (int j = 0; j < 9; j++) acc[j] += s[j * 1024 + w * 256 + k] * wv;
  }
#pragma unroll
  for (int j = 0; j < 9; j++) red[(w * 9 + j) * 64 + lane] = acc[j];
  __syncthreads();
  for (int i = tid; i < 9 * 64; i += 256) {
    const int j = i >> 6, l = i & 63;
    const float v = ((red[(0 * 9 + j) * 64 + l] + red[(1 * 9 + j) * 64 + l]) + red[(2 * 9 + j) * 64 + l]) + red[(3 * 9 + j) * 64 + l];
    p.mods[(L * 9 + j) * 6144 + nt * 64 + l] = v + p.b_mod[L * 6144 + nt * 64 + l];
  }
}

__device__ __forceinline__ void job_convT(const float* src, int ldsrc, int c0, int k0, u16* dst, int K, int n0, const float* scale, char* smem) {
  float* t = (float*)smem;
  const int tid = TIDS;
  __syncthreads();
  const int nc = tid & 31, kr = tid >> 5;
#pragma unroll 4
  for (int kk = kr; kk < 128; kk += 8) {
    float v = 0.f;
    if (src) { v = src[(long)(k0 + kk) * ldsrc + c0 + nc]; if (scale) v *= scale[k0 + kk]; }
    t[nc * 129 + kk] = v;
  }
  __syncthreads();
  const int nr = tid >> 3, kc = (tid & 7) * 16;
  unsigned o[8];
#pragma unroll
  for (int q = 0; q < 8; q++) o[q] = pack2(t[nr * 129 + kc + 2 * q], t[nr * 129 + kc + 2 * q + 1]);
  uint4* dp = (uint4*)(dst + (long)(n0 + nr) * K + k0 + kc);
  dp[0] = make_uint4(o[0], o[1], o[2], o[3]);
  dp[1] = make_uint4(o[4], o[5], o[6], o[7]);
}

#define NJ_W2 (40 * 8)
#define NJ_WG (96 * 8)
#define NJ_UKV (32 * 1)
#define NJ_UQ (24 * 2)
#define NJ_BA (32 * 4)
#define NJ_BF (32 * 2)
#define NJ_BC (32 * 2)
#define NJ_OUT (32 * 8)
#define NJ_WQ (32 * 8)
#define NJ_CONV_LAYER (NJ_W2 + NJ_WG + NJ_UKV + NJ_UQ + NJ_BA + NJ_BF + NJ_BC + NJ_OUT + NJ_WQ)

__device__ __forceinline__ void job_conv_weights(const Params& p, int job, char* smem) {
  const int L = job / NJ_CONV_LAYER;
  int j = job % NJ_CONV_LAYER;
  const float* src; int ldsrc, c0, k0, K, n0; u16* dst; const float* scale = nullptr;
  if (j < NJ_W2) {
    const int nt = j >> 3, kt = j & 7; n0 = nt * 32;
    bool valid = true;
    if (n0 < 256) c0 = 160 + n0;
    else if (n0 < 512) c0 = 416 + (n0 - 256);
    else if (n0 < 1024) c0 = 672 + (n0 - 512);
    else if (n0 < 1152) c0 = n0 - 1024;
    else if (n0 < 1184) c0 = 128 + (n0 - 1152);
    else { c0 = 0; valid = false; }
    src = valid ? p.w_in + (long)L * 1024 * 4256 : nullptr; ldsrc = 4256; k0 = kt * 128; dst = p.W2T + (long)L * W2T_SZ; K = 1024;
  } else if ((j -= NJ_W2) < NJ_WG) {
    const int nt = j >> 3, kt = j & 7;
    src = p.w_in + (long)L * 1024 * 4256; ldsrc = 4256; c0 = 1184 + nt * 32; k0 = kt * 128; dst = p.WgT + (long)L * WGT_SZ; K = 1024; n0 = nt * 32;
  } else if ((j -= NJ_WG) < NJ_UKV) {
    src = p.w_ukv + (long)L * 128 * 1024; ldsrc = 1024; c0 = j * 32; k0 = 0; dst = p.WukvT + (long)L * WUKV_SZ; K = 128; n0 = j * 32; scale = p.g_ckv + L * 128;
  } else if ((j -= NJ_UKV) < NJ_UQ) {
    const int nt = j >> 1, kt = j & 1;
    src = p.w_uq + (long)L * 256 * 768; ldsrc = 768; c0 = nt * 32; k0 = kt * 128; dst = p.WuqT + (long)L * WUQ_SZ; K = 256; n0 = nt * 32; scale = p.g_cq + L * 256;
  } else if ((j -= NJ_UQ) < NJ_BA) {
    const int nt = j >> 2, kt = j & 3;
    src = p.wb_attn + (long)L * 512 * 1024; ldsrc = 1024; c0 = nt * 32; k0 = kt * 128; dst = p.WbaT + (long)L * WBA_SZ; K = 512; n0 = nt * 32;
  } else if ((j -= NJ_BA) < NJ_BF) {
    const int nt = j >> 1, kt = j & 1;
    src = p.wb_fnet + (long)L * 256 * 1024; ldsrc = 1024; c0 = nt * 32; k0 = kt * 128; dst = p.WbfT + (long)L * WBF_SZ; K = 256; n0 = nt * 32;
  } else if ((j -= NJ_BF) < NJ_BC) {
    const int nt = j >> 1, kt = j & 1;
    src = p.wb_conv + (long)L * 256 * 1024; ldsrc = 1024; c0 = nt * 32; k0 = kt * 128; dst = p.WbcT + (long)L * WBC_SZ; K = 256; n0 = nt * 32;
  } else if ((j -= NJ_BC) < NJ_OUT) {
    const int nt = j >> 3, kt = j & 7;
    src = p.w_out + (long)L * 1024 * 1024; ldsrc = 1024; c0 = nt * 32; k0 = kt * 128; dst = p.WoutT + (long)L * WOUT_SZ; K = 1024; n0 = nt * 32;
  } else {
    j -= NJ_OUT;
    const int nt = j >> 3, kt = j & 7;
    src = p.w_query + (long)L * 1024 * 1024; ldsrc = 1024; c0 = nt * 32; k0 = kt * 128; dst = p.WqT + (long)L * WQ_SZ; K = 1024; n0 = nt * 32;
  }
  job_convT(src, ldsrc, c0, k0, dst, K, n0, scale, smem);
}

__device__ __forceinline__ void job_cvt_straight(const float* src, u16* dst, long job) {
  const long base = job * 8192 + TIDS * 8;
#pragma unroll
  for (int i = 0; i < 4; i++) {
    const long o = base + i * 2048;
    float4 a = *(const float4*)(src + o), b = *(const float4*)(src + o + 4);
    *(uint4*)(dst + o) = make_uint4(pack2(a.x, a.y), pack2(a.z, a.w), pack2(b.x, b.y), pack2(b.z, b.w));
  }
}

#define NJ_MISC 87
__device__ __forceinline__ void job_misc(const Params& p, int job) {
  const int tid = TIDS;
#pragma unroll 1
  for (int q = 0; q < 8; q++) {
    const int e = tid + 256 * q;
    if (job < 64) {
      const int i = job * 2048 + e;
      const int k = i >> 9, ee = i & 511, part = ee >> 8, t = ee & 255;
      const float a = (float)((k * t) & 255) * (1.0f / 128.0f);
      p.Dctx[i] = tobf((part == 0 ? cospif(a) : -sinpif(a)) * (1.0f / 16.0f));
    } else if (job < 72) {
      const int i = (job - 64) * 2048 + e;
      const int R = i >> 7, kk = i & 127, k1 = (R >> 6) * 32 + (R & 31), pr = (R >> 5) & 1, part = kk >> 6, t1 = kk & 63;
      const float a = (float)((k1 * t1) & 63) * (1.0f / 32.0f);
      const float cs = cospif(a), sn = sinpif(a);
      const float v = (pr == 0) ? (part == 0 ? cs : -sn) : (part == 0 ? -sn : -cs);
      p.WA[i] = tobf(v * 0.125f);
    } else if (job < 80) {
      const int i = (job - 72) * 2048 + e;
      const int k2 = i >> 7, kk = i & 127, part = kk >> 6, t2 = kk & 63;
      const float a = (float)((k2 * t2) & 63) * (1.0f / 32.0f);
      p.WC[i] = (k2 < 64) ? tobf((part == 0 ? cospif(a) : sinpif(a)) * 0.125f) : (u16)0;
    } else if (job < 84) {
      const int i = (job - 80) * 2048 + e;
      const int n = i >> 6, d = i & 63, pp = n >> 6, en = n & 63;
      const float a = (float)((en * d) & 63) * (1.0f / 32.0f);
      p.Wcs[i] = tobf((pp == 0 ? cospif(a) : sinpif(a)) * 0.125f);
    } else if (job < 86) {
      const int i = (job - 84) * 2048 + e;
      const float a = (float)i * (1.0f / 2048.0f);
      p.tw[2 * i] = cospif(a); p.tw[2 * i + 1] = sinpif(a);
    } else if (e < 512) {
      const int pos = e >> 3, mm = e & 7;
      const float inv = powf(10000.0f, -(float)(2 * mm) / 16.0f);
      const float ang = (float)pos * inv;
      p.ropetab[e * 2] = cosf(ang);
      p.ropetab[e * 2 + 1] = sinf(ang);
    }
  }
}

#define NJ_MODS 192
#define NJ_CONVW (2 * NJ_CONV_LAYER)
#define NJ_SUBK 32
#define NJ_PREP (NJ_MODS + NJ_CONVW + NJ_SUBK + NJ_MISC)

__device__ __forceinline__ void phase_prep(const Params& p, char* smem) {
  char* sm = smem + HALF_ * LDS_SMALL;
  FOR_PAIRED(NJ_MODS, j) job_mods(p, j, sm); }
  FOR_PAIRED(NJ_CONVW, j) job_conv_weights(p, j, sm); }
  for (int j = VBID; j < NJ_SUBK; j += NVB) job_cvt_straight(p.sub_keys, p.SubK, j);
  for (int j = NVB - 1 - VBID; j < NJ_MISC; j += NVB) job_misc(p, j);
}

__device__ __forceinline__ void phase_norm(const Params& p, int L, int which, int nrows) {
  const int lane = TIDS & 63;
  const int gw = VBID * 4 + (TIDS >> 6), nw = NVB * 4;
  const float* g = (which == 0 ? p.g_norm1 : p.g_norm2) + L * 1024;
  for (int r0 = gw; r0 < nrows; r0 += 2 * nw) {
    float4 v[2][4];
    int rr[2]; bool ok[2];
#pragma unroll
    for (int u = 0; u < 2; u++) {
      const int r = r0 + u * nw;
      ok[u] = r < nrows; rr[u] = ok[u] ? r : r0;
      const float* src;
      if (which == 0 && L == 0) src = (rr[u] < TLAT) ? p.x + (long)rr[u] * 1024 : p.ctx + (long)(rr[u] - TLAT) * 1024;
      else src = (rr[u] < TLAT) ? p.out + (long)rr[u] * 1024 : p.ctx1 + (long)(rr[u] - TLAT) * 1024;
#pragma unroll
      for (int i = 0; i < 4; i++) v[u][i] = *(const float4*)(src + i * 256 + lane * 4);
    }
#pragma unroll
    for (int u = 0; u < 2; u++) {
      const int r = rr[u];
      const float* md = p.mods + (long)(L * 9 + row_mod(r)) * 6144 + (which == 0 ? 0 : 3072);
      float ss = 0.f;
#pragma unroll
      for (int i = 0; i < 4; i++) ss += v[u][i].x * v[u][i].x + v[u][i].y * v[u][i].y + v[u][i].z * v[u][i].z + v[u][i].w * v[u][i].w;
      ss = wave_sum(ss);
      const float rs = rsqrtf(ss * (1.0f / 1024.0f) + EPSV);
      if (!ok[u]) continue;
#pragma unroll
      for (int i = 0; i < 4; i++) {
        const int c = i * 256 + lane * 4;
        const float4 gg = *(const float4*)(g + c);
        const float4 sh = *(const float4*)(md + c);
        const float4 sc = *(const float4*)(md + 1024 + c);
        const float o0 = v[u][i].x * rs * gg.x * (1.f + sc.x) + sh.x;
        const float o1 = v[u][i].y * rs * gg.y * (1.f + sc.y) + sh.y;
        const float o2 = v[u][i].z * rs * gg.z * (1.f + sc.z) + sh.z;
        const float o3 = v[u][i].w * rs * gg.w * (1.f + sc.w) + sh.w;
        *(uint2*)(p.hx + (long)r * 1024 + c) = make_uint2(pack2(o0, o1), pack2(o2, o3));
      }
    }
  }
}
#define U8_SCALE 32.0f
#define V8_SCALE 4.0f
__device__ __forceinline__ unsigned pack_fp8x4(float4 v, float s) {
  int w = 0;
  w = __builtin_amdgcn_cvt_pk_fp8_f32(v.x * s, v.y * s, w, false);
  w = __builtin_amdgcn_cvt_pk_fp8_f32(v.z * s, v.w * s, w, true);
  return (unsigned)w;
}
__device__ __forceinline__ void phase_tables(const Params& p, int L) {
  const int tid = TIDS;
  for (int job = VBID; job < 4096; job += NVB) {
    const bool isu = job < 2048;
    const float* src = (isu ? p.u_tab : p.v_tab) + (long)L * NEXP * 1024;
    unsigned char* dst = isu ? p.UT8 : p.VT8;
    const float s = isu ? U8_SCALE : V8_SCALE;
    const long base = (long)(isu ? job : job - 2048) * 8192 + tid * 16;
#pragma unroll
    for (int i = 0; i < 2; i++) {
      const long o = base + i * 4096;
      const float4 a = *(const float4*)(src + o), b = *(const float4*)(src + o + 4);
      const float4 c = *(const float4*)(src + o + 8), d = *(const float4*)(src + o + 12);
      const long e = o >> 10; const int col = (int)(o & 1023), sl = col >> 7, cc = col & 127;
      *(uint4*)(dst + ((long)sl * NEXP + e) * 128 + cc) = make_uint4(pack_fp8x4(a, s), pack_fp8x4(b, s), pack_fp8x4(c, s), pack_fp8x4(d, s));
    }
  }
}

template <bool BIG>
__device__ __forceinline__ void phase_s2(const Params& p, int L, char* smem) {
  constexpr int TM = BIG ? 256 : 128;
  const int lane = TIDX & 63, w = TIDX >> 6, wr = w >> 1, wc = w & 1;
  for (int pass = 0; pass < (L == 0 ? 1 : 2); pass++) {
  const int g_nrt = (L == 0) ? RTOT / TM : (pass == 0 ? TLAT / TM : TCTX / TM), g_nct = (L == 0 || pass == 0) ? 10 : 2;
  FOR_UNITS_XCD(g_nrt, g_nct, rt_, ct_)
    const int rt = (L == 1 && pass == 1) ? TLAT / TM + rt_ : rt_, ct = (L == 1 && pass == 1) ? 8 + ct_ : ct_;
    f32x16 acc[2][2];
    ZERO_ACC(acc);
    if constexpr (BIG) gemm256(p.hx + (long)rt * TM * 1024, 1024, p.W2T + (long)L * W2T_SZ + (long)ct * 128 * 1024, 1024, 1024, acc, smem);
    else gemm128(p.hx + (long)rt * TM * 1024, 1024, p.W2T + (long)L * W2T_SZ + (long)ct * 128 * 1024, 1024, 1024, acc, smem);
    const int row0 = rt * TM;
#define S2_STORE(DST, LDD, C0) { u16* dp = (DST) + (long)row0 * (LDD) + (C0); \
      const int tb = opaque((wr * 64 + 4 * (lane >> 5)) * (LDD) + wc * 64 + (lane & 31)); \
      _Pragma("unroll") for (int i = 0; i < 2; i++) _Pragma("unroll") for (int j = 0; j < 2; j++) _Pragma("unroll") for (int r = 0; r < 16; r++) \
        dp[tb + (i * 32 + (r & 3) + 8 * (r >> 2)) * (LDD) + j * 32] = tobf(acc[i][j][r]); }
    if (ct < 2) S2_STORE(p.cq, 256, ct * 128)
    else if (ct < 4) S2_STORE(p.zf, 256, (ct - 2) * 128)
    else if (ct < 8) S2_STORE(p.zc, 512, (ct - 4) * 128)
    else if (ct == 8) S2_STORE(p.ckv, 128, 0)
#undef S2_STORE
    else if (wc == 0) {
      float* dp = p.kr + (long)row0 * 32;
      const int tb = opaque((wr * 64 + 4 * (lane >> 5)) * 32 + (lane & 31));
#pragma unroll
      for (int i = 0; i < 2; i++)
#pragma unroll
        for (int r = 0; r < 16; r++)
          dp[tb + (i * 32 + (r & 3) + 8 * (r >> 2)) * 32] = acc[i][0][r];
    }
  }
  }
}

__device__ __forceinline__ void unit_kv(const Params& p, int L, int rt, int h, char* smem) {
  u16* As = (u16*)smem;
  u16* Ws = (u16*)(smem + 128 * 136 * 2);
  float* rrs = (float*)(smem + 2 * 128 * 136 * 2);
  const int tid = TIDS, lane = tid & 63, w = tid >> 6, hh = lane >> 5, c = lane & 31;
  const int row0 = rt * 128;
  __syncthreads();
  {
    const u16* ap = p.ckv + (long)row0 * 128;
    const u16* wp = p.WukvT + (long)L * WUKV_SZ + (long)h * 128 * 128;
#pragma unroll
    for (int i = 0; i < 8; i++) {
      const int idx = tid + 256 * i, rw = idx >> 4, ch = idx & 15;
      *(uint4*)(As + rw * 136 + ch * 8) = ldg16(ap + rw * 128 + ch * 8);
      *(uint4*)(Ws + rw * 136 + ch * 8) = ldg16(wp + rw * 128 + ch * 8);
    }
  }
  __syncthreads();
  {
    const int rw = tid >> 1, hf = tid & 1;
    float ss = 0.f;
#pragma unroll
    for (int q = 0; q < 8; q++) {
      uint4 v = *(const uint4*)(As + rw * 136 + hf * 64 + q * 8);
      float a;
      a = bf_lo(v.x); ss += a * a; a = bf_hi(v.x); ss += a * a;
      a = bf_lo(v.y); ss += a * a; a = bf_hi(v.y); ss += a * a;
      a = bf_lo(v.z); ss += a * a; a = bf_hi(v.z); ss += a * a;
      a = bf_lo(v.w); ss += a * a; a = bf_hi(v.w); ss += a * a;
    }
    ss += __shfl_xor(ss, 1);
    if (hf == 0) rrs[rw] = rsqrtf(ss * (1.0f / 128.0f) + EPSV);
  }
  __syncthreads();
  f32x16 aK[2], aV[2];
#pragma unroll
  for (int r = 0; r < 16; r++) { aK[0][r] = 0.f; aK[1][r] = 0.f; aV[0][r] = 0.f; aV[1][r] = 0.f; }
#pragma unroll
  for (int s = 0; s < 8; s++) {
    const int ko = s * 16 + hh * 8;
    uint4 tk = *(const uint4*)(As + (32 * w + c) * 136 + ko);
    uint4 w0 = *(const uint4*)(Ws + (c) * 136 + ko);
    uint4 w1 = *(const uint4*)(Ws + (32 + c) * 136 + ko);
    uint4 w2 = *(const uint4*)(Ws + (64 + c) * 136 + ko);
    uint4 w3 = *(const uint4*)(Ws + (96 + c) * 136 + ko);
    aK[0] = mfma32(tk, w0, aK[0]);
    aK[1] = mfma32(tk, w1, aK[1]);
    aV[0] = mfma32(w2, tk, aV[0]);
    aV[1] = mfma32(w3, tk, aV[1]);
  }
  const bool lat = row0 < TLAT;
  const int b = lat ? (row0 >> 12) : ((row0 - TLAT) >> 8);
  const int s0 = lat ? (row0 & 4095) : ((row0 - TLAT) & 255);
  const int kpos0 = lat ? (CTXL + s0) : s0;
  const float* gkn = p.g_kn + L * 96;
  const float gk0 = gkn[c], gk1 = gkn[32 + c], gk2 = gkn[64 + c];
  u16* Kdst = p.Kb + ((long)(b * 8 + h) * SKEYS + kpos0) * 96;
#pragma unroll
  for (int r = 0; r < 16; r++) {
    const int tl = 32 * w + (r & 3) + 8 * (r >> 2) + 4 * hh;
    const float rc = rrs[tl];
    const float v0 = aK[0][r] * rc, v1 = aK[1][r] * rc;
    const float kv = p.kr[(long)(row0 + tl) * 32 + c];
    const float ss = half_sum(v0 * v0 + v1 * v1 + kv * kv);
    const float rk = rsqrtf(ss * (1.0f / 96.0f) + EPSV);
    const float krn = kv * rk * gk2;
    const float partner = __shfl_xor(krn, 8);
    float o2 = krn;
    if (lat) {
      const int s = s0 + tl;
      const int pos = (c < 16) ? (s >> 6) : (s & 63);
      const float2 cs = *(const float2*)(p.ropetab + (pos * 8 + (c & 7)) * 2);
      const float rot = (c & 8) ? partner : -partner;
      o2 = krn * cs.x + rot * cs.y;
    }
    u16* kd = Kdst + (long)tl * 96;
    kd[c] = tobf(v0 * rk * gk0);
    kd[32 + c] = tobf(v1 * rk * gk1);
    kd[64 + c] = tobf(o2);
  }
  u16* Vdst = p.Vtb + (long)(b * 8 + h) * 64 * SKEYS + kpos0;
  const float rcv = rrs[32 * w + c];
#pragma unroll
  for (int i = 0; i < 2; i++)
#pragma unroll
    for (int r = 0; r < 16; r++) {
      const int d = 32 * i + (r & 3) + 8 * (r >> 2) + 4 * hh;
      Vdst[(long)d * SKEYS + 32 * w + c] = tobf(aV[i][r] * rcv);
    }
}

__device__ __forceinline__ void unit_chdft(const Params& p, int ut, int g, bool lat, char* smem) {
  const int lane = TIDS & 63, w = TIDS >> 6, wr = w >> 1, wc = w & 1;
  f32x16 acc[2][2];
  ZERO_ACC(acc);
  if (lat) {
    const int b = ut >> 5, j = ut & 31;
    gemm128x(p.Wcs, 64, p.zf + ((long)(b * SEQ + 2 * j) * 256 + g * 64), 64 * 256, 32 * 64 * 256, 256, 64, acc, smem);
    u16* dst = p.Ytl + ((long)(b * 256 + g * 64) * 64 + 2 * j) * 128;
#pragma unroll
    for (int i = 0; i < 2; i++)
#pragma unroll
      for (int jj = 0; jj < 2; jj++)
#pragma unroll
        for (int r = 0; r < 16; r++) {
          const int e = i * 32 + (r & 3) + 8 * (r >> 2) + 4 * (lane >> 5);
          dst[((long)e * 64 + wc) * 128 + wr * 64 + jj * 32 + (lane & 31)] = tobf(acc[i][jj][r]);
        }
  } else {
    const int row0 = TLAT + ut * 128;
    gemm128(p.Wcs, 64, p.zf + (long)row0 * 256 + g * 64, 256, 64, acc, smem);
    const int b = (row0 - TLAT) >> 8, s0 = (row0 - TLAT) & 255;
#pragma unroll
    for (int i = 0; i < 2; i++)
#pragma unroll
      for (int jj = 0; jj < 2; jj++)
#pragma unroll
        for (int r = 0; r < 16; r++) {
          const int n = ACC_ROW(wr, i, r, lane);
          const int t = s0 + ACC_COL(wc, jj, lane);
          p.Ytc[((long)(b * 256 + g * 64 + (n & 63))) * 512 + (n >> 6) * 256 + t] = tobf(acc[i][jj][r]);
        }
  }
}

__device__ __forceinline__ void unit_conv(const Params& p, int L, int ut, char* smem) {
  float* U = (float*)smem;
  const int tid = TIDS, lane = tid & 63, w = tid >> 6;
  const int row0 = ut * 32;
  const bool lat = row0 < TLAT;
  const int seqlen = lat ? SEQ : CTXL;
  const int s0 = lat ? (row0 & 4095) : ((row0 - TLAT) & 255);
  __syncthreads();
  {
    uint4 ca[8], cg[8];
#pragma unroll
    for (int q = 0; q < 8; q++) {
      const int id = tid + 256 * q, i = id >> 5, k = id & 31;
      const int s = s0 - 15 + i;
      ca[q] = make_uint4(0u, 0u, 0u, 0u); cg[q] = ca[q];
      if (i < 62 && s >= 0 && s < seqlen) {
        const u16* zr = p.zc + (long)(row0 - 15 + i) * 512 + k * 8;
        ca[q] = ldg16(zr); cg[q] = ldg16(zr + 256);
      }
    }
#pragma unroll
    for (int q = 0; q < 8; q++) {
      const int id = tid + 256 * q, i = id >> 5, k = id & 31;
      if (i < 62) {
        float4 u0, u1;
        u0.x = bf_lo(ca[q].x) * sigmoidf_(bf_lo(cg[q].x)); u0.y = bf_hi(ca[q].x) * sigmoidf_(bf_hi(cg[q].x));
        u0.z = bf_lo(ca[q].y) * sigmoidf_(bf_lo(cg[q].y)); u0.w = bf_hi(ca[q].y) * sigmoidf_(bf_hi(cg[q].y));
        u1.x = bf_lo(ca[q].z) * sigmoidf_(bf_lo(cg[q].z)); u1.y = bf_hi(ca[q].z) * sigmoidf_(bf_hi(cg[q].z));
        u1.z = bf_lo(ca[q].w) * sigmoidf_(bf_lo(cg[q].w)); u1.w = bf_hi(ca[q].w) * sigmoidf_(bf_hi(cg[q].w));
        *(float4*)(U + i * 256 + k * 8) = u0;
        *(float4*)(U + i * 256 + k * 8 + 4) = u1;
      }
    }
  }
  __syncthreads();
  float wv[31];
#pragma unroll
  for (int j = 0; j < 31; j++) wv[j] = p.w_dw[(long)L * 31 * 256 + j * 256 + tid];
  const float bias = p.b_dw[L * 256 + tid];
#pragma unroll 2
  for (int t = 0; t < 32; t++) {
    float acc = bias;
#pragma unroll
    for (int j = 0; j < 31; j++) acc += U[(t + j) * 256 + tid] * wv[j];
    U[t * 256 + tid] = acc;
  }
  __syncthreads();
  const float4 gg = *(const float4*)(p.g_cln + L * 256 + lane * 4);
  const float4 bb = *(const float4*)(p.b_cln + L * 256 + lane * 4);
#pragma unroll
  for (int q = 0; q < 8; q++) {
    const int t = w * 8 + q;
    const float4 v = *(const float4*)(U + t * 256 + lane * 4);
    const float mu = wave_sum(v.x + v.y + v.z + v.w) * (1.0f / 256.0f);
    const float d0 = v.x - mu, d1 = v.y - mu, d2 = v.z - mu, d3 = v.w - mu;
    const float var = wave_sum(d0 * d0 + d1 * d1 + d2 * d2 + d3 * d3) * (1.0f / 256.0f);
    const float rs = rsqrtf(var + EPSV);
    const float y0 = siluf_(d0 * rs * gg.x + bb.x), y1 = siluf_(d1 * rs * gg.y + bb.y);
    const float y2 = siluf_(d2 * rs * gg.z + bb.z), y3 = siluf_(d3 * rs * gg.w + bb.w);
    *(uint2*)(p.cv + (long)(row0 + t) * 256 + lane * 4) = make_uint2(pack2(y0, y1), pack2(y2, y3));
  }
}

#ifndef S3_REP_MASK
#define S3_REP_MASK 7
#endif
__device__ __forceinline__ void phase_s3(const Params& p, int L, char* smem, bool rep = false) {
  const int msk = rep ? S3_REP_MASK : 7;
  char* sm = smem + HALF_ * LDS_SMALL;
  const int nrt_all = (L == 0) ? 272 : 256;
  if (msk & 1) { FOR_PAIRED(272 * 8, u) unit_kv(p, L, u >> 3, u & 7, sm); } }
  if (msk & 2) { FOR_PAIRED(nrt_all * 4, v) const int ut = v >> 2; unit_chdft(p, ut < 256 ? ut : ut - 256, v & 3, ut < 256, sm); } }
  if (msk & 4) { FOR_PAIRED(nrt_all * 4, v) unit_conv(p, L, v, sm); } }
}

#define KLD 104
__device__ __forceinline__ void unit_attn(const Params& p, int L, int b, int h, int qt, bool isctx, char* smem) {
  const int tf = TIDX, NT = (int)blockDim.x, nh = NT >> 8, half = tf >> 8, wf = tf >> 6;
  const int tid = tf & 255, lane = tid & 63, w = tid >> 6, hh = lane >> 5, c = lane & 31;
  const int qtile = qt * nh + half;
  const int qrow0 = isctx ? (TLAT + b * CTXL + qtile * 128) : (b * SEQ + qtile * 128);
  const int nkt = isctx ? (CTXL / 64) : (SKEYS / 64);
  char* smh = smem + half * LDS_SMALL;
  u16* As = (u16*)smh;
  u16* Bs = (u16*)(smh + 128 * LDT * 2);
  u16* Qs = (u16*)(smh + (128 + 96) * LDT * 2);
  f32x16 aq[3];
#pragma unroll
  for (int r = 0; r < 16; r++) { aq[0][r] = 0.f; aq[1][r] = 0.f; aq[2][r] = 0.f; }
  float ssq = 0.f;
  const u16* cqp = p.cq + (long)qrow0 * 256;
  const u16* wqp = p.WuqT + (long)L * WUQ_SZ + (long)h * 96 * 256;
  for (int kc = 0; kc < 4; kc++) {
    __syncthreads();
#pragma unroll
    for (int i = 0; i < 4; i++) {
      const int idx = tid + 256 * i, rw = idx >> 3, ch = idx & 7;
      *(uint4*)(As + rw * LDT + ch * 8) = ldg16(cqp + rw * 256 + kc * 64 + ch * 8);
    }
#pragma unroll
    for (int i = 0; i < 3; i++) {
      const int idx = tid + 256 * i, rw = idx >> 3, ch = idx & 7;
      *(uint4*)(Bs + rw * LDT + ch * 8) = ldg16(wqp + rw * 256 + kc * 64 + ch * 8);
    }
    __syncthreads();
#pragma unroll
    for (int q = 0; q < 4; q++) {
      uint4 v = *(const uint4*)(As + (32 * w + c) * LDT + hh * 32 + q * 8);
      float a;
      a = bf_lo(v.x); ssq += a * a; a = bf_hi(v.x); ssq += a * a;
      a = bf_lo(v.y); ssq += a * a; a = bf_hi(v.y); ssq += a * a;
      a = bf_lo(v.z); ssq += a * a; a = bf_hi(v.z); ssq += a * a;
      a = bf_lo(v.w); ssq += a * a; a = bf_hi(v.w); ssq += a * a;
    }
#pragma unroll
    for (int kk = 0; kk < 4; kk++) {
      uint4 a = *(const uint4*)(As + (32 * w + c) * LDT + kk * 16 + hh * 8);
#pragma unroll
      for (int j = 0; j < 3; j++) {
        uint4 bq = *(const uint4*)(Bs + (32 * j + c) * LDT + kk * 16 + hh * 8);
        aq[j] = mfma32(a, bq, aq[j]);
      }
    }
  }
  ssq += __shfl_xor(ssq, 32);
  const float rr_lane = rsqrtf(ssq * (1.0f / 256.0f) + EPSV);
  {
    const float* gqn = p.g_qn + L * 96;
    const float g0 = gqn[c], g1 = gqn[32 + c], g2 = gqn[64 + c];
    const float qscale = 0.10206207261596577f * 1.4426950408889634f;
    u16* Qw = Qs + w * 32 * KLD;
#pragma unroll
    for (int r = 0; r < 16; r++) {
      const int rl = (r & 3) + 8 * (r >> 2) + 4 * hh;
      const float rc = __shfl(rr_lane, rl);
      const float q0 = aq[0][r] * rc, q1 = aq[1][r] * rc, q2 = aq[2][r] * rc;
      const float ss = half_sum(q0 * q0 + q1 * q1 + q2 * q2);
      const float rq = rsqrtf(ss * (1.0f / 96.0f) + EPSV);
      const float qn2 = q2 * rq * g2;
      const float partner = __shfl_xor(qn2, 8);
      float o2 = qn2;
      if (!isctx) {
        const int s = qtile * 128 + 32 * w + rl;
        const int pos = (c < 16) ? (s >> 6) : (s & 63);
        const float2 cs = *(const float2*)(p.ropetab + (pos * 8 + (c & 7)) * 2);
        const float rot = (c & 8) ? partner : -partner;
        o2 = qn2 * cs.x + rot * cs.y;
      }
      Qw[rl * KLD + c] = tobf(q0 * rq * g0 * qscale);
      Qw[rl * KLD + 32 + c] = tobf(q1 * rq * g1 * qscale);
      Qw[rl * KLD + 64 + c] = tobf(o2 * qscale);
    }
  }
  __syncthreads();
  uint4 qf[6];
#pragma unroll
  for (int s = 0; s < 6; s++) qf[s] = *(const uint4*)(Qs + (w * 32 + c) * KLD + s * 16 + hh * 8);
  __syncthreads();
  u16* Ks = (u16*)smem;
  u16* Vs = (u16*)(smem + 2 * 64 * KLD * 2);
  const u16* kg = p.Kb + (long)(b * 8 + h) * SKEYS * 96;
  const u16* vg = p.Vtb + (long)(b * 8 + h) * 64 * SKEYS;
  uint4 rk[3], rv[2];
  int krow[3], kch[3], vrw[2], vch[2];
#pragma unroll
  for (int i = 0; i < 3; i++) { const int idx = tf + NT * i; krow[i] = idx / 12; kch[i] = idx % 12; }
#pragma unroll
  for (int i = 0; i < 2; i++) { const int idx = tf + NT * i; vrw[i] = idx >> 3; vch[i] = idx & 7; }
#pragma unroll
  for (int i = 0; i < 3; i++) if (tf + NT * i < 768) rk[i] = ldg16(kg + (long)(tf + NT * i) * 8);
#pragma unroll
  for (int i = 0; i < 2; i++) if (tf + NT * i < 512) rv[i] = ldg16(vg + (long)vrw[i] * SKEYS + vch[i] * 8);
#pragma unroll
  for (int i = 0; i < 3; i++) if (tf + NT * i < 768) *(uint4*)(Ks + krow[i] * KLD + kch[i] * 8) = rk[i];
#pragma unroll
  for (int i = 0; i < 2; i++) if (tf + NT * i < 512) *(uint4*)(Vs + vrw[i] * LDT + vch[i] * 8) = rv[i];
  __syncthreads();
  f32x16 aO[2];
#pragma unroll
  for (int r = 0; r < 16; r++) { aO[0][r] = 0.f; aO[1][r] = 0.f; }
  float mref = 0.f;
  f32x2 lsum2 = {0.f, 0.f};
  const int kperm = (c & ~12) | ((c & 4) << 1) | ((c & 8) >> 1);
  for (int kt = 0; kt < nkt; kt++) {
    const int cur = kt & 1;
    if (kt + 1 < nkt) {
#pragma unroll
      for (int i = 0; i < 3; i++) if (tf + NT * i < 768) rk[i] = ldg16(kg + (long)(kt + 1) * 64 * 96 + (long)(tf + NT * i) * 8);
#pragma unroll
      for (int i = 0; i < 2; i++) if (tf + NT * i < 512) rv[i] = ldg16(vg + (long)vrw[i] * SKEYS + (kt + 1) * 64 + vch[i] * 8);
    }
    __builtin_amdgcn_sched_barrier(0);
    const u16* Kc = Ks + cur * 64 * KLD;
    const u16* Vc = Vs + cur * 64 * LDT;
    f32x16 aS[2];
    {
      const float nm = -mref;
#pragma unroll
      for (int r = 0; r < 16; r++) { aS[0][r] = nm; aS[1][r] = nm; }
    }
#pragma unroll
    for (int s = 0; s < 6; s++) {
      uint4 k0 = *(const uint4*)(Kc + (kperm) * KLD + s * 16 + hh * 8);
      uint4 k1 = *(const uint4*)(Kc + (32 + kperm) * KLD + s * 16 + hh * 8);
      aS[0] = mfma32(k0, qf[s], aS[0]);
      aS[1] = mfma32(k1, qf[s], aS[1]);
    }
    float mx = fmaxf(aS[0][0], aS[1][0]);
#pragma unroll
    for (int r = 1; r < 16; r++) mx = fmaxf(fmaxf(mx, aS[0][r]), aS[1][r]);
    if (__any(mx > 8.0f)) {
      const float mo = fmaxf(mx, __shfl_xor(mx, 32));
      const float delta = (mo > 8.0f) ? mo : 0.f;
      const float alpha = __builtin_amdgcn_exp2f(-delta);
      mref += delta;
      lsum2 *= alpha;
#pragma unroll
      for (int r = 0; r < 16; r++) {
        aO[0][r] *= alpha; aO[1][r] *= alpha;
        aS[0][r] -= delta; aS[1][r] -= delta;
      }
    }
#pragma unroll
    for (int r = 0; r < 16; r += 2) {
      aS[0][r] = __builtin_amdgcn_exp2f(aS[0][r]); aS[0][r + 1] = __builtin_amdgcn_exp2f(aS[0][r + 1]);
      aS[1][r] = __builtin_amdgcn_exp2f(aS[1][r]); aS[1][r + 1] = __builtin_amdgcn_exp2f(aS[1][r + 1]);
      const f32x2 p0 = {aS[0][r], aS[0][r + 1]}, p1 = {aS[1][r], aS[1][r + 1]};
      lsum2 += p0; lsum2 += p1;
    }
#pragma unroll
    for (int i = 0; i < 2; i++)
#pragma unroll
      for (int s2 = 0; s2 < 2; s2++) {
        uint4 pf = make_uint4(pack2(aS[i][8 * s2 + 0], aS[i][8 * s2 + 1]), pack2(aS[i][8 * s2 + 2], aS[i][8 * s2 + 3]),
                              pack2(aS[i][8 * s2 + 4], aS[i][8 * s2 + 5]), pack2(aS[i][8 * s2 + 6], aS[i][8 * s2 + 7]));
        uint4 v0 = *(const uint4*)(Vc + (c) * LDT + 32 * i + 16 * s2 + 8 * hh);
        uint4 v1 = *(const uint4*)(Vc + (32 + c) * LDT + 32 * i + 16 * s2 + 8 * hh);
        aO[0] = mfma32(v0, pf, aO[0]);
        aO[1] = mfma32(v1, pf, aO[1]);
      }
    if (kt + 1 < nkt) {
      const int nx = cur ^ 1;
#pragma unroll
      for (int i = 0; i < 3; i++) if (tf + NT * i < 768) *(uint4*)(Ks + nx * 64 * KLD + krow[i] * KLD + kch[i] * 8) = rk[i];
#pragma unroll
      for (int i = 0; i < 2; i++) if (tf + NT * i < 512) *(uint4*)(Vs + nx * 64 * LDT + vrw[i] * LDT + vch[i] * 8) = rv[i];
    }
    __syncthreads();
  }
  float lsum = lsum2.x + lsum2.y;
  lsum += __shfl_xor(lsum, 32);
  const float inv = 1.0f / lsum;
  u16* Os = (u16*)smem + wf * 32 * LDT;
#pragma unroll
  for (int i = 0; i < 2; i++)
#pragma unroll
    for (int r = 0; r < 16; r++) {
      const int d = 32 * i + (r & 3) + 8 * (r >> 2) + 4 * hh;
      Os[c * LDT + d] = tobf(aO[i][r] * inv);
    }
  __syncthreads();
#pragma unroll
  for (int i = 0; i < 4; i++) {
    const int idx = lane + 64 * i, q = idx >> 3, ch = idx & 7;
    *(uint4*)(p.Ob + (long)(qrow0 + 32 * w + q) * 512 + h * 64 + ch * 8) = *(const uint4*)(Os + q * LDT + ch * 8);
  }
}

__device__ __forceinline__ void unit_dftA(const Params& p, int b, int np, char* smem) {
  const int lane = TIDS & 63, w = TIDS >> 6, wr = w >> 1, wc = w & 1, hh = lane >> 5, c = lane & 31;
  f32x16 acc[2][2];
  ZERO_ACC(acc);
  gemm128(p.WA, 128, p.Ytl + (long)(b * 256 + 2 * np) * 64 * 128, 128, 128, acc, smem);
  const int n = 2 * np + wc;
#pragma unroll
  for (int jj = 0; jj < 2; jj++) {
    const int t2 = jj * 32 + c;
#pragma unroll
    for (int r = 0; r < 16; r++) {
      const int k1 = wr * 32 + (r & 3) + 8 * (r >> 2) + 4 * hh;
      const float2 t = *(const float2*)(p.tw + 2 * ((k1 * t2) & 4095));
      const float gr = acc[0][jj][r], gi = acc[1][jj][r];
      u16* dst = p.GB + ((long)((b * 64 + k1) * 256 + n)) * 128 + t2;
      dst[0] = tobf(gr * t.x + gi * t.y);
      dst[64] = tobf(gi * t.x - gr * t.y);
    }
  }
}
__device__ __forceinline__ void unit_dftC(const Params& p, int b, int k1, int nt, char* smem) {
  const int lane = TIDS & 63, w = TIDS >> 6, wr = w >> 1, wc = w & 1, hh = lane >> 5, c = lane & 31;
  f32x16 acc[2][2];
  ZERO_ACC(acc);
  gemm128(p.WC, 128, p.GB + ((long)((b * 64 + k1) * 256 + nt * 128)) * 128, 128, 128, acc, smem);
  if (wr == 0) {
#pragma unroll
    for (int i = 0; i < 2; i++)
#pragma unroll
      for (int jj = 0; jj < 2; jj++)
#pragma unroll
        for (int r = 0; r < 16; r++) {
          const int k2 = i * 32 + (r & 3) + 8 * (r >> 2) + 4 * hh;
          p.Fb[((long)b * SEQ + k1 + 64 * k2) * 256 + nt * 128 + wc * 64 + jj * 32 + c] = tobf(acc[i][jj][r]);
        }
  }
}
__device__ __forceinline__ void unit_seqdft_ctx(const Params& p, int b, int mt, int nt, char* smem) {
  const int lane = TIDS & 63, w = TIDS >> 6, wr = w >> 1, wc = w & 1;
  f32x16 acc[2][2];
  ZERO_ACC(acc);
  gemm128(p.Dctx + (long)mt * 128 * 512, 512, p.Ytc + (long)(b * 256 + nt * 128) * 512, 512, 512, acc, smem);
  const long orow0 = (long)TLAT + b * CTXL + mt * 128;
#pragma unroll
  for (int i = 0; i < 2; i++)
#pragma unroll
    for (int j = 0; j < 2; j++)
#pragma unroll
      for (int r = 0; r < 16; r++)
        p.Fb[(orow0 + ACC_ROW(wr, i, r, lane)) * 256 + nt * 128 + ACC_COL(wc, j, lane)] = tobf(acc[i][j][r]);
}
__device__ __forceinline__ void phase_dftC(const Params& p, char* smem) {
  char* sm = smem + HALF_ * LDS_SMALL;
  FOR_PAIRED(8 * 64 * 2, u) unit_dftC(p, u >> 7, (u >> 1) & 63, u & 1, sm); }
}

__device__ __forceinline__ void phase_s4(const Params& p, int L, char* smem) {
  char* sm = smem + HALF_ * LDS_SMALL;
  const int nh = (int)(blockDim.x >> 8), tpp = 32 / nh;
  {
    const int x = blockIdx.x & 7, l = blockIdx.x >> 3, nl = gridDim.x >> 3;
    for (int s = l; s < 8 * tpp; s += nl) {
      const int bh = x * 8 + s / tpp;
      unit_attn(p, L, bh >> 3, bh & 7, s % tpp, false, smem);
    }
  }
  FOR_PAIRED(8 * 128, v) unit_dftA(p, v >> 7, v & 127, sm); }
  if (L == 0) {
    FOR_PAIRED(8 * 2 * 2, v) unit_seqdft_ctx(p, v >> 2, (v >> 1) & 1, v & 1, sm); }
    const int tpc = 2 / nh;
    for (int v = blockIdx.x; v < 64 * tpc; v += gridDim.x) unit_attn(p, L, (v / tpc) >> 3, (v / tpc) & 7, v % tpc, true, smem);
  }
}

template <bool BIG>
__device__ __forceinline__ void phase_s7(const Params& p, int L, char* smem) {
  constexpr int TM = BIG ? 256 : 128;
  const int nrt = ((L == 0) ? RTOT : TLAT) / TM;
  FOR_UNITS_XCD(nrt, 8, rt, ct)
    const int row0 = rt * TM;
    f32x16 macc[2][2];
    ZERO_ACC(macc);
#pragma unroll 1
    for (int br = 0; br < 3; br++) {
      unsigned gp[2][2][8];
      {
      f32x16 acc[2][2];
      ZERO_ACC(acc);
      if constexpr (BIG) gemm256(p.hx + (long)row0 * 1024, 1024, p.WgT + (long)L * WGT_SZ + (long)(br * 1024 + ct * 128) * 1024, 1024, 1024, acc, smem);
      else gemm128(p.hx + (long)row0 * 1024, 1024, p.WgT + (long)L * WGT_SZ + (long)(br * 1024 + ct * 128) * 1024, 1024, 1024, acc, smem);
#pragma unroll
      for (int i = 0; i < 2; i++)
#pragma unroll
        for (int j = 0; j < 2; j++)
#pragma unroll
          for (int r = 0; r < 8; r++) gp[i][j][r] = pack2(sigmoidf_(acc[i][j][2 * r]), sigmoidf_(acc[i][j][2 * r + 1]));
      }
      const u16* A2; const u16* B2; int K2;
      if (br == 0) { A2 = p.Ob + (long)row0 * 512; B2 = p.WbaT + (long)L * WBA_SZ + (long)ct * 128 * 512; K2 = 512; }
      else if (br == 1) { A2 = p.Fb + (long)row0 * 256; B2 = p.WbfT + (long)L * WBF_SZ + (long)ct * 128 * 256; K2 = 256; }
      else { A2 = p.cv + (long)row0 * 256; B2 = p.WbcT + (long)L * WBC_SZ + (long)ct * 128 * 256; K2 = 256; }
      {
        f32x16 ab[2][2];
        ZERO_ACC(ab);
        if constexpr (BIG) gemm256(A2, K2, B2, K2, K2, ab, smem); else gemm128(A2, K2, B2, K2, K2, ab, smem);
#pragma unroll
        for (int i = 0; i < 2; i++)
#pragma unroll
          for (int j = 0; j < 2; j++)
#pragma unroll
            for (int r = 0; r < 8; r++) {
              if ((ABL_BR >> br) & 1) {
              macc[i][j][2 * r] += bf_lo(gp[i][j][r]) * ab[i][j][2 * r];
              macc[i][j][2 * r + 1] += bf_hi(gp[i][j][r]) * ab[i][j][2 * r + 1];
              }
            }
      }
    }
    u16* mp = p.m + (long)row0 * 1024 + ct * 128;
    const int tid = TIDX, lane = tid & 63, w = tid >> 6, wr = w >> 1, wc = w & 1;
    const int tb = (wr * 64 + 4 * (lane >> 5)) * 1024 + wc * 64 + (lane & 31);
#pragma unroll
    for (int i = 0; i < 2; i++)
#pragma unroll
      for (int j = 0; j < 2; j++)
#pragma unroll
        for (int r = 0; r < 16; r++)
          mp[tb + (i * 32 + (r & 3) + 8 * (r >> 2)) * 1024 + j * 32] = tobf(macc[i][j][r]);
  }
}

template <bool BIG>
__device__ __forceinline__ void phase_s8(const Params& p, int L, char* smem, bool dry = false) {
  constexpr int TM = BIG ? 256 : 128;
  const int lane = TIDX & 63, w = TIDX >> 6, wr = w >> 1, wc = w & 1;
  const int nrt = ((L == 0) ? RTOT : TLAT) / TM;
  FOR_UNITS_XCD(nrt, 8, rt, ct)
    const long row0 = (long)rt * TM;
    f32x16 acc[2][2];
    ZERO_ACC(acc);
    if constexpr (BIG) gemm256(p.m + row0 * 1024, 1024, p.WoutT + (long)L * WOUT_SZ + (long)ct * 128 * 1024, 1024, 1024, acc, smem);
    else gemm128(p.m + row0 * 1024, 1024, p.WoutT + (long)L * WOUT_SZ + (long)ct * 128 * 1024, 1024, 1024, acc, smem);
    const int mr = row_mod((int)row0);
    const float* gt = p.mods + (long)(L * 9 + mr) * 6144 + 2048 + ct * 128;
    const float* src; float* dst;
    if (row0 < TLAT) { src = (L == 0 ? p.x : p.out) + row0 * 1024; dst = p.out + row0 * 1024; }
    else { src = (L == 0 ? p.ctx : p.ctx1) + (row0 - TLAT) * 1024; dst = p.ctx1 + (row0 - TLAT) * 1024; }
    src += ct * 128; dst += ct * 128;
    const int tb = opaque((wr * 64 + 4 * (lane >> 5)) * 1024 + wc * 64 + (lane & 31));
#pragma unroll
    for (int j = 0; j < 2; j++) {
      const float gv = gt[ACC_COL(wc, j, lane)];
#pragma unroll
      for (int i = 0; i < 2; i++)
#pragma unroll
        for (int r = 0; r < 16; r++) {
          const int o = tb + (i * 32 + (r & 3) + 8 * (r >> 2)) * 1024 + j * 32;
          const float nv = src[o] + gv * acc[i][j][r];
          if (!dry) dst[o] = nv;
        }
    }
  }
}

#define CE_DESC(a, b) { const float _x = fmaxf(a, b); const float _y = fminf(a, b); a = _x; b = _y; }
template <int N>
__device__ __forceinline__ void bitonic_sort_desc(float (&v)[N]) {
#pragma unroll
  for (int k = 2; k <= N; k <<= 1)
#pragma unroll
    for (int j = k >> 1; j > 0; j >>= 1)
#pragma unroll
      for (int i = 0; i < N; i++) {
        const int l = i ^ j;
        if (l > i) {
          if ((i & k) == 0) { CE_DESC(v[i], v[l]); } else { CE_DESC(v[l], v[i]); }
        }
      }
}
template <int N>
__device__ __forceinline__ void bitonic_merge_desc(float (&v)[N]) {
#pragma unroll
  for (int j = N >> 1; j > 0; j >>= 1)
#pragma unroll
    for (int i = 0; i < N; i++) {
      const int l = i ^ j;
      if (l > i) { CE_DESC(v[i], v[l]); }
    }
}
__device__ __forceinline__ void merge_top16(float (&a)[16], const float (&b)[16]) {
#pragma unroll
  for (int i = 0; i < 16; i++) a[i] = fmaxf(a[i], b[15 - i]);
  bitonic_merge_desc<16>(a);
}
__device__ __forceinline__ void top16_of_tiles(const f32x16 (&s)[4], int hh, float (&res)[16]) {
  float g[4][16];
#pragma unroll
  for (int t = 0; t < 4; t++) {
#pragma unroll
    for (int r = 0; r < 16; r++) {
      const unsigned key = (unsigned)(32 * t + (r & 3) + 8 * (r >> 2)) + (unsigned)(4 * hh);
      g[t][r] = __uint_as_float((__float_as_uint(s[t][r]) & 0xffffff80u) | key);
    }
    bitonic_sort_desc<16>(g[t]);
  }
  merge_top16(g[0], g[1]);
  merge_top16(g[2], g[3]);
  merge_top16(g[0], g[2]);
  float o[16];
#pragma unroll
  for (int i = 0; i < 16; i++) o[i] = __shfl_xor(g[0][i], 32);
  merge_top16(g[0], o);
#pragma unroll
  for (int i = 0; i < 16; i++) res[i] = g[0][i];
}

template <bool BIG>
__device__ __forceinline__ void unit_peer_query(const Params& p, int L, int rt, int h, char* smem) {
  constexpr int TM = BIG ? 256 : 128, NT = BIG ? 512 : 256;
  const int tid = TIDX, lane = tid & 63, w = tid >> 6, wr = w >> 1, wc = w & 1, hh = lane >> 5, c = lane & 31;
  const long row0 = (long)rt * TM;
  u16* Qs = (u16*)smem;
  u16* Ss = (u16*)(smem + TM * 136 * 2);
  {
    f32x16 acc[2][2];
    ZERO_ACC(acc);
    if constexpr (BIG) gemm256(p.hx + row0 * 1024, 1024, p.WqT + (long)L * WQ_SZ + (long)h * 128 * 1024, 1024, 1024, acc, smem);
    else gemm128(p.hx + row0 * 1024, 1024, p.WqT + (long)L * WQ_SZ + (long)h * 128 * 1024, 1024, 1024, acc, smem);
#pragma unroll
    for (int i = 0; i < 2; i++)
#pragma unroll
      for (int j = 0; j < 2; j++)
#pragma unroll
        for (int r = 0; r < 16; r++) Qs[ACC_ROW(wr, i, r, lane) * 136 + ACC_COL(wc, j, lane)] = tobf(acc[i][j][r]);
    const u16* sk = p.SubK + (long)L * SUBK_SZ + (long)h * 2 * 128 * 64;
#pragma unroll
    for (int i = 0; i < 2048 / NT; i++) {
      const int idx = tid + NT * i, rw = idx >> 3, ch = idx & 7;
      *(uint4*)(Ss + rw * LDT + ch * 8) = ldg16(sk + rw * 64 + ch * 8);
    }
  }
  __syncthreads();
  float top[2][16];
#pragma unroll
  for (int pp = 0; pp < 2; pp++) {
    f32x16 s[4];
#pragma unroll
    for (int t = 0; t < 4; t++)
#pragma unroll
      for (int r = 0; r < 16; r++) s[t][r] = 0.f;
#pragma unroll
    for (int kk = 0; kk < 4; kk++) {
      uint4 bq = *(const uint4*)(Qs + (32 * w + c) * 136 + pp * 64 + kk * 16 + hh * 8);
#pragma unroll
      for (int t = 0; t < 4; t++) {
        uint4 ak = *(const uint4*)(Ss + (pp * 128 + 32 * t + c) * LDT + kk * 16 + hh * 8);
        s[t] = mfma32(ak, bq, s[t]);
      }
    }
    top16_of_tiles(s, hh, top[pp]);
  }
  float cand[64];
#define CAND(q, a, b) cand[q] = __uint_as_float((__float_as_uint(top[0][a] + top[1][b]) & 0xffffff00u) | (unsigned)((a) * 16 + (b)));
  CAND(0, 0, 0)
  CAND(1, 0, 1)
  CAND(2, 0, 2)
  CAND(3, 0, 3)
  CAND(4, 0, 4)
  CAND(5, 0, 5)
  CAND(6, 0, 6)
  CAND(7, 0, 7)
  CAND(8, 0, 8)
  CAND(9, 0, 9)
  CAND(10, 0, 10)
  CAND(11, 0, 11)
  CAND(12, 0, 12)
  CAND(13, 0, 13)
  CAND(14, 0, 14)
  CAND(15, 0, 15)
  CAND(16, 1, 0)
  CAND(17, 1, 1)
  CAND(18, 1, 2)
  CAND(19, 1, 3)
  CAND(20, 1, 4)
  CAND(21, 1, 5)
  CAND(22, 1, 6)
  CAND(23, 1, 7)
  CAND(24, 2, 0)
  CAND(25, 2, 1)
  CAND(26, 2, 2)
  CAND(27, 2, 3)
  CAND(28, 2, 4)
  CAND(29, 3, 0)
  CAND(30, 3, 1)
  CAND(31, 3, 2)
  CAND(32, 3, 3)
  CAND(33, 4, 0)
  CAND(34, 4, 1)
  CAND(35, 4, 2)
  CAND(36, 5, 0)
  CAND(37, 5, 1)
  CAND(38, 6, 0)
  CAND(39, 6, 1)
  CAND(40, 7, 0)
  CAND(41, 7, 1)
  CAND(42, 8, 0)
  CAND(43, 9, 0)
  CAND(44, 10, 0)
  CAND(45, 11, 0)
  CAND(46, 12, 0)
  CAND(47, 13, 0)
  CAND(48, 14, 0)
  CAND(49, 15, 0)
#undef CAND
#pragma unroll
  for (int q = 50; q < 64; q++) cand[q] = -3.0e38f;
  float best[16];
  {
    float g[4][16];
#pragma unroll
    for (int t = 0; t < 4; t++) {
#pragma unroll
      for (int r = 0; r < 16; r++) g[t][r] = cand[t * 16 + r];
      bitonic_sort_desc<16>(g[t]);
    }
    merge_top16(g[0], g[1]);
    merge_top16(g[2], g[3]);
    merge_top16(g[0], g[2]);
#pragma unroll
    for (int i = 0; i < 16; i++) best[i] = g[0][i];
  }
  float e[16], es = 0.f;
#pragma unroll
  for (int i = 0; i < 16; i++) { e[i] = __expf(best[i] - best[0]); es += e[i]; }
  const float einv = 1.0f / es;
  __syncthreads();
  int* Ix = (int*)smem + w * 32 * 33;
  if (hh == 0) {
#pragma unroll
    for (int i = 0; i < 16; i++) {
      Ix[c * 33 + i] = (int)(__float_as_uint(top[0][i]) & 127u);
      Ix[c * 33 + 16 + i] = (int)(__float_as_uint(top[1][i]) & 127u);
    }
  }
  __syncthreads();
  const long orow = row0 + 32 * w + c;
  int* ed = p.eid + orow * 128 + h * 16 + hh * 8;
  float* gd = p.gate + orow * 128 + h * 16 + hh * 8;
  int ev[8]; float gv[8];
#pragma unroll
  for (int i = 0; i < 8; i++) {
    const unsigned hm = 0u - (unsigned)hh;
    const unsigned bselu = (__float_as_uint(best[8 + i]) & hm) | (__float_as_uint(best[i]) & ~hm);
    const float esel = __uint_as_float((__float_as_uint(e[8 + i]) & hm) | (__float_as_uint(e[i]) & ~hm));
    const unsigned id = bselu & 255u;
    const int ia = Ix[c * 33 + (id >> 4)], ib = Ix[c * 33 + 16 + (id & 15)];
    ev[i] = ia * 128 + ib;
    gv[i] = esel * einv;
  }
  *(int4*)(ed) = make_int4(ev[0], ev[1], ev[2], ev[3]);
  *(int4*)(ed + 4) = make_int4(ev[4], ev[5], ev[6], ev[7]);
  *(float4*)(gd) = make_float4(gv[0], gv[1], gv[2], gv[3]);
  *(float4*)(gd + 4) = make_float4(gv[4], gv[5], gv[6], gv[7]);
}

template <bool BIG>
__device__ __forceinline__ void phase_s10(const Params& p, int L, char* smem) {
  const int nrt = ((L == 0) ? RTOT : TLAT) / (BIG ? 256 : 128);
  FOR_UNITS_XCD(nrt, 8, rt, hd) unit_peer_query<BIG>(p, L, rt, hd, smem); }
}

#define CVT8(w, lo2, hi2) { lo2 = __builtin_amdgcn_cvt_pk_f32_fp8((int)(w), false); hi2 = __builtin_amdgcn_cvt_pk_f32_fp8((int)(w), true); }
#if CHECK_ATTN
#define NB11 1
#else
#define NB11 2
#endif
__device__ __forceinline__ void phase_s11a(const Params& p, int L) {
  const int lane = TIDS & 63, j = lane >> 3, cch = lane & 7;
  const int sl = VBID & 7;
  const int lw = (VBID >> 3) * 4 + (TIDS >> 6), nlw = (NVB >> 3) * 4;
  const int nrows = (L == 0) ? RTOT : TLAT;
  const unsigned char* Us = p.UT8 + (long)sl * NEXP * 128 + cch * 16;
  for (int r0 = lw; r0 < nrows; r0 += NB11 * nlw) {
    int rr[NB11]; bool ok[NB11];
    uint4 ha[NB11], hb[NB11]; int e_lo[NB11], e_hi[NB11];
#pragma unroll
    for (int u = 0; u < NB11; u++) {
      const int r = r0 + u * nlw;
      ok[u] = r < nrows; rr[u] = ok[u] ? r : r0;
      ha[u] = ldg16(p.hx + (long)rr[u] * 1024 + sl * 128 + cch * 16);
      hb[u] = ldg16(p.hx + (long)rr[u] * 1024 + sl * 128 + cch * 16 + 8);
      e_lo[u] = p.eid[(long)rr[u] * 128 + lane]; e_hi[u] = p.eid[(long)rr[u] * 128 + 64 + lane];
    }
    uint4 uu[NB11][16];
#pragma unroll
    for (int u = 0; u < NB11; u++)
#pragma unroll
      for (int i = 0; i < 16; i++) {
        const int e = __shfl(i < 8 ? e_lo[u] : e_hi[u], 8 * (i & 7) + j);
        uu[u][i] = ldg16(Us + (long)e * 128);
      }
    __builtin_amdgcn_sched_barrier(0);
#pragma unroll
    for (int u = 0; u < NB11; u++) {
      f32x2 h2[8];
      h2[0] = f32x2{bf_lo(ha[u].x), bf_hi(ha[u].x)}; h2[1] = f32x2{bf_lo(ha[u].y), bf_hi(ha[u].y)};
      h2[2] = f32x2{bf_lo(ha[u].z), bf_hi(ha[u].z)}; h2[3] = f32x2{bf_lo(ha[u].w), bf_hi(ha[u].w)};
      h2[4] = f32x2{bf_lo(hb[u].x), bf_hi(hb[u].x)}; h2[5] = f32x2{bf_lo(hb[u].y), bf_hi(hb[u].y)};
      h2[6] = f32x2{bf_lo(hb[u].z), bf_hi(hb[u].z)}; h2[7] = f32x2{bf_lo(hb[u].w), bf_hi(hb[u].w)};
      float d[16];
#pragma unroll
      for (int i = 0; i < 16; i++) {
        f32x2 a0, a1, acc = {0.f, 0.f};
        CVT8(uu[u][i].x, a0, a1); acc += a0 * h2[0]; acc += a1 * h2[1];
        CVT8(uu[u][i].y, a0, a1); acc += a0 * h2[2]; acc += a1 * h2[3];
        CVT8(uu[u][i].z, a0, a1); acc += a0 * h2[4]; acc += a1 * h2[5];
        CVT8(uu[u][i].w, a0, a1); acc += a0 * h2[6]; acc += a1 * h2[7];
        d[i] = acc.x + acc.y;
      }
      float t8[8], t4[4], t2[2];
      { const bool up = (lane & 4) != 0;
#pragma unroll
        for (int k = 0; k < 8; k++) { const float send = up ? d[k] : d[k + 8], keep = up ? d[k + 8] : d[k]; t8[k] = keep + __shfl_xor(send, 4); } }
      { const bool up = (lane & 2) != 0;
#pragma unroll
        for (int k = 0; k < 4; k++) { const float send = up ? t8[k] : t8[k + 4], keep = up ? t8[k + 4] : t8[k]; t4[k] = keep + __shfl_xor(send, 2); } }
      { const bool up = (lane & 1) != 0;
#pragma unroll
        for (int k = 0; k < 2; k++) { const float send = up ? t4[k] : t4[k + 2], keep = up ? t4[k + 2] : t4[k]; t2[k] = keep + __shfl_xor(send, 1); } }
      if (ok[u]) p.PD[((long)sl * RTOT + rr[u]) * 64 + cch * 8 + j] = pack2(t2[0], t2[1]);
    }
  }
}
__device__ __forceinline__ void phase_s11b(const Params& p, int L, bool dry = false) {
  const int lane = TIDS & 63, j = lane >> 3, cch = lane & 7;
  const int sl = VBID & 7;
  const int lw = (VBID >> 3) * 4 + (TIDS >> 6), nlw = (NVB >> 3) * 4;
  const int nrows = (L == 0) ? RTOT : TLAT;
  const unsigned char* Vs = p.VT8 + (long)sl * NEXP * 128 + cch * 16;
  const int P0 = 16 * (lane >> 3) + (lane & 7);
  const int col = sl * 128 + cch * 16 + 2 * j;
  for (int r0 = lw; r0 < nrows; r0 += NB11 * nlw) {
    int rr[NB11]; bool ok[NB11];
    unsigned pw[NB11][8]; float g0[NB11], g1[NB11]; int e_lo[NB11], e_hi[NB11];
#pragma unroll
    for (int u = 0; u < NB11; u++) {
      const int r = r0 + u * nlw;
      ok[u] = r < nrows; rr[u] = ok[u] ? r : r0;
#pragma unroll
      for (int s2 = 0; s2 < 8; s2++) pw[u][s2] = p.PD[((long)s2 * RTOT + rr[u]) * 64 + lane];
      g0[u] = p.gate[(long)rr[u] * 128 + P0]; g1[u] = p.gate[(long)rr[u] * 128 + P0 + 8];
      e_lo[u] = p.eid[(long)rr[u] * 128 + lane]; e_hi[u] = p.eid[(long)rr[u] * 128 + 64 + lane];
    }
    uint4 vv[NB11][16];
#pragma unroll
    for (int u = 0; u < NB11; u++)
#pragma unroll
      for (int i = 0; i < 16; i++) {
        const int e = __shfl(i < 8 ? e_lo[u] : e_hi[u], 8 * (i & 7) + j);
        vv[u][i] = ldg16(Vs + (long)e * 128);
      }
    __builtin_amdgcn_sched_barrier(0);
#pragma unroll
    for (int u = 0; u < NB11; u++) {
      float d0 = 0.f, d1 = 0.f;
#pragma unroll
      for (int s2 = 0; s2 < 8; s2++) { d0 += bf_lo(pw[u][s2]); d1 += bf_hi(pw[u][s2]); }
      const float act0 = gelu_tanh(d0 * (1.0f / U8_SCALE)) * g0[u] * (1.0f / V8_SCALE);
      const float act1 = gelu_tanh(d1 * (1.0f / U8_SCALE)) * g1[u] * (1.0f / V8_SCALE);
      f32x2 o2[8];
#pragma unroll
      for (int q = 0; q < 8; q++) o2[q] = f32x2{0.f, 0.f};
#pragma unroll
      for (int i = 0; i < 16; i++) {
        const float a = __shfl((i & 1) ? act1 : act0, (i >> 1) * 8 + j);
        const f32x2 aa = {a, a};
        f32x2 a0, a1;
        CVT8(vv[u][i].x, a0, a1); o2[0] += aa * a0; o2[1] += aa * a1;
        CVT8(vv[u][i].y, a0, a1); o2[2] += aa * a0; o2[3] += aa * a1;
        CVT8(vv[u][i].z, a0, a1); o2[4] += aa * a0; o2[5] += aa * a1;
        CVT8(vv[u][i].w, a0, a1); o2[6] += aa * a0; o2[7] += aa * a1;
      }
      float o[16];
#pragma unroll
      for (int q = 0; q < 8; q++) { o[2 * q] = o2[q].x; o[2 * q + 1] = o2[q].y; }
      float t8[8], t4[4], t2[2];
      { const bool up = (lane & 32) != 0;
#pragma unroll
        for (int k = 0; k < 8; k++) { const float send = up ? o[k] : o[k + 8], keep = up ? o[k + 8] : o[k]; t8[k] = keep + __shfl_xor(send, 32); } }
      { const bool up = (lane & 16) != 0;
#pragma unroll
        for (int k = 0; k < 4; k++) { const float send = up ? t8[k] : t8[k + 4], keep = up ? t8[k + 4] : t8[k]; t4[k] = keep + __shfl_xor(send, 16); } }
      { const bool up = (lane & 8) != 0;
#pragma unroll
        for (int k = 0; k < 2; k++) { const float send = up ? t4[k] : t4[k + 2], keep = up ? t4[k + 2] : t4[k]; t2[k] = keep + __shfl_xor(send, 8); } }
      if (!ABL_PEER || !ok[u]) continue;
      const int r = rr[u];
      float* xr = ((r < TLAT) ? p.out + (long)r * 1024 : p.ctx1 + (long)(r - TLAT) * 1024) + col;
      const float2 gt = *(const float2*)(p.mods + (long)(L * 9 + row_mod(r)) * 6144 + 5120 + col);
      float2 xv = *(const float2*)xr;
      xv.x += gt.x * t2[0]; xv.y += gt.y * t2[1];
      if (!dry) *(float2*)xr = xv;
    }
  }
}


#if CHECK_ATTN
__device__ __forceinline__ float blk_sum(float v, float* red) {
  v = wave_sum(v);
  __syncthreads();
  if ((TIDS & 63) == 0) red[TIDS >> 6] = v;
  __syncthreads();
  return red[0] + red[1] + red[2] + red[3];
}
__device__ __forceinline__ float blk_max(float v, float* red) {
#pragma unroll
  for (int o = 32; o > 0; o >>= 1) v = fmaxf(v, __shfl_xor(v, o));
  __syncthreads();
  if ((TIDS & 63) == 0) red[TIDS >> 6] = v;
  __syncthreads();
  return fmaxf(fmaxf(red[0], red[1]), fmaxf(red[2], red[3]));
}
__device__ __forceinline__ bool far(float got, float ref, float rel, float ab) { return !(fabsf(got - ref) <= rel * fabsf(ref) + ab); }
__device__ __forceinline__ void rope_ref(const float* z, float* o, int s) {
  for (int c = 0; c < 32; c++) {
    const int pos = (c < 16) ? (s / 64) : (s % 64);
    const float inv = powf(10000.0f, -(float)(2 * (c % 8)) / 16.0f);
    const float ang = (float)pos * inv;
    const int cb = c & 16, cc = c & 15;
    const float rot = (cc < 8) ? -z[cb + cc + 8] : z[cb + cc - 8];
    o[c] = z[c] * cosf(ang) + rot * sinf(ang);
  }
}
__device__ __forceinline__ void check_proj(const Params& p, int L, int r, char* smem) {
  float* hrow = (float*)smem;
  float* z = hrow + 1024;
  float* kvr = z + 416;
  float* red = kvr + 1024;
  float* kk = red + 8;
  const int tid = TIDS;
  __syncthreads();
  for (int k = tid; k < 1024; k += 256) hrow[k] = bf1(p.hx[(long)r * 1024 + k]);
  __syncthreads();
  for (int n = tid; n < 416; n += 256) {
    float a = 0.f;
    for (int k = 0; k < 1024; k++) a += hrow[k] * p.w_in[((long)L * 1024 + k) * 4256 + n];
    z[n] = a;
  }
  __syncthreads();
  unsigned bad = 0;
  if (L == 0 || r < TLAT)
  for (int n = tid; n < 256; n += 256) if (far(bf1(p.cq[(long)r * 256 + n]), z[160 + n], 0.02f, 0.03f)) bad |= 1u;
  for (int n = tid; n < 32; n += 256) if (far(p.kr[(long)r * 32 + n], z[128 + n], 0.02f, 0.03f)) bad |= 1u;
  const float ssc = blk_sum(tid < 128 ? z[tid] * z[tid] : 0.f, red);
  const float rc = rsqrtf(ssc / 128.0f + EPSV);
  for (int n = tid; n < 1024; n += 256) {
    float a = 0.f;
    for (int k = 0; k < 128; k++) a += z[k] * rc * p.g_ckv[L * 128 + k] * p.w_ukv[((long)L * 128 + k) * 1024 + n];
    kvr[n] = a;
  }
  __syncthreads();
  const bool lat = r < TLAT;
  const int b = lat ? (r >> 12) : ((r - TLAT) >> 8), s = lat ? (r & 4095) : ((r - TLAT) & 255), kpos = lat ? CTXL + s : s;
  for (int h = 0; h < 8; h++) {
    float sq = 0.f;
    if (tid < 64) sq = kvr[h * 128 + tid] * kvr[h * 128 + tid]; else if (tid < 96) sq = z[128 + tid - 64] * z[128 + tid - 64];
    const float ssk = blk_sum(sq, red);
    const float rk = rsqrtf(ssk / 96.0f + EPSV);
    if (tid == 0) {
      float* zr = kk + 96; float* zo = zr + 32;
      for (int c = 0; c < 32; c++) zr[c] = z[128 + c] * rk * p.g_kn[L * 96 + 64 + c];
      if (lat) rope_ref(zr, zo, s); else for (int c = 0; c < 32; c++) zo[c] = zr[c];
      for (int c = 0; c < 32; c++) kk[64 + c] = zo[c];
    }
    if (tid < 64) kk[tid] = kvr[h * 128 + tid] * rk * p.g_kn[L * 96 + tid];
    __syncthreads();
    if (tid < 96 && far(bf1(p.Kb[((long)(b * 8 + h) * SKEYS + kpos) * 96 + tid]), kk[tid], 0.03f, 0.03f)) bad |= 2u;
    if (tid < 64 && far(bf1(p.Vtb[((long)(b * 8 + h) * 64 + tid) * SKEYS + kpos]), kvr[h * 128 + 64 + tid], 0.03f, 0.03f)) bad |= 4u;
    __syncthreads();
  }
  if (bad & CHECK_MASK) atomicOr(&p.bar[0], bad & CHECK_MASK);
}
__device__ __forceinline__ void check_attn(const Params& p, int L, int r, int h, char* smem) {
  float* cqr = (float*)smem;
  float* q = cqr + 256;
  float* sc = q + 96;
  float* red = sc + 4352;
  const int tid = TIDS;
  const bool lat = r < TLAT;
  const int b = lat ? (r >> 12) : ((r - TLAT) >> 8), s = lat ? (r & 4095) : ((r - TLAT) & 255);
  const int nkeys = lat ? SKEYS : CTXL;
  __syncthreads();
  cqr[tid] = bf1(p.cq[(long)r * 256 + tid]);
  __syncthreads();
  const float rc = rsqrtf(blk_sum(cqr[tid] * cqr[tid], red) / 256.0f + EPSV);
  float qr = 0.f;
  if (tid < 96) for (int k = 0; k < 256; k++) qr += cqr[k] * rc * p.g_cq[L * 256 + k] * p.w_uq[((long)L * 256 + k) * 768 + h * 96 + tid];
  const float rq = rsqrtf(blk_sum(tid < 96 ? qr * qr : 0.f, red) / 96.0f + EPSV);
  if (tid < 96) q[tid] = qr * rq * p.g_qn[L * 96 + tid];
  __syncthreads();
  if (tid == 0 && lat) {
    float* zr = red + 8; float* zo = zr + 32;
    for (int c = 0; c < 32; c++) zr[c] = q[64 + c];
    rope_ref(zr, zo, s);
    for (int c = 0; c < 32; c++) q[64 + c] = zo[c];
  }
  __syncthreads();
  float mx = -1e30f;
  for (int key = tid; key < nkeys; key += 256) {
    float a = 0.f;
    for (int d = 0; d < 96; d++) a += q[d] * bf1(p.Kb[((long)(b * 8 + h) * SKEYS + key) * 96 + d]);
    a *= 0.10206207261596577f;
    sc[key] = a; mx = fmaxf(mx, a);
  }
  mx = blk_max(mx, red);
  float ps = 0.f;
  for (int key = tid; key < nkeys; key += 256) { const float e = expf(sc[key] - mx); sc[key] = e; ps += e; }
  const float tot = blk_sum(ps, red);
  unsigned bad = 0;
  if (tid < 64) {
    float a = 0.f;
    for (int key = 0; key < nkeys; key++) a += sc[key] * bf1(p.Vtb[((long)(b * 8 + h) * 64 + tid) * SKEYS + key]);
    a /= tot;
    if (far(bf1(p.Ob[(long)r * 512 + h * 64 + tid]), a, 0.04f, 1.5e-3f)) bad |= 8u;
  }
  if (bad & CHECK_MASK) atomicOr(&p.bar[0], bad & CHECK_MASK);
}
__device__ __forceinline__ void phase_check(const Params& p, int L, char* smem) {
  const int nq = (L == 0) ? 12 : 8;
  char* sm = smem + HALF_ * LDS_SMALL;
  for (int pass = 0; pass < 2; pass++) {
  FOR_PAIRED(pass == 0 ? 12 : nq * 8, uu)
    const int u = (pass == 0) ? uu : uu + 12;
    const int si = (u < 12) ? u : ((u - 12) >> 3);
    int r;
    switch (si) {
      case 0: r = 0; break; case 1: r = 63; break; case 2: r = 64; break; case 3: r = 4095; break;
      case 4: r = 4096 + 777; break; case 5: r = 12345; break; case 6: r = 20000; break; case 7: r = 32767; break;
      case 8: r = TLAT; break; case 9: r = TLAT + 255; break; case 10: r = TLAT + 256 + 100; break; default: r = TLAT + 2047; break;
    }
    if (u < 12) check_proj(p, L, r, sm);
    else check_attn(p, L, r, (u - 12) & 7, sm);
  }
  }
}
#endif

#define XB_TMO      128
#define XB_XCNT(j)  (256  + 64 * (j))
#define XB_XSUB(j)  (1280 + 64 * (j))
#define XB_XGEN(j)  (2304 + 64 * (j))
#define XB_TOP      3328
#define XB_TOPGEN   3392
#define XCD_BAR_WORDS 3456
#define XB_SPIN_CAP (1u << 22)
#define LAS __attribute__((address_space(3)))
__device__ __forceinline__ unsigned xb_ld(unsigned* p)              { return __hip_atomic_load(p, __ATOMIC_RELAXED, __HIP_MEMORY_SCOPE_AGENT); }
__device__ __forceinline__ unsigned xb_add(unsigned* p, unsigned v) { return __hip_atomic_fetch_add(p, v, __ATOMIC_RELAXED, __HIP_MEMORY_SCOPE_AGENT); }
__device__ __forceinline__ unsigned xb_xcc_id() { return (unsigned)__builtin_amdgcn_s_getreg((3 << 11) | 20) & 0xFu; }
#define XB_SPIN(cond, bar) do { unsigned _sp = 0; while (cond) { __builtin_amdgcn_s_sleep(1); \
    if ((++_sp & 255u) == 0u) { if (xb_ld(&(bar)[XB_TMO])) break; if (_sp > XB_SPIN_CAP) { atomicAdd(&(bar)[XB_TMO], 1u); break; } } } } while (0)
struct XcdBarrier { unsigned* bar; unsigned x; volatile LAS unsigned* st; };
__device__ __forceinline__ XcdBarrier xcd_barrier_post(unsigned* bar, volatile LAS unsigned* st) {
  XcdBarrier b; b.bar = bar; b.x = xb_xcc_id(); b.st = st;
  if (threadIdx.x == 0) (void)xb_add(&bar[XB_XCNT(b.x)], 1u);
  return b;
}
__device__ __forceinline__ void xcd_barrier_complete(unsigned* bar, unsigned x, unsigned& nloc, unsigned& nx) {
  const unsigned G = gridDim.x * gridDim.y * gridDim.z;
  unsigned sum, cnt, mine, sp = 0u;
  for (;;) {
    sum = 0u; cnt = 0u; mine = 0u;
#pragma unroll
    for (unsigned j = 0; j < 16; ++j) { const unsigned c = xb_ld(&bar[XB_XCNT(j)]); sum += c; cnt += (c > 0u) ? 1u : 0u; mine = (j == x) ? c : mine; }
    if (sum == G) break;
    __builtin_amdgcn_s_sleep(1);
    if ((++sp & 255u) == 0u) { if (xb_ld(&bar[XB_TMO])) break; if (sp > XB_SPIN_CAP) { atomicAdd(&bar[XB_TMO], 1u); break; } }
  }
  nloc = mine > 0u ? mine : 1u; nx = cnt > 0u ? cnt : 1u;
}
__device__ __forceinline__ void xcd_barrier(const XcdBarrier& b) {
  asm volatile("s_waitcnt vmcnt(0)" ::: "memory");
  __syncthreads();
  if (threadIdx.x == 0) {
    unsigned* bar = b.bar;
    asm volatile("" : "+s"(bar));
    __builtin_amdgcn_s_waitcnt(0);
    unsigned nloc = b.st[0], nx = b.st[1];
    if (nloc == 0u) { xcd_barrier_complete(bar, b.x, nloc, nx); b.st[0] = nloc; b.st[1] = nx; }
    const unsigned old = xb_add(&bar[XB_XSUB(b.x)], 1u);
    const unsigned gen = old / nloc;
    if (old + 1u == (gen + 1u) * nloc) {
      __builtin_amdgcn_fence(__ATOMIC_RELEASE, "agent");
      asm volatile("s_waitcnt vmcnt(0)" ::: "memory");
      const unsigned og = xb_add(&bar[XB_TOP], 1u);
      const unsigned tg = og / nx;
      if (og + 1u == (tg + 1u) * nx) xb_add(&bar[XB_TOPGEN], 1u);
      else XB_SPIN(xb_ld(&bar[XB_TOPGEN]) == tg, bar);
      __builtin_amdgcn_fence(__ATOMIC_ACQUIRE, "agent");
      xb_add(&bar[XB_XGEN(b.x)], 1u);
      asm volatile("s_waitcnt vmcnt(0)" ::: "memory");
    } else {
      XB_SPIN(xb_ld(&bar[XB_XGEN(b.x)]) == gen, bar);
      __builtin_amdgcn_fence(__ATOMIC_ACQUIRE, "agent");
      asm volatile("s_waitcnt vmcnt(0)" ::: "memory");
    }
  }
  __syncthreads();
}

#define NPHASE (23 + CHECK_ATTN)
#ifndef PH_LIMIT
#define PH_LIMIT NPHASE
#endif
__device__ __forceinline__ void run_phase(const Params& p, int ph, char* smem, bool dry = false, bool big = false) {
  if (ph == 0) { phase_prep(p, smem); return; }
#if CHECK_ATTN
  if (ph == 23) {
    if (blockIdx.x == 0 && threadIdx.x == 0 && __hip_atomic_load(&p.bar[0], __ATOMIC_RELAXED, __HIP_MEMORY_SCOPE_AGENT) != 0u) p.out[0] = __uint_as_float(0x7fc00000u);
    return;
  }
#endif
  const int L = (ph - 1) / 11, s = (ph - 1) % 11;
  if (s == 0 || s == 7) {
    phase_norm(p, L, s == 0 ? 0 : 1, (s == 0 || L == 0) ? RTOT : TLAT);
    if (s == 0) phase_tables(p, L);
    return;
  }
  switch (s) {
    case 1: phase_s2<true>(p, L, smem); break;
    case 2: phase_s3(p, L, smem, dry); break;
    case 3: phase_s4(p, L, smem); break;
    case 4: phase_dftC(p, smem);
#if CHECK_ATTN
      phase_check(p, L, smem);
#endif
      break;
    case 5: phase_s7<true>(p, L, smem); break;
    case 6: phase_s8<true>(p, L, smem, dry); break;
    case 8: phase_s10<true>(p, L, smem); break;
    case 9: phase_s11a(p, L); break;
    case 10: phase_s11b(p, L, dry); break;
  }
}

__global__ void __launch_bounds__(512, 2) mega(Params p, int ph0, int ph1) {
  extern __shared__ __attribute__((aligned(16))) char smem[];
  __shared__ uint4 xb_words;
  cg::grid_group grid = cg::this_grid();
  const bool multi = (ph1 - ph0) > 1;
  const bool big = blockDim.x == 512;
  XcdBarrier xb;
  if (multi) {
    if (threadIdx.x == 0) xb_words = make_uint4(0u, 0u, 0u, 0u);
    __syncthreads();
    xb = xcd_barrier_post(p.bar, (volatile LAS unsigned*)&xb_words);
  }
  for (int ph = ph0; ph < ph1; ph++) {
    if (ph > ph0) {
      if (ph == ph0 + 1) grid.sync();
      else xcd_barrier(xb);
    }
#if PROBE_S >= 0
    {
      const int kind = (ph == 0) ? 11 : (ph - 1) % 11;
      const int reps = (kind == PROBE_S) ? PROBE_REPS * p.one : 0;
      for (int rep = 0; rep <= reps; rep++) {
        if (rep > 0) xcd_barrier(xb);
        const bool dry = (rep < reps);
        if (kind == PROBE_S && (kind == 6 || kind == 10 || kind == 2)) run_phase(p, ph, smem, dry, big);
        else run_phase(p, ph, smem, false, big);
      }
    }
#else
    run_phase(p, ph, smem, false, big);
#endif
  }
}

static inline size_t al256(size_t x) { return (x + 255) & ~(size_t)255; }
extern "C" void kernel_launch(void* const* d_in, const int* in_sizes, int n_in, void* d_out, int out_size, void* d_ws,
                              size_t ws_size, hipStream_t stream) {
  Params p{};
  const float* const* in = (const float* const*)d_in;
  p.x = in[0]; p.c = in[1]; p.ctx = in[2]; p.c_ctx = in[3]; p.w_mod = in[4]; p.b_mod = in[5]; p.g_norm1 = in[6];
  p.w_in = in[7]; p.g_ckv = in[8]; p.w_ukv = in[9]; p.g_cq = in[10]; p.w_uq = in[11]; p.g_qn = in[12]; p.g_kn = in[13];
  p.w_dw = in[14]; p.b_dw = in[15]; p.g_cln = in[16]; p.b_cln = in[17]; p.wb_attn = in[18]; p.wb_fnet = in[19];
  p.wb_conv = in[20]; p.w_out = in[21]; p.g_norm2 = in[22]; p.w_query = in[23]; p.sub_keys = in[24]; p.u_tab = in[25];
  p.v_tab = in[26];
  p.out = (float*)d_out;
  p.one = 1; p.pad_ = 0;
  char* ws = (char*)d_ws;
  size_t off = 0;
  auto take = [&](size_t bytes) { char* q = ws + off; off += al256(bytes); return q; };
  p.bar = (unsigned*)take(XCD_BAR_WORDS * 4);
  const size_t mods_bytes = 2 * 9 * 6144 * 4;
  p.mods = (float*)take(mods_bytes);
  p.ropetab = (float*)take(64 * 8 * 2 * 4);
  p.W2T = (u16*)take(2ull * W2T_SZ * 2);
  p.WgT = (u16*)take(2ull * WGT_SZ * 2);
  p.WukvT = (u16*)take(2ull * WUKV_SZ * 2);
  p.WuqT = (u16*)take(2ull * WUQ_SZ * 2);
  p.WbaT = (u16*)take(2ull * WBA_SZ * 2);
  p.WbfT = (u16*)take(2ull * WBF_SZ * 2);
  p.WbcT = (u16*)take(2ull * WBC_SZ * 2);
  p.WoutT = (u16*)take(2ull * WOUT_SZ * 2);
  p.WqT = (u16*)take(2ull * WQ_SZ * 2);
  p.SubK = (u16*)take(2ull * SUBK_SZ * 2);
  p.WA = (u16*)take(128 * 128 * 2);
  p.WC = (u16*)take(128 * 128 * 2);
  p.tw = (float*)take(4096 * 2 * 4);
  p.GB = (u16*)take((size_t)NB * 256 * 8192 * 2);
  p.Dctx = (u16*)take(256ull * 512 * 2);
  p.Wcs = (u16*)take(128ull * 64 * 2);
  p.UT8 = (unsigned char*)take((size_t)NEXP * 1024);
  p.VT8 = (unsigned char*)take((size_t)NEXP * 1024);
  p.hx = (u16*)take((size_t)RTOT * 1024 * 2);
  {
    const size_t b0 = off;
    p.cq = (u16*)take((size_t)RTOT * 256 * 2);
    p.zf = (u16*)take((size_t)RTOT * 256 * 2);
    p.zc = (u16*)take((size_t)RTOT * 512 * 2);
    p.ckv = (u16*)take((size_t)RTOT * 128 * 2);
    p.kr = (float*)take((size_t)RTOT * 32 * 4);
    p.m = (u16*)(ws + b0);
    p.PD = (unsigned*)(ws + b0);
  }
  {
    const size_t c0 = off;
    p.Kb = (u16*)take((size_t)NB * NH * SKEYS * 96 * 2);
    p.Vtb = (u16*)take((size_t)NB * NH * 64 * SKEYS * 2);
    p.eid = (int*)(ws + c0);
    p.gate = (float*)(ws + c0 + al256((size_t)RTOT * 128 * 4));
  }
  p.Ytl = (u16*)take((size_t)NB * 256 * 8192 * 2);
  p.Ytc = (u16*)take((size_t)NB * 256 * 512 * 2);
  p.Ob = (u16*)take((size_t)RTOT * 512 * 2);
  p.Fb = (u16*)take((size_t)RTOT * 256 * 2);
  p.cv = (u16*)take((size_t)RTOT * 256 * 2);
  p.ctx1 = (float*)take((size_t)TCTX * 1024 * 4);
  if (off > ws_size) { fprintf(stderr, "workspace too small: need %zu have %zu\n", off, ws_size); return; }

  (void)hipMemsetAsync(p.bar, 0, XCD_BAR_WORDS * 4, stream);
  static int cus = 0;
  if (!cus) {
    int dev = 0;
    (void)hipGetDevice(&dev);
    (void)hipDeviceGetAttribute(&cus, hipDeviceAttributeMultiprocessorCount, dev);
    (void)hipFuncSetAttribute((const void*)mega, hipFuncAttributeMaxDynamicSharedMemorySize, LDS_BIG);
  }
#if ONE_LAUNCH
  int ph0 = 0, ph1 = NPHASE;
  void* args[] = {&p, &ph0, &ph1};
  hipError_t e = hipLaunchCooperativeKernel((void*)mega, dim3(cus), dim3(512), args, LDS_BIG, stream);
  if (e != hipSuccess) fprintf(stderr, "cooperative launch failed: %s (grid %d)\n", hipGetErrorString(e), cus);
#else
  for (int ph = 0; ph < PH_LIMIT; ph++) {
    const int kind = (ph == 0) ? 11 : (ph - 1) % 11;
    const bool bigp = (kind == 1 || kind == 5 || kind == 6 || kind == 8);
    if (bigp) mega<<<cus, 512, LDS_BIG, stream>>>(p, ph, ph + 1);
    else mega<<<cus * 2, 256, LDS_SMALL, stream>>>(p, ph, ph + 1);
  }
#endif
}
```

```cpp
#include <hip/hip_runtime.h>
#include <hip/hip_cooperative_groups.h>
#include <cstdio>
#include <cstdint>
namespace cg = cooperative_groups;

#ifndef ABL_PEER
#define ABL_PEER 1
#endif
#ifndef ABL_BR
#define ABL_BR 7
#endif
#ifndef PROBE_S
#define PROBE_S (-1)
#endif
#ifndef PROBE_REPS
#define PROBE_REPS 4
#endif
#ifndef CHECK_ATTN
#define CHECK_ATTN 0
#endif
#ifndef CHECK_MASK
#define CHECK_MASK 0xff
#endif
#ifndef ONE_LAUNCH
#define ONE_LAUNCH 1
#endif

typedef unsigned short u16;
typedef __attribute__((ext_vector_type(8))) __bf16 bf16x8;
typedef __attribute__((ext_vector_type(2))) __bf16 bf16x2;
typedef __attribute__((ext_vector_type(16))) float f32x16;
typedef __attribute__((ext_vector_type(2))) float f32x2;

#define NB 8
#define SEQ 4096
#define DM 1024
#define CTXL 256
#define TLAT (NB * SEQ)
#define TCTX (NB * CTXL)
#define RTOT (TLAT + TCTX)
#define SKEYS (CTXL + SEQ)
#define NH 8
#define QKD 96
#define N2 1280
#define NEXP 16384
#define EPSV 1e-6f

struct Params {
  const float *x, *c, *ctx, *c_ctx, *w_mod, *b_mod, *g_norm1, *w_in, *g_ckv, *w_ukv, *g_cq, *w_uq, *g_qn, *g_kn,
      *w_dw, *b_dw, *g_cln, *b_cln, *wb_attn, *wb_fnet, *wb_conv, *w_out, *g_norm2, *w_query, *sub_keys, *u_tab, *v_tab;
  float* out;
  unsigned* bar;
  float* mods;
  float* ropetab;
  u16 *W2T, *WgT, *WukvT, *WuqT, *WbaT, *WbfT, *WbcT, *WoutT, *WqT, *SubK;
  u16 *WA, *WC, *Dctx, *Wcs;
  float* tw;
  u16* GB;
  unsigned char *UT8, *VT8;
  unsigned* PD;
  u16* hx;
  u16 *cq, *zf, *zc, *ckv; float* kr;
  u16* m;
  u16 *Kb, *Vtb;
  int* eid; float* gate;
  u16 *Ytl, *Ytc, *Ob, *Fb, *cv;
  float* ctx1;
  int one; int pad_;
};

#define W2T_SZ (N2 * 1024)
#define WGT_SZ (3072 * 1024)
#define WUKV_SZ (1024 * 128)
#define WUQ_SZ (768 * 256)
#define WBA_SZ (1024 * 512)
#define WBF_SZ (1024 * 256)
#define WBC_SZ (1024 * 256)
#define WOUT_SZ (1024 * 1024)
#define WQ_SZ (1024 * 1024)
#define SUBK_SZ (8 * 2 * 128 * 64)

__device__ __forceinline__ unsigned pack2(float a, float b) {
  f32x2 v = {a, b};
  return __builtin_bit_cast(unsigned, __builtin_convertvector(v, bf16x2));
}
__device__ __forceinline__ u16 tobf(float a) { return (u16)(pack2(a, 0.f) & 0xffffu); }
__device__ __forceinline__ float bf_lo(unsigned u) { return __uint_as_float(u << 16); }
__device__ __forceinline__ float bf_hi(unsigned u) { return __uint_as_float(u & 0xffff0000u); }
__device__ __forceinline__ float bf1(u16 u) { return __uint_as_float(((unsigned)u) << 16); }
__device__ __forceinline__ f32x16 mfma32(uint4 a, uint4 b, f32x16 c) {
  return __builtin_amdgcn_mfma_f32_32x32x16_bf16(__builtin_bit_cast(bf16x8, a), __builtin_bit_cast(bf16x8, b), c, 0, 0, 0);
}
__device__ __forceinline__ uint4 ldg16(const void* p) { return *(const uint4*)p; }
__device__ __forceinline__ int opaque(int x) { asm volatile("" : "+v"(x)); return x; }
#define TIDX opaque((int)threadIdx.x)
#define HALF_ (opaque((int)threadIdx.x) >> 8)
#define TIDS (opaque((int)threadIdx.x) & 255)
#define VBID ((int)blockIdx.x + HALF_ * (int)gridDim.x)
#define NVB ((int)gridDim.x * (int)(blockDim.x >> 8))
#define FOR_PAIRED(N, U) for (int _b = (int)blockIdx.x, _g = (int)gridDim.x, _st = _g * (int)(blockDim.x >> 8); _b < (N); _b += _st) { \
    int U = _b + HALF_ * _g; if (U >= (N)) U = _b;
__device__ __forceinline__ float wave_sum(float v) {
#pragma unroll
  for (int o = 32; o > 0; o >>= 1) v += __shfl_xor(v, o);
  return v;
}
__device__ __forceinline__ float half_sum(float v) {
#pragma unroll
  for (int o = 16; o > 0; o >>= 1) v += __shfl_xor(v, o);
  return v;
}
__device__ __forceinline__ float sigmoidf_(float x) { return 1.f / (1.f + __expf(-x)); }
__device__ __forceinline__ float siluf_(float x) { return x / (1.f + __expf(-x)); }
__device__ __forceinline__ float gelu_tanh(float x) {
  float u = 0.7978845608028654f * (x + 0.044715f * x * x * x);
  float t = 1.f - 2.f / (1.f + __expf(2.f * u));
  return 0.5f * x * (1.f + t);
}
__device__ __forceinline__ int row_mod(int r) { return r < TLAT ? (r >> 12) : 8; }

#define SMEM_BYTES 73728
#define LDS_SMALL 73728
#define LDS_BIG 147456
#define LDT 72

#define LAS3 __attribute__((address_space(3)))
__device__ __forceinline__ void glds16(const u16* g, char* lds_wave_base) {
  __builtin_amdgcn_global_load_lds((const unsigned*)g, (LAS3 unsigned*)lds_wave_base, 16, 0, 0);
}
__device__ __forceinline__ void gemm128x(const u16* __restrict__ A, int lda, const u16* __restrict__ Bt, int ldb, int bs1, int bs2, int K,
                                         f32x16 (&acc)[2][2], char* smem) {
  char* As = smem;
  char* Bs = smem + 32768;
  const int tid = TIDS, lane = tid & 63, w = tid >> 6, wr = w >> 1, wc = w & 1;
  const int nk = K >> 6;
  const int srow = w * 8 + (lane >> 3);
  const int schunk = (lane & 7) ^ ((srow >> 1) & 7);
  const int aoff = srow * lda + schunk * 8, boff = srow * ldb + schunk * 8;
  const int a32 = 32 * lda;
  __syncthreads();
#pragma unroll
  for (int i = 0; i < 4; i++) {
    glds16(A + (aoff + i * a32), As + (i * 4 + w) * 1024);
    glds16(Bt + (boff + (i & 1) * bs1 + (i >> 1) * bs2), Bs + (i * 4 + w) * 1024);
  }
  __syncthreads();
  const int fr = lane & 31, hh = lane >> 5;
  const int sw = (fr >> 1) & 7;
  for (int kt = 0; kt < nk; kt++) {
    const int cur = kt & 1;
    if (kt + 1 < nk) {
      const int ko = (kt + 1) * 64;
      char* An = As + (cur ^ 1) * 16384;
      char* Bn = Bs + (cur ^ 1) * 16384;
#pragma unroll
      for (int i = 0; i < 4; i++) {
        glds16(A + (aoff + i * a32 + ko), An + (i * 4 + w) * 1024);
        glds16(Bt + (boff + (i & 1) * bs1 + (i >> 1) * bs2 + ko), Bn + (i * 4 + w) * 1024);
      }
    }
    const char* Ac = As + cur * 16384 + (wr * 64 + fr) * 128;
    const char* Bc = Bs + cur * 16384 + (wc * 64 + fr) * 128;
#pragma unroll
    for (int kk = 0; kk < 4; kk++) {
      const int so = ((2 * kk + hh) ^ sw) << 4;
      uint4 a0 = *(const uint4*)(Ac + so);
      uint4 a1 = *(const uint4*)(Ac + 32 * 128 + so);
      uint4 b0 = *(const uint4*)(Bc + so);
      uint4 b1 = *(const uint4*)(Bc + 32 * 128 + so);
      acc[0][0] = mfma32(a0, b0, acc[0][0]);
      acc[0][1] = mfma32(a0, b1, acc[0][1]);
      acc[1][0] = mfma32(a1, b0, acc[1][0]);
      acc[1][1] = mfma32(a1, b1, acc[1][1]);
    }
    __syncthreads();
  }
}
__device__ __forceinline__ void gemm128(const u16* __restrict__ A, int lda, const u16* __restrict__ Bt, int ldb, int K,
                                        f32x16 (&acc)[2][2], char* smem) {
  gemm128x(A, lda, Bt, ldb, 32 * ldb, 64 * ldb, K, acc, smem);
}
__device__ __forceinline__ void gemm128h(const u16* __restrict__ A, int lda, const u16* __restrict__ Bt, int ldb, int K, int jh,
                                         f32x16 (&acc)[2], char* smem) {
  char* As = smem;
  char* Bs = smem + 32768;
  const int tid = TIDS, lane = tid & 63, w = tid >> 6, wr = w >> 1, wc = w & 1;
  const int nk = K >> 6;
  const int srow = w * 8 + (lane >> 3);
  const int schunk = (lane & 7) ^ ((srow >> 1) & 7);
  const int aoff = srow * lda + schunk * 8;
  const int a32 = 32 * lda;
  const int boff = (jh * 32 + srow) * ldb + schunk * 8, b64 = 64 * ldb;
  __syncthreads();
#pragma unroll
  for (int i = 0; i < 4; i++) glds16(A + (aoff + i * a32), As + (i * 4 + w) * 1024);
#pragma unroll
  for (int i = 0; i < 2; i++) glds16(Bt + (boff + i * b64), Bs + (i * 4 + w) * 1024);
  __syncthreads();
  const int fr = lane & 31, hh = lane >> 5;
  const int sw = (fr >> 1) & 7;
  for (int kt = 0; kt < nk; kt++) {
    const int cur = kt & 1;
    if (kt + 1 < nk) {
      const int ko = (kt + 1) * 64;
      char* An = As + (cur ^ 1) * 16384;
      char* Bn = Bs + (cur ^ 1) * 8192;
#pragma unroll
      for (int i = 0; i < 4; i++) glds16(A + (aoff + i * a32 + ko), An + (i * 4 + w) * 1024);
#pragma unroll
      for (int i = 0; i < 2; i++) glds16(Bt + (boff + i * b64 + ko), Bn + (i * 4 + w) * 1024);
    }
    const char* Ac = As + cur * 16384 + (wr * 64 + fr) * 128;
    const char* Bc = Bs + cur * 8192 + (wc * 32 + fr) * 128;
#pragma unroll
    for (int kk = 0; kk < 4; kk++) {
      const int so = ((2 * kk + hh) ^ sw) << 4;
      uint4 a0 = *(const uint4*)(Ac + so);
      uint4 a1 = *(const uint4*)(Ac + 32 * 128 + so);
      uint4 b0 = *(const uint4*)(Bc + so);
      acc[0] = mfma32(a0, b0, acc[0]);
      acc[1] = mfma32(a1, b0, acc[1]);
    }
    __syncthreads();
  }
}
#define WAIT_VM(n) asm volatile("s_waitcnt vmcnt(%0)" ::"n"(n) : "memory")
#define G256_STAGE 49152
__device__ __forceinline__ void gemm256(const u16* __restrict__ A, int lda, const u16* __restrict__ Bt, int ldb, int K,
                                        f32x16 (&acc)[2][2], char* smem) {
  const int tid = TIDX, lane = tid & 63, w = tid >> 6, wr = w >> 1, wc = w & 1;
  const int nk = K >> 6;
  const int srow = w * 8 + (lane >> 3);
  const int schunk = (lane & 7) ^ ((srow >> 1) & 7);
  const int aoff = srow * lda + schunk * 8, boff = srow * ldb + schunk * 8;
  const int a64 = 64 * lda, b64 = 64 * ldb;
  auto issue = [&](int kt) __attribute__((always_inline)) {
    char* As = smem + (kt % 3) * G256_STAGE;
    char* Bs = As + 32768;
    const int ko = kt * 64;
#pragma unroll
    for (int i = 0; i < 4; i++) glds16(A + (aoff + i * a64 + ko), As + (w + 8 * i) * 1024);
#pragma unroll
    for (int i = 0; i < 2; i++) glds16(Bt + (boff + i * b64 + ko), Bs + (w + 8 * i) * 1024);
  };
  WAIT_VM(0);
  __syncthreads();
  issue(0);
  if (nk > 1) issue(1);
  const int fr = lane & 31, hh = lane >> 5;
  const int sw = (fr >> 1) & 7;
  const int rdA = (wr * 64 + fr) * 128, rdB = 32768 + (wc * 64 + fr) * 128;
  for (int kt = 0; kt < nk; kt++) {
    if (kt + 1 < nk) WAIT_VM(6); else WAIT_VM(0);
    __builtin_amdgcn_s_barrier();
    if (kt + 2 < nk) issue(kt + 2);
    const char* Sb = smem + (kt % 3) * G256_STAGE;
#pragma unroll
    for (int kk = 0; kk < 4; kk++) {
      const int so = ((2 * kk + hh) ^ sw) << 4;
      uint4 a0 = *(const uint4*)(Sb + rdA + so);
      uint4 a1 = *(const uint4*)(Sb + rdA + 32 * 128 + so);
      uint4 b0 = *(const uint4*)(Sb + rdB + so);
      uint4 b1 = *(const uint4*)(Sb + rdB + 32 * 128 + so);
      acc[0][0] = mfma32(a0, b0, acc[0][0]);
      acc[0][1] = mfma32(a0, b1, acc[0][1]);
      acc[1][0] = mfma32(a1, b0, acc[1][0]);
      acc[1][1] = mfma32(a1, b1, acc[1][1]);
    }
  }
  __syncthreads();
}
__device__ __forceinline__ void gemm256h(const u16* __restrict__ A, int lda, const u16* __restrict__ Bt, int ldb, int K, int jh,
                                         f32x16 (&acc)[2], char* smem) {
  const int tid = TIDX, lane = tid & 63, w = tid >> 6, wr = w >> 1, wc = w & 1;
  const int nk = K >> 6;
  const int srow = w * 8 + (lane >> 3);
  const int schunk = (lane & 7) ^ ((srow >> 1) & 7);
  const int aoff = srow * lda + schunk * 8;
  const int a64 = 64 * lda;
  const int boff = ((srow >> 5) * 64 + jh * 32 + (srow & 31)) * ldb + schunk * 8;
  auto issue = [&](int kt) __attribute__((always_inline)) {
    char* As = smem + (kt % 3) * G256_STAGE;
    char* Bs = As + 32768;
    const int ko = kt * 64;
#pragma unroll
    for (int i = 0; i < 4; i++) glds16(A + (aoff + i * a64 + ko), As + (w + 8 * i) * 1024);
    glds16(Bt + (boff + ko), Bs + w * 1024);
  };
  WAIT_VM(0);
  __syncthreads();
  issue(0);
  if (nk > 1) issue(1);
  const int fr = lane & 31, hh = lane >> 5;
  const int sw = (fr >> 1) & 7;
  const int rdA = (wr * 64 + fr) * 128, rdB = 32768 + (wc * 32 + fr) * 128;
  for (int kt = 0; kt < nk; kt++) {
    if (kt + 1 < nk) WAIT_VM(5); else WAIT_VM(0);
    __builtin_amdgcn_s_barrier();
    if (kt + 2 < nk) issue(kt + 2);
    const char* Sb = smem + (kt % 3) * G256_STAGE;
#pragma unroll
    for (int kk = 0; kk < 4; kk++) {
      const int so = ((2 * kk + hh) ^ sw) << 4;
      uint4 a0 = *(const uint4*)(Sb + rdA + so);
      uint4 a1 = *(const uint4*)(Sb + rdA + 32 * 128 + so);
      uint4 b0 = *(const uint4*)(Sb + rdB + so);
      acc[0] = mfma32(a0, b0, acc[0]);
      acc[1] = mfma32(a1, b0, acc[1]);
    }
  }
  __syncthreads();
}
#define FOR_UNITS_XCD(NRT, NCT, RT, CT) \
  for (int _s = (int)(blockIdx.x >> 3), _per = (NRT) >> 3, _n = _per * (NCT); _s < _n; _s += (int)(gridDim.x >> 3)) { \
    const int RT = (int)(blockIdx.x & 7) * _per + _s / (NCT), CT = _s % (NCT);
#define ZERO_ACC(acc) { _Pragma("unroll") for (int _i = 0; _i < 2; _i++) _Pragma("unroll") for (int _j = 0; _j < 2; _j++) _Pragma("unroll") for (int _r = 0; _r < 16; _r++) acc[_i][_j][_r] = 0.f; }
#define ACC_ROW(wr, i, r, lane) ((wr) * 64 + (i) * 32 + ((r) & 3) + 8 * ((r) >> 2) + 4 * ((lane) >> 5))
#define ACC_COL(wc, j, lane) ((wc) * 64 + (j) * 32 + ((lane) & 31))

__device__ __forceinline__ void job_mods(const Params& p, int job, char* smem) {
  float* s = (float*)smem;
  float* red = s + 9 * 1024;
  const int L = job / 96, nt = job % 96;
  const int tid = TIDS, lane = tid & 63, w = tid >> 6;
  __syncthreads();
  for (int i = tid; i < 9 * 1024; i += 256) {
    const int j = i >> 10, k = i & 1023;
    const float cv = (j < 8) ? p.c[j * 1024 + k] : p.c_ctx[k];
    s[i] = siluf_(cv);
  }
  __syncthreads();
  const int n = nt * 64 + lane;
  float acc[9];
#pragma unroll
  for (int j = 0; j < 9; j++) acc[j] = 0.f;
  const float* wp = p.w_mod + (long)L * 1024 * 6144 + (long)(w * 256) * 6144 + n;
#pragma unroll 8
  for (int k = 0; k < 256; k++) {
    const float wv = wp[(long)k * 6144];
#pragma unroll
    for (int j = 0; j < 9; j++) acc[j] += s[j * 1024 + w * 256 + k] * wv;
  }
#pragma unroll
  for (int j = 0; j < 9; j++) red[(w * 9 + j) * 64 + lane] = acc[j];
  __syncthreads();
  for (int i = tid; i < 9 * 64; i += 256) {
    const int j = i >> 6, l = i & 63;
    const float v = ((red[(0 * 9 + j) * 64 + l] + red[(1 * 9 + j) * 64 + l]) + red[(2 * 9 + j) * 64 + l]) + red[(3 * 9 + j) * 64 + l];
    p.mods[(L * 9 + j) * 6144 + nt * 64 + l] = v + p.b_mod[L * 6144 + nt * 64 + l];
  }
}

__device__ __forceinline__ void job_convT(const float* src, int ldsrc, int c0, int k0, u16* dst, int K, int n0, const float* scale, char* smem) {
  float* t = (float*)smem;
  const int tid = TIDS;
  __syncthreads();
  const int nc = tid & 31, kr = tid >> 5;
#pragma unroll 4
  for (int kk = kr; kk < 128; kk += 8) {
    float v = 0.f;
    if (src) { v = src[(long)(k0 + kk) * ldsrc + c0 + nc]; if (scale) v *= scale[k0 + kk]; }
    t[nc * 129 + kk] = v;
  }
  __syncthreads();
  const int nr = tid >> 3, kc = (tid & 7) * 16;
  unsigned o[8];
#pragma unroll
  for (int q = 0; q < 8; q++) o[q] = pack2(t[nr * 129 + kc + 2 * q], t[nr * 129 + kc + 2 * q + 1]);
  uint4* dp = (uint4*)(dst + (long)(n0 + nr) * K + k0 + kc);
  dp[0] = make_uint4(o[0], o[1], o[2], o[3]);
  dp[1] = make_uint4(o[4], o[5], o[6], o[7]);
}

#define NJ_W2 (40 * 8)
#define NJ_WG (96 * 8)
#define NJ_UKV (32 * 1)
#define NJ_UQ (24 * 2)
#define NJ_BA (32 * 4)
#define NJ_BF (32 * 2)
#define NJ_BC (32 * 2)
#define NJ_OUT (32 * 8)
#define NJ_WQ (32 * 8)
#define NJ_CONV_LAYER (NJ_W2 + NJ_WG + NJ_UKV + NJ_UQ + NJ_BA + NJ_BF + NJ_BC + NJ_OUT + NJ_WQ)

__device__ __forceinline__ void job_conv_weights(const Params& p, int job, char* smem) {
  const int L = job / NJ_CONV_LAYER;
  int j = job % NJ_CONV_LAYER;
  const float* src; int ldsrc, c0, k0, K, n0; u16* dst; const float* scale = nullptr;
  if (j < NJ_W2) {
    const int nt = j >> 3, kt = j & 7; n0 = nt * 32;
    bool valid = true;
    if (n0 < 256) c0 = 160 + n0;
    else if (n0 < 512) c0 = 416 + (n0 - 256);
    else if (n0 < 1024) c0 = 672 + (n0 - 512);
    else if (n0 < 1152) c0 = n0 - 1024;
    else if (n0 < 1184) c0 = 128 + (n0 - 1152);
    else { c0 = 0; valid = false; }
    src = valid ? p.w_in + (long)L * 1024 * 4256 : nullptr; ldsrc = 4256; k0 = kt * 128; dst = p.W2T + (long)L * W2T_SZ; K = 1024;
  } else if ((j -= NJ_W2) < NJ_WG) {
    const int nt = j >> 3, kt = j & 7;
    src = p.w_in + (long)L * 1024 * 4256; ldsrc = 4256; c0 = 1184 + nt * 32; k0 = kt * 128; dst = p.WgT + (long)L * WGT_SZ; K = 1024; n0 = nt * 32;
  } else if ((j -= NJ_WG) < NJ_UKV) {
    src = p.w_ukv + (long)L * 128 * 1024; ldsrc = 1024; c0 = j * 32; k0 = 0; dst = p.WukvT + (long)L * WUKV_SZ; K = 128; n0 = j * 32; scale = p.g_ckv + L * 128;
  } else if ((j -= NJ_UKV) < NJ_UQ) {
    const int nt = j >> 1, kt = j & 1;
    src = p.w_uq + (long)L * 256 * 768; ldsrc = 768; c0 = nt * 32; k0 = kt * 128; dst = p.WuqT + (long)L * WUQ_SZ; K = 256; n0 = nt * 32; scale = p.g_cq + L * 256;
  } else if ((j -= NJ_UQ) < NJ_BA) {
    const int nt = j >> 2, kt = j & 3;
    src = p.wb_attn + (long)L * 512 * 1024; ldsrc = 1024; c0 = nt * 32; k0 = kt * 128; dst = p.WbaT + (long)L * WBA_SZ; K = 512; n0 = nt * 32;
  } else if ((j -= NJ_BA) < NJ_BF) {
    const int nt = j >> 1, kt = j & 1;
    src = p.wb_fnet + (long)L * 256 * 1024; ldsrc = 1024; c0 = nt * 32; k0 = kt * 128; dst = p.WbfT + (long)L * WBF_SZ; K = 256; n0 = nt * 32;
  } else if ((j -= NJ_BF) < NJ_BC) {
    const int nt = j >> 1, kt = j & 1;
    src = p.wb_conv + (long)L * 256 * 1024; ldsrc = 1024; c0 = nt * 32; k0 = kt * 128; dst = p.WbcT + (long)L * WBC_SZ; K = 256; n0 = nt * 32;
  } else if ((j -= NJ_BC) < NJ_OUT) {
    const int nt = j >> 3, kt = j & 7;
    src = p.w_out + (long)L * 1024 * 1024; ldsrc = 1024; c0 = nt * 32; k0 = kt * 128; dst = p.WoutT + (long)L * WOUT_SZ; K = 1024; n0 = nt * 32;
  } else {
    j -= NJ_OUT;
    const int nt = j >> 3, kt = j & 7;
    src = p.w_query + (long)L * 1024 * 1024; ldsrc = 1024; c0 = nt * 32; k0 = kt * 128; dst = p.WqT + (long)L * WQ_SZ; K = 1024; n0 = nt * 32;
  }
  job_convT(src, ldsrc, c0, k0, dst, K, n0, scale, smem);
}

__device__ __forceinline__ void job_cvt_straight(const float* src, u16* dst, long job) {
  const long base = job * 8192 + TIDS * 8;
#pragma unroll
  for (int i = 0; i < 4; i++) {
    const long o = base + i * 2048;
    float4 a = *(const float4*)(src + o), b = *(const float4*)(src + o + 4);
    *(uint4*)(dst + o) = make_uint4(pack2(a.x, a.y), pack2(a.z, a.w), pack2(b.x, b.y), pack2(b.z, b.w));
  }
}

#define NJ_MISC 87
__device__ __forceinline__ void job_misc(const Params& p, int job) {
  const int tid = TIDS;
#pragma unroll 1
  for (int q = 0; q < 8; q++) {
    const int e = tid + 256 * q;
    if (job < 64) {
      const int i = job * 2048 + e;
      const int k = i >> 9, ee = i & 511, part = ee >> 8, t = ee & 255;
      const float a = (float)((k * t) & 255) * (1.0f / 128.0f);
      p.Dctx[i] = tobf((part == 0 ? cospif(a) : -sinpif(a)) * (1.0f / 16.0f));
    } else if (job < 72) {
      const int i = (job - 64) * 2048 + e;
      const int R = i >> 7, kk = i & 127, k1 = (R >> 6) * 32 + (R & 31), pr = (R >> 5) & 1, part = kk >> 6, t1 = kk & 63;
      const float a = (float)((k1 * t1) & 63) * (1.0f / 32.0f);
      const float cs = cospif(a), sn = sinpif(a);
      const float v = (pr == 0) ? (part == 0 ? cs : -sn) : (part == 0 ? -sn : -cs);
      p.WA[i] = tobf(v * 0.125f);
    } else if (job < 80) {
      const int i = (job - 72) * 2048 + e;
      const int k2 = i >> 7, kk = i & 127, part = kk >> 6, t2 = kk & 63;
      const float a = (float)((k2 * t2) & 63) * (1.0f / 32.0f);
      p.WC[i] = (k2 < 64) ? tobf((part == 0 ? cospif(a) : sinpif(a)) * 0.125f) : (u16)0;
    } else if (job < 84) {
      const int i = (job - 80) * 2048 + e;
      const int n = i >> 6, d = i & 63, pp = n >> 6, en = n & 63;
      const float a = (float)((en * d) & 63) * (1.0f / 32.0f);
      p.Wcs[i] = tobf((pp == 0 ? cospif(a) : sinpif(a)) * 0.125f);
    } else if (job < 86) {
      const int i = (job - 84) * 2048 + e;
      const float a = (float)i * (1.0f / 2048.0f);
      p.tw[2 * i] = cospif(a); p.tw[2 * i + 1] = sinpif(a);
    } else if (e < 512) {
      const int pos = e >> 3, mm = e & 7;
      const float inv = powf(10000.0f, -(float)(2 * mm) / 16.0f);
      const float ang = (float)pos * inv;
      p.ropetab[e * 2] = cosf(ang);
      p.ropetab[e * 2 + 1] = sinf(ang);
    }
  }
}

#define NJ_MODS 192
#define NJ_CONVW (2 * NJ_CONV_LAYER)
#define NJ_SUBK 32
#define NJ_PREP (NJ_MODS + NJ_CONVW + NJ_SUBK + NJ_MISC)

__device__ __forceinline__ void phase_prep(const Params& p, char* smem) {
  char* sm = smem + HALF_ * LDS_SMALL;
  FOR_PAIRED(NJ_MODS, j) job_mods(p, j, sm); }
  FOR_PAIRED(NJ_CONVW, j) job_conv_weights(p, j, sm); }
  for (int j = VBID; j < NJ_SUBK; j += NVB) job_cvt_straight(p.sub_keys, p.SubK, j);
  for (int j = NVB - 1 - VBID; j < NJ_MISC; j += NVB) job_misc(p, j);
}

__device__ __forceinline__ void phase_norm(const Params& p, int L, int which, int nrows) {
  const int lane = TIDS & 63;
  const int gw = VBID * 4 + (TIDS >> 6), nw = NVB * 4;
  const float* g = (which == 0 ? p.g_norm1 : p.g_norm2) + L * 1024;
  for (int r0 = gw; r0 < nrows; r0 += 2 * nw) {
    float4 v[2][4];
    int rr[2]; bool ok[2];
#pragma unroll
    for (int u = 0; u < 2; u++) {
      const int r = r0 + u * nw;
      ok[u] = r < nrows; rr[u] = ok[u] ? r : r0;
      const float* src;
      if (which == 0 && L == 0) src = (rr[u] < TLAT) ? p.x + (long)rr[u] * 1024 : p.ctx + (long)(rr[u] - TLAT) * 1024;
      else src = (rr[u] < TLAT) ? p.out + (long)rr[u] * 1024 : p.ctx1 + (long)(rr[u] - TLAT) * 1024;
#pragma unroll
      for (int i = 0; i < 4; i++) v[u][i] = *(const float4*)(src + i * 256 + lane * 4);
    }
#pragma unroll
    for (int u = 0; u < 2; u++) {
      const int r = rr[u];
      const float* md = p.mods + (long)(L * 9 + row_mod(r)) * 6144 + (which == 0 ? 0 : 3072);
      float ss = 0.f;
#pragma unroll
      for (int i = 0; i < 4; i++) ss += v[u][i].x * v[u][i].x + v[u][i].y * v[u][i].y + v[u][i].z * v[u][i].z + v[u][i].w * v[u][i].w;
      ss = wave_sum(ss);
      const float rs = rsqrtf(ss * (1.0f / 1024.0f) + EPSV);
      if (!ok[u]) continue;
#pragma unroll
      for (int i = 0; i < 4; i++) {
        const int c = i * 256 + lane * 4;
        const float4 gg = *(const float4*)(g + c);
        const float4 sh = *(const float4*)(md + c);
        const float4 sc = *(const float4*)(md + 1024 + c);
        const float o0 = v[u][i].x * rs * gg.x * (1.f + sc.x) + sh.x;
        const float o1 = v[u][i].y * rs * gg.y * (1.f + sc.y) + sh.y;
        const float o2 = v[u][i].z * rs * gg.z * (1.f + sc.z) + sh.z;
        const float o3 = v[u][i].w * rs * gg.w * (1.f + sc.w) + sh.w;
        *(uint2*)(p.hx + (long)r * 1024 + c) = make_uint2(pack2(o0, o1), pack2(o2, o3));
      }
    }
  }
}
#define U8_SCALE 32.0f
#define V8_SCALE 4.0f
__device__ __forceinline__ unsigned pack_fp8x4(float4 v, float s) {
  int w = 0;
  w = __builtin_amdgcn_cvt_pk_fp8_f32(v.x * s, v.y * s, w, false);
  w = __builtin_amdgcn_cvt_pk_fp8_f32(v.z * s, v.w * s, w, true);
  return (unsigned)w;
}
__device__ __forceinline__ void phase_tables(const Params& p, int L) {
  const int tid = TIDS;
  for (int job = VBID; job < 4096; job += NVB) {
    const bool isu = job < 2048;
    const float* src = (isu ? p.u_tab : p.v_tab) + (long)L * NEXP * 1024;
    unsigned char* dst = isu ? p.UT8 : p.VT8;
    const float s = isu ? U8_SCALE : V8_SCALE;
    const long base = (long)(isu ? job : job - 2048) * 8192 + tid * 16;
#pragma unroll
    for (int i = 0; i < 2; i++) {
      const long o = base + i * 4096;
      const float4 a = *(const float4*)(src + o), b = *(const float4*)(src + o + 4);
      const float4 c = *(const float4*)(src + o + 8), d = *(const float4*)(src + o + 12);
      const long e = o >> 10; const int col = (int)(o & 1023), sl = col >> 7, cc = col & 127;
      *(uint4*)(dst + ((long)sl * NEXP + e) * 128 + cc) = make_uint4(pack_fp8x4(a, s), pack_fp8x4(b, s), pack_fp8x4(c, s), pack_fp8x4(d, s));
    }
  }
}

template <bool BIG>
__device__ __forceinline__ void phase_s2(const Params& p, int L, char* smem) {
  constexpr int TM = BIG ? 256 : 128;
  const int lane = TIDX & 63, w = TIDX >> 6, wr = w >> 1, wc = w & 1;
  for (int pass = 0; pass < (L == 0 ? 1 : 2); pass++) {
  const int g_nrt = (L == 0) ? RTOT / TM : (pass == 0 ? TLAT / TM : TCTX / TM), g_nct = (L == 0 || pass == 0) ? 10 : 2;
  FOR_UNITS_XCD(g_nrt, g_nct, rt_, ct_)
    const int rt = (L == 1 && pass == 1) ? TLAT / TM + rt_ : rt_, ct = (L == 1 && pass == 1) ? 8 + ct_ : ct_;
    f32x16 acc[2][2];
    ZERO_ACC(acc);
    if constexpr (BIG) gemm256(p.hx + (long)rt * TM * 1024, 1024, p.W2T + (long)L * W2T_SZ + (long)ct * 128 * 1024, 1024, 1024, acc, smem);
    else gemm128(p.hx + (long)rt * TM * 1024, 1024, p.W2T + (long)L * W2T_SZ + (long)ct * 128 * 1024, 1024, 1024, acc, smem);
    const int row0 = rt * TM;
#define S2_STORE(DST, LDD, C0) { u16* dp = (DST) + (long)row0 * (LDD) + (C0); \
      const int tb = opaque((wr * 64 + 4 * (lane >> 5)) * (LDD) + wc * 64 + (lane & 31)); \
      _Pragma("unroll") for (int i = 0; i < 2; i++) _Pragma("unroll") for (int j = 0; j < 2; j++) _Pragma("unroll") for (int r = 0; r < 16; r++) \
        dp[tb + (i * 32 + (r & 3) + 8 * (r >> 2)) * (LDD) + j * 32] = tobf(acc[i][j][r]); }
    if (ct < 2) S2_STORE(p.cq, 256, ct * 128)
    else if (ct < 4) S2_STORE(p.zf, 256, (ct - 2) * 128)
    else if (ct < 8) S2_STORE(p.zc, 512, (ct - 4) * 128)
    else if (ct == 8) S2_STORE(p.ckv, 128, 0)
#undef S2_STORE
    else if (wc == 0) {
      float* dp = p.kr + (long)row0 * 32;
      const int tb = opaque((wr * 64 + 4 * (lane >> 5)) * 32 + (lane & 31));
#pragma unroll
      for (int i = 0; i < 2; i++)
#pragma unroll
        for (int r = 0; r < 16; r++)
          dp[tb + (i * 32 + (r & 3) + 8 * (r >> 2)) * 32] = acc[i][0][r];
    }
  }
  }
}

__device__ __forceinline__ void unit_kv(const Params& p, int L, int rt, int h, char* smem) {
  u16* As = (u16*)smem;
  u16* Ws = (u16*)(smem + 128 * 136 * 2);
  float* rrs = (float*)(smem + 2 * 128 * 136 * 2);
  const int tid = TIDS, lane = tid & 63, w = tid >> 6, hh = lane >> 5, c = lane & 31;
  const int row0 = rt * 128;
  __syncthreads();
  {
    const u16* ap = p.ckv + (long)row0 * 128;
    const u16* wp = p.WukvT + (long)L * WUKV_SZ + (long)h * 128 * 128;
#pragma unroll
    for (int i = 0; i < 8; i++) {
      const int idx = tid + 256 * i, rw = idx >> 4, ch = idx & 15;
      *(uint4*)(As + rw * 136 + ch * 8) = ldg16(ap + rw * 128 + ch * 8);
      *(uint4*)(Ws + rw * 136 + ch * 8) = ldg16(wp + rw * 128 + ch * 8);
    }
  }
  __syncthreads();
  {
    const int rw = tid >> 1, hf = tid & 1;
    float ss = 0.f;
#pragma unroll
    for (int q = 0; q < 8; q++) {
      uint4 v = *(const uint4*)(As + rw * 136 + hf * 64 + q * 8);
      float a;
      a = bf_lo(v.x); ss += a * a; a = bf_hi(v.x); ss += a * a;
      a = bf_lo(v.y); ss += a * a; a = bf_hi(v.y); ss += a * a;
      a = bf_lo(v.z); ss += a * a; a = bf_hi(v.z); ss += a * a;
      a = bf_lo(v.w); ss += a * a; a = bf_hi(v.w); ss += a * a;
    }
    ss += __shfl_xor(ss, 1);
    if (hf == 0) rrs[rw] = rsqrtf(ss * (1.0f / 128.0f) + EPSV);
  }
  __syncthreads();
  f32x16 aK[2], aV[2];
#pragma unroll
  for (int r = 0; r < 16; r++) { aK[0][r] = 0.f; aK[1][r] = 0.f; aV[0][r] = 0.f; aV[1][r] = 0.f; }
#pragma unroll
  for (int s = 0; s < 8; s++) {
    const int ko = s * 16 + hh * 8;
    uint4 tk = *(const uint4*)(As + (32 * w + c) * 136 + ko);
    uint4 w0 = *(const uint4*)(Ws + (c) * 136 + ko);
    uint4 w1 = *(const uint4*)(Ws + (32 + c) * 136 + ko);
    uint4 w2 = *(const uint4*)(Ws + (64 + c) * 136 + ko);
    uint4 w3 = *(const uint4*)(Ws + (96 + c) * 136 + ko);
    aK[0] = mfma32(tk, w0, aK[0]);
    aK[1] = mfma32(tk, w1, aK[1]);
    aV[0] = mfma32(w2, tk, aV[0]);
    aV[1] = mfma32(w3, tk, aV[1]);
  }
  const bool lat = row0 < TLAT;
  const int b = lat ? (row0 >> 12) : ((row0 - TLAT) >> 8);
  const int s0 = lat ? (row0 & 4095) : ((row0 - TLAT) & 255);
  const int kpos0 = lat ? (CTXL + s0) : s0;
  const float* gkn = p.g_kn + L * 96;
  const float gk0 = gkn[c], gk1 = gkn[32 + c], gk2 = gkn[64 + c];
  u16* Kdst = p.Kb + ((long)(b * 8 + h) * SKEYS + kpos0) * 96;
#pragma unroll
  for (int r = 0; r < 16; r++) {
    const int tl = 32 * w + (r & 3) + 8 * (r >> 2) + 4 * hh;
    const float rc = rrs[tl];
    const float v0 = aK[0][r] * rc, v1 = aK[1][r] * rc;
    const float kv = p.kr[(long)(row0 + tl) * 32 + c];
    const float ss = half_sum(v0 * v0 + v1 * v1 + kv * kv);
    const float rk = rsqrtf(ss * (1.0f / 96.0f) + EPSV);
    const float krn = kv * rk * gk2;
    const float partner = __shfl_xor(krn, 8);
    float o2 = krn;
    if (lat) {
      const int s = s0 + tl;
      const int pos = (c < 16) ? (s >> 6) : (s & 63);
      const float2 cs = *(const float2*)(p.ropetab + (pos * 8 + (c & 7)) * 2);
      const float rot = (c & 8) ? partner : -partner;
      o2 = krn * cs.x + rot * cs.y;
    }
    u16* kd = Kdst + (long)tl * 96;
    kd[c] = tobf(v0 * rk * gk0);
    kd[32 + c] = tobf(v1 * rk * gk1);
    kd[64 + c] = tobf(o2);
  }
  u16* Vdst = p.Vtb + (long)(b * 8 + h) * 64 * SKEYS + kpos0;
  const float rcv = rrs[32 * w + c];
#pragma unroll
  for (int i = 0; i < 2; i++)
#pragma unroll
    for (int r = 0; r < 16; r++) {
      const int d = 32 * i + (r & 3) + 8 * (r >> 2) + 4 * hh;
      Vdst[(long)d * SKEYS + 32 * w + c] = tobf(aV[i][r] * rcv);
    }
}

__device__ __forceinline__ void unit_chdft(const Params& p, int ut, int g, bool lat, char* smem) {
  const int lane = TIDS & 63, w = TIDS >> 6, wr = w >> 1, wc = w & 1;
  f32x16 acc[2][2];
  ZERO_ACC(acc);
  if (lat) {
    const int b = ut >> 5, j = ut & 31;
    gemm128x(p.Wcs, 64, p.zf + ((long)(b * SEQ + 2 * j) * 256 + g * 64), 64 * 256, 32 * 64 * 256, 256, 64, acc, smem);
    u16* dst = p.Ytl + ((long)(b * 256 + g * 64) * 64 + 2 * j) * 128;
#pragma unroll
    for (int i = 0; i < 2; i++)
#pragma unroll
      for (int jj = 0; jj < 2; jj++)
#pragma unroll
        for (int r = 0; r < 16; r++) {
          const int e = i * 32 + (r & 3) + 8 * (r >> 2) + 4 * (lane >> 5);
          dst[((long)e * 64 + wc) * 128 + wr * 64 + jj * 32 + (lane & 31)] = tobf(acc[i][jj][r]);
        }
  } else {
    const int row0 = TLAT + ut * 128;
    gemm128(p.Wcs, 64, p.zf + (long)row0 * 256 + g * 64, 256, 64, acc, smem);
    const int b = (row0 - TLAT) >> 8, s0 = (row0 - TLAT) & 255;
#pragma unroll
    for (int i = 0; i < 2; i++)
#pragma unroll
      for (int jj = 0; jj < 2; jj++)
#pragma unroll
        for (int r = 0; r < 16; r++) {
          const int n = ACC_ROW(wr, i, r, lane);
          const int t = s0 + ACC_COL(wc, jj, lane);
          p.Ytc[((long)(b * 256 + g * 64 + (n & 63))) * 512 + (n >> 6) * 256 + t] = tobf(acc[i][jj][r]);
        }
  }
}

__device__ __forceinline__ void unit_conv(const Params& p, int L, int ut, char* smem) {
  float* U = (float*)smem;
  const int tid = TIDS, lane = tid & 63, w = tid >> 6;
  const int row0 = ut * 32;
  const bool lat = row0 < TLAT;
  const int seqlen = lat ? SEQ : CTXL;
  const int s0 = lat ? (row0 & 4095) : ((row0 - TLAT) & 255);
  __syncthreads();
  {
    uint4 ca[8], cg[8];
#pragma unroll
    for (int q = 0; q < 8; q++) {
      const int id = tid + 256 * q, i = id >> 5, k = id & 31;
      const int s = s0 - 15 + i;
      ca[q] = make_uint4(0u, 0u, 0u, 0u); cg[q] = ca[q];
      if (i < 62 && s >= 0 && s < seqlen) {
        const u16* zr = p.zc + (long)(row0 - 15 + i) * 512 + k * 8;
        ca[q] = ldg16(zr); cg[q] = ldg16(zr + 256);
      }
    }
#pragma unroll
    for (int q = 0; q < 8; q++) {
      const int id = tid + 256 * q, i = id >> 5, k = id & 31;
      if (i < 62) {
        float4 u0, u1;
        u0.x = bf_lo(ca[q].x) * sigmoidf_(bf_lo(cg[q].x)); u0.y = bf_hi(ca[q].x) * sigmoidf_(bf_hi(cg[q].x));
        u0.z = bf_lo(ca[q].y) * sigmoidf_(bf_lo(cg[q].y)); u0.w = bf_hi(ca[q].y) * sigmoidf_(bf_hi(cg[q].y));
        u1.x = bf_lo(ca[q].z) * sigmoidf_(bf_lo(cg[q].z)); u1.y = bf_hi(ca[q].z) * sigmoidf_(bf_hi(cg[q].z));
        u1.z = bf_lo(ca[q].w) * sigmoidf_(bf_lo(cg[q].w)); u1.w = bf_hi(ca[q].w) * sigmoidf_(bf_hi(cg[q].w));
        *(float4*)(U + i * 256 + k * 8) = u0;
        *(float4*)(U + i * 256 + k * 8 + 4) = u1;
      }
    }
  }
  __syncthreads();
  float wv[31];
#pragma unroll
  for (int j = 0; j < 31; j++) wv[j] = p.w_dw[(long)L * 31 * 256 + j * 256 + tid];
  const float bias = p.b_dw[L * 256 + tid];
#pragma unroll 2
  for (int t = 0; t < 32; t++) {
    float acc = bias;
#pragma unroll
    for (int j = 0; j < 31; j++) acc += U[(t + j) * 256 + tid] * wv[j];
    U[t * 256 + tid] = acc;
  }
  __syncthreads();
  const float4 gg = *(const float4*)(p.g_cln + L * 256 + lane * 4);
  const float4 bb = *(const float4*)(p.b_cln + L * 256 + lane * 4);
#pragma unroll
  for (int q = 0; q < 8; q++) {
    const int t = w * 8 + q;
    const float4 v = *(const float4*)(U + t * 256 + lane * 4);
    const float mu = wave_sum(v.x + v.y + v.z + v.w) * (1.0f / 256.0f);
    const float d0 = v.x - mu, d1 = v.y - mu, d2 = v.z - mu, d3 = v.w - mu;
    const float var = wave_sum(d0 * d0 + d1 * d1 + d2 * d2 + d3 * d3) * (1.0f / 256.0f);
    const float rs = rsqrtf(var + EPSV);
    const float y0 = siluf_(d0 * rs * gg.x + bb.x), y1 = siluf_(d1 * rs * gg.y + bb.y);
    const float y2 = siluf_(d2 * rs * gg.z + bb.z), y3 = siluf_(d3 * rs * gg.w + bb.w);
    *(uint2*)(p.cv + (long)(row0 + t) * 256 + lane * 4) = make_uint2(pack2(y0, y1), pack2(y2, y3));
  }
}

#ifndef S3_REP_MASK
#define S3_REP_MASK 7
#endif
__device__ __forceinline__ void phase_s3(const Params& p, int L, char* smem, bool rep = false) {
  const int msk = rep ? S3_REP_MASK : 7;
  char* sm = smem + HALF_ * LDS_SMALL;
  const int nrt_all = (L == 0) ? 272 : 256;
  if (msk & 1) { FOR_PAIRED(272 * 8, u) unit_kv(p, L, u >> 3, u & 7, sm); } }
  if (msk & 2) { FOR_PAIRED(nrt_all * 4, v) const int ut = v >> 2; unit_chdft(p, ut < 256 ? ut : ut - 256, v & 3, ut < 256, sm); } }
  if (msk & 4) { FOR_PAIRED(nrt_all * 4, v) unit_conv(p, L, v, sm); } }
}

#define KLD 104
__device__ __forceinline__ void unit_attn(const Params& p, int L, int b, int h, int qt, bool isctx, char* smem) {
  const int tf = TIDX, NT = (int)blockDim.x, nh = NT >> 8, half = tf >> 8, wf = tf >> 6;
  const int tid = tf & 255, lane = tid & 63, w = tid >> 6, hh = lane >> 5, c = lane & 31;
  const int qtile = qt * nh + half;
  const int qrow0 = isctx ? (TLAT + b * CTXL + qtile * 128) : (b * SEQ + qtile * 128);
  const int nkt = isctx ? (CTXL / 64) : (SKEYS / 64);
  char* smh = smem + half * LDS_SMALL;
  u16* As = (u16*)smh;
  u16* Bs = (u16*)(smh + 128 * LDT * 2);
  u16* Qs = (u16*)(smh + (128 + 96) * LDT * 2);
  f32x16 aq[3];
#pragma unroll
  for (int r = 0; r < 16; r++) { aq[0][r] = 0.f; aq[1][r] = 0.f; aq[2][r] = 0.f; }
  float ssq = 0.f;
  const u16* cqp = p.cq + (long)qrow0 * 256;
  const u16* wqp = p.WuqT + (long)L * WUQ_SZ + (long)h * 96 * 256;
  uint4 pa[4][4], pb[4][3];
#pragma unroll
  for (int kc = 0; kc < 4; kc++) {
#pragma unroll
    for (int i = 0; i < 4; i++) { const int idx = tid + 256 * i; pa[kc][i] = ldg16(cqp + (idx >> 3) * 256 + kc * 64 + (idx & 7) * 8); }
#pragma unroll
    for (int i = 0; i < 3; i++) { const int idx = tid + 256 * i; pb[kc][i] = ldg16(wqp + (idx >> 3) * 256 + kc * 64 + (idx & 7) * 8); }
  }
  __builtin_amdgcn_sched_barrier(0);
#pragma unroll
  for (int kc = 0; kc < 4; kc++) {
    __syncthreads();
#pragma unroll
    for (int i = 0; i < 4; i++) {
      const int idx = tid + 256 * i, rw = idx >> 3, ch = idx & 7;
      *(uint4*)(As + rw * LDT + ch * 8) = pa[kc][i];
    }
#pragma unroll
    for (int i = 0; i < 3; i++) {
      const int idx = tid + 256 * i, rw = idx >> 3, ch = idx & 7;
      *(uint4*)(Bs + rw * LDT + ch * 8) = pb[kc][i];
    }
    __syncthreads();
#pragma unroll
    for (int q = 0; q < 4; q++) {
      uint4 v = *(const uint4*)(As + (32 * w + c) * LDT + hh * 32 + q * 8);
      float a;
      a = bf_lo(v.x); ssq += a * a; a = bf_hi(v.x); ssq += a * a;
      a = bf_lo(v.y); ssq += a * a; a = bf_hi(v.y); ssq += a * a;
      a = bf_lo(v.z); ssq += a * a; a = bf_hi(v.z); ssq += a * a;
      a = bf_lo(v.w); ssq += a * a; a = bf_hi(v.w); ssq += a * a;
    }
#pragma unroll
    for (int kk = 0; kk < 4; kk++) {
      uint4 a = *(const uint4*)(As + (32 * w + c) * LDT + kk * 16 + hh * 8);
#pragma unroll
      for (int j = 0; j < 3; j++) {
        uint4 bq = *(const uint4*)(Bs + (32 * j + c) * LDT + kk * 16 + hh * 8);
        aq[j] = mfma32(a, bq, aq[j]);
      }
    }
  }
  ssq += __shfl_xor(ssq, 32);
  const float rr_lane = rsqrtf(ssq * (1.0f / 256.0f) + EPSV);
  {
    const float* gqn = p.g_qn + L * 96;
    const float g0 = gqn[c], g1 = gqn[32 + c], g2 = gqn[64 + c];
    const float qscale = 0.10206207261596577f * 1.4426950408889634f;
    u16* Qw = Qs + w * 32 * KLD;
#pragma unroll
    for (int r = 0; r < 16; r++) {
      const int rl = (r & 3) + 8 * (r >> 2) + 4 * hh;
      const float rc = __shfl(rr_lane, rl);
      const float q0 = aq[0][r] * rc, q1 = aq[1][r] * rc, q2 = aq[2][r] * rc;
      const float ss = half_sum(q0 * q0 + q1 * q1 + q2 * q2);
      const float rq = rsqrtf(ss * (1.0f / 96.0f) + EPSV);
      const float qn2 = q2 * rq * g2;
      const float partner = __shfl_xor(qn2, 8);
      float o2 = qn2;
      if (!isctx) {
        const int s = qtile * 128 + 32 * w + rl;
        const int pos = (c < 16) ? (s >> 6) : (s & 63);
        const float2 cs = *(const float2*)(p.ropetab + (pos * 8 + (c & 7)) * 2);
        const float rot = (c & 8) ? partner : -partner;
        o2 = qn2 * cs.x + rot * cs.y;
      }
      Qw[rl * KLD + c] = tobf(q0 * rq * g0 * qscale);
      Qw[rl * KLD + 32 + c] = tobf(q1 * rq * g1 * qscale);
      Qw[rl * KLD + 64 + c] = tobf(o2 * qscale);
    }
  }
  __syncthreads();
  uint4 qf[6];
#pragma unroll
  for (int s = 0; s < 6; s++) qf[s] = *(const uint4*)(Qs + (w * 32 + c) * KLD + s * 16 + hh * 8);
  __syncthreads();
  u16* Ks = (u16*)smem;
  u16* Vs = (u16*)(smem + 2 * 64 * KLD * 2);
  const u16* kg = p.Kb + (long)(b * 8 + h) * SKEYS * 96;
  const u16* vg = p.Vtb + (long)(b * 8 + h) * 64 * SKEYS;
  uint4 rk[3], rv[2];
  int krow[3], kch[3], vrw[2], vch[2];
#pragma unroll
  for (int i = 0; i < 3; i++) { const int idx = tf + NT * i; krow[i] = idx / 12; kch[i] = idx % 12; }
#pragma unroll
  for (int i = 0; i < 2; i++) { const int idx = tf + NT * i; vrw[i] = idx >> 3; vch[i] = idx & 7; }
#pragma unroll
  for (int i = 0; i < 3; i++) if (tf + NT * i < 768) rk[i] = ldg16(kg + (long)(tf + NT * i) * 8);
#pragma unroll
  for (int i = 0; i < 2; i++) if (tf + NT * i < 512) rv[i] = ldg16(vg + (long)vrw[i] * SKEYS + vch[i] * 8);
#pragma unroll
  for (int i = 0; i < 3; i++) if (tf + NT * i < 768) *(uint4*)(Ks + krow[i] * KLD + kch[i] * 8) = rk[i];
#pragma unroll
  for (int i = 0; i < 2; i++) if (tf + NT * i < 512) *(uint4*)(Vs + vrw[i] * LDT + vch[i] * 8) = rv[i];
  __syncthreads();
  f32x16 aO[2];
#pragma unroll
  for (int r = 0; r < 16; r++) { aO[0][r] = 0.f; aO[1][r] = 0.f; }
  float mref = 0.f;
  f32x2 lsum2 = {0.f, 0.f};
  const int kperm = (c & ~12) | ((c & 4) << 1) | ((c & 8) >> 1);
  for (int kt = 0; kt < nkt; kt++) {
    const int cur = kt & 1;
    if (kt + 1 < nkt) {
#pragma unroll
      for (int i = 0; i < 3; i++) if (tf + NT * i < 768) rk[i] = ldg16(kg + (long)(kt + 1) * 64 * 96 + (long)(tf + NT * i) * 8);
#pragma unroll
      for (int i = 0; i < 2; i++) if (tf + NT * i < 512) rv[i] = ldg16(vg + (long)vrw[i] * SKEYS + (kt + 1) * 64 + vch[i] * 8);
    }
    __builtin_amdgcn_sched_barrier(0);
    const u16* Kc = Ks + cur * 64 * KLD;
    const u16* Vc = Vs + cur * 64 * LDT;
    f32x16 aS[2];
    {
      const float nm = -mref;
#pragma unroll
      for (int r = 0; r < 16; r++) { aS[0][r] = nm; aS[1][r] = nm; }
    }
#pragma unroll
    for (int s = 0; s < 6; s++) {
      uint4 k0 = *(const uint4*)(Kc + (kperm) * KLD + s * 16 + hh * 8);
      uint4 k1 = *(const uint4*)(Kc + (32 + kperm) * KLD + s * 16 + hh * 8);
      aS[0] = mfma32(k0, qf[s], aS[0]);
      aS[1] = mfma32(k1, qf[s], aS[1]);
    }
    float mx = fmaxf(aS[0][0], aS[1][0]);
#pragma unroll
    for (int r = 1; r < 16; r++) mx = fmaxf(fmaxf(mx, aS[0][r]), aS[1][r]);
    if (__any(mx > 8.0f)) {
      const float mo = fmaxf(mx, __shfl_xor(mx, 32));
      const float delta = (mo > 8.0f) ? mo : 0.f;
      const float alpha = __builtin_amdgcn_exp2f(-delta);
      mref += delta;
      lsum2 *= alpha;
#pragma unroll
      for (int r = 0; r < 16; r++) {
        aO[0][r] *= alpha; aO[1][r] *= alpha;
        aS[0][r] -= delta; aS[1][r] -= delta;
      }
    }
#pragma unroll
    for (int r = 0; r < 16; r += 2) {
      aS[0][r] = __builtin_amdgcn_exp2f(aS[0][r]); aS[0][r + 1] = __builtin_amdgcn_exp2f(aS[0][r + 1]);
      aS[1][r] = __builtin_amdgcn_exp2f(aS[1][r]); aS[1][r + 1] = __builtin_amdgcn_exp2f(aS[1][r + 1]);
      const f32x2 p0 = {aS[0][r], aS[0][r + 1]}, p1 = {aS[1][r], aS[1][r + 1]};
      lsum2 += p0; lsum2 += p1;
    }
#pragma unroll
    for (int i = 0; i < 2; i++)
#pragma unroll
      for (int s2 = 0; s2 < 2; s2++) {
        uint4 pf = make_uint4(pack2(aS[i][8 * s2 + 0], aS[i][8 * s2 + 1]), pack2(aS[i][8 * s2 + 2], aS[i][8 * s2 + 3]),
                              pack2(aS[i][8 * s2 + 4], aS[i][8 * s2 + 5]), pack2(aS[i][8 * s2 + 6], aS[i][8 * s2 + 7]));
        uint4 v0 = *(const uint4*)(Vc + (c) * LDT + 32 * i + 16 * s2 + 8 * hh);
        uint4 v1 = *(const uint4*)(Vc + (32 + c) * LDT + 32 * i + 16 * s2 + 8 * hh);
        aO[0] = mfma32(v0, pf, aO[0]);
        aO[1] = mfma32(v1, pf, aO[1]);
      }
    if (kt + 1 < nkt) {
      const int nx = cur ^ 1;
#pragma unroll
      for (int i = 0; i < 3; i++) if (tf + NT * i < 768) *(uint4*)(Ks + nx * 64 * KLD + krow[i] * KLD + kch[i] * 8) = rk[i];
#pragma unroll
      for (int i = 0; i < 2; i++) if (tf + NT * i < 512) *(uint4*)(Vs + nx * 64 * LDT + vrw[i] * LDT + vch[i] * 8) = rv[i];
    }
    __syncthreads();
  }
  float lsum = lsum2.x + lsum2.y;
  lsum += __shfl_xor(lsum, 32);
  const float inv = 1.0f / lsum;
  u16* Os = (u16*)smem + wf * 32 * LDT;
#pragma unroll
  for (int i = 0; i < 2; i++)
#pragma unroll
    for (int r = 0; r < 16; r++) {
      const int d = 32 * i + (r & 3) + 8 * (r >> 2) + 4 * hh;
      Os[c * LDT + d] = tobf(aO[i][r] * inv);
    }
  __syncthreads();
#pragma unroll
  for (int i = 0; i < 4; i++) {
    const int idx = lane + 64 * i, q = idx >> 3, ch = idx & 7;
    *(uint4*)(p.Ob + (long)(qrow0 + 32 * w + q) * 512 + h * 64 + ch * 8) = *(const uint4*)(Os + q * LDT + ch * 8);
  }
}

__device__ __forceinline__ void unit_dftA(const Params& p, int b, int np, char* smem) {
  const int lane = TIDS & 63, w = TIDS >> 6, wr = w >> 1, wc = w & 1, hh = lane >> 5, c = lane & 31;
  f32x16 acc[2][2];
  ZERO_ACC(acc);
  gemm128(p.WA, 128, p.Ytl + (long)(b * 256 + 2 * np) * 64 * 128, 128, 128, acc, smem);
  const int n = 2 * np + wc;
#pragma unroll
  for (int jj = 0; jj < 2; jj++) {
    const int t2 = jj * 32 + c;
#pragma unroll
    for (int r = 0; r < 16; r++) {
      const int k1 = wr * 32 + (r & 3) + 8 * (r >> 2) + 4 * hh;
      const float2 t = *(const float2*)(p.tw + 2 * ((k1 * t2) & 4095));
      const float gr = acc[0][jj][r], gi = acc[1][jj][r];
      u16* dst = p.GB + ((long)((b * 64 + k1) * 256 + n)) * 128 + t2;
      dst[0] = tobf(gr * t.x + gi * t.y);
      dst[64] = tobf(gi * t.x - gr * t.y);
    }
  }
}
__device__ __forceinline__ void unit_dftC(const Params& p, int b, int k1, int nt, char* smem) {
  const int lane = TIDS & 63, w = TIDS >> 6, wr = w >> 1, wc = w & 1, hh = lane >> 5, c = lane & 31;
  f32x16 acc[2][2];
  ZERO_ACC(acc);
  gemm128(p.WC, 128, p.GB + ((long)((b * 64 + k1) * 256 + nt * 128)) * 128, 128, 128, acc, smem);
  if (wr == 0) {
#pragma unroll
    for (int i = 0; i < 2; i++)
#pragma unroll
      for (int jj = 0; jj < 2; jj++)
#pragma unroll
        for (int r = 0; r < 16; r++) {
          const int k2 = i * 32 + (r & 3) + 8 * (r >> 2) + 4 * hh;
          p.Fb[((long)b * SEQ + k1 + 64 * k2) * 256 + nt * 128 + wc * 64 + jj * 32 + c] = tobf(acc[i][jj][r]);
        }
  }
}
__device__ __forceinline__ void unit_seqdft_ctx(const Params& p, int b, int mt, int nt, char* smem) {
  const int lane = TIDS & 63, w = TIDS >> 6, wr = w >> 1, wc = w & 1;
  f32x16 acc[2][2];
  ZERO_ACC(acc);
  gemm128(p.Dctx + (long)mt * 128 * 512, 512, p.Ytc + (long)(b * 256 + nt * 128) * 512, 512, 512, acc, smem);
  const long orow0 = (long)TLAT + b * CTXL + mt * 128;
#pragma unroll
  for (int i = 0; i < 2; i++)
#pragma unroll
    for (int j = 0; j < 2; j++)
#pragma unroll
      for (int r = 0; r < 16; r++)
        p.Fb[(orow0 + ACC_ROW(wr, i, r, lane)) * 256 + nt * 128 + ACC_COL(wc, j, lane)] = tobf(acc[i][j][r]);
}
__device__ __forceinline__ void phase_dftC(const Params& p, char* smem) {
  char* sm = smem + HALF_ * LDS_SMALL;
  FOR_PAIRED(8 * 64 * 2, u) unit_dftC(p, u >> 7, (u >> 1) & 63, u & 1, sm); }
}

__device__ __forceinline__ void phase_s4(const Params& p, int L, char* smem) {
  char* sm = smem + HALF_ * LDS_SMALL;
  const int nh = (int)(blockDim.x >> 8), tpp = 32 / nh;
  {
    const int x = blockIdx.x & 7, l = blockIdx.x >> 3, nl = gridDim.x >> 3;
    for (int s = l; s < 8 * tpp; s += nl) {
      const int bh = x * 8 + s / tpp;
      unit_attn(p, L, bh >> 3, bh & 7, s % tpp, false, smem);
    }
  }
  FOR_PAIRED(8 * 128, v) unit_dftA(p, v >> 7, v & 127, sm); }
  if (L == 0) {
    FOR_PAIRED(8 * 2 * 2, v) unit_seqdft_ctx(p, v >> 2, (v >> 1) & 1, v & 1, sm); }
    const int tpc = 2 / nh;
    for (int v = blockIdx.x; v < 64 * tpc; v += gridDim.x) unit_attn(p, L, (v / tpc) >> 3, (v / tpc) & 7, v % tpc, true, smem);
  }
}

template <bool BIG>
__device__ __forceinline__ void phase_s7(const Params& p, int L, char* smem) {
  constexpr int TM = BIG ? 256 : 128;
  const int nrt = ((L == 0) ? RTOT : TLAT) / TM;
  FOR_UNITS_XCD(nrt, 8, rt, ct)
    const int row0 = rt * TM;
    f32x16 macc[2][2];
    ZERO_ACC(macc);
#pragma unroll 1
    for (int br = 0; br < 3; br++) {
      unsigned gp[2][2][8];
      {
      f32x16 acc[2][2];
      ZERO_ACC(acc);
      if constexpr (BIG) gemm256(p.hx + (long)row0 * 1024, 1024, p.WgT + (long)L * WGT_SZ + (long)(br * 1024 + ct * 128) * 1024, 1024, 1024, acc, smem);
      else gemm128(p.hx + (long)row0 * 1024, 1024, p.WgT + (long)L * WGT_SZ + (long)(br * 1024 + ct * 128) * 1024, 1024, 1024, acc, smem);
#pragma unroll
      for (int i = 0; i < 2; i++)
#pragma unroll
        for (int j = 0; j < 2; j++)
#pragma unroll
          for (int r = 0; r < 8; r++) gp[i][j][r] = pack2(sigmoidf_(acc[i][j][2 * r]), sigmoidf_(acc[i][j][2 * r + 1]));
      }
      const u16* A2; const u16* B2; int K2;
      if (br == 0) { A2 = p.Ob + (long)row0 * 512; B2 = p.WbaT + (long)L * WBA_SZ + (long)ct * 128 * 512; K2 = 512; }
      else if (br == 1) { A2 = p.Fb + (long)row0 * 256; B2 = p.WbfT + (long)L * WBF_SZ + (long)ct * 128 * 256; K2 = 256; }
      else { A2 = p.cv + (long)row0 * 256; B2 = p.WbcT + (long)L * WBC_SZ + (long)ct * 128 * 256; K2 = 256; }
      {
        f32x16 ab[2][2];
        ZERO_ACC(ab);
        if constexpr (BIG) gemm256(A2, K2, B2, K2, K2, ab, smem); else gemm128(A2, K2, B2, K2, K2, ab, smem);
#pragma unroll
        for (int i = 0; i < 2; i++)
#pragma unroll
          for (int j = 0; j < 2; j++)
#pragma unroll
            for (int r = 0; r < 8; r++) {
              if ((ABL_BR >> br) & 1) {
              macc[i][j][2 * r] += bf_lo(gp[i][j][r]) * ab[i][j][2 * r];
              macc[i][j][2 * r + 1] += bf_hi(gp[i][j][r]) * ab[i][j][2 * r + 1];
              }
            }
      }
    }
    u16* mp = p.m + (long)row0 * 1024 + ct * 128;
    const int tid = TIDX, lane = tid & 63, w = tid >> 6, wr = w >> 1, wc = w & 1;
    const int tb = (wr * 64 + 4 * (lane >> 5)) * 1024 + wc * 64 + (lane & 31);
#pragma unroll
    for (int i = 0; i < 2; i++)
#pragma unroll
      for (int j = 0; j < 2; j++)
#pragma unroll
        for (int r = 0; r < 16; r++)
          mp[tb + (i * 32 + (r & 3) + 8 * (r >> 2)) * 1024 + j * 32] = tobf(macc[i][j][r]);
  }
}

template <bool BIG>
__device__ __forceinline__ void phase_s8(const Params& p, int L, char* smem, bool dry = false) {
  constexpr int TM = BIG ? 256 : 128;
  const int lane = TIDX & 63, w = TIDX >> 6, wr = w >> 1, wc = w & 1;
  const int nrt = ((L == 0) ? RTOT : TLAT) / TM;
  FOR_UNITS_XCD(nrt, 8, rt, ct)
    const long row0 = (long)rt * TM;
    f32x16 acc[2][2];
    ZERO_ACC(acc);
    if constexpr (BIG) gemm256(p.m + row0 * 1024, 1024, p.WoutT + (long)L * WOUT_SZ + (long)ct * 128 * 1024, 1024, 1024, acc, smem);
    else gemm128(p.m + row0 * 1024, 1024, p.WoutT + (long)L * WOUT_SZ + (long)ct * 128 * 1024, 1024, 1024, acc, smem);
    const int mr = row_mod((int)row0);
    const float* gt = p.mods + (long)(L * 9 + mr) * 6144 + 2048 + ct * 128;
    const float* src; float* dst;
    if (row0 < TLAT) { src = (L == 0 ? p.x : p.out) + row0 * 1024; dst = p.out + row0 * 1024; }
    else { src = (L == 0 ? p.ctx : p.ctx1) + (row0 - TLAT) * 1024; dst = p.ctx1 + (row0 - TLAT) * 1024; }
    src += ct * 128; dst += ct * 128;
    const int tb = opaque((wr * 64 + 4 * (lane >> 5)) * 1024 + wc * 64 + (lane & 31));
#pragma unroll
    for (int j = 0; j < 2; j++) {
      const float gv = gt[ACC_COL(wc, j, lane)];
#pragma unroll
      for (int i = 0; i < 2; i++)
#pragma unroll
        for (int r = 0; r < 16; r++) {
          const int o = tb + (i * 32 + (r & 3) + 8 * (r >> 2)) * 1024 + j * 32;
          const float nv = src[o] + gv * acc[i][j][r];
          if (!dry) dst[o] = nv;
        }
    }
  }
}

#define CE_DESC(a, b) { const float _x = fmaxf(a, b); const float _y = fminf(a, b); a = _x; b = _y; }
template <int N>
__device__ __forceinline__ void bitonic_sort_desc(float (&v)[N]) {
#pragma unroll
  for (int k = 2; k <= N; k <<= 1)
#pragma unroll
    for (int j = k >> 1; j > 0; j >>= 1)
#pragma unroll
      for (int i = 0; i < N; i++) {
        const int l = i ^ j;
        if (l > i) {
          if ((i & k) == 0) { CE_DESC(v[i], v[l]); } else { CE_DESC(v[l], v[i]); }
        }
      }
}
template <int N>
__device__ __forceinline__ void bitonic_merge_desc(float (&v)[N]) {
#pragma unroll
  for (int j = N >> 1; j > 0; j >>= 1)
#pragma unroll
    for (int i = 0; i < N; i++) {
      const int l = i ^ j;
      if (l > i) { CE_DESC(v[i], v[l]); }
    }
}
__device__ __forceinline__ void merge_top16(float (&a)[16], const float (&b)[16]) {
#pragma unroll
  for (int i = 0; i < 16; i++) a[i] = fmaxf(a[i], b[15 - i]);
  bitonic_merge_desc<16>(a);
}
__device__ __forceinline__ void top16_of_tiles(const f32x16 (&s)[4], int hh, float (&res)[16]) {
  float g[4][16];
#pragma unroll
  for (int t = 0; t < 4; t++) {
#pragma unroll
    for (int r = 0; r < 16; r++) {
      const unsigned key = (unsigned)(32 * t + (r & 3) + 8 * (r >> 2)) + (unsigned)(4 * hh);
      g[t][r] = __uint_as_float((__float_as_uint(s[t][r]) & 0xffffff80u) | key);
    }
    bitonic_sort_desc<16>(g[t]);
  }
  merge_top16(g[0], g[1]);
  merge_top16(g[2], g[3]);
  merge_top16(g[0], g[2]);
  float o[16];
#pragma unroll
  for (int i = 0; i < 16; i++) o[i] = __shfl_xor(g[0][i], 32);
  merge_top16(g[0], o);
#pragma unroll
  for (int i = 0; i < 16; i++) res[i] = g[0][i];
}

template <bool BIG>
__device__ __forceinline__ void unit_peer_query(const Params& p, int L, int rt, int h, char* smem) {
  constexpr int TM = BIG ? 256 : 128, NT = BIG ? 512 : 256;
  const int tid = TIDX, lane = tid & 63, w = tid >> 6, wr = w >> 1, wc = w & 1, hh = lane >> 5, c = lane & 31;
  const long row0 = (long)rt * TM;
  u16* Qs = (u16*)smem;
  u16* Ss = (u16*)(smem + TM * 136 * 2);
  {
    f32x16 acc[2][2];
    ZERO_ACC(acc);
    if constexpr (BIG) gemm256(p.hx + row0 * 1024, 1024, p.WqT + (long)L * WQ_SZ + (long)h * 128 * 1024, 1024, 1024, acc, smem);
    else gemm128(p.hx + row0 * 1024, 1024, p.WqT + (long)L * WQ_SZ + (long)h * 128 * 1024, 1024, 1024, acc, smem);
#pragma unroll
    for (int i = 0; i < 2; i++)
#pragma unroll
      for (int j = 0; j < 2; j++)
#pragma unroll
        for (int r = 0; r < 16; r++) Qs[ACC_ROW(wr, i, r, lane) * 136 + ACC_COL(wc, j, lane)] = tobf(acc[i][j][r]);
    const u16* sk = p.SubK + (long)L * SUBK_SZ + (long)h * 2 * 128 * 64;
#pragma unroll
    for (int i = 0; i < 2048 / NT; i++) {
      const int idx = tid + NT * i, rw = idx >> 3, ch = idx & 7;
      *(uint4*)(Ss + rw * LDT + ch * 8) = ldg16(sk + rw * 64 + ch * 8);
    }
  }
  __syncthreads();
  float top[2][16];
#pragma unroll
  for (int pp = 0; pp < 2; pp++) {
    f32x16 s[4];
#pragma unroll
    for (int t = 0; t < 4; t++)
#pragma unroll
      for (int r = 0; r < 16; r++) s[t][r] = 0.f;
#pragma unroll
    for (int kk = 0; kk < 4; kk++) {
      uint4 bq = *(const uint4*)(Qs + (32 * w + c) * 136 + pp * 64 + kk * 16 + hh * 8);
#pragma unroll
      for (int t = 0; t < 4; t++) {
        uint4 ak = *(const uint4*)(Ss + (pp * 128 + 32 * t + c) * LDT + kk * 16 + hh * 8);
        s[t] = mfma32(ak, bq, s[t]);
      }
    }
    top16_of_tiles(s, hh, top[pp]);
  }
  float cand[64];
#define CAND(q, a, b) cand[q] = __uint_as_float((__float_as_uint(top[0][a] + top[1][b]) & 0xffffff00u) | (unsigned)((a) * 16 + (b)));
  CAND(0, 0, 0)
  CAND(1, 0, 1)
  CAND(2, 0, 2)
  CAND(3, 0, 3)
  CAND(4, 0, 4)
  CAND(5, 0, 5)
  CAND(6, 0, 6)
  CAND(7, 0, 7)
  CAND(8, 0, 8)
  CAND(9, 0, 9)
  CAND(10, 0, 10)
  CAND(11, 0, 11)
  CAND(12, 0, 12)
  CAND(13, 0, 13)
  CAND(14, 0, 14)
  CAND(15, 0, 15)
  CAND(16, 1, 0)
  CAND(17, 1, 1)
  CAND(18, 1, 2)
  CAND(19, 1, 3)
  CAND(20, 1, 4)
  CAND(21, 1, 5)
  CAND(22, 1, 6)
  CAND(23, 1, 7)
  CAND(24, 2, 0)
  CAND(25, 2, 1)
  CAND(26, 2, 2)
  CAND(27, 2, 3)
  CAND(28, 2, 4)
  CAND(29, 3, 0)
  CAND(30, 3, 1)
  CAND(31, 3, 2)
  CAND(32, 3, 3)
  CAND(33, 4, 0)
  CAND(34, 4, 1)
  CAND(35, 4, 2)
  CAND(36, 5, 0)
  CAND(37, 5, 1)
  CAND(38, 6, 0)
  CAND(39, 6, 1)
  CAND(40, 7, 0)
  CAND(41, 7, 1)
  CAND(42, 8, 0)
  CAND(43, 9, 0)
  CAND(44, 10, 0)
  CAND(45, 11, 0)
  CAND(46, 12, 0)
  CAND(47, 13, 0)
  CAND(48, 14, 0)
  CAND(49, 15, 0)
#undef CAND
#pragma unroll
  for (int q = 50; q < 64; q++) cand[q] = -3.0e38f;
  float best[16];
  {
    float g[4][16];
#pragma unroll
    for (int t = 0; t < 4; t++) {
#pragma unroll
      for (int r = 0; r < 16; r++) g[t][r] = cand[t * 16 + r];
      bitonic_sort_desc<16>(g[t]);
    }
    merge_top16(g[0], g[1]);
    merge_top16(g[2], g[3]);
    merge_top16(g[0], g[2]);
#pragma unroll
    for (int i = 0; i < 16; i++) best[i] = g[0][i];
  }
  float e[16], es = 0.f;
#pragma unroll
  for (int i = 0; i < 16; i++) { e[i] = __expf(best[i] - best[0]); es += e[i]; }
  const float einv = 1.0f / es;
  __syncthreads();
  int* Ix = (int*)smem + w * 32 * 33;
  if (hh == 0) {
#pragma unroll
    for (int i = 0; i < 16; i++) {
      Ix[c * 33 + i] = (int)(__float_as_uint(top[0][i]) & 127u);
      Ix[c * 33 + 16 + i] = (int)(__float_as_uint(top[1][i]) & 127u);
    }
  }
  __syncthreads();
  const long orow = row0 + 32 * w + c;
  int* ed = p.eid + orow * 128 + h * 16 + hh * 8;
  float* gd = p.gate + orow * 128 + h * 16 + hh * 8;
  int ev[8]; float gv[8];
#pragma unroll
  for (int i = 0; i < 8; i++) {
    const unsigned hm = 0u - (unsigned)hh;
    const unsigned bselu = (__float_as_uint(best[8 + i]) & hm) | (__float_as_uint(best[i]) & ~hm);
    const float esel = __uint_as_float((__float_as_uint(e[8 + i]) & hm) | (__float_as_uint(e[i]) & ~hm));
    const unsigned id = bselu & 255u;
    const int ia = Ix[c * 33 + (id >> 4)], ib = Ix[c * 33 + 16 + (id & 15)];
    ev[i] = ia * 128 + ib;
    gv[i] = esel * einv;
  }
  *(int4*)(ed) = make_int4(ev[0], ev[1], ev[2], ev[3]);
  *(int4*)(ed + 4) = make_int4(ev[4], ev[5], ev[6], ev[7]);
  *(float4*)(gd) = make_float4(gv[0], gv[1], gv[2], gv[3]);
  *(float4*)(gd + 4) = make_float4(gv[4], gv[5], gv[6], gv[7]);
}

template <bool BIG>
__device__ __forceinline__ void phase_s10(const Params& p, int L, char* smem) {
  const int nrt = ((L == 0) ? RTOT : TLAT) / (BIG ? 256 : 128);
  FOR_UNITS_XCD(nrt, 8, rt, hd) unit_peer_query<BIG>(p, L, rt, hd, smem); }
}

#define CVT8(w, lo2, hi2) { lo2 = __builtin_amdgcn_cvt_pk_f32_fp8((int)(w), false); hi2 = __builtin_amdgcn_cvt_pk_f32_fp8((int)(w), true); }
#if CHECK_ATTN
#define NB11 1
#else
#define NB11 2
#endif
__device__ __forceinline__ void phase_s11a(const Params& p, int L) {
  const int lane = TIDS & 63, j = lane >> 3, cch = lane & 7;
  const int sl = VBID & 7;
  const int lw = (VBID >> 3) * 4 + (TIDS >> 6), nlw = (NVB >> 3) * 4;
  const int nrows = (L == 0) ? RTOT : TLAT;
  const unsigned char* Us = p.UT8 + (long)sl * NEXP * 128 + cch * 16;
  int rrN[NB11]; bool okN[NB11];
  uint4 haN[NB11], hbN[NB11]; int e_loN[NB11], e_hiN[NB11];
  auto load_idx = [&](int r0) __attribute__((always_inline)) {
#pragma unroll
    for (int u = 0; u < NB11; u++) {
      const int r = r0 + u * nlw;
      okN[u] = r < nrows; rrN[u] = okN[u] ? r : lw;
      haN[u] = ldg16(p.hx + (long)rrN[u] * 1024 + sl * 128 + cch * 16);
      hbN[u] = ldg16(p.hx + (long)rrN[u] * 1024 + sl * 128 + cch * 16 + 8);
      e_loN[u] = p.eid[(long)rrN[u] * 128 + lane]; e_hiN[u] = p.eid[(long)rrN[u] * 128 + 64 + lane];
    }
  };
  if (lw < nrows) load_idx(lw);
  for (int r0 = lw; r0 < nrows; r0 += NB11 * nlw) {
    int rr[NB11]; bool ok[NB11];
    uint4 ha[NB11], hb[NB11]; int e_lo[NB11], e_hi[NB11];
#pragma unroll
    for (int u = 0; u < NB11; u++) { rr[u] = rrN[u]; ok[u] = okN[u]; ha[u] = haN[u]; hb[u] = hbN[u]; e_lo[u] = e_loN[u]; e_hi[u] = e_hiN[u]; }
    uint4 uu[NB11][16];
#pragma unroll
    for (int u = 0; u < NB11; u++)
#pragma unroll
      for (int i = 0; i < 16; i++) {
        const int e = __shfl(i < 8 ? e_lo[u] : e_hi[u], 8 * (i & 7) + j);
        uu[u][i] = ldg16(Us + (long)e * 128);
      }
    if (r0 + NB11 * nlw < nrows) load_idx(r0 + NB11 * nlw);
    __builtin_amdgcn_sched_barrier(0);
#pragma unroll
    for (int u = 0; u < NB11; u++) {
      f32x2 h2[8];
      h2[0] = f32x2{bf_lo(ha[u].x), bf_hi(ha[u].x)}; h2[1] = f32x2{bf_lo(ha[u].y), bf_hi(ha[u].y)};
      h2[2] = f32x2{bf_lo(ha[u].z), bf_hi(ha[u].z)}; h2[3] = f32x2{bf_lo(ha[u].w), bf_hi(ha[u].w)};
      h2[4] = f32x2{bf_lo(hb[u].x), bf_hi(hb[u].x)}; h2[5] = f32x2{bf_lo(hb[u].y), bf_hi(hb[u].y)};
      h2[6] = f32x2{bf_lo(hb[u].z), bf_hi(hb[u].z)}; h2[7] = f32x2{bf_lo(hb[u].w), bf_hi(hb[u].w)};
      float d[16];
#pragma unroll
      for (int i = 0; i < 16; i++) {
        f32x2 a0, a1, acc = {0.f, 0.f};
        CVT8(uu[u][i].x, a0, a1); acc += a0 * h2[0]; acc += a1 * h2[1];
        CVT8(uu[u][i].y, a0, a1); acc += a0 * h2[2]; acc += a1 * h2[3];
        CVT8(uu[u][i].z, a0, a1); acc += a0 * h2[4]; acc += a1 * h2[5];
        CVT8(uu[u][i].w, a0, a1); acc += a0 * h2[6]; acc += a1 * h2[7];
        d[i] = acc.x + acc.y;
      }
      float t8[8], t4[4], t2[2];
      { const bool up = (lane & 4) != 0;
#pragma unroll
        for (int k = 0; k < 8; k++) { const float send = up ? d[k] : d[k + 8], keep = up ? d[k + 8] : d[k]; t8[k] = keep + __shfl_xor(send, 4); } }
      { const bool up = (lane & 2) != 0;
#pragma unroll
        for (int k = 0; k < 4; k++) { const float send = up ? t8[k] : t8[k + 4], keep = up ? t8[k + 4] : t8[k]; t4[k] = keep + __shfl_xor(send, 2); } }
      { const bool up = (lane & 1) != 0;
#pragma unroll
        for (int k = 0; k < 2; k++) { const float send = up ? t4[k] : t4[k + 2], keep = up ? t4[k + 2] : t4[k]; t2[k] = keep + __shfl_xor(send, 1); } }
      if (ok[u]) p.PD[((long)sl * RTOT + rr[u]) * 64 + cch * 8 + j] = pack2(t2[0], t2[1]);
    }
  }
}
__device__ __forceinline__ void phase_s11b(const Params& p, int L, bool dry = false) {
  const int lane = TIDS & 63, j = lane >> 3, cch = lane & 7;
  const int sl = VBID & 7;
  const int lw = (VBID >> 3) * 4 + (TIDS >> 6), nlw = (NVB >> 3) * 4;
  const int nrows = (L == 0) ? RTOT : TLAT;
  const unsigned char* Vs = p.VT8 + (long)sl * NEXP * 128 + cch * 16;
  const int P0 = 16 * (lane >> 3) + (lane & 7);
  const int col = sl * 128 + cch * 16 + 2 * j;
  int rrN[NB11]; bool okN[NB11];
  unsigned pwN[NB11][8]; float g0N[NB11], g1N[NB11]; int e_loN[NB11], e_hiN[NB11];
  auto load_idx = [&](int r0) __attribute__((always_inline)) {
#pragma unroll
    for (int u = 0; u < NB11; u++) {
      const int r = r0 + u * nlw;
      okN[u] = r < nrows; rrN[u] = okN[u] ? r : lw;
#pragma unroll
      for (int s2 = 0; s2 < 8; s2++) pwN[u][s2] = p.PD[((long)s2 * RTOT + rrN[u]) * 64 + lane];
      g0N[u] = p.gate[(long)rrN[u] * 128 + P0]; g1N[u] = p.gate[(long)rrN[u] * 128 + P0 + 8];
      e_loN[u] = p.eid[(long)rrN[u] * 128 + lane]; e_hiN[u] = p.eid[(long)rrN[u] * 128 + 64 + lane];
    }
  };
  if (lw < nrows) load_idx(lw);
  for (int r0 = lw; r0 < nrows; r0 += NB11 * nlw) {
    int rr[NB11]; bool ok[NB11];
    unsigned pw[NB11][8]; float g0[NB11], g1[NB11]; int e_lo[NB11], e_hi[NB11];
#pragma unroll
    for (int u = 0; u < NB11; u++) {
      rr[u] = rrN[u]; ok[u] = okN[u]; g0[u] = g0N[u]; g1[u] = g1N[u]; e_lo[u] = e_loN[u]; e_hi[u] = e_hiN[u];
#pragma unroll
      for (int s2 = 0; s2 < 8; s2++) pw[u][s2] = pwN[u][s2];
    }
    uint4 vv[NB11][16];
#pragma unroll
    for (int u = 0; u < NB11; u++)
#pragma unroll
      for (int i = 0; i < 16; i++) {
        const int e = __shfl(i < 8 ? e_lo[u] : e_hi[u], 8 * (i & 7) + j);
        vv[u][i] = ldg16(Vs + (long)e * 128);
      }
    if (r0 + NB11 * nlw < nrows) load_idx(r0 + NB11 * nlw);
    __builtin_amdgcn_sched_barrier(0);
#pragma unroll
    for (int u = 0; u < NB11; u++) {
      float d0 = 0.f, d1 = 0.f;
#pragma unroll
      for (int s2 = 0; s2 < 8; s2++) { d0 += bf_lo(pw[u][s2]); d1 += bf_hi(pw[u][s2]); }
      const float act0 = gelu_tanh(d0 * (1.0f / U8_SCALE)) * g0[u] * (1.0f / V8_SCALE);
      const float act1 = gelu_tanh(d1 * (1.0f / U8_SCALE)) * g1[u] * (1.0f / V8_SCALE);
      f32x2 o2[8];
#pragma unroll
      for (int q = 0; q < 8; q++) o2[q] = f32x2{0.f, 0.f};
#pragma unroll
      for (int i = 0; i < 16; i++) {
        const float a = __shfl((i & 1) ? act1 : act0, (i >> 1) * 8 + j);
        const f32x2 aa = {a, a};
        f32x2 a0, a1;
        CVT8(vv[u][i].x, a0, a1); o2[0] += aa * a0; o2[1] += aa * a1;
        CVT8(vv[u][i].y, a0, a1); o2[2] += aa * a0; o2[3] += aa * a1;
        CVT8(vv[u][i].z, a0, a1); o2[4] += aa * a0; o2[5] += aa * a1;
        CVT8(vv[u][i].w, a0, a1); o2[6] += aa * a0; o2[7] += aa * a1;
      }
      float o[16];
#pragma unroll
      for (int q = 0; q < 8; q++) { o[2 * q] = o2[q].x; o[2 * q + 1] = o2[q].y; }
      float t8[8], t4[4], t2[2];
      { const bool up = (lane & 32) != 0;
#pragma unroll
        for (int k = 0; k < 8; k++) { const float send = up ? o[k] : o[k + 8], keep = up ? o[k + 8] : o[k]; t8[k] = keep + __shfl_xor(send, 32); } }
      { const bool up = (lane & 16) != 0;
#pragma unroll
        for (int k = 0; k < 4; k++) { const float send = up ? t8[k] : t8[k + 4], keep = up ? t8[k + 4] : t8[k]; t4[k] = keep + __shfl_xor(send, 16); } }
      { const bool up = (lane & 8) != 0;
#pragma unroll
        for (int k = 0; k < 2; k++) { const float send = up ? t4[k] : t4[k + 2], keep = up ? t4[k + 2] : t4[k]; t2[k] = keep + __shfl_xor(send, 8); } }
      if (!ABL_PEER || !ok[u]) continue;
      const int r = rr[u];
      float* xr = ((r < TLAT) ? p.out + (long)r * 1024 : p.ctx1 + (long)(r - TLAT) * 1024) + col;
      const float2 gt = *(const float2*)(p.mods + (long)(L * 9 + row_mod(r)) * 6144 + 5120 + col);
      float2 xv = *(const float2*)xr;
      xv.x += gt.x * t2[0]; xv.y += gt.y * t2[1];
      if (!dry) *(float2*)xr = xv;
    }
  }
}


#if CHECK_ATTN
__device__ __forceinline__ float blk_sum(float v, float* red) {
  v = wave_sum(v);
  __syncthreads();
  if ((TIDS & 63) == 0) red[TIDS >> 6] = v;
  __syncthreads();
  return red[0] + red[1] + red[2] + red[3];
}
__device__ __forceinline__ float blk_max(float v, float* red) {
#pragma unroll
  for (int o = 32; o > 0; o >>= 1) v = fmaxf(v, __shfl_xor(v, o));
  __syncthreads();
  if ((TIDS & 63) == 0) red[TIDS >> 6] = v;
  __syncthreads();
  return fmaxf(fmaxf(red[0], red[1]), fmaxf(red[2], red[3]));
}
__device__ __forceinline__ bool far(float got, float ref, float rel, float ab) { return !(fabsf(got - ref) <= rel * fabsf(ref) + ab); }
__device__ __forceinline__ void rope_ref(const float* z, float* o, int s) {
  for (int c = 0; c < 32; c++) {
    const int pos = (c < 16) ? (s / 64) : (s % 64);
    const float inv = powf(10000.0f, -(float)(2 * (c % 8)) / 16.0f);
    const float ang = (float)pos * inv;
    const int cb = c & 16, cc = c & 15;
    const float rot = (cc < 8) ? -z[cb + cc + 8] : z[cb + cc - 8];
    o[c] = z[c] * cosf(ang) + rot * sinf(ang);
  }
}
__device__ __forceinline__ void check_proj(const Params& p, int L, int r, char* smem) {
  float* hrow = (float*)smem;
  float* z = hrow + 1024;
  float* kvr = z + 416;
  float* red = kvr + 1024;
  float* kk = red + 8;
  const int tid = TIDS;
  __syncthreads();
  for (int k = tid; k < 1024; k += 256) hrow[k] = bf1(p.hx[(long)r * 1024 + k]);
  __syncthreads();
  for (int n = tid; n < 416; n += 256) {
    float a = 0.f;
    for (int k = 0; k < 1024; k++) a += hrow[k] * p.w_in[((long)L * 1024 + k) * 4256 + n];
    z[n] = a;
  }
  __syncthreads();
  unsigned bad = 0;
  if (L == 0 || r < TLAT)
  for (int n = tid; n < 256; n += 256) if (far(bf1(p.cq[(long)r * 256 + n]), z[160 + n], 0.02f, 0.03f)) bad |= 1u;
  for (int n = tid; n < 32; n += 256) if (far(p.kr[(long)r * 32 + n], z[128 + n], 0.02f, 0.03f)) bad |= 1u;
  const float ssc = blk_sum(tid < 128 ? z[tid] * z[tid] : 0.f, red);
  const float rc = rsqrtf(ssc / 128.0f + EPSV);
  for (int n = tid; n < 1024; n += 256) {
    float a = 0.f;
    for (int k = 0; k < 128; k++) a += z[k] * rc * p.g_ckv[L * 128 + k] * p.w_ukv[((long)L * 128 + k) * 1024 + n];
    kvr[n] = a;
  }
  __syncthreads();
  const bool lat = r < TLAT;
  const int b = lat ? (r >> 12) : ((r - TLAT) >> 8), s = lat ? (r & 4095) : ((r - TLAT) & 255), kpos = lat ? CTXL + s : s;
  for (int h = 0; h < 8; h++) {
    float sq = 0.f;
    if (tid < 64) sq = kvr[h * 128 + tid] * kvr[h * 128 + tid]; else if (tid < 96) sq = z[128 + tid - 64] * z[128 + tid - 64];
    const float ssk = blk_sum(sq, red);
    const float rk = rsqrtf(ssk / 96.0f + EPSV);
    if (tid == 0) {
      float* zr = kk + 96; float* zo = zr + 32;
      for (int c = 0; c < 32; c++) zr[c] = z[128 + c] * rk * p.g_kn[L * 96 + 64 + c];
      if (lat) rope_ref(zr, zo, s); else for (int c = 0; c < 32; c++) zo[c] = zr[c];
      for (int c = 0; c < 32; c++) kk[64 + c] = zo[c];
    }
    if (tid < 64) kk[tid] = kvr[h * 128 + tid] * rk * p.g_kn[L * 96 + tid];
    __syncthreads();
    if (tid < 96 && far(bf1(p.Kb[((long)(b * 8 + h) * SKEYS + kpos) * 96 + tid]), kk[tid], 0.03f, 0.03f)) bad |= 2u;
    if (tid < 64 && far(bf1(p.Vtb[((long)(b * 8 + h) * 64 + tid) * SKEYS + kpos]), kvr[h * 128 + 64 + tid], 0.03f, 0.03f)) bad |= 4u;
    __syncthreads();
  }
  if (bad & CHECK_MASK) atomicOr(&p.bar[0], bad & CHECK_MASK);
}
__device__ __forceinline__ void check_attn(const Params& p, int L, int r, int h, char* smem) {
  float* cqr = (float*)smem;
  float* q = cqr + 256;
  float* sc = q + 96;
  float* red = sc + 4352;
  const int tid = TIDS;
  const bool lat = r < TLAT;
  const int b = lat ? (r >> 12) : ((r - TLAT) >> 8), s = lat ? (r & 4095) : ((r - TLAT) & 255);
  const int nkeys = lat ? SKEYS : CTXL;
  __syncthreads();
  cqr[tid] = bf1(p.cq[(long)r * 256 + tid]);
  __syncthreads();
  const float rc = rsqrtf(blk_sum(cqr[tid] * cqr[tid], red) / 256.0f + EPSV);
  float qr = 0.f;
  if (tid < 96) for (int k = 0; k < 256; k++) qr += cqr[k] * rc * p.g_cq[L * 256 + k] * p.w_uq[((long)L * 256 + k) * 768 + h * 96 + tid];
  const float rq = rsqrtf(blk_sum(tid < 96 ? qr * qr : 0.f, red) / 96.0f + EPSV);
  if (tid < 96) q[tid] = qr * rq * p.g_qn[L * 96 + tid];
  __syncthreads();
  if (tid == 0 && lat) {
    float* zr = red + 8; float* zo = zr + 32;
    for (int c = 0; c < 32; c++) zr[c] = q[64 + c];
    rope_ref(zr, zo, s);
    for (int c = 0; c < 32; c++) q[64 + c] = zo[c];
  }
  __syncthreads();
  float mx = -1e30f;
  for (int key = tid; key < nkeys; key += 256) {
    float a = 0.f;
    for (int d = 0; d < 96; d++) a += q[d] * bf1(p.Kb[((long)(b * 8 + h) * SKEYS + key) * 96 + d]);
    a *= 0.10206207261596577f;
    sc[key] = a; mx = fmaxf(mx, a);
  }
  mx = blk_max(mx, red);
  float ps = 0.f;
  for (int key = tid; key < nkeys; key += 256) { const float e = expf(sc[key] - mx); sc[key] = e; ps += e; }
  const float tot = blk_sum(ps, red);
  unsigned bad = 0;
  if (tid < 64) {
    float a = 0.f;
    for (int key = 0; key < nkeys; key++) a += sc[key] * bf1(p.Vtb[((long)(b * 8 + h) * 64 + tid) * SKEYS + key]);
    a /= tot;
    if (far(bf1(p.Ob[(long)r * 512 + h * 64 + tid]), a, 0.04f, 1.5e-3f)) bad |= 8u;
  }
  if (bad & CHECK_MASK) atomicOr(&p.bar[0], bad & CHECK_MASK);
}
__device__ __forceinline__ void phase_check(const Params& p, int L, char* smem) {
  const int nq = (L == 0) ? 12 : 8;
  char* sm = smem + HALF_ * LDS_SMALL;
  for (int pass = 0; pass < 2; pass++) {
  FOR_PAIRED(pass == 0 ? 12 : nq * 8, uu)
    const int u = (pass == 0) ? uu : uu + 12;
    const int si = (u < 12) ? u : ((u - 12) >> 3);
    int r;
    switch (si) {
      case 0: r = 0; break; case 1: r = 63; break; case 2: r = 64; break; case 3: r = 4095; break;
      case 4: r = 4096 + 777; break; case 5: r = 12345; break; case 6: r = 20000; break; case 7: r = 32767; break;
      case 8: r = TLAT; break; case 9: r = TLAT + 255; break; case 10: r = TLAT + 256 + 100; break; default: r = TLAT + 2047; break;
    }
    if (u < 12) check_proj(p, L, r, sm);
    else check_attn(p, L, r, (u - 12) & 7, sm);
  }
  }
}
#endif

#define XB_TMO      128
#define XB_XCNT(j)  (256  + 64 * (j))
#define XB_XSUB(j)  (1280 + 64 * (j))
#define XB_XGEN(j)  (2304 + 64 * (j))
#define XB_TOP      3328
#define XB_TOPGEN   3392
#define XCD_BAR_WORDS 3456
#define XB_SPIN_CAP (1u << 22)
#define LAS __attribute__((address_space(3)))
__device__ __forceinline__ unsigned xb_ld(unsigned* p)              { return __hip_atomic_load(p, __ATOMIC_RELAXED, __HIP_MEMORY_SCOPE_AGENT); }
__device__ __forceinline__ unsigned xb_add(unsigned* p, unsigned v) { return __hip_atomic_fetch_add(p, v, __ATOMIC_RELAXED, __HIP_MEMORY_SCOPE_AGENT); }
__device__ __forceinline__ unsigned xb_xcc_id() { return (unsigned)__builtin_amdgcn_s_getreg((3 << 11) | 20) & 0xFu; }
#define XB_SPIN(cond, bar) do { unsigned _sp = 0; while (cond) { __builtin_amdgcn_s_sleep(1); \
    if ((++_sp & 255u) == 0u) { if (xb_ld(&(bar)[XB_TMO])) break; if (_sp > XB_SPIN_CAP) { atomicAdd(&(bar)[XB_TMO], 1u); break; } } } } while (0)
struct XcdBarrier { unsigned* bar; unsigned x; volatile LAS unsigned* st; };
__device__ __forceinline__ XcdBarrier xcd_barrier_post(unsigned* bar, volatile LAS unsigned* st) {
  XcdBarrier b; b.bar = bar; b.x = xb_xcc_id(); b.st = st;
  if (threadIdx.x == 0) (void)xb_add(&bar[XB_XCNT(b.x)], 1u);
  return b;
}
__device__ __forceinline__ void xcd_barrier_complete(unsigned* bar, unsigned x, unsigned& nloc, unsigned& nx) {
  const unsigned G = gridDim.x * gridDim.y * gridDim.z;
  unsigned sum, cnt, mine, sp = 0u;
  for (;;) {
    sum = 0u; cnt = 0u; mine = 0u;
#pragma unroll
    for (unsigned j = 0; j < 16; ++j) { const unsigned c = xb_ld(&bar[XB_XCNT(j)]); sum += c; cnt += (c > 0u) ? 1u : 0u; mine = (j == x) ? c : mine; }
    if (sum == G) break;
    __builtin_amdgcn_s_sleep(1);
    if ((++sp & 255u) == 0u) { if (xb_ld(&bar[XB_TMO])) break; if (sp > XB_SPIN_CAP) { atomicAdd(&bar[XB_TMO], 1u); break; } }
  }
  nloc = mine > 0u ? mine : 1u; nx = cnt > 0u ? cnt : 1u;
}
__device__ __forceinline__ void xcd_barrier(const XcdBarrier& b) {
  asm volatile("s_waitcnt vmcnt(0)" ::: "memory");
  __syncthreads();
  if (threadIdx.x == 0) {
    unsigned* bar = b.bar;
    asm volatile("" : "+s"(bar));
    __builtin_amdgcn_s_waitcnt(0);
    unsigned nloc = b.st[0], nx = b.st[1];
    if (nloc == 0u) { xcd_barrier_complete(bar, b.x, nloc, nx); b.st[0] = nloc; b.st[1] = nx; }
    const unsigned old = xb_add(&bar[XB_XSUB(b.x)], 1u);
    const unsigned gen = old / nloc;
    if (old + 1u == (gen + 1u) * nloc) {
      __builtin_amdgcn_fence(__ATOMIC_RELEASE, "agent");
      asm volatile("s_waitcnt vmcnt(0)" ::: "memory");
      const unsigned og = xb_add(&bar[XB_TOP], 1u);
      const unsigned tg = og / nx;
      if (og + 1u == (tg + 1u) * nx) xb_add(&bar[XB_TOPGEN], 1u);
      else XB_SPIN(xb_ld(&bar[XB_TOPGEN]) == tg, bar);
      __builtin_amdgcn_fence(__ATOMIC_ACQUIRE, "agent");
      xb_add(&bar[XB_XGEN(b.x)], 1u);
      asm volatile("s_waitcnt vmcnt(0)" ::: "memory");
    } else {
      XB_SPIN(xb_ld(&bar[XB_XGEN(b.x)]) == gen, bar);
      __builtin_amdgcn_fence(__ATOMIC_ACQUIRE, "agent");
      asm volatile("s_waitcnt vmcnt(0)" ::: "memory");
    }
  }
  __syncthreads();
}

#define NPHASE (23 + CHECK_ATTN)
#ifndef PH_LIMIT
#define PH_LIMIT NPHASE
#endif
__device__ __forceinline__ void run_phase(const Params& p, int ph, char* smem, bool dry = false, bool big = false) {
  if (ph == 0) { phase_prep(p, smem); return; }
#if CHECK_ATTN
  if (ph == 23) {
    if (blockIdx.x == 0 && threadIdx.x == 0 && __hip_atomic_load(&p.bar[0], __ATOMIC_RELAXED, __HIP_MEMORY_SCOPE_AGENT) != 0u) p.out[0] = __uint_as_float(0x7fc00000u);
    return;
  }
#endif
  const int L = (ph - 1) / 11, s = (ph - 1) % 11;
  if (s == 0 || s == 7) {
    phase_norm(p, L, s == 0 ? 0 : 1, (s == 0 || L == 0) ? RTOT : TLAT);
    if (s == 0) phase_tables(p, L);
    return;
  }
  switch (s) {
    case 1: phase_s2<true>(p, L, smem); break;
    case 2: phase_s3(p, L, smem, dry); break;
    case 3: phase_s4(p, L, smem); break;
    case 4: phase_dftC(p, smem);
#if CHECK_ATTN
      phase_check(p, L, smem);
#endif
      break;
    case 5: phase_s7<true>(p, L, smem); break;
    case 6: phase_s8<true>(p, L, smem, dry); break;
    case 8: phase_s10<true>(p, L, smem); break;
    case 9: phase_s11a(p, L); break;
    case 10: phase_s11b(p, L, dry); break;
  }
}

__global__ void __launch_bounds__(512, 2) mega(Params p, int ph0, int ph1) {
  extern __shared__ __attribute__((aligned(16))) char smem[];
  __shared__ uint4 xb_words;
  cg::grid_group grid = cg::this_grid();
  const bool multi = (ph1 - ph0) > 1;
  const bool big = blockDim.x == 512;
  XcdBarrier xb;
  if (multi) {
    if (threadIdx.x == 0) xb_words = make_uint4(0u, 0u, 0u, 0u);
    __syncthreads();
    xb = xcd_barrier_post(p.bar, (volatile LAS unsigned*)&xb_words);
  }
  for (int ph = ph0; ph < ph1; ph++) {
    if (ph > ph0) {
      if (ph == ph0 + 1) grid.sync();
      else xcd_barrier(xb);
    }
#if PROBE_S >= 0
    {
      const int kind = (ph == 0) ? 11 : (ph - 1) % 11;
      const int reps = (kind == PROBE_S) ? PROBE_REPS * p.one : 0;
      for (int rep = 0; rep <= reps; rep++) {
        if (rep > 0) xcd_barrier(xb);
        const bool dry = (rep < reps);
        if (kind == PROBE_S && (kind == 6 || kind == 10 || kind == 2)) run_phase(p, ph, smem, dry, big);
        else run_phase(p, ph, smem, false, big);
      }
    }
#else
    run_phase(p, ph, smem, false, big);
#endif
  }
}

static inline size_t al256(size_t x) { return (x + 255) & ~(size_t)255; }
extern "C" void kernel_launch(void* const* d_in, const int* in_sizes, int n_in, void* d_out, int out_size, void* d_ws,
                              size_t ws_size, hipStream_t stream) {
  Params p{};
  const float* const* in = (const float* const*)d_in;
  p.x = in[0]; p.c = in[1]; p.ctx = in[2]; p.c_ctx = in[3]; p.w_mod = in[4]; p.b_mod = in[5]; p.g_norm1 = in[6];
  p.w_in = in[7]; p.g_ckv = in[8]; p.w_ukv = in[9]; p.g_cq = in[10]; p.w_uq = in[11]; p.g_qn = in[12]; p.g_kn = in[13];
  p.w_dw = in[14]; p.b_dw = in[15]; p.g_cln = in[16]; p.b_cln = in[17]; p.wb_attn = in[18]; p.wb_fnet = in[19];
  p.wb_conv = in[20]; p.w_out = in[21]; p.g_norm2 = in[22]; p.w_query = in[23]; p.sub_keys = in[24]; p.u_tab = in[25];
  p.v_tab = in[26];
  p.out = (float*)d_out;
  p.one = 1; p.pad_ = 0;
  char* ws = (char*)d_ws;
  size_t off = 0;
  auto take = [&](size_t bytes) { char* q = ws + off; off += al256(bytes); return q; };
  p.bar = (unsigned*)take(XCD_BAR_WORDS * 4);
  const size_t mods_bytes = 2 * 9 * 6144 * 4;
  p.mods = (float*)take(mods_bytes);
  p.ropetab = (float*)take(64 * 8 * 2 * 4);
  p.W2T = (u16*)take(2ull * W2T_SZ * 2);
  p.WgT = (u16*)take(2ull * WGT_SZ * 2);
  p.WukvT = (u16*)take(2ull * WUKV_SZ * 2);
  p.WuqT = (u16*)take(2ull * WUQ_SZ * 2);
  p.WbaT = (u16*)take(2ull * WBA_SZ * 2);
  p.WbfT = (u16*)take(2ull * WBF_SZ * 2);
  p.WbcT = (u16*)take(2ull * WBC_SZ * 2);
  p.WoutT = (u16*)take(2ull * WOUT_SZ * 2);
  p.WqT = (u16*)take(2ull * WQ_SZ * 2);
  p.SubK = (u16*)take(2ull * SUBK_SZ * 2);
  p.WA = (u16*)take(128 * 128 * 2);
  p.WC = (u16*)take(128 * 128 * 2);
  p.tw = (float*)take(4096 * 2 * 4);
  p.GB = (u16*)take((size_t)NB * 256 * 8192 * 2);
  p.Dctx = (u16*)take(256ull * 512 * 2);
  p.Wcs = (u16*)take(128ull * 64 * 2);
  p.UT8 = (unsigned char*)take((size_t)NEXP * 1024);
  p.VT8 = (unsigned char*)take((size_t)NEXP * 1024);
  p.hx = (u16*)take((size_t)RTOT * 1024 * 2);
  {
    const size_t b0 = off;
    p.cq = (u16*)take((size_t)RTOT * 256 * 2);
    p.zf = (u16*)take((size_t)RTOT * 256 * 2);
    p.zc = (u16*)take((size_t)RTOT * 512 * 2);
    p.ckv = (u16*)take((size_t)RTOT * 128 * 2);
    p.kr = (float*)take((size_t)RTOT * 32 * 4);
    p.m = (u16*)(ws + b0);
    p.PD = (unsigned*)(ws + b0);
  }
  {
    const size_t c0 = off;
    p.Kb = (u16*)take((size_t)NB * NH * SKEYS * 96 * 2);
    p.Vtb = (u16*)take((size_t)NB * NH * 64 * SKEYS * 2);
    p.eid = (int*)(ws + c0);
    p.gate = (float*)(ws + c0 + al256((size_t)RTOT * 128 * 4));
  }
  p.Ytl = (u16*)take((size_t)NB * 256 * 8192 * 2);
  p.Ytc = (u16*)take((size_t)NB * 256 * 512 * 2);
  p.Ob = (u16*)take((size_t)RTOT * 512 * 2);
  p.Fb = (u16*)take((size_t)RTOT * 256 * 2);
  p.cv = (u16*)take((size_t)RTOT * 256 * 2);
  p.ctx1 = (float*)take((size_t)TCTX * 1024 * 4);
  if (off > ws_size) { fprintf(stderr, "workspace too small: need %zu have %zu\n", off, ws_size); return; }

  (void)hipMemsetAsync(p.bar, 0, XCD_BAR_WORDS * 4, stream);
  static int cus = 0;
  if (!cus) {
    int dev = 0;
    (void)hipGetDevice(&dev);
    (void)hipDeviceGetAttribute(&cus, hipDeviceAttributeMultiprocessorCount, dev);
    (void)hipFuncSetAttribute((const void*)mega, hipFuncAttributeMaxDynamicSharedMemorySize, LDS_BIG);
  }
#if ONE_LAUNCH
  int ph0 = 0, ph1 = NPHASE;
  void* args[] = {&p, &ph0, &ph1};
  hipError_t e = hipLaunchCooperativeKernel((void*)mega, dim3(cus), dim3(512), args, LDS_BIG, stream);
  if (e != hipSuccess) fprintf(stderr, "cooperative launch failed: %s (grid %d)\n", hipGetErrorString(e), cus);
#else
  for (int ph = 0; ph < PH_LIMIT; ph++) {
    const int kind = (ph == 0) ? 11 : (ph - 1) % 11;
    const bool bigp = (kind == 1 || kind == 5 || kind == 6 || kind == 8);
    if (bigp) mega<<<cus, 512, LDS_BIG, stream>>>(p, ph, ph + 1);
    else mega<<<cus * 2, 256, LDS_SMALL, stream>>>(p, ph, ph + 1);
  }
#endif
}
```

```cpp
#include <hip/hip_runtime.h>
#include <hip/hip_cooperative_groups.h>
#include <cstdio>
#include <cstdint>
namespace cg = cooperative_groups;

#ifndef ABL_PEER
#define ABL_PEER 1
#endif
#ifndef ABL_BR
#define ABL_BR 7
#endif
#ifndef PROBE_S
#define PROBE_S (-1)
#endif
#ifndef PROBE_REPS
#define PROBE_REPS 4
#endif
#ifndef CHECK_ATTN
#define CHECK_ATTN 0
#endif
#ifndef CHECK_MASK
#define CHECK_MASK 0xff
#endif
#ifndef ONE_LAUNCH
#define ONE_LAUNCH 1
#endif

typedef unsigned short u16;
typedef __attribute__((ext_vector_type(8))) __bf16 bf16x8;
typedef __attribute__((ext_vector_type(2))) __bf16 bf16x2;
typedef __attribute__((ext_vector_type(16))) float f32x16;
typedef __attribute__((ext_vector_type(2))) float f32x2;

#define NB 8
#define SEQ 4096
#define DM 1024
#define CTXL 256
#define TLAT (NB * SEQ)
#define TCTX (NB * CTXL)
#define RTOT (TLAT + TCTX)
#define SKEYS (CTXL + SEQ)
#define NH 8
#define QKD 96
#define N2 1280
#define NEXP 16384
#define EPSV 1e-6f

struct Params {
  const float *x, *c, *ctx, *c_ctx, *w_mod, *b_mod, *g_norm1, *w_in, *g_ckv, *w_ukv, *g_cq, *w_uq, *g_qn, *g_kn,
      *w_dw, *b_dw, *g_cln, *b_cln, *wb_attn, *wb_fnet, *wb_conv, *w_out, *g_norm2, *w_query, *sub_keys, *u_tab, *v_tab;
  float* out;
  unsigned* bar;
  float* mods;
  float* ropetab;
  u16 *W2T, *WgT, *WukvT, *WuqT, *WbaT, *WbfT, *WbcT, *WoutT, *WqT, *SubK;
  u16 *WA, *WC, *Dctx, *Wcs;
  float* tw;
  u16* GB;
  unsigned char *UT8, *VT8;
  unsigned* PD;
  u16* hx;
  u16 *cq, *zf, *zc, *ckv; float* kr;
  u16* m;
  u16 *Kb, *Vtb;
  int* eid; float* gate;
  u16 *Ytl, *Ytc, *Ob, *Fb, *cv;
  float* ctx1;
  int one; int pad_;
};

#define W2T_SZ (N2 * 1024)
#define WGT_SZ (3072 * 1024)
#define WUKV_SZ (1024 * 128)
#define WUQ_SZ (768 * 256)
#define WBA_SZ (1024 * 512)
#define WBF_SZ (1024 * 256)
#define WBC_SZ (1024 * 256)
#define WOUT_SZ (1024 * 1024)
#define WQ_SZ (1024 * 1024)
#define SUBK_SZ (8 * 2 * 128 * 64)

__device__ __forceinline__ unsigned pack2(float a, float b) {
  f32x2 v = {a, b};
  return __builtin_bit_cast(unsigned, __builtin_convertvector(v, bf16x2));
}
__device__ __forceinline__ u16 tobf(float a) { return (u16)(pack2(a, 0.f) & 0xffffu); }
__device__ __forceinline__ float bf_lo(unsigned u) { return __uint_as_float(u << 16); }
__device__ __forceinline__ float bf_hi(unsigned u) { return __uint_as_float(u & 0xffff0000u); }
__device__ __forceinline__ float bf1(u16 u) { return __uint_as_float(((unsigned)u) << 16); }
__device__ __forceinline__ f32x16 mfma32(uint4 a, uint4 b, f32x16 c) {
  return __builtin_amdgcn_mfma_f32_32x32x16_bf16(__builtin_bit_cast(bf16x8, a), __builtin_bit_cast(bf16x8, b), c, 0, 0, 0);
}
__device__ __forceinline__ uint4 ldg16(const void* p) { return *(const uint4*)p; }
__device__ __forceinline__ int opaque(int x) { asm volatile("" : "+v"(x)); return x; }
#define TIDX opaque((int)threadIdx.x)
#define HALF_ (opaque((int)threadIdx.x) >> 8)
#define TIDS (opaque((int)threadIdx.x) & 255)
#define VBID ((int)blockIdx.x + HALF_ * (int)gridDim.x)
#define NVB ((int)gridDim.x * (int)(blockDim.x >> 8))
#define FOR_PAIRED(N, U) for (int _b = (int)blockIdx.x, _g = (int)gridDim.x, _st = _g * (int)(blockDim.x >> 8); _b < (N); _b += _st) { \
    int U = _b + HALF_ * _g; if (U >= (N)) U = _b;
__device__ __forceinline__ float wave_sum(float v) {
#pragma unroll
  for (int o = 32; o > 0; o >>= 1) v += __shfl_xor(v, o);
  return v;
}
__device__ __forceinline__ float half_sum(float v) {
#pragma unroll
  for (int o = 16; o > 0; o >>= 1) v += __shfl_xor(v, o);
  return v;
}
__device__ __forceinline__ float sigmoidf_(float x) { return 1.f / (1.f + __expf(-x)); }
__device__ __forceinline__ float siluf_(float x) { return x / (1.f + __expf(-x)); }
__device__ __forceinline__ float gelu_tanh(float x) {
  float u = 0.7978845608028654f * (x + 0.044715f * x * x * x);
  float t = 1.f - 2.f / (1.f + __expf(2.f * u));
  return 0.5f * x * (1.f + t);
}
__device__ __forceinline__ int row_mod(int r) { return r < TLAT ? (r >> 12) : 8; }

#define SMEM_BYTES 73728
#define LDS_SMALL 73728
#define LDS_BIG 147456
#define LDT 72

#define LAS3 __attribute__((address_space(3)))
__device__ __forceinline__ void glds16(const u16* g, char* lds_wave_base) {
  __builtin_amdgcn_global_load_lds((const unsigned*)g, (LAS3 unsigned*)lds_wave_base, 16, 0, 0);
}
__device__ __forceinline__ void gemm128x(const u16* __restrict__ A, int lda, const u16* __restrict__ Bt, int ldb, int bs1, int bs2, int K,
                                         f32x16 (&acc)[2][2], char* smem) {
  char* As = smem;
  char* Bs = smem + 32768;
  const int tid = TIDS, lane = tid & 63, w = tid >> 6, wr = w >> 1, wc = w & 1;
  const int nk = K >> 6;
  const int srow = w * 8 + (lane >> 3);
  const int schunk = (lane & 7) ^ ((srow >> 1) & 7);
  const int aoff = srow * lda + schunk * 8, boff = srow * ldb + schunk * 8;
  const int a32 = 32 * lda;
  __syncthreads();
#pragma unroll
  for (int i = 0; i < 4; i++) {
    glds16(A + (aoff + i * a32), As + (i * 4 + w) * 1024);
    glds16(Bt + (boff + (i & 1) * bs1 + (i >> 1) * bs2), Bs + (i * 4 + w) * 1024);
  }
  __syncthreads();
  const int fr = lane & 31, hh = lane >> 5;
  const int sw = (fr >> 1) & 7;
  for (int kt = 0; kt < nk; kt++) {
    const int cur = kt & 1;
    if (kt + 1 < nk) {
      const int ko = (kt + 1) * 64;
      char* An = As + (cur ^ 1) * 16384;
      char* Bn = Bs + (cur ^ 1) * 16384;
#pragma unroll
      for (int i = 0; i < 4; i++) {
        glds16(A + (aoff + i * a32 + ko), An + (i * 4 + w) * 1024);
        glds16(Bt + (boff + (i & 1) * bs1 + (i >> 1) * bs2 + ko), Bn + (i * 4 + w) * 1024);
      }
    }
    const char* Ac = As + cur * 16384 + (wr * 64 + fr) * 128;
    const char* Bc = Bs + cur * 16384 + (wc * 64 + fr) * 128;
#pragma unroll
    for (int kk = 0; kk < 4; kk++) {
      const int so = ((2 * kk + hh) ^ sw) << 4;
      uint4 a0 = *(const uint4*)(Ac + so);
      uint4 a1 = *(const uint4*)(Ac + 32 * 128 + so);
      uint4 b0 = *(const uint4*)(Bc + so);
      uint4 b1 = *(const uint4*)(Bc + 32 * 128 + so);
      acc[0][0] = mfma32(a0, b0, acc[0][0]);
      acc[0][1] = mfma32(a0, b1, acc[0][1]);
      acc[1][0] = mfma32(a1, b0, acc[1][0]);
      acc[1][1] = mfma32(a1, b1, acc[1][1]);
    }
    __syncthreads();
  }
}
__device__ __forceinline__ void gemm128(const u16* __restrict__ A, int lda, const u16* __restrict__ Bt, int ldb, int K,
                                        f32x16 (&acc)[2][2], char* smem) {
  gemm128x(A, lda, Bt, ldb, 32 * ldb, 64 * ldb, K, acc, smem);
}
__device__ __forceinline__ void gemm128h(const u16* __restrict__ A, int lda, const u16* __restrict__ Bt, int ldb, int K, int jh,
                                         f32x16 (&acc)[2], char* smem) {
  char* As = smem;
  char* Bs = smem + 32768;
  const int tid = TIDS, lane = tid & 63, w = tid >> 6, wr = w >> 1, wc = w & 1;
  const int nk = K >> 6;
  const int srow = w * 8 + (lane >> 3);
  const int schunk = (lane & 7) ^ ((srow >> 1) & 7);
  const int aoff = srow * lda + schunk * 8;
  const int a32 = 32 * lda;
  const int boff = (jh * 32 + srow) * ldb + schunk * 8, b64 = 64 * ldb;
  __syncthreads();
#pragma unroll
  for (int i = 0; i < 4; i++) glds16(A + (aoff + i * a32), As + (i * 4 + w) * 1024);
#pragma unroll
  for (int i = 0; i < 2; i++) glds16(Bt + (boff + i * b64), Bs + (i * 4 + w) * 1024);
  __syncthreads();
  const int fr = lane & 31, hh = lane >> 5;
  const int sw = (fr >> 1) & 7;
  for (int kt = 0; kt < nk; kt++) {
    const int cur = kt & 1;
    if (kt + 1 < nk) {
      const int ko = (kt + 1) * 64;
      char* An = As + (cur ^ 1) * 16384;
      char* Bn = Bs + (cur ^ 1) * 8192;
#pragma unroll
      for (int i = 0; i < 4; i++) glds16(A + (aoff + i * a32 + ko), An + (i * 4 + w) * 1024);
#pragma unroll
      for (int i = 0; i < 2; i++) glds16(Bt + (boff + i * b64 + ko), Bn + (i * 4 + w) * 1024);
    }
    const char* Ac = As + cur * 16384 + (wr * 64 + fr) * 128;
    const char* Bc = Bs + cur * 8192 + (wc * 32 + fr) * 128;
#pragma unroll
    for (int kk = 0; kk < 4; kk++) {
      const int so = ((2 * kk + hh) ^ sw) << 4;
      uint4 a0 = *(const uint4*)(Ac + so);
      uint4 a1 = *(const uint4*)(Ac + 32 * 128 + so);
      uint4 b0 = *(const uint4*)(Bc + so);
      acc[0] = mfma32(a0, b0, acc[0]);
      acc[1] = mfma32(a1, b0, acc[1]);
    }
    __syncthreads();
  }
}
#define WAIT_VM(n) asm volatile("s_waitcnt vmcnt(%0)" ::"n"(n) : "memory")
#define G256_STAGE 49152
__device__ __forceinline__ void gemm256(const u16* __restrict__ A, int lda, const u16* __restrict__ Bt, int ldb, int K,
                                        f32x16 (&acc)[2][2], char* smem) {
  const int tid = TIDX, lane = tid & 63, w = tid >> 6, wr = w >> 1, wc = w & 1;
  const int nk = K >> 6;
  const int srow = w * 8 + (lane >> 3);
  const int schunk = (lane & 7) ^ ((srow >> 1) & 7);
  const int aoff = srow * lda + schunk * 8, boff = srow * ldb + schunk * 8;
  const int a64 = 64 * lda, b64 = 64 * ldb;
  auto issue = [&](int kt) __attribute__((always_inline)) {
    char* As = smem + (kt % 3) * G256_STAGE;
    char* Bs = As + 32768;
    const int ko = kt * 64;
#pragma unroll
    for (int i = 0; i < 4; i++) glds16(A + (aoff + i * a64 + ko), As + (w + 8 * i) * 1024);
#pragma unroll
    for (int i = 0; i < 2; i++) glds16(Bt + (boff + i * b64 + ko), Bs + (w + 8 * i) * 1024);
  };
  WAIT_VM(0);
  __syncthreads();
  issue(0);
  if (nk > 1) issue(1);
  const int fr = lane & 31, hh = lane >> 5;
  const int sw = (fr >> 1) & 7;
  const int rdA = (wr * 64 + fr) * 128, rdB = 32768 + (wc * 64 + fr) * 128;
  for (int kt = 0; kt < nk; kt++) {
    if (kt + 1 < nk) WAIT_VM(6); else WAIT_VM(0);
    __builtin_amdgcn_s_barrier();
    if (kt + 2 < nk) issue(kt + 2);
    const char* Sb = smem + (kt % 3) * G256_STAGE;
#pragma unroll
    for (int kk = 0; kk < 4; kk++) {
      const int so = ((2 * kk + hh) ^ sw) << 4;
      uint4 a0 = *(const uint4*)(Sb + rdA + so);
      uint4 a1 = *(const uint4*)(Sb + rdA + 32 * 128 + so);
      uint4 b0 = *(const uint4*)(Sb + rdB + so);
      uint4 b1 = *(const uint4*)(Sb + rdB + 32 * 128 + so);
      acc[0][0] = mfma32(a0, b0, acc[0][0]);
      acc[0][1] = mfma32(a0, b1, acc[0][1]);
      acc[1][0] = mfma32(a1, b0, acc[1][0]);
      acc[1][1] = mfma32(a1, b1, acc[1][1]);
    }
  }
  __syncthreads();
}
__device__ __forceinline__ void gemm256h(const u16* __restrict__ A, int lda, const u16* __restrict__ Bt, int ldb, int K, int jh,
                                         f32x16 (&acc)[2], char* smem) {
  const int tid = TIDX, lane = tid & 63, w = tid >> 6, wr = w >> 1, wc = w & 1;
  const int nk = K >> 6;
  const int srow = w * 8 + (lane >> 3);
  const int schunk = (lane & 7) ^ ((srow >> 1) & 7);
  const int aoff = srow * lda + schunk * 8;
  const int a64 = 64 * lda;
  const int boff = ((srow >> 5) * 64 + jh * 32 + (srow & 31)) * ldb + schunk * 8;
  auto issue = [&](int kt) __attribute__((always_inline)) {
    char* As = smem + (kt % 3) * G256_STAGE;
    char* Bs = As + 32768;
    const int ko = kt * 64;
#pragma unroll
    for (int i = 0; i < 4; i++) glds16(A + (aoff + i * a64 + ko), As + (w + 8 * i) * 1024);
    glds16(Bt + (boff + ko), Bs + w * 1024);
  };
  WAIT_VM(0);
  __syncthreads();
  issue(0);
  if (nk > 1) issue(1);
  const int fr = lane & 31, hh = lane >> 5;
  const int sw = (fr >> 1) & 7;
  const int rdA = (wr * 64 + fr) * 128, rdB = 32768 + (wc * 32 + fr) * 128;
  for (int kt = 0; kt < nk; kt++) {
    if (kt + 1 < nk) WAIT_VM(5); else WAIT_VM(0);
    __builtin_amdgcn_s_barrier();
    if (kt + 2 < nk) issue(kt + 2);
    const char* Sb = smem + (kt % 3) * G256_STAGE;
#pragma unroll
    for (int kk = 0; kk < 4; kk++) {
      const int so = ((2 * kk + hh) ^ sw) << 4;
      uint4 a0 = *(const uint4*)(Sb + rdA + so);
      uint4 a1 = *(const uint4*)(Sb + rdA + 32 * 128 + so);
      uint4 b0 = *(const uint4*)(Sb + rdB + so);
      acc[0] = mfma32(a0, b0, acc[0]);
      acc[1] = mfma32(a1, b0, acc[1]);
    }
  }
  __syncthreads();
}
#define FOR_UNITS_XCD(NRT, NCT, RT, CT) \
  for (int _s = (int)(blockIdx.x >> 3), _per = (NRT) >> 3, _n = _per * (NCT); _s < _n; _s += (int)(gridDim.x >> 3)) { \
    const int RT = (int)(blockIdx.x & 7) * _per + _s / (NCT), CT = _s % (NCT);
#define ZERO_ACC(acc) { _Pragma("unroll") for (int _i = 0; _i < 2; _i++) _Pragma("unroll") for (int _j = 0; _j < 2; _j++) _Pragma("unroll") for (int _r = 0; _r < 16; _r++) acc[_i][_j][_r] = 0.f; }
#define ACC_ROW(wr, i, r, lane) ((wr) * 64 + (i) * 32 + ((r) & 3) + 8 * ((r) >> 2) + 4 * ((lane) >> 5))
#define ACC_COL(wc, j, lane) ((wc) * 64 + (j) * 32 + ((lane) & 31))

__device__ __forceinline__ void job_mods(const Params& p, int job, char* smem) {
  float* s = (float*)smem;
  float* red = s + 9 * 1024;
  const int L = job / 96, nt = job % 96;
  const int tid = TIDS, lane = tid & 63, w = tid >> 6;
  __syncthreads();
  for (int i = tid; i < 9 * 1024; i += 256) {
    const int j = i >> 10, k = i & 1023;
    const float cv = (j < 8) ? p.c[j * 1024 + k] : p.c_ctx[k];
    s[i] = siluf_(cv);
  }
  __syncthreads();
  const int n = nt * 64 + lane;
  float acc[9];
#pragma unroll
  for (int j = 0; j < 9; j++) acc[j] = 0.f;
  const float* wp = p.w_mod + (long)L * 1024 * 6144 + (long)(w * 256) * 6144 + n;
#pragma unroll 8
  for (int k = 0; k < 256; k++) {
    const float wv = wp[(long)k * 6144];
#pragma unroll
    for (int j = 0; j < 9; j++) acc[j] += s[j * 1024 + w * 256 + k] * wv;
  }
#pragma unroll
  for (int j = 0; j < 9; j++) red[(w * 9 + j) * 64 + lane] = acc[j];
  __syncthreads();
  for (int i = tid; i < 9 * 64; i += 256) {
    const int j = i >> 6, l = i & 63;
    const float v = ((red[(0 * 9 + j) * 64 + l] + red[(1 * 9 + j) * 64 + l]) + red[(2 * 9 + j) * 64 + l]) + red[(3 * 9 + j) * 64 + l];
    p.mods[(L * 9 + j) * 6144 + nt * 64 + l] = v + p.b_mod[L * 6144 + nt * 64 + l];
  }
}

__device__ __forceinline__ void job_convT(const float* src, int ldsrc, int c0, int k0, u16* dst, int K, int n0, const float* scale, char* smem) {
  float* t = (float*)smem;
  const int tid = TIDS;
  __syncthreads();
  const int nc = tid & 31, kr = tid >> 5;
#pragma unroll 4
  for (int kk = kr; kk < 128; kk += 8) {
    float v = 0.f;
    if (src) { v = src[(long)(k0 + kk) * ldsrc + c0 + nc]; if (scale) v *= scale[k0 + kk]; }
    t[nc * 129 + kk] = v;
  }
  __syncthreads();
  const int nr = tid >> 3, kc = (tid & 7) * 16;
  unsigned o[8];
#pragma unroll
  for (int q = 0; q < 8; q++) o[q] = pack2(t[nr * 129 + kc + 2 * q], t[nr * 129 + kc + 2 * q + 1]);
  uint4* dp = (uint4*)(dst + (long)(n0 + nr) * K + k0 + kc);
  dp[0] = make_uint4(o[0], o[1], o[2], o[3]);
  dp[1] = make_uint4(o[4], o[5], o[6], o[7]);
}

#define NJ_W2 (40 * 8)
#define NJ_WG (96 * 8)
#define NJ_UKV (32 * 1)
#define NJ_UQ (24 * 2)
#define NJ_BA (32 * 4)
#define NJ_BF (32 * 2)
#define NJ_BC (32 * 2)
#define NJ_OUT (32 * 8)
#define NJ_WQ (32 * 8)
#define NJ_CONV_LAYER (NJ_W2 + NJ_WG + NJ_UKV + NJ_UQ + NJ_BA + NJ_BF + NJ_BC + NJ_OUT + NJ_WQ)

__device__ __forceinline__ void job_conv_weights(const Params& p, int job, char* smem) {
  const int L = job / NJ_CONV_LAYER;
  int j = job % NJ_CONV_LAYER;
  const float* src; int ldsrc, c0, k0, K, n0; u16* dst; const float* scale = nullptr;
  if (j < NJ_W2) {
    const int nt = j >> 3, kt = j & 7; n0 = nt * 32;
    bool valid = true;
    if (n0 < 256) c0 = 160 + n0;
    else if (n0 < 512) c0 = 416 + (n0 - 256);
    else if (n0 < 1024) c0 = 672 + (n0 - 512);
    else if (n0 < 1152) c0 = n0 - 1024;
    else if (n0 < 1184) c0 = 128 + (n0 - 1152);
    else { c0 = 0; valid = false; }
    src = valid ? p.w_in + (long)L * 1024 * 4256 : nullptr; ldsrc = 4256; k0 = kt * 128; dst = p.W2T + (long)L * W2T_SZ; K = 1024;
  } else if ((j -= NJ_W2) < NJ_WG) {
    const int nt = j >> 3, kt = j & 7;
    src = p.w_in + (long)L * 1024 * 4256; ldsrc = 4256; c0 = 1184 + nt * 32; k0 = kt * 128; dst = p.WgT + (long)L * WGT_SZ; K = 1024; n0 = nt * 32;
  } else if ((j -= NJ_WG) < NJ_UKV) {
    src = p.w_ukv + (long)L * 128 * 1024; ldsrc = 1024; c0 = j * 32; k0 = 0; dst = p.WukvT + (long)L * WUKV_SZ; K = 128; n0 = j * 32; scale = p.g_ckv + L * 128;
  } else if ((j -= NJ_UKV) < NJ_UQ) {
    const int nt = j >> 1, kt = j & 1;
    src = p.w_uq + (long)L * 256 * 768; ldsrc = 768; c0 = nt * 32; k0 = kt * 128; dst = p.WuqT + (long)L * WUQ_SZ; K = 256; n0 = nt * 32; scale = p.g_cq + L * 256;
  } else if ((j -= NJ_UQ) < NJ_BA) {
    const int nt = j >> 2, kt = j & 3;
    src = p.wb_attn + (long)L * 512 * 1024; ldsrc = 1024; c0 = nt * 32; k0 = kt * 128; dst = p.WbaT + (long)L * WBA_SZ; K = 512; n0 = nt * 32;
  } else if ((j -= NJ_BA) < NJ_BF) {
    const int nt = j >> 1, kt = j & 1;
    src = p.wb_fnet + (long)L * 256 * 1024; ldsrc = 1024; c0 = nt * 32; k0 = kt * 128; dst = p.WbfT + (long)L * WBF_SZ; K = 256; n0 = nt * 32;
  } else if ((j -= NJ_BF) < NJ_BC) {
    const int nt = j >> 1, kt = j & 1;
    src = p.wb_conv + (long)L * 256 * 1024; ldsrc = 1024; c0 = nt * 32; k0 = kt * 128; dst = p.WbcT + (long)L * WBC_SZ; K = 256; n0 = nt * 32;
  } else if ((j -= NJ_BC) < NJ_OUT) {
    const int nt = j >> 3, kt = j & 7;
    src = p.w_out + (long)L * 1024 * 1024; ldsrc = 1024; c0 = nt * 32; k0 = kt * 128; dst = p.WoutT + (long)L * WOUT_SZ; K = 1024; n0 = nt * 32;
  } else {
    j -= NJ_OUT;
    const int nt = j >> 3, kt = j & 7;
    src = p.w_query + (long)L * 1024 * 1024; ldsrc = 1024; c0 = nt * 32; k0 = kt * 128; dst = p.WqT + (long)L * WQ_SZ; K = 1024; n0 = nt * 32;
  }
  job_convT(src, ldsrc, c0, k0, dst, K, n0, scale, smem);
}

__device__ __forceinline__ void job_cvt_straight(const float* src, u16* dst, long job) {
  const long base = job * 8192 + TIDS * 8;
#pragma unroll
  for (int i = 0; i < 4; i++) {
    const long o = base + i * 2048;
    float4 a = *(const float4*)(src + o), b = *(const float4*)(src + o + 4);
    *(uint4*)(dst + o) = make_uint4(pack2(a.x, a.y), pack2(a.z, a.w), pack2(b.x, b.y), pack2(b.z, b.w));
  }
}

#define NJ_MISC 87
__device__ __forceinline__ void job_misc(const Params& p, int job) {
  const int tid = TIDS;
#pragma unroll 1
  for (int q = 0; q < 8; q++) {
    const int e = tid + 256 * q;
    if (job < 64) {
      const int i = job * 2048 + e;
      const int k = i >> 9, ee = i & 511, part = ee >> 8, t = ee & 255;
      const float a = (float)((k * t) & 255) * (1.0f / 128.0f);
      p.Dctx[i] = tobf((part == 0 ? cospif(a) : -sinpif(a)) * (1.0f / 16.0f));
    } else if (job < 72) {
      const int i = (job - 64) * 2048 + e;
      const int R = i >> 7, kk = i & 127, k1 = (R >> 6) * 32 + (R & 31), pr = (R >> 5) & 1, part = kk >> 6, t1 = kk & 63;
      const float a = (float)((k1 * t1) & 63) * (1.0f / 32.0f);
      const float cs = cospif(a), sn = sinpif(a);
      const float v = (pr == 0) ? (part == 0 ? cs : -sn) : (part == 0 ? -sn : -cs);
      p.WA[i] = tobf(v * 0.125f);
    } else if (job < 80) {
      const int i = (job - 72) * 2048 + e;
      const int k2 = i >> 7, kk = i & 127, part = kk >> 6, t2 = kk & 63;
      const float a = (float)((k2 * t2) & 63) * (1.0f / 32.0f);
      p.WC[i] = (k2 < 64) ? tobf((part == 0 ? cospif(a) : sinpif(a)) * 0.125f) : (u16)0;
    } else if (job < 84) {
      const int i = (job - 80) * 2048 + e;
      const int n = i >> 6, d = i & 63, pp = n >> 6, en = n & 63;
      const float a = (float)((en * d) & 63) * (1.0f / 32.0f);
      p.Wcs[i] = tobf((pp == 0 ? cospif(a) : sinpif(a)) * 0.125f);
    } else if (job < 86) {
      const int i = (job - 84) * 2048 + e;
      const float a = (float)i * (1.0f / 2048.0f);
      p.tw[2 * i] = cospif(a); p.tw[2 * i + 1] = sinpif(a);
    } else if (e < 512) {
      const int pos = e >> 3, mm = e & 7;
      const float inv = powf(10000.0f, -(float)(2 * mm) / 16.0f);
      const float ang = (float)pos * inv;
      p.ropetab[e * 2] = cosf(ang);
      p.ropetab[e * 2 + 1] = sinf(ang);
    }
  }
}

#define NJ_MODS 192
#define NJ_CONVW (2 * NJ_CONV_LAYER)
#define NJ_SUBK 32
#define NJ_PREP (NJ_MODS + NJ_CONVW + NJ_SUBK + NJ_MISC)

__device__ __forceinline__ void phase_prep(const Params& p, char* smem) {
  char* sm = smem + HALF_ * LDS_SMALL;
  FOR_PAIRED(NJ_MODS, j) job_mods(p, j, sm); }
  FOR_PAIRED(NJ_CONVW, j) job_conv_weights(p, j, sm); }
  for (int j = VBID; j < NJ_SUBK; j += NVB) job_cvt_straight(p.sub_keys, p.SubK, j);
  for (int j = NVB - 1 - VBID; j < NJ_MISC; j += NVB) job_misc(p, j);
}

__device__ __forceinline__ void phase_norm(const Params& p, int L, int which, int nrows) {
  const int lane = TIDS & 63;
  const int gw = VBID * 4 + (TIDS >> 6), nw = NVB * 4;
  const float* g = (which == 0 ? p.g_norm1 : p.g_norm2) + L * 1024;
  for (int r0 = gw; r0 < nrows; r0 += 2 * nw) {
    float4 v[2][4];
    int rr[2]; bool ok[2];
#pragma unroll
    for (int u = 0; u < 2; u++) {
      const int r = r0 + u * nw;
      ok[u] = r < nrows; rr[u] = ok[u] ? r : r0;
      const float* src;
      if (which == 0 && L == 0) src = (rr[u] < TLAT) ? p.x + (long)rr[u] * 1024 : p.ctx + (long)(rr[u] - TLAT) * 1024;
      else src = (rr[u] < TLAT) ? p.out + (long)rr[u] * 1024 : p.ctx1 + (long)(rr[u] - TLAT) * 1024;
#pragma unroll
      for (int i = 0; i < 4; i++) v[u][i] = *(const float4*)(src + i * 256 + lane * 4);
    }
#pragma unroll
    for (int u = 0; u < 2; u++) {
      const int r = rr[u];
      const float* md = p.mods + (long)(L * 9 + row_mod(r)) * 6144 + (which == 0 ? 0 : 3072);
      float ss = 0.f;
#pragma unroll
      for (int i = 0; i < 4; i++) ss += v[u][i].x * v[u][i].x + v[u][i].y * v[u][i].y + v[u][i].z * v[u][i].z + v[u][i].w * v[u][i].w;
      ss = wave_sum(ss);
      const float rs = rsqrtf(ss * (1.0f / 1024.0f) + EPSV);
      if (!ok[u]) continue;
#pragma unroll
      for (int i = 0; i < 4; i++) {
        const int c = i * 256 + lane * 4;
        const float4 gg = *(const float4*)(g + c);
        const float4 sh = *(const float4*)(md + c);
        const float4 sc = *(const float4*)(md + 1024 + c);
        const float o0 = v[u][i].x * rs * gg.x * (1.f + sc.x) + sh.x;
        const float o1 = v[u][i].y * rs * gg.y * (1.f + sc.y) + sh.y;
        const float o2 = v[u][i].z * rs * gg.z * (1.f + sc.z) + sh.z;
        const float o3 = v[u][i].w * rs * gg.w * (1.f + sc.w) + sh.w;
        *(uint2*)(p.hx + (long)r * 1024 + c) = make_uint2(pack2(o0, o1), pack2(o2, o3));
      }
    }
  }
}
#define U8_SCALE 32.0f
#define V8_SCALE 4.0f
__device__ __forceinline__ unsigned pack_fp8x4(float4 v, float s) {
  int w = 0;
  w = __builtin_amdgcn_cvt_pk_fp8_f32(v.x * s, v.y * s, w, false);
  w = __builtin_amdgcn_cvt_pk_fp8_f32(v.z * s, v.w * s, w, true);
  return (unsigned)w;
}
__device__ __forceinline__ void phase_tables(const Params& p, int L, int wrank = -1, int nworkers = 0) {
  const int tid = TIDS;
  if (wrank < 0) { wrank = VBID; nworkers = NVB; }
  for (int job = wrank; job < 4096; job += nworkers) {
    const bool isu = job < 2048;
    const float* src = (isu ? p.u_tab : p.v_tab) + (long)L * NEXP * 1024;
    unsigned char* dst = isu ? p.UT8 : p.VT8;
    const float s = isu ? U8_SCALE : V8_SCALE;
    const long base = (long)(isu ? job : job - 2048) * 8192 + tid * 16;
#pragma unroll
    for (int i = 0; i < 2; i++) {
      const long o = base + i * 4096;
      const float4 a = *(const float4*)(src + o), b = *(const float4*)(src + o + 4);
      const float4 c = *(const float4*)(src + o + 8), d = *(const float4*)(src + o + 12);
      const long e = o >> 10; const int col = (int)(o & 1023), sl = col >> 7, cc = col & 127;
      *(uint4*)(dst + ((long)sl * NEXP + e) * 128 + cc) = make_uint4(pack_fp8x4(a, s), pack_fp8x4(b, s), pack_fp8x4(c, s), pack_fp8x4(d, s));
    }
  }
}

template <bool BIG>
__device__ __forceinline__ void phase_s2(const Params& p, int L, char* smem) {
  constexpr int TM = BIG ? 256 : 128;
  const int lane = TIDX & 63, w = TIDX >> 6, wr = w >> 1, wc = w & 1;
  for (int pass = 0; pass < (L == 0 ? 1 : 2); pass++) {
  const int g_nrt = (L == 0) ? RTOT / TM : (pass == 0 ? TLAT / TM : TCTX / TM), g_nct = (L == 0 || pass == 0) ? 10 : 2;
  FOR_UNITS_XCD(g_nrt, g_nct, rt_, ct_)
    const int rt = (L == 1 && pass == 1) ? TLAT / TM + rt_ : rt_, ct = (L == 1 && pass == 1) ? 8 + ct_ : ct_;
    f32x16 acc[2][2];
    ZERO_ACC(acc);
    if constexpr (BIG) gemm256(p.hx + (long)rt * TM * 1024, 1024, p.W2T + (long)L * W2T_SZ + (long)ct * 128 * 1024, 1024, 1024, acc, smem);
    else gemm128(p.hx + (long)rt * TM * 1024, 1024, p.W2T + (long)L * W2T_SZ + (long)ct * 128 * 1024, 1024, 1024, acc, smem);
    const int row0 = rt * TM;
#define S2_STORE(DST, LDD, C0) { u16* dp = (DST) + (long)row0 * (LDD) + (C0); \
      const int tb = opaque((wr * 64 + 4 * (lane >> 5)) * (LDD) + wc * 64 + (lane & 31)); \
      _Pragma("unroll") for (int i = 0; i < 2; i++) _Pragma("unroll") for (int j = 0; j < 2; j++) _Pragma("unroll") for (int r = 0; r < 16; r++) \
        dp[tb + (i * 32 + (r & 3) + 8 * (r >> 2)) * (LDD) + j * 32] = tobf(acc[i][j][r]); }
    if (ct < 2) S2_STORE(p.cq, 256, ct * 128)
    else if (ct < 4) S2_STORE(p.zf, 256, (ct - 2) * 128)
    else if (ct < 8) S2_STORE(p.zc, 512, (ct - 4) * 128)
    else if (ct == 8) S2_STORE(p.ckv, 128, 0)
#undef S2_STORE
    else if (wc == 0) {
      float* dp = p.kr + (long)row0 * 32;
      const int tb = opaque((wr * 64 + 4 * (lane >> 5)) * 32 + (lane & 31));
#pragma unroll
      for (int i = 0; i < 2; i++)
#pragma unroll
        for (int r = 0; r < 16; r++)
          dp[tb + (i * 32 + (r & 3) + 8 * (r >> 2)) * 32] = acc[i][0][r];
    }
  }
  }
}

__device__ __forceinline__ void unit_kv(const Params& p, int L, int rt, int h, char* smem) {
  u16* As = (u16*)smem;
  u16* Ws = (u16*)(smem + 128 * 136 * 2);
  float* rrs = (float*)(smem + 2 * 128 * 136 * 2);
  const int tid = TIDS, lane = tid & 63, w = tid >> 6, hh = lane >> 5, c = lane & 31;
  const int row0 = rt * 128;
  __syncthreads();
  {
    const u16* ap = p.ckv + (long)row0 * 128;
    const u16* wp = p.WukvT + (long)L * WUKV_SZ + (long)h * 128 * 128;
#pragma unroll
    for (int i = 0; i < 8; i++) {
      const int idx = tid + 256 * i, rw = idx >> 4, ch = idx & 15;
      *(uint4*)(As + rw * 136 + ch * 8) = ldg16(ap + rw * 128 + ch * 8);
      *(uint4*)(Ws + rw * 136 + ch * 8) = ldg16(wp + rw * 128 + ch * 8);
    }
  }
  __syncthreads();
  {
    const int rw = tid >> 1, hf = tid & 1;
    float ss = 0.f;
#pragma unroll
    for (int q = 0; q < 8; q++) {
      uint4 v = *(const uint4*)(As + rw * 136 + hf * 64 + q * 8);
      float a;
      a = bf_lo(v.x); ss += a * a; a = bf_hi(v.x); ss += a * a;
      a = bf_lo(v.y); ss += a * a; a = bf_hi(v.y); ss += a * a;
      a = bf_lo(v.z); ss += a * a; a = bf_hi(v.z); ss += a * a;
      a = bf_lo(v.w); ss += a * a; a = bf_hi(v.w); ss += a * a;
    }
    ss += __shfl_xor(ss, 1);
    if (hf == 0) rrs[rw] = rsqrtf(ss * (1.0f / 128.0f) + EPSV);
  }
  __syncthreads();
  f32x16 aK[2], aV[2];
#pragma unroll
  for (int r = 0; r < 16; r++) { aK[0][r] = 0.f; aK[1][r] = 0.f; aV[0][r] = 0.f; aV[1][r] = 0.f; }
#pragma unroll
  for (int s = 0; s < 8; s++) {
    const int ko = s * 16 + hh * 8;
    uint4 tk = *(const uint4*)(As + (32 * w + c) * 136 + ko);
    uint4 w0 = *(const uint4*)(Ws + (c) * 136 + ko);
    uint4 w1 = *(const uint4*)(Ws + (32 + c) * 136 + ko);
    uint4 w2 = *(const uint4*)(Ws + (64 + c) * 136 + ko);
    uint4 w3 = *(const uint4*)(Ws + (96 + c) * 136 + ko);
    aK[0] = mfma32(tk, w0, aK[0]);
    aK[1] = mfma32(tk, w1, aK[1]);
    aV[0] = mfma32(w2, tk, aV[0]);
    aV[1] = mfma32(w3, tk, aV[1]);
  }
  const bool lat = row0 < TLAT;
  const int b = lat ? (row0 >> 12) : ((row0 - TLAT) >> 8);
  const int s0 = lat ? (row0 & 4095) : ((row0 - TLAT) & 255);
  const int kpos0 = lat ? (CTXL + s0) : s0;
  const float* gkn = p.g_kn + L * 96;
  const float gk0 = gkn[c], gk1 = gkn[32 + c], gk2 = gkn[64 + c];
  u16* Kdst = p.Kb + ((long)(b * 8 + h) * SKEYS + kpos0) * 96;
#pragma unroll
  for (int r = 0; r < 16; r++) {
    const int tl = 32 * w + (r & 3) + 8 * (r >> 2) + 4 * hh;
    const float rc = rrs[tl];
    const float v0 = aK[0][r] * rc, v1 = aK[1][r] * rc;
    const float kv = p.kr[(long)(row0 + tl) * 32 + c];
    const float ss = half_sum(v0 * v0 + v1 * v1 + kv * kv);
    const float rk = rsqrtf(ss * (1.0f / 96.0f) + EPSV);
    const float krn = kv * rk * gk2;
    const float partner = __shfl_xor(krn, 8);
    float o2 = krn;
    if (lat) {
      const int s = s0 + tl;
      const int pos = (c < 16) ? (s >> 6) : (s & 63);
      const float2 cs = *(const float2*)(p.ropetab + (pos * 8 + (c & 7)) * 2);
      const float rot = (c & 8) ? partner : -partner;
      o2 = krn * cs.x + rot * cs.y;
    }
    u16* kd = Kdst + (long)tl * 96;
    kd[c] = tobf(v0 * rk * gk0);
    kd[32 + c] = tobf(v1 * rk * gk1);
    kd[64 + c] = tobf(o2);
  }
  u16* Vdst = p.Vtb + (long)(b * 8 + h) * 64 * SKEYS + kpos0;
  const float rcv = rrs[32 * w + c];
#pragma unroll
  for (int i = 0; i < 2; i++)
#pragma unroll
    for (int r = 0; r < 16; r++) {
      const int d = 32 * i + (r & 3) + 8 * (r >> 2) + 4 * hh;
      Vdst[(long)d * SKEYS + 32 * w + c] = tobf(aV[i][r] * rcv);
    }
}

__device__ __forceinline__ void unit_chdft(const Params& p, int ut, int g, bool lat, char* smem) {
  const int lane = TIDS & 63, w = TIDS >> 6, wr = w >> 1, wc = w & 1;
  f32x16 acc[2][2];
  ZERO_ACC(acc);
  if (lat) {
    const int b = ut >> 5, j = ut & 31;
    gemm128x(p.Wcs, 64, p.zf + ((long)(b * SEQ + 2 * j) * 256 + g * 64), 64 * 256, 32 * 64 * 256, 256, 64, acc, smem);
    u16* dst = p.Ytl + ((long)(b * 256 + g * 64) * 64 + 2 * j) * 128;
#pragma unroll
    for (int i = 0; i < 2; i++)
#pragma unroll
      for (int jj = 0; jj < 2; jj++)
#pragma unroll
        for (int r = 0; r < 16; r++) {
          const int e = i * 32 + (r & 3) + 8 * (r >> 2) + 4 * (lane >> 5);
          dst[((long)e * 64 + wc) * 128 + wr * 64 + jj * 32 + (lane & 31)] = tobf(acc[i][jj][r]);
        }
  } else {
    const int row0 = TLAT + ut * 128;
    gemm128(p.Wcs, 64, p.zf + (long)row0 * 256 + g * 64, 256, 64, acc, smem);
    const int b = (row0 - TLAT) >> 8, s0 = (row0 - TLAT) & 255;
#pragma unroll
    for (int i = 0; i < 2; i++)
#pragma unroll
      for (int jj = 0; jj < 2; jj++)
#pragma unroll
        for (int r = 0; r < 16; r++) {
          const int n = ACC_ROW(wr, i, r, lane);
          const int t = s0 + ACC_COL(wc, jj, lane);
          p.Ytc[((long)(b * 256 + g * 64 + (n & 63))) * 512 + (n >> 6) * 256 + t] = tobf(acc[i][jj][r]);
        }
  }
}

__device__ __forceinline__ void unit_conv(const Params& p, int L, int ut, char* smem) {
  float* U = (float*)smem;
  const int tid = TIDS, lane = tid & 63, w = tid >> 6;
  const int row0 = ut * 32;
  const bool lat = row0 < TLAT;
  const int seqlen = lat ? SEQ : CTXL;
  const int s0 = lat ? (row0 & 4095) : ((row0 - TLAT) & 255);
  __syncthreads();
  {
    uint4 ca[8], cg[8];
#pragma unroll
    for (int q = 0; q < 8; q++) {
      const int id = tid + 256 * q, i = id >> 5, k = id & 31;
      const int s = s0 - 15 + i;
      ca[q] = make_uint4(0u, 0u, 0u, 0u); cg[q] = ca[q];
      if (i < 62 && s >= 0 && s < seqlen) {
        const u16* zr = p.zc + (long)(row0 - 15 + i) * 512 + k * 8;
        ca[q] = ldg16(zr); cg[q] = ldg16(zr + 256);
      }
    }
#pragma unroll
    for (int q = 0; q < 8; q++) {
      const int id = tid + 256 * q, i = id >> 5, k = id & 31;
      if (i < 62) {
        float4 u0, u1;
        u0.x = bf_lo(ca[q].x) * sigmoidf_(bf_lo(cg[q].x)); u0.y = bf_hi(ca[q].x) * sigmoidf_(bf_hi(cg[q].x));
        u0.z = bf_lo(ca[q].y) * sigmoidf_(bf_lo(cg[q].y)); u0.w = bf_hi(ca[q].y) * sigmoidf_(bf_hi(cg[q].y));
        u1.x = bf_lo(ca[q].z) * sigmoidf_(bf_lo(cg[q].z)); u1.y = bf_hi(ca[q].z) * sigmoidf_(bf_hi(cg[q].z));
        u1.z = bf_lo(ca[q].w) * sigmoidf_(bf_lo(cg[q].w)); u1.w = bf_hi(ca[q].w) * sigmoidf_(bf_hi(cg[q].w));
        *(float4*)(U + i * 256 + k * 8) = u0;
        *(float4*)(U + i * 256 + k * 8 + 4) = u1;
      }
    }
  }
  __syncthreads();
  float wv[31];
#pragma unroll
  for (int j = 0; j < 31; j++) wv[j] = p.w_dw[(long)L * 31 * 256 + j * 256 + tid];
  const float bias = p.b_dw[L * 256 + tid];
#pragma unroll 2
  for (int t = 0; t < 32; t++) {
    float acc = bias;
#pragma unroll
    for (int j = 0; j < 31; j++) acc += U[(t + j) * 256 + tid] * wv[j];
    U[t * 256 + tid] = acc;
  }
  __syncthreads();
  const float4 gg = *(const float4*)(p.g_cln + L * 256 + lane * 4);
  const float4 bb = *(const float4*)(p.b_cln + L * 256 + lane * 4);
#pragma unroll
  for (int q = 0; q < 8; q++) {
    const int t = w * 8 + q;
    const float4 v = *(const float4*)(U + t * 256 + lane * 4);
    const float mu = wave_sum(v.x + v.y + v.z + v.w) * (1.0f / 256.0f);
    const float d0 = v.x - mu, d1 = v.y - mu, d2 = v.z - mu, d3 = v.w - mu;
    const float var = wave_sum(d0 * d0 + d1 * d1 + d2 * d2 + d3 * d3) * (1.0f / 256.0f);
    const float rs = rsqrtf(var + EPSV);
    const float y0 = siluf_(d0 * rs * gg.x + bb.x), y1 = siluf_(d1 * rs * gg.y + bb.y);
    const float y2 = siluf_(d2 * rs * gg.z + bb.z), y3 = siluf_(d3 * rs * gg.w + bb.w);
    *(uint2*)(p.cv + (long)(row0 + t) * 256 + lane * 4) = make_uint2(pack2(y0, y1), pack2(y2, y3));
  }
}

#ifndef S3_REP_MASK
#define S3_REP_MASK 7
#endif
__device__ __forceinline__ void phase_s3(const Params& p, int L, char* smem, bool rep = false) {
  const int msk = rep ? S3_REP_MASK : 7;
  char* sm = smem + HALF_ * LDS_SMALL;
  const int nrt_all = (L == 0) ? 272 : 256;
  if (msk & 1) { FOR_PAIRED(272 * 8, u) unit_kv(p, L, u >> 3, u & 7, sm); } }
  if (msk & 2) { FOR_PAIRED(nrt_all * 4, v) const int ut = v >> 2; unit_chdft(p, ut < 256 ? ut : ut - 256, v & 3, ut < 256, sm); } }
  if (msk & 4) { FOR_PAIRED(nrt_all * 4, v) unit_conv(p, L, v, sm); } }
}

#define KLD 104
__device__ __forceinline__ void unit_attn(const Params& p, int L, int b, int h, int qt, bool isctx, char* smem) {
  const int tf = TIDX, NT = (int)blockDim.x, nh = NT >> 8, half = tf >> 8, wf = tf >> 6;
  const int tid = tf & 255, lane = tid & 63, w = tid >> 6, hh = lane >> 5, c = lane & 31;
  const int qtile = qt * nh + half;
  const int qrow0 = isctx ? (TLAT + b * CTXL + qtile * 128) : (b * SEQ + qtile * 128);
  const int nkt = isctx ? (CTXL / 64) : (SKEYS / 64);
  char* smh = smem + half * LDS_SMALL;
  u16* As = (u16*)smh;
  u16* Bs = (u16*)(smh + 128 * LDT * 2);
  u16* Qs = (u16*)(smh + (128 + 96) * LDT * 2);
  f32x16 aq[3];
#pragma unroll
  for (int r = 0; r < 16; r++) { aq[0][r] = 0.f; aq[1][r] = 0.f; aq[2][r] = 0.f; }
  float ssq = 0.f;
  const u16* cqp = p.cq + (long)qrow0 * 256;
  const u16* wqp = p.WuqT + (long)L * WUQ_SZ + (long)h * 96 * 256;
  uint4 pa[4][4], pb[4][3];
#pragma unroll
  for (int kc = 0; kc < 4; kc++) {
#pragma unroll
    for (int i = 0; i < 4; i++) { const int idx = tid + 256 * i; pa[kc][i] = ldg16(cqp + (idx >> 3) * 256 + kc * 64 + (idx & 7) * 8); }
#pragma unroll
    for (int i = 0; i < 3; i++) { const int idx = tid + 256 * i; pb[kc][i] = ldg16(wqp + (idx >> 3) * 256 + kc * 64 + (idx & 7) * 8); }
  }
  __builtin_amdgcn_sched_barrier(0);
#pragma unroll
  for (int kc = 0; kc < 4; kc++) {
    __syncthreads();
#pragma unroll
    for (int i = 0; i < 4; i++) {
      const int idx = tid + 256 * i, rw = idx >> 3, ch = idx & 7;
      *(uint4*)(As + rw * LDT + ch * 8) = pa[kc][i];
    }
#pragma unroll
    for (int i = 0; i < 3; i++) {
      const int idx = tid + 256 * i, rw = idx >> 3, ch = idx & 7;
      *(uint4*)(Bs + rw * LDT + ch * 8) = pb[kc][i];
    }
    __syncthreads();
#pragma unroll
    for (int q = 0; q < 4; q++) {
      uint4 v = *(const uint4*)(As + (32 * w + c) * LDT + hh * 32 + q * 8);
      float a;
      a = bf_lo(v.x); ssq += a * a; a = bf_hi(v.x); ssq += a * a;
      a = bf_lo(v.y); ssq += a * a; a = bf_hi(v.y); ssq += a * a;
      a = bf_lo(v.z); ssq += a * a; a = bf_hi(v.z); ssq += a * a;
      a = bf_lo(v.w); ssq += a * a; a = bf_hi(v.w); ssq += a * a;
    }
#pragma unroll
    for (int kk = 0; kk < 4; kk++) {
      uint4 a = *(const uint4*)(As + (32 * w + c) * LDT + kk * 16 + hh * 8);
#pragma unroll
      for (int j = 0; j < 3; j++) {
        uint4 bq = *(const uint4*)(Bs + (32 * j + c) * LDT + kk * 16 + hh * 8);
        aq[j] = mfma32(a, bq, aq[j]);
      }
    }
  }
  ssq += __shfl_xor(ssq, 32);
  const float rr_lane = rsqrtf(ssq * (1.0f / 256.0f) + EPSV);
  {
    const float* gqn = p.g_qn + L * 96;
    const float g0 = gqn[c], g1 = gqn[32 + c], g2 = gqn[64 + c];
    const float qscale = 0.10206207261596577f * 1.4426950408889634f;
    u16* Qw = Qs + w * 32 * KLD;
#pragma unroll
    for (int r = 0; r < 16; r++) {
      const int rl = (r & 3) + 8 * (r >> 2) + 4 * hh;
      const float rc = __shfl(rr_lane, rl);
      const float q0 = aq[0][r] * rc, q1 = aq[1][r] * rc, q2 = aq[2][r] * rc;
      const float ss = half_sum(q0 * q0 + q1 * q1 + q2 * q2);
      const float rq = rsqrtf(ss * (1.0f / 96.0f) + EPSV);
      const float qn2 = q2 * rq * g2;
      const float partner = __shfl_xor(qn2, 8);
      float o2 = qn2;
      if (!isctx) {
        const int s = qtile * 128 + 32 * w + rl;
        const int pos = (c < 16) ? (s >> 6) : (s & 63);
        const float2 cs = *(const float2*)(p.ropetab + (pos * 8 + (c & 7)) * 2);
        const float rot = (c & 8) ? partner : -partner;
        o2 = qn2 * cs.x + rot * cs.y;
      }
      Qw[rl * KLD + c] = tobf(q0 * rq * g0 * qscale);
      Qw[rl * KLD + 32 + c] = tobf(q1 * rq * g1 * qscale);
      Qw[rl * KLD + 64 + c] = tobf(o2 * qscale);
    }
  }
  __syncthreads();
  uint4 qf[6];
#pragma unroll
  for (int s = 0; s < 6; s++) qf[s] = *(const uint4*)(Qs + (w * 32 + c) * KLD + s * 16 + hh * 8);
  __syncthreads();
  u16* Ks = (u16*)smem;
  u16* Vs = (u16*)(smem + 2 * 64 * KLD * 2);
  const u16* kg = p.Kb + (long)(b * 8 + h) * SKEYS * 96;
  const u16* vg = p.Vtb + (long)(b * 8 + h) * 64 * SKEYS;
  uint4 rk[3], rv[2];
  int krow[3], kch[3], vrw[2], vch[2];
#pragma unroll
  for (int i = 0; i < 3; i++) { const int idx = tf + NT * i; krow[i] = idx / 12; kch[i] = idx % 12; }
#pragma unroll
  for (int i = 0; i < 2; i++) { const int idx = tf + NT * i; vrw[i] = idx >> 3; vch[i] = idx & 7; }
#pragma unroll
  for (int i = 0; i < 3; i++) if (tf + NT * i < 768) rk[i] = ldg16(kg + (long)(tf + NT * i) * 8);
#pragma unroll
  for (int i = 0; i < 2; i++) if (tf + NT * i < 512) rv[i] = ldg16(vg + (long)vrw[i] * SKEYS + vch[i] * 8);
#pragma unroll
  for (int i = 0; i < 3; i++) if (tf + NT * i < 768) *(uint4*)(Ks + krow[i] * KLD + kch[i] * 8) = rk[i];
#pragma unroll
  for (int i = 0; i < 2; i++) if (tf + NT * i < 512) *(uint4*)(Vs + vrw[i] * LDT + vch[i] * 8) = rv[i];
  __syncthreads();
  f32x16 aO[2];
#pragma unroll
  for (int r = 0; r < 16; r++) { aO[0][r] = 0.f; aO[1][r] = 0.f; }
  float mref = 0.f;
  f32x2 lsum2 = {0.f, 0.f};
  const int kperm = (c & ~12) | ((c & 4) << 1) | ((c & 8) >> 1);
  for (int kt = 0; kt < nkt; kt++) {
    const int cur = kt & 1;
    if (kt + 1 < nkt) {
#pragma unroll
      for (int i = 0; i < 3; i++) if (tf + NT * i < 768) rk[i] = ldg16(kg + (long)(kt + 1) * 64 * 96 + (long)(tf + NT * i) * 8);
#pragma unroll
      for (int i = 0; i < 2; i++) if (tf + NT * i < 512) rv[i] = ldg16(vg + (long)vrw[i] * SKEYS + (kt + 1) * 64 + vch[i] * 8);
    }
    __builtin_amdgcn_sched_barrier(0);
    const u16* Kc = Ks + cur * 64 * KLD;
    const u16* Vc = Vs + cur * 64 * LDT;
    f32x16 aS[2];
    {
      const float nm = -mref;
#pragma unroll
      for (int r = 0; r < 16; r++) { aS[0][r] = nm; aS[1][r] = nm; }
    }
#pragma unroll
    for (int s = 0; s < 6; s++) {
      uint4 k0 = *(const uint4*)(Kc + (kperm) * KLD + s * 16 + hh * 8);
      uint4 k1 = *(const uint4*)(Kc + (32 + kperm) * KLD + s * 16 + hh * 8);
      aS[0] = mfma32(k0, qf[s], aS[0]);
      aS[1] = mfma32(k1, qf[s], aS[1]);
    }
    float mx = fmaxf(aS[0][0], aS[1][0]);
#pragma unroll
    for (int r = 1; r < 16; r++) mx = fmaxf(fmaxf(mx, aS[0][r]), aS[1][r]);
    if (__any(mx > 8.0f)) {
      const float mo = fmaxf(mx, __shfl_xor(mx, 32));
      const float delta = (mo > 8.0f) ? mo : 0.f;
      const float alpha = __builtin_amdgcn_exp2f(-delta);
      mref += delta;
      lsum2 *= alpha;
#pragma unroll
      for (int r = 0; r < 16; r++) {
        aO[0][r] *= alpha; aO[1][r] *= alpha;
        aS[0][r] -= delta; aS[1][r] -= delta;
      }
    }
#pragma unroll
    for (int r = 0; r < 16; r += 2) {
      aS[0][r] = __builtin_amdgcn_exp2f(aS[0][r]); aS[0][r + 1] = __builtin_amdgcn_exp2f(aS[0][r + 1]);
      aS[1][r] = __builtin_amdgcn_exp2f(aS[1][r]); aS[1][r + 1] = __builtin_amdgcn_exp2f(aS[1][r + 1]);
      const f32x2 p0 = {aS[0][r], aS[0][r + 1]}, p1 = {aS[1][r], aS[1][r + 1]};
      lsum2 += p0; lsum2 += p1;
    }
#pragma unroll
    for (int i = 0; i < 2; i++)
#pragma unroll
      for (int s2 = 0; s2 < 2; s2++) {
        uint4 pf = make_uint4(pack2(aS[i][8 * s2 + 0], aS[i][8 * s2 + 1]), pack2(aS[i][8 * s2 + 2], aS[i][8 * s2 + 3]),
                              pack2(aS[i][8 * s2 + 4], aS[i][8 * s2 + 5]), pack2(aS[i][8 * s2 + 6], aS[i][8 * s2 + 7]));
        uint4 v0 = *(const uint4*)(Vc + (c) * LDT + 32 * i + 16 * s2 + 8 * hh);
        uint4 v1 = *(const uint4*)(Vc + (32 + c) * LDT + 32 * i + 16 * s2 + 8 * hh);
        aO[0] = mfma32(v0, pf, aO[0]);
        aO[1] = mfma32(v1, pf, aO[1]);
      }
    if (kt + 1 < nkt) {
      const int nx = cur ^ 1;
#pragma unroll
      for (int i = 0; i < 3; i++) if (tf + NT * i < 768) *(uint4*)(Ks + nx * 64 * KLD + krow[i] * KLD + kch[i] * 8) = rk[i];
#pragma unroll
      for (int i = 0; i < 2; i++) if (tf + NT * i < 512) *(uint4*)(Vs + nx * 64 * LDT + vrw[i] * LDT + vch[i] * 8) = rv[i];
    }
    __syncthreads();
  }
  float lsum = lsum2.x + lsum2.y;
  lsum += __shfl_xor(lsum, 32);
  const float inv = 1.0f / lsum;
  u16* Os = (u16*)smem + wf * 32 * LDT;
#pragma unroll
  for (int i = 0; i < 2; i++)
#pragma unroll
    for (int r = 0; r < 16; r++) {
      const int d = 32 * i + (r & 3) + 8 * (r >> 2) + 4 * hh;
      Os[c * LDT + d] = tobf(aO[i][r] * inv);
    }
  __syncthreads();
#pragma unroll
  for (int i = 0; i < 4; i++) {
    const int idx = lane + 64 * i, q = idx >> 3, ch = idx & 7;
    *(uint4*)(p.Ob + (long)(qrow0 + 32 * w + q) * 512 + h * 64 + ch * 8) = *(const uint4*)(Os + q * LDT + ch * 8);
  }
}

__device__ __forceinline__ void unit_dftA(const Params& p, int b, int np, char* smem) {
  const int lane = TIDS & 63, w = TIDS >> 6, wr = w >> 1, wc = w & 1, hh = lane >> 5, c = lane & 31;
  f32x16 acc[2][2];
  ZERO_ACC(acc);
  gemm128(p.WA, 128, p.Ytl + (long)(b * 256 + 2 * np) * 64 * 128, 128, 128, acc, smem);
  const int n = 2 * np + wc;
#pragma unroll
  for (int jj = 0; jj < 2; jj++) {
    const int t2 = jj * 32 + c;
#pragma unroll
    for (int r = 0; r < 16; r++) {
      const int k1 = wr * 32 + (r & 3) + 8 * (r >> 2) + 4 * hh;
      const float2 t = *(const float2*)(p.tw + 2 * ((k1 * t2) & 4095));
      const float gr = acc[0][jj][r], gi = acc[1][jj][r];
      u16* dst = p.GB + ((long)((b * 64 + k1) * 256 + n)) * 128 + t2;
      dst[0] = tobf(gr * t.x + gi * t.y);
      dst[64] = tobf(gi * t.x - gr * t.y);
    }
  }
}
__device__ __forceinline__ void unit_dftC(const Params& p, int b, int k1, int nt, char* smem) {
  const int lane = TIDS & 63, w = TIDS >> 6, wr = w >> 1, wc = w & 1, hh = lane >> 5, c = lane & 31;
  f32x16 acc[2][2];
  ZERO_ACC(acc);
  gemm128(p.WC, 128, p.GB + ((long)((b * 64 + k1) * 256 + nt * 128)) * 128, 128, 128, acc, smem);
  if (wr == 0) {
#pragma unroll
    for (int i = 0; i < 2; i++)
#pragma unroll
      for (int jj = 0; jj < 2; jj++)
#pragma unroll
        for (int r = 0; r < 16; r++) {
          const int k2 = i * 32 + (r & 3) + 8 * (r >> 2) + 4 * hh;
          p.Fb[((long)b * SEQ + k1 + 64 * k2) * 256 + nt * 128 + wc * 64 + jj * 32 + c] = tobf(acc[i][jj][r]);
        }
  }
}
__device__ __forceinline__ void unit_seqdft_ctx(const Params& p, int b, int mt, int nt, char* smem) {
  const int lane = TIDS & 63, w = TIDS >> 6, wr = w >> 1, wc = w & 1;
  f32x16 acc[2][2];
  ZERO_ACC(acc);
  gemm128(p.Dctx + (long)mt * 128 * 512, 512, p.Ytc + (long)(b * 256 + nt * 128) * 512, 512, 512, acc, smem);
  const long orow0 = (long)TLAT + b * CTXL + mt * 128;
#pragma unroll
  for (int i = 0; i < 2; i++)
#pragma unroll
    for (int j = 0; j < 2; j++)
#pragma unroll
      for (int r = 0; r < 16; r++)
        p.Fb[(orow0 + ACC_ROW(wr, i, r, lane)) * 256 + nt * 128 + ACC_COL(wc, j, lane)] = tobf(acc[i][j][r]);
}
__device__ __forceinline__ void phase_dftC(const Params& p, char* smem) {
  char* sm = smem + HALF_ * LDS_SMALL;
  FOR_PAIRED(8 * 64 * 2, u) unit_dftC(p, u >> 7, (u >> 1) & 63, u & 1, sm); }
}

__device__ __forceinline__ void phase_s4(const Params& p, int L, char* smem) {
  char* sm = smem + HALF_ * LDS_SMALL;
  const int nh = (int)(blockDim.x >> 8), tpp = 32 / nh;
  {
    const int x = blockIdx.x & 7, l = blockIdx.x >> 3, nl = gridDim.x >> 3;
    for (int s = l; s < 8 * tpp; s += nl) {
      const int bh = x * 8 + s / tpp;
      unit_attn(p, L, bh >> 3, bh & 7, s % tpp, false, smem);
    }
  }
  FOR_PAIRED(8 * 128, v) unit_dftA(p, v >> 7, v & 127, sm); }
  if (L == 0) {
    FOR_PAIRED(8 * 2 * 2, v) unit_seqdft_ctx(p, v >> 2, (v >> 1) & 1, v & 1, sm); }
    const int tpc = 2 / nh;
    for (int v = blockIdx.x; v < 64 * tpc; v += gridDim.x) unit_attn(p, L, (v / tpc) >> 3, (v / tpc) & 7, v % tpc, true, smem);
  }
}

template <bool BIG>
__device__ __forceinline__ void phase_s7(const Params& p, int L, char* smem) {
  constexpr int TM = BIG ? 256 : 128;
  const int nrt = ((L == 0) ? RTOT : TLAT) / TM;
  FOR_UNITS_XCD(nrt, 8, rt, ct)
    const int row0 = rt * TM;
    f32x16 macc[2][2];
    ZERO_ACC(macc);
#pragma unroll 1
    for (int br = 0; br < 3; br++) {
      unsigned gp[2][2][8];
      {
      f32x16 acc[2][2];
      ZERO_ACC(acc);
      if constexpr (BIG) gemm256(p.hx + (long)row0 * 1024, 1024, p.WgT + (long)L * WGT_SZ + (long)(br * 1024 + ct * 128) * 1024, 1024, 1024, acc, smem);
      else gemm128(p.hx + (long)row0 * 1024, 1024, p.WgT + (long)L * WGT_SZ + (long)(br * 1024 + ct * 128) * 1024, 1024, 1024, acc, smem);
#pragma unroll
      for (int i = 0; i < 2; i++)
#pragma unroll
        for (int j = 0; j < 2; j++)
#pragma unroll
          for (int r = 0; r < 8; r++) gp[i][j][r] = pack2(sigmoidf_(acc[i][j][2 * r]), sigmoidf_(acc[i][j][2 * r + 1]));
      }
      const u16* A2; const u16* B2; int K2;
      if (br == 0) { A2 = p.Ob + (long)row0 * 512; B2 = p.WbaT + (long)L * WBA_SZ + (long)ct * 128 * 512; K2 = 512; }
      else if (br == 1) { A2 = p.Fb + (long)row0 * 256; B2 = p.WbfT + (long)L * WBF_SZ + (long)ct * 128 * 256; K2 = 256; }
      else { A2 = p.cv + (long)row0 * 256; B2 = p.WbcT + (long)L * WBC_SZ + (long)ct * 128 * 256; K2 = 256; }
      {
        f32x16 ab[2][2];
        ZERO_ACC(ab);
        if constexpr (BIG) gemm256(A2, K2, B2, K2, K2, ab, smem); else gemm128(A2, K2, B2, K2, K2, ab, smem);
#pragma unroll
        for (int i = 0; i < 2; i++)
#pragma unroll
          for (int j = 0; j < 2; j++)
#pragma unroll
            for (int r = 0; r < 8; r++) {
              if ((ABL_BR >> br) & 1) {
              macc[i][j][2 * r] += bf_lo(gp[i][j][r]) * ab[i][j][2 * r];
              macc[i][j][2 * r + 1] += bf_hi(gp[i][j][r]) * ab[i][j][2 * r + 1];
              }
            }
      }
    }
    u16* mp = p.m + (long)row0 * 1024 + ct * 128;
    const int tid = TIDX, lane = tid & 63, w = tid >> 6, wr = w >> 1, wc = w & 1;
    const int tb = (wr * 64 + 4 * (lane >> 5)) * 1024 + wc * 64 + (lane & 31);
#pragma unroll
    for (int i = 0; i < 2; i++)
#pragma unroll
      for (int j = 0; j < 2; j++)
#pragma unroll
        for (int r = 0; r < 16; r++)
          mp[tb + (i * 32 + (r & 3) + 8 * (r >> 2)) * 1024 + j * 32] = tobf(macc[i][j][r]);
  }
  if (L == 0) {
    const int per_xcd = (int)(gridDim.x >> 3), l = (int)(blockIdx.x >> 3), x = (int)(blockIdx.x & 7);
    const int n5 = (nrt >> 3) * 8 - 4 * per_xcd;
    if (n5 >= 0 && n5 < per_xcd) {
      const int nidle = per_xcd - n5, nh = (int)(blockDim.x >> 8);
      if (l >= n5) phase_tables(p, L, (x * nidle + (l - n5)) * nh + HALF_, 8 * nidle * nh);
    } else phase_tables(p, L);
  }
}

template <bool BIG>
__device__ __forceinline__ void phase_s8(const Params& p, int L, char* smem, bool dry = false) {
  constexpr int TM = BIG ? 256 : 128;
  const int lane = TIDX & 63, w = TIDX >> 6, wr = w >> 1, wc = w & 1;
  const int nrt = ((L == 0) ? RTOT : TLAT) / TM;
  FOR_UNITS_XCD(nrt, 8, rt, ct)
    const long row0 = (long)rt * TM;
    f32x16 acc[2][2];
    ZERO_ACC(acc);
    if constexpr (BIG) gemm256(p.m + row0 * 1024, 1024, p.WoutT + (long)L * WOUT_SZ + (long)ct * 128 * 1024, 1024, 1024, acc, smem);
    else gemm128(p.m + row0 * 1024, 1024, p.WoutT + (long)L * WOUT_SZ + (long)ct * 128 * 1024, 1024, 1024, acc, smem);
    const int mr = row_mod((int)row0);
    const float* gt = p.mods + (long)(L * 9 + mr) * 6144 + 2048 + ct * 128;
    const float* src; float* dst;
    if (row0 < TLAT) { src = (L == 0 ? p.x : p.out) + row0 * 1024; dst = p.out + row0 * 1024; }
    else { src = (L == 0 ? p.ctx : p.ctx1) + (row0 - TLAT) * 1024; dst = p.ctx1 + (row0 - TLAT) * 1024; }
    src += ct * 128; dst += ct * 128;
    const int tb = opaque((wr * 64 + 4 * (lane >> 5)) * 1024 + wc * 64 + (lane & 31));
#pragma unroll
    for (int j = 0; j < 2; j++) {
      const float gv = gt[ACC_COL(wc, j, lane)];
#pragma unroll
      for (int i = 0; i < 2; i++)
#pragma unroll
        for (int r = 0; r < 16; r++) {
          const int o = tb + (i * 32 + (r & 3) + 8 * (r >> 2)) * 1024 + j * 32;
          const float nv = src[o] + gv * acc[i][j][r];
          if (!dry) dst[o] = nv;
        }
    }
  }
}

#define CE_DESC(a, b) { const float _x = fmaxf(a, b); const float _y = fminf(a, b); a = _x; b = _y; }
template <int N>
__device__ __forceinline__ void bitonic_sort_desc(float (&v)[N]) {
#pragma unroll
  for (int k = 2; k <= N; k <<= 1)
#pragma unroll
    for (int j = k >> 1; j > 0; j >>= 1)
#pragma unroll
      for (int i = 0; i < N; i++) {
        const int l = i ^ j;
        if (l > i) {
          if ((i & k) == 0) { CE_DESC(v[i], v[l]); } else { CE_DESC(v[l], v[i]); }
        }
      }
}
template <int N>
__device__ __forceinline__ void bitonic_merge_desc(float (&v)[N]) {
#pragma unroll
  for (int j = N >> 1; j > 0; j >>= 1)
#pragma unroll
    for (int i = 0; i < N; i++) {
      const int l = i ^ j;
      if (l > i) { CE_DESC(v[i], v[l]); }
    }
}
__device__ __forceinline__ void merge_top16(float (&a)[16], const float (&b)[16]) {
#pragma unroll
  for (int i = 0; i < 16; i++) a[i] = fmaxf(a[i], b[15 - i]);
  bitonic_merge_desc<16>(a);
}
__device__ __forceinline__ void top16_of_tiles(const f32x16 (&s)[4], int hh, float (&res)[16]) {
  float g[4][16];
#pragma unroll
  for (int t = 0; t < 4; t++) {
#pragma unroll
    for (int r = 0; r < 16; r++) {
      const unsigned key = (unsigned)(32 * t + (r & 3) + 8 * (r >> 2)) + (unsigned)(4 * hh);
      g[t][r] = __uint_as_float((__float_as_uint(s[t][r]) & 0xffffff80u) | key);
    }
    bitonic_sort_desc<16>(g[t]);
  }
  merge_top16(g[0], g[1]);
  merge_top16(g[2], g[3]);
  merge_top16(g[0], g[2]);
  float o[16];
#pragma unroll
  for (int i = 0; i < 16; i++) o[i] = __shfl_xor(g[0][i], 32);
  merge_top16(g[0], o);
#pragma unroll
  for (int i = 0; i < 16; i++) res[i] = g[0][i];
}

template <bool BIG>
__device__ __forceinline__ void unit_peer_query(const Params& p, int L, int rt, int h, char* smem) {
  constexpr int TM = BIG ? 256 : 128, NT = BIG ? 512 : 256;
  const int tid = TIDX, lane = tid & 63, w = tid >> 6, wr = w >> 1, wc = w & 1, hh = lane >> 5, c = lane & 31;
  const long row0 = (long)rt * TM;
  u16* Qs = (u16*)smem;
  u16* Ss = (u16*)(smem + TM * 136 * 2);
  {
    f32x16 acc[2][2];
    ZERO_ACC(acc);
    if constexpr (BIG) gemm256(p.hx + row0 * 1024, 1024, p.WqT + (long)L * WQ_SZ + (long)h * 128 * 1024, 1024, 1024, acc, smem);
    else gemm128(p.hx + row0 * 1024, 1024, p.WqT + (long)L * WQ_SZ + (long)h * 128 * 1024, 1024, 1024, acc, smem);
#pragma unroll
    for (int i = 0; i < 2; i++)
#pragma unroll
      for (int j = 0; j < 2; j++)
#pragma unroll
        for (int r = 0; r < 16; r++) Qs[ACC_ROW(wr, i, r, lane) * 136 + ACC_COL(wc, j, lane)] = tobf(acc[i][j][r]);
    const u16* sk = p.SubK + (long)L * SUBK_SZ + (long)h * 2 * 128 * 64;
#pragma unroll
    for (int i = 0; i < 2048 / NT; i++) {
      const int idx = tid + NT * i, rw = idx >> 3, ch = idx & 7;
      *(uint4*)(Ss + rw * LDT + ch * 8) = ldg16(sk + rw * 64 + ch * 8);
    }
  }
  __syncthreads();
  float top[2][16];
#pragma unroll
  for (int pp = 0; pp < 2; pp++) {
    f32x16 s[4];
#pragma unroll
    for (int t = 0; t < 4; t++)
#pragma unroll
      for (int r = 0; r < 16; r++) s[t][r] = 0.f;
#pragma unroll
    for (int kk = 0; kk < 4; kk++) {
      uint4 bq = *(const uint4*)(Qs + (32 * w + c) * 136 + pp * 64 + kk * 16 + hh * 8);
#pragma unroll
      for (int t = 0; t < 4; t++) {
        uint4 ak = *(const uint4*)(Ss + (pp * 128 + 32 * t + c) * LDT + kk * 16 + hh * 8);
        s[t] = mfma32(ak, bq, s[t]);
      }
    }
    top16_of_tiles(s, hh, top[pp]);
  }
  float cand[64];
#define CAND(q, a, b) cand[q] = __uint_as_float((__float_as_uint(top[0][a] + top[1][b]) & 0xffffff00u) | (unsigned)((a) * 16 + (b)));
  CAND(0, 0, 0)
  CAND(1, 0, 1)
  CAND(2, 0, 2)
  CAND(3, 0, 3)
  CAND(4, 0, 4)
  CAND(5, 0, 5)
  CAND(6, 0, 6)
  CAND(7, 0, 7)
  CAND(8, 0, 8)
  CAND(9, 0, 9)
  CAND(10, 0, 10)
  CAND(11, 0, 11)
  CAND(12, 0, 12)
  CAND(13, 0, 13)
  CAND(14, 0, 14)
  CAND(15, 0, 15)
  CAND(16, 1, 0)
  CAND(17, 1, 1)
  CAND(18, 1, 2)
  CAND(19, 1, 3)
  CAND(20, 1, 4)
  CAND(21, 1, 5)
  CAND(22, 1, 6)
  CAND(23, 1, 7)
  CAND(24, 2, 0)
  CAND(25, 2, 1)
  CAND(26, 2, 2)
  CAND(27, 2, 3)
  CAND(28, 2, 4)
  CAND(29, 3, 0)
  CAND(30, 3, 1)
  CAND(31, 3, 2)
  CAND(32, 3, 3)
  CAND(33, 4, 0)
  CAND(34, 4, 1)
  CAND(35, 4, 2)
  CAND(36, 5, 0)
  CAND(37, 5, 1)
  CAND(38, 6, 0)
  CAND(39, 6, 1)
  CAND(40, 7, 0)
  CAND(41, 7, 1)
  CAND(42, 8, 0)
  CAND(43, 9, 0)
  CAND(44, 10, 0)
  CAND(45, 11, 0)
  CAND(46, 12, 0)
  CAND(47, 13, 0)
  CAND(48, 14, 0)
  CAND(49, 15, 0)
#undef CAND
#pragma unroll
  for (int q = 50; q < 64; q++) cand[q] = -3.0e38f;
  float best[16];
  {
    float g[4][16];
#pragma unroll
    for (int t = 0; t < 4; t++) {
#pragma unroll
      for (int r = 0; r < 16; r++) g[t][r] = cand[t * 16 + r];
      bitonic_sort_desc<16>(g[t]);
    }
    merge_top16(g[0], g[1]);
    merge_top16(g[2], g[3]);
    merge_top16(g[0], g[2]);
#pragma unroll
    for (int i = 0; i < 16; i++) best[i] = g[0][i];
  }
  float e[16], es = 0.f;
#pragma unroll
  for (int i = 0; i < 16; i++) { e[i] = __expf(best[i] - best[0]); es += e[i]; }
  const float einv = 1.0f / es;
  __syncthreads();
  int* Ix = (int*)smem + w * 32 * 33;
  if (hh == 0) {
#pragma unroll
    for (int i = 0; i < 16; i++) {
      Ix[c * 33 + i] = (int)(__float_as_uint(top[0][i]) & 127u);
      Ix[c * 33 + 16 + i] = (int)(__float_as_uint(top[1][i]) & 127u);
    }
  }
  __syncthreads();
  const long orow = row0 + 32 * w + c;
  int* ed = p.eid + orow * 128 + h * 16 + hh * 8;
  float* gd = p.gate + orow * 128 + h * 16 + hh * 8;
  int ev[8]; float gv[8];
#pragma unroll
  for (int i = 0; i < 8; i++) {
    const unsigned hm = 0u - (unsigned)hh;
    const unsigned bselu = (__float_as_uint(best[8 + i]) & hm) | (__float_as_uint(best[i]) & ~hm);
    const float esel = __uint_as_float((__float_as_uint(e[8 + i]) & hm) | (__float_as_uint(e[i]) & ~hm));
    const unsigned id = bselu & 255u;
    const int ia = Ix[c * 33 + (id >> 4)], ib = Ix[c * 33 + 16 + (id & 15)];
    ev[i] = ia * 128 + ib;
    gv[i] = esel * einv;
  }
  *(int4*)(ed) = make_int4(ev[0], ev[1], ev[2], ev[3]);
  *(int4*)(ed + 4) = make_int4(ev[4], ev[5], ev[6], ev[7]);
  *(float4*)(gd) = make_float4(gv[0], gv[1], gv[2], gv[3]);
  *(float4*)(gd + 4) = make_float4(gv[4], gv[5], gv[6], gv[7]);
}

template <bool BIG>
__device__ __forceinline__ void phase_s10(const Params& p, int L, char* smem) {
  const int nrt = ((L == 0) ? RTOT : TLAT) / (BIG ? 256 : 128);
  FOR_UNITS_XCD(nrt, 8, rt, hd) unit_peer_query<BIG>(p, L, rt, hd, smem); }
}

#define CVT8(w, lo2, hi2) { lo2 = __builtin_amdgcn_cvt_pk_f32_fp8((int)(w), false); hi2 = __builtin_amdgcn_cvt_pk_f32_fp8((int)(w), true); }
#if CHECK_ATTN
#define NB11 1
#else
#define NB11 2
#endif
__device__ __forceinline__ void phase_s11a(const Params& p, int L) {
  const int lane = TIDS & 63, j = lane >> 3, cch = lane & 7;
  const int sl = VBID & 7;
  const int lw = (VBID >> 3) * 4 + (TIDS >> 6), nlw = (NVB >> 3) * 4;
  const int nrows = (L == 0) ? RTOT : TLAT;
  const unsigned char* Us = p.UT8 + (long)sl * NEXP * 128 + cch * 16;
  int rrN[NB11]; bool okN[NB11];
  uint4 haN[NB11], hbN[NB11]; int e_loN[NB11], e_hiN[NB11];
  auto load_idx = [&](int r0) __attribute__((always_inline)) {
#pragma unroll
    for (int u = 0; u < NB11; u++) {
      const int r = r0 + u * nlw;
      okN[u] = r < nrows; rrN[u] = okN[u] ? r : lw;
      haN[u] = ldg16(p.hx + (long)rrN[u] * 1024 + sl * 128 + cch * 16);
      hbN[u] = ldg16(p.hx + (long)rrN[u] * 1024 + sl * 128 + cch * 16 + 8);
      e_loN[u] = p.eid[(long)rrN[u] * 128 + lane]; e_hiN[u] = p.eid[(long)rrN[u] * 128 + 64 + lane];
    }
  };
  if (lw < nrows) load_idx(lw);
  for (int r0 = lw; r0 < nrows; r0 += NB11 * nlw) {
    int rr[NB11]; bool ok[NB11];
    uint4 ha[NB11], hb[NB11]; int e_lo[NB11], e_hi[NB11];
#pragma unroll
    for (int u = 0; u < NB11; u++) { rr[u] = rrN[u]; ok[u] = okN[u]; ha[u] = haN[u]; hb[u] = hbN[u]; e_lo[u] = e_loN[u]; e_hi[u] = e_hiN[u]; }
    uint4 uu[NB11][16];
#pragma unroll
    for (int u = 0; u < NB11; u++)
#pragma unroll
      for (int i = 0; i < 16; i++) {
        const int e = __shfl(i < 8 ? e_lo[u] : e_hi[u], 8 * (i & 7) + j);
        uu[u][i] = ldg16(Us + (long)e * 128);
      }
    if (r0 + NB11 * nlw < nrows) load_idx(r0 + NB11 * nlw);
    __builtin_amdgcn_sched_barrier(0);
#pragma unroll
    for (int u = 0; u < NB11; u++) {
      f32x2 h2[8];
      h2[0] = f32x2{bf_lo(ha[u].x), bf_hi(ha[u].x)}; h2[1] = f32x2{bf_lo(ha[u].y), bf_hi(ha[u].y)};
      h2[2] = f32x2{bf_lo(ha[u].z), bf_hi(ha[u].z)}; h2[3] = f32x2{bf_lo(ha[u].w), bf_hi(ha[u].w)};
      h2[4] = f32x2{bf_lo(hb[u].x), bf_hi(hb[u].x)}; h2[5] = f32x2{bf_lo(hb[u].y), bf_hi(hb[u].y)};
      h2[6] = f32x2{bf_lo(hb[u].z), bf_hi(hb[u].z)}; h2[7] = f32x2{bf_lo(hb[u].w), bf_hi(hb[u].w)};
      float d[16];
#pragma unroll
      for (int i = 0; i < 16; i++) {
        f32x2 a0, a1, acc = {0.f, 0.f};
        CVT8(uu[u][i].x, a0, a1); acc += a0 * h2[0]; acc += a1 * h2[1];
        CVT8(uu[u][i].y, a0, a1); acc += a0 * h2[2]; acc += a1 * h2[3];
        CVT8(uu[u][i].z, a0, a1); acc += a0 * h2[4]; acc += a1 * h2[5];
        CVT8(uu[u][i].w, a0, a1); acc += a0 * h2[6]; acc += a1 * h2[7];
        d[i] = acc.x + acc.y;
      }
      float t8[8], t4[4], t2[2];
      { const bool up = (lane & 4) != 0;
#pragma unroll
        for (int k = 0; k < 8; k++) { const float send = up ? d[k] : d[k + 8], keep = up ? d[k + 8] : d[k]; t8[k] = keep + __shfl_xor(send, 4); } }
      { const bool up = (lane & 2) != 0;
#pragma unroll
        for (int k = 0; k < 4; k++) { const float send = up ? t8[k] : t8[k + 4], keep = up ? t8[k + 4] : t8[k]; t4[k] = keep + __shfl_xor(send, 2); } }
      { const bool up = (lane & 1) != 0;
#pragma unroll
        for (int k = 0; k < 2; k++) { const float send = up ? t4[k] : t4[k + 2], keep = up ? t4[k + 2] : t4[k]; t2[k] = keep + __shfl_xor(send, 1); } }
      if (ok[u]) p.PD[((long)sl * RTOT + rr[u]) * 64 + cch * 8 + j] = pack2(t2[0], t2[1]);
    }
  }
}
__device__ __forceinline__ void phase_s11b(const Params& p, int L, bool dry = false) {
  const int lane = TIDS & 63, j = lane >> 3, cch = lane & 7;
  const int sl = VBID & 7;
  const int lw = (VBID >> 3) * 4 + (TIDS >> 6), nlw = (NVB >> 3) * 4;
  const int nrows = (L == 0) ? RTOT : TLAT;
  const unsigned char* Vs = p.VT8 + (long)sl * NEXP * 128 + cch * 16;
  const int P0 = 16 * (lane >> 3) + (lane & 7);
  const int col = sl * 128 + cch * 16 + 2 * j;
  int rrN[NB11]; bool okN[NB11];
  unsigned pwN[NB11][8]; float g0N[NB11], g1N[NB11]; int e_loN[NB11], e_hiN[NB11];
  auto load_idx = [&](int r0) __attribute__((always_inline)) {
#pragma unroll
    for (int u = 0; u < NB11; u++) {
      const int r = r0 + u * nlw;
      okN[u] = r < nrows; rrN[u] = okN[u] ? r : lw;
#pragma unroll
      for (int s2 = 0; s2 < 8; s2++) pwN[u][s2] = p.PD[((long)s2 * RTOT + rrN[u]) * 64 + lane];
      g0N[u] = p.gate[(long)rrN[u] * 128 + P0]; g1N[u] = p.gate[(long)rrN[u] * 128 + P0 + 8];
      e_loN[u] = p.eid[(long)rrN[u] * 128 + lane]; e_hiN[u] = p.eid[(long)rrN[u] * 128 + 64 + lane];
    }
  };
  if (lw < nrows) load_idx(lw);
  for (int r0 = lw; r0 < nrows; r0 += NB11 * nlw) {
    int rr[NB11]; bool ok[NB11];
    unsigned pw[NB11][8]; float g0[NB11], g1[NB11]; int e_lo[NB11], e_hi[NB11];
#pragma unroll
    for (int u = 0; u < NB11; u++) {
      rr[u] = rrN[u]; ok[u] = okN[u]; g0[u] = g0N[u]; g1[u] = g1N[u]; e_lo[u] = e_loN[u]; e_hi[u] = e_hiN[u];
#pragma unroll
      for (int s2 = 0; s2 < 8; s2++) pw[u][s2] = pwN[u][s2];
    }
    uint4 vv[NB11][16];
#pragma unroll
    for (int u = 0; u < NB11; u++)
#pragma unroll
      for (int i = 0; i < 16; i++) {
        const int e = __shfl(i < 8 ? e_lo[u] : e_hi[u], 8 * (i & 7) + j);
        vv[u][i] = ldg16(Vs + (long)e * 128);
      }
    if (r0 + NB11 * nlw < nrows) load_idx(r0 + NB11 * nlw);
    __builtin_amdgcn_sched_barrier(0);
#pragma unroll
    for (int u = 0; u < NB11; u++) {
      float d0 = 0.f, d1 = 0.f;
#pragma unroll
      for (int s2 = 0; s2 < 8; s2++) { d0 += bf_lo(pw[u][s2]); d1 += bf_hi(pw[u][s2]); }
      const float act0 = gelu_tanh(d0 * (1.0f / U8_SCALE)) * g0[u] * (1.0f / V8_SCALE);
      const float act1 = gelu_tanh(d1 * (1.0f / U8_SCALE)) * g1[u] * (1.0f / V8_SCALE);
      f32x2 o2[8];
#pragma unroll
      for (int q = 0; q < 8; q++) o2[q] = f32x2{0.f, 0.f};
#pragma unroll
      for (int i = 0; i < 16; i++) {
        const float a = __shfl((i & 1) ? act1 : act0, (i >> 1) * 8 + j);
        const f32x2 aa = {a, a};
        f32x2 a0, a1;
        CVT8(vv[u][i].x, a0, a1); o2[0] += aa * a0; o2[1] += aa * a1;
        CVT8(vv[u][i].y, a0, a1); o2[2] += aa * a0; o2[3] += aa * a1;
        CVT8(vv[u][i].z, a0, a1); o2[4] += aa * a0; o2[5] += aa * a1;
        CVT8(vv[u][i].w, a0, a1); o2[6] += aa * a0; o2[7] += aa * a1;
      }
      float o[16];
#pragma unroll
      for (int q = 0; q < 8; q++) { o[2 * q] = o2[q].x; o[2 * q + 1] = o2[q].y; }
      float t8[8], t4[4], t2[2];
      { const bool up = (lane & 32) != 0;
#pragma unroll
        for (int k = 0; k < 8; k++) { const float send = up ? o[k] : o[k + 8], keep = up ? o[k + 8] : o[k]; t8[k] = keep + __shfl_xor(send, 32); } }
      { const bool up = (lane & 16) != 0;
#pragma unroll
        for (int k = 0; k < 4; k++) { const float send = up ? t8[k] : t8[k + 4], keep = up ? t8[k + 4] : t8[k]; t4[k] = keep + __shfl_xor(send, 16); } }
      { const bool up = (lane & 8) != 0;
#pragma unroll
        for (int k = 0; k < 2; k++) { const float send = up ? t4[k] : t4[k + 2], keep = up ? t4[k + 2] : t4[k]; t2[k] = keep + __shfl_xor(send, 8); } }
      if (!ABL_PEER || !ok[u]) continue;
      const int r = rr[u];
      float* xr = ((r < TLAT) ? p.out + (long)r * 1024 : p.ctx1 + (long)(r - TLAT) * 1024) + col;
      const float2 gt = *(const float2*)(p.mods + (long)(L * 9 + row_mod(r)) * 6144 + 5120 + col);
      float2 xv = *(const float2*)xr;
      xv.x += gt.x * t2[0]; xv.y += gt.y * t2[1];
      if (!dry) *(float2*)xr = xv;
    }
  }
}


#if CHECK_ATTN
__device__ __forceinline__ float blk_sum(float v, float* red) {
  v = wave_sum(v);
  __syncthreads();
  if ((TIDS & 63) == 0) red[TIDS >> 6] = v;
  __syncthreads();
  return red[0] + red[1] + red[2] + red[3];
}
__device__ __forceinline__ float blk_max(float v, float* red) {
#pragma unroll
  for (int o = 32; o > 0; o >>= 1) v = fmaxf(v, __shfl_xor(v, o));
  __syncthreads();
  if ((TIDS & 63) == 0) red[TIDS >> 6] = v;
  __syncthreads();
  return fmaxf(fmaxf(red[0], red[1]), fmaxf(red[2], red[3]));
}
__device__ __forceinline__ bool far(float got, float ref, float rel, float ab) { return !(fabsf(got - ref) <= rel * fabsf(ref) + ab); }
__device__ __forceinline__ void rope_ref(const float* z, float* o, int s) {
  for (int c = 0; c < 32; c++) {
    const int pos = (c < 16) ? (s / 64) : (s % 64);
    const float inv = powf(10000.0f, -(float)(2 * (c % 8)) / 16.0f);
    const float ang = (float)pos * inv;
    const int cb = c & 16, cc = c & 15;
    const float rot = (cc < 8) ? -z[cb + cc + 8] : z[cb + cc - 8];
    o[c] = z[c] * cosf(ang) + rot * sinf(ang);
  }
}
__device__ __forceinline__ void check_proj(const Params& p, int L, int r, char* smem) {
  float* hrow = (float*)smem;
  float* z = hrow + 1024;
  float* kvr = z + 416;
  float* red = kvr + 1024;
  float* kk = red + 8;
  const int tid = TIDS;
  __syncthreads();
  for (int k = tid; k < 1024; k += 256) hrow[k] = bf1(p.hx[(long)r * 1024 + k]);
  __syncthreads();
  for (int n = tid; n < 416; n += 256) {
    float a = 0.f;
    for (int k = 0; k < 1024; k++) a += hrow[k] * p.w_in[((long)L * 1024 + k) * 4256 + n];
    z[n] = a;
  }
  __syncthreads();
  unsigned bad = 0;
  if (L == 0 || r < TLAT)
  for (int n = tid; n < 256; n += 256) if (far(bf1(p.cq[(long)r * 256 + n]), z[160 + n], 0.02f, 0.03f)) bad |= 1u;
  for (int n = tid; n < 32; n += 256) if (far(p.kr[(long)r * 32 + n], z[128 + n], 0.02f, 0.03f)) bad |= 1u;
  const float ssc = blk_sum(tid < 128 ? z[tid] * z[tid] : 0.f, red);
  const float rc = rsqrtf(ssc / 128.0f + EPSV);
  for (int n = tid; n < 1024; n += 256) {
    float a = 0.f;
    for (int k = 0; k < 128; k++) a += z[k] * rc * p.g_ckv[L * 128 + k] * p.w_ukv[((long)L * 128 + k) * 1024 + n];
    kvr[n] = a;
  }
  __syncthreads();
  const bool lat = r < TLAT;
  const int b = lat ? (r >> 12) : ((r - TLAT) >> 8), s = lat ? (r & 4095) : ((r - TLAT) & 255), kpos = lat ? CTXL + s : s;
  for (int h = 0; h < 8; h++) {
    float sq = 0.f;
    if (tid < 64) sq = kvr[h * 128 + tid] * kvr[h * 128 + tid]; else if (tid < 96) sq = z[128 + tid - 64] * z[128 + tid - 64];
    const float ssk = blk_sum(sq, red);
    const float rk = rsqrtf(ssk / 96.0f + EPSV);
    if (tid == 0) {
      float* zr = kk + 96; float* zo = zr + 32;
      for (int c = 0; c < 32; c++) zr[c] = z[128 + c] * rk * p.g_kn[L * 96 + 64 + c];
      if (lat) rope_ref(zr, zo, s); else for (int c = 0; c < 32; c++) zo[c] = zr[c];
      for (int c = 0; c < 32; c++) kk[64 + c] = zo[c];
    }
    if (tid < 64) kk[tid] = kvr[h * 128 + tid] * rk * p.g_kn[L * 96 + tid];
    __syncthreads();
    if (tid < 96 && far(bf1(p.Kb[((long)(b * 8 + h) * SKEYS + kpos) * 96 + tid]), kk[tid], 0.03f, 0.03f)) bad |= 2u;
    if (tid < 64 && far(bf1(p.Vtb[((long)(b * 8 + h) * 64 + tid) * SKEYS + kpos]), kvr[h * 128 + 64 + tid], 0.03f, 0.03f)) bad |= 4u;
    __syncthreads();
  }
  if (bad & CHECK_MASK) atomicOr(&p.bar[0], bad & CHECK_MASK);
}
__device__ __forceinline__ void check_attn(const Params& p, int L, int r, int h, char* smem) {
  float* cqr = (float*)smem;
  float* q = cqr + 256;
  float* sc = q + 96;
  float* red = sc + 4352;
  const int tid = TIDS;
  const bool lat = r < TLAT;
  const int b = lat ? (r >> 12) : ((r - TLAT) >> 8), s = lat ? (r & 4095) : ((r - TLAT) & 255);
  const int nkeys = lat ? SKEYS : CTXL;
  __syncthreads();
  cqr[tid] = bf1(p.cq[(long)r * 256 + tid]);
  __syncthreads();
  const float rc = rsqrtf(blk_sum(cqr[tid] * cqr[tid], red) / 256.0f + EPSV);
  float qr = 0.f;
  if (tid < 96) for (int k = 0; k < 256; k++) qr += cqr[k] * rc * p.g_cq[L * 256 + k] * p.w_uq[((long)L * 256 + k) * 768 + h * 96 + tid];
  const float rq = rsqrtf(blk_sum(tid < 96 ? qr * qr : 0.f, red) / 96.0f + EPSV);
  if (tid < 96) q[tid] = qr * rq * p.g_qn[L * 96 + tid];
  __syncthreads();
  if (tid == 0 && lat) {
    float* zr = red + 8; float* zo = zr + 32;
    for (int c = 0; c < 32; c++) zr[c] = q[64 + c];
    rope_ref(zr, zo, s);
    for (int c = 0; c < 32; c++) q[64 + c] = zo[c];
  }
  __syncthreads();
  float mx = -1e30f;
  for (int key = tid; key < nkeys; key += 256) {
    float a = 0.f;
    for (int d = 0; d < 96; d++) a += q[d] * bf1(p.Kb[((long)(b * 8 + h) * SKEYS + key) * 96 + d]);
    a *= 0.10206207261596577f;
    sc[key] = a; mx = fmaxf(mx, a);
  }
  mx = blk_max(mx, red);
  float ps = 0.f;
  for (int key = tid; key < nkeys; key += 256) { const float e = expf(sc[key] - mx); sc[key] = e; ps += e; }
  const float tot = blk_sum(ps, red);
  unsigned bad = 0;
  if (tid < 64) {
    float a = 0.f;
    for (int key = 0; key < nkeys; key++) a += sc[key] * bf1(p.Vtb[((long)(b * 8 + h) * 64 + tid) * SKEYS + key]);
    a /= tot;
    if (far(bf1(p.Ob[(long)r * 512 + h * 64 + tid]), a, 0.04f, 1.5e-3f)) bad |= 8u;
  }
  if (bad & CHECK_MASK) atomicOr(&p.bar[0], bad & CHECK_MASK);
}
__device__ __forceinline__ void phase_check(const Params& p, int L, char* smem) {
  const int nq = (L == 0) ? 12 : 8;
  char* sm = smem + HALF_ * LDS_SMALL;
  for (int pass = 0; pass < 2; pass++) {
  FOR_PAIRED(pass == 0 ? 12 : nq * 8, uu)
    const int u = (pass == 0) ? uu : uu + 12;
    const int si = (u < 12) ? u : ((u - 12) >> 3);
    int r;
    switch (si) {
      case 0: r = 0; break; case 1: r = 63; break; case 2: r = 64; break; case 3: r = 4095; break;
      case 4: r = 4096 + 777; break; case 5: r = 12345; break; case 6: r = 20000; break; case 7: r = 32767; break;
      case 8: r = TLAT; break; case 9: r = TLAT + 255; break; case 10: r = TLAT + 256 + 100; break; default: r = TLAT + 2047; break;
    }
    if (u < 12) check_proj(p, L, r, sm);
    else check_attn(p, L, r, (u - 12) & 7, sm);
  }
  }
}
#endif

#define XB_TMO      128
#define XB_XCNT(j)  (256  + 64 * (j))
#define XB_XSUB(j)  (1280 + 64 * (j))
#define XB_XGEN(j)  (2304 + 64 * (j))
#define XB_TOP      3328
#define XB_TOPGEN   3392
#define XCD_BAR_WORDS 3456
#define XB_SPIN_CAP (1u << 22)
#define LAS __attribute__((address_space(3)))
__device__ __forceinline__ unsigned xb_ld(unsigned* p)              { return __hip_atomic_load(p, __ATOMIC_RELAXED, __HIP_MEMORY_SCOPE_AGENT); }
__device__ __forceinline__ unsigned xb_add(unsigned* p, unsigned v) { return __hip_atomic_fetch_add(p, v, __ATOMIC_RELAXED, __HIP_MEMORY_SCOPE_AGENT); }
__device__ __forceinline__ unsigned xb_xcc_id() { return (unsigned)__builtin_amdgcn_s_getreg((3 << 11) | 20) & 0xFu; }
#define XB_SPIN(cond, bar) do { unsigned _sp = 0; while (cond) { __builtin_amdgcn_s_sleep(1); \
    if ((++_sp & 255u) == 0u) { if (xb_ld(&(bar)[XB_TMO])) break; if (_sp > XB_SPIN_CAP) { atomicAdd(&(bar)[XB_TMO], 1u); break; } } } } while (0)
struct XcdBarrier { unsigned* bar; unsigned x; volatile LAS unsigned* st; };
__device__ __forceinline__ XcdBarrier xcd_barrier_post(unsigned* bar, volatile LAS unsigned* st) {
  XcdBarrier b; b.bar = bar; b.x = xb_xcc_id(); b.st = st;
  if (threadIdx.x == 0) (void)xb_add(&bar[XB_XCNT(b.x)], 1u);
  return b;
}
__device__ __forceinline__ void xcd_barrier_complete(unsigned* bar, unsigned x, unsigned& nloc, unsigned& nx) {
  const unsigned G = gridDim.x * gridDim.y * gridDim.z;
  unsigned sum, cnt, mine, sp = 0u;
  for (;;) {
    sum = 0u; cnt = 0u; mine = 0u;
#pragma unroll
    for (unsigned j = 0; j < 16; ++j) { const unsigned c = xb_ld(&bar[XB_XCNT(j)]); sum += c; cnt += (c > 0u) ? 1u : 0u; mine = (j == x) ? c : mine; }
    if (sum == G) break;
    __builtin_amdgcn_s_sleep(1);
    if ((++sp & 255u) == 0u) { if (xb_ld(&bar[XB_TMO])) break; if (sp > XB_SPIN_CAP) { atomicAdd(&bar[XB_TMO], 1u); break; } }
  }
  nloc = mine > 0u ? mine : 1u; nx = cnt > 0u ? cnt : 1u;
}
__device__ __forceinline__ void xcd_barrier(const XcdBarrier& b) {
  asm volatile("s_waitcnt vmcnt(0)" ::: "memory");
  __syncthreads();
  if (threadIdx.x == 0) {
    unsigned* bar = b.bar;
    asm volatile("" : "+s"(bar));
    __builtin_amdgcn_s_waitcnt(0);
    unsigned nloc = b.st[0], nx = b.st[1];
    if (nloc == 0u) { xcd_barrier_complete(bar, b.x, nloc, nx); b.st[0] = nloc; b.st[1] = nx; }
    const unsigned old = xb_add(&bar[XB_XSUB(b.x)], 1u);
    const unsigned gen = old / nloc;
    if (old + 1u == (gen + 1u) * nloc) {
      __builtin_amdgcn_fence(__ATOMIC_RELEASE, "agent");
      asm volatile("s_waitcnt vmcnt(0)" ::: "memory");
      const unsigned og = xb_add(&bar[XB_TOP], 1u);
      const unsigned tg = og / nx;
      if (og + 1u == (tg + 1u) * nx) xb_add(&bar[XB_TOPGEN], 1u);
      else XB_SPIN(xb_ld(&bar[XB_TOPGEN]) == tg, bar);
      __builtin_amdgcn_fence(__ATOMIC_ACQUIRE, "agent");
      xb_add(&bar[XB_XGEN(b.x)], 1u);
      asm volatile("s_waitcnt vmcnt(0)" ::: "memory");
    } else {
      XB_SPIN(xb_ld(&bar[XB_XGEN(b.x)]) == gen, bar);
      __builtin_amdgcn_fence(__ATOMIC_ACQUIRE, "agent");
      asm volatile("s_waitcnt vmcnt(0)" ::: "memory");
    }
  }
  __syncthreads();
}

#define NPHASE (23 + CHECK_ATTN)
#ifndef PH_LIMIT
#define PH_LIMIT NPHASE
#endif
__device__ __forceinline__ void run_phase(const Params& p, int ph, char* smem, bool dry = false, bool big = false) {
  if (ph == 0) { phase_prep(p, smem); return; }
#if CHECK_ATTN
  if (ph == 23) {
    if (blockIdx.x == 0 && threadIdx.x == 0 && __hip_atomic_load(&p.bar[0], __ATOMIC_RELAXED, __HIP_MEMORY_SCOPE_AGENT) != 0u) p.out[0] = __uint_as_float(0x7fc00000u);
    return;
  }
#endif
  const int L = (ph - 1) / 11, s = (ph - 1) % 11;
  if (s == 0 || s == 7) {
    phase_norm(p, L, s == 0 ? 0 : 1, (s == 0 || L == 0) ? RTOT : TLAT);
    if (s == 0 && L == 1) phase_tables(p, L);
    return;
  }
  switch (s) {
    case 1: phase_s2<true>(p, L, smem); break;
    case 2: phase_s3(p, L, smem, dry); break;
    case 3: phase_s4(p, L, smem); break;
    case 4: phase_dftC(p, smem);
#if CHECK_ATTN
      phase_check(p, L, smem);
#endif
      break;
    case 5: phase_s7<true>(p, L, smem); break;
    case 6: phase_s8<true>(p, L, smem, dry); break;
    case 8: phase_s10<true>(p, L, smem); break;
    case 9: phase_s11a(p, L); break;
    case 10: phase_s11b(p, L, dry); break;
  }
}

__global__ void __launch_bounds__(512, 2) mega(Params p, int ph0, int ph1) {
  extern __shared__ __attribute__((aligned(16))) char smem[];
  __shared__ uint4 xb_words;
  cg::grid_group grid = cg::this_grid();
  const bool multi = (ph1 - ph0) > 1;
  const bool big = blockDim.x == 512;
  XcdBarrier xb;
  if (multi) {
    if (threadIdx.x == 0) xb_words = make_uint4(0u, 0u, 0u, 0u);
    __syncthreads();
    xb = xcd_barrier_post(p.bar, (volatile LAS unsigned*)&xb_words);
  }
  for (int ph = ph0; ph < ph1; ph++) {
    if (ph > ph0) {
      if (ph == ph0 + 1) grid.sync();
      else xcd_barrier(xb);
    }
#if PROBE_S >= 0
    {
      const int kind = (ph == 0) ? 11 : (ph - 1) % 11;
      const int reps = (kind == PROBE_S) ? PROBE_REPS * p.one : 0;
      for (int rep = 0; rep <= reps; rep++) {
        if (rep > 0) xcd_barrier(xb);
        const bool dry = (rep < reps);
        if (kind == PROBE_S && (kind == 6 || kind == 10 || kind == 2)) run_phase(p, ph, smem, dry, big);
        else run_phase(p, ph, smem, false, big);
      }
    }
#else
    run_phase(p, ph, smem, false, big);
#endif
  }
}

static inline size_t al256(size_t x) { return (x + 255) & ~(size_t)255; }
extern "C" void kernel_launch(void* const* d_in, const int* in_sizes, int n_in, void* d_out, int out_size, void* d_ws,
                              size_t ws_size, hipStream_t stream) {
  Params p{};
  const float* const* in = (const float* const*)d_in;
  p.x = in[0]; p.c = in[1]; p.ctx = in[2]; p.c_ctx = in[3]; p.w_mod = in[4]; p.b_mod = in[5]; p.g_norm1 = in[6];
  p.w_in = in[7]; p.g_ckv = in[8]; p.w_ukv = in[9]; p.g_cq = in[10]; p.w_uq = in[11]; p.g_qn = in[12]; p.g_kn = in[13];
  p.w_dw = in[14]; p.b_dw = in[15]; p.g_cln = in[16]; p.b_cln = in[17]; p.wb_attn = in[18]; p.wb_fnet = in[19];
  p.wb_conv = in[20]; p.w_out = in[21]; p.g_norm2 = in[22]; p.w_query = in[23]; p.sub_keys = in[24]; p.u_tab = in[25];
  p.v_tab = in[26];
  p.out = (float*)d_out;
  p.one = 1; p.pad_ = 0;
  char* ws = (char*)d_ws;
  size_t off = 0;
  auto take = [&](size_t bytes) { char* q = ws + off; off += al256(bytes); return q; };
  p.bar = (unsigned*)take(XCD_BAR_WORDS * 4);
  const size_t mods_bytes = 2 * 9 * 6144 * 4;
  p.mods = (float*)take(mods_bytes);
  p.ropetab = (float*)take(64 * 8 * 2 * 4);
  p.W2T = (u16*)take(2ull * W2T_SZ * 2);
  p.WgT = (u16*)take(2ull * WGT_SZ * 2);
  p.WukvT = (u16*)take(2ull * WUKV_SZ * 2);
  p.WuqT = (u16*)take(2ull * WUQ_SZ * 2);
  p.WbaT = (u16*)take(2ull * WBA_SZ * 2);
  p.WbfT = (u16*)take(2ull * WBF_SZ * 2);
  p.WbcT = (u16*)take(2ull * WBC_SZ * 2);
  p.WoutT = (u16*)take(2ull * WOUT_SZ * 2);
  p.WqT = (u16*)take(2ull * WQ_SZ * 2);
  p.SubK = (u16*)take(2ull * SUBK_SZ * 2);
  p.WA = (u16*)take(128 * 128 * 2);
  p.WC = (u16*)take(128 * 128 * 2);
  p.tw = (float*)take(4096 * 2 * 4);
  p.GB = (u16*)take((size_t)NB * 256 * 8192 * 2);
  p.Dctx = (u16*)take(256ull * 512 * 2);
  p.Wcs = (u16*)take(128ull * 64 * 2);
  p.UT8 = (unsigned char*)take((size_t)NEXP * 1024);
  p.VT8 = (unsigned char*)take((size_t)NEXP * 1024);
  p.hx = (u16*)take((size_t)RTOT * 1024 * 2);
  {
    const size_t b0 = off;
    p.cq = (u16*)take((size_t)RTOT * 256 * 2);
    p.zf = (u16*)take((size_t)RTOT * 256 * 2);
    p.zc = (u16*)take((size_t)RTOT * 512 * 2);
    p.ckv = (u16*)take((size_t)RTOT * 128 * 2);
    p.kr = (float*)take((size_t)RTOT * 32 * 4);
    p.m = (u16*)(ws + b0);
    p.PD = (unsigned*)(ws + b0);
  }
  {
    const size_t c0 = off;
    p.Kb = (u16*)take((size_t)NB * NH * SKEYS * 96 * 2);
    p.Vtb = (u16*)take((size_t)NB * NH * 64 * SKEYS * 2);
    p.eid = (int*)(ws + c0);
    p.gate = (float*)(ws + c0 + al256((size_t)RTOT * 128 * 4));
  }
  p.Ytl = (u16*)take((size_t)NB * 256 * 8192 * 2);
  p.Ytc = (u16*)take((size_t)NB * 256 * 512 * 2);
  p.Ob = (u16*)take((size_t)RTOT * 512 * 2);
  p.Fb = (u16*)take((size_t)RTOT * 256 * 2);
  p.cv = (u16*)take((size_t)RTOT * 256 * 2);
  p.ctx1 = (float*)take((size_t)TCTX * 1024 * 4);
  if (off > ws_size) { fprintf(stderr, "workspace too small: need %zu have %zu\n", off, ws_size); return; }

  (void)hipMemsetAsync(p.bar, 0, XCD_BAR_WORDS * 4, stream);
  static int cus = 0;
  if (!cus) {
    int dev = 0;
    (void)hipGetDevice(&dev);
    (void)hipDeviceGetAttribute(&cus, hipDeviceAttributeMultiprocessorCount, dev);
    (void)hipFuncSetAttribute((const void*)mega, hipFuncAttributeMaxDynamicSharedMemorySize, LDS_BIG);
  }
#if ONE_LAUNCH
  int ph0 = 0, ph1 = NPHASE;
  void* args[] = {&p, &ph0, &ph1};
  hipError_t e = hipLaunchCooperativeKernel((void*)mega, dim3(cus), dim3(512), args, LDS_BIG, stream);
  if (e != hipSuccess) fprintf(stderr, "cooperative launch failed: %s (grid %d)\n", hipGetErrorString(e), cus);
#else
  for (int ph = 0; ph < PH_LIMIT; ph++) {
    const int kind = (ph == 0) ? 11 : (ph - 1) % 11;
    const bool bigp = (kind == 1 || kind == 5 || kind == 6 || kind == 8);
    if (bigp) mega<<<cus, 512, LDS_BIG, stream>>>(p, ph, ph + 1);
    else mega<<<cus * 2, 256, LDS_SMALL, stream>>>(p, ph, ph + 1);
  }
#endif
}
```

```cpp
#include <hip/hip_runtime.h>
#include <hip/hip_cooperative_groups.h>
#include <cstdio>
#include <cstdint>
namespace cg = cooperative_groups;

#ifndef ABL_PEER
#define ABL_PEER 1
#endif
#ifndef ABL_BR
#define ABL_BR 7
#endif
#ifndef PROBE_S
#define PROBE_S (-1)
#endif
#ifndef PROBE_REPS
#define PROBE_REPS 4
#endif
#ifndef CHECK_ATTN
#define CHECK_ATTN 0
#endif
#ifndef CHECK_MASK
#define CHECK_MASK 0xff
#endif
#ifndef ONE_LAUNCH
#define ONE_LAUNCH 1
#endif

typedef unsigned short u16;
typedef __attribute__((ext_vector_type(8))) __bf16 bf16x8;
typedef __attribute__((ext_vector_type(2))) __bf16 bf16x2;
typedef __attribute__((ext_vector_type(16))) float f32x16;
typedef __attribute__((ext_vector_type(2))) float f32x2;

#define NB 8
#define SEQ 4096
#define DM 1024
#define CTXL 256
#define TLAT (NB * SEQ)
#define TCTX (NB * CTXL)
#define RTOT (TLAT + TCTX)
#define SKEYS (CTXL + SEQ)
#define NH 8
#define QKD 96
#define N2 1280
#define NEXP 16384
#define EPSV 1e-6f

struct Params {
  const float *x, *c, *ctx, *c_ctx, *w_mod, *b_mod, *g_norm1, *w_in, *g_ckv, *w_ukv, *g_cq, *w_uq, *g_qn, *g_kn,
      *w_dw, *b_dw, *g_cln, *b_cln, *wb_attn, *wb_fnet, *wb_conv, *w_out, *g_norm2, *w_query, *sub_keys, *u_tab, *v_tab;
  float* out;
  unsigned* bar;
  float* mods;
  float* ropetab;
  u16 *W2T, *WgT, *WukvT, *WuqT, *WbaT, *WbfT, *WbcT, *WoutT, *WqT, *SubK;
  u16 *WA, *WC, *Dctx, *Wcs;
  float* tw;
  u16* GB;
  unsigned* REC;
  unsigned char *UT8, *VT8;
  float* su;
  unsigned char* hq8;
  float* hs;
  unsigned* PD;
  u16* hx;
  u16 *cq, *zf, *zc, *ckv; float* kr;
  u16* m;
  u16 *Kb, *Vtb;
  u16* eid; float* gate;
  u16 *Ytl, *Ytc, *Ob, *Fb, *cv;
  float* ctx1;
  int one; int pad_;
};

#define W2T_SZ (N2 * 1024)
#define WGT_SZ (3072 * 1024)
#define WUKV_SZ (1024 * 128)
#define WUQ_SZ (768 * 256)
#define WBA_SZ (1024 * 512)
#define WBF_SZ (1024 * 256)
#define WBC_SZ (1024 * 256)
#define WOUT_SZ (1024 * 1024)
#define WQ_SZ (1024 * 1024)
#define SUBK_SZ (8 * 2 * 128 * 64)

__device__ __forceinline__ unsigned pack2(float a, float b) {
  f32x2 v = {a, b};
  return __builtin_bit_cast(unsigned, __builtin_convertvector(v, bf16x2));
}
__device__ __forceinline__ u16 tobf(float a) { return (u16)(pack2(a, 0.f) & 0xffffu); }
__device__ __forceinline__ float bf_lo(unsigned u) { return __uint_as_float(u << 16); }
__device__ __forceinline__ float bf_hi(unsigned u) { return __uint_as_float(u & 0xffff0000u); }
__device__ __forceinline__ float bf1(u16 u) { return __uint_as_float(((unsigned)u) << 16); }
__device__ __forceinline__ f32x16 mfma32(uint4 a, uint4 b, f32x16 c) {
  return __builtin_amdgcn_mfma_f32_32x32x16_bf16(__builtin_bit_cast(bf16x8, a), __builtin_bit_cast(bf16x8, b), c, 0, 0, 0);
}
__device__ __forceinline__ uint4 ldg16(const void* p) { return *(const uint4*)p; }
__device__ __forceinline__ int opaque(int x) { asm volatile("" : "+v"(x)); return x; }
#define TIDX opaque((int)threadIdx.x)
#define HALF_ (opaque((int)threadIdx.x) >> 8)
#define TIDS (opaque((int)threadIdx.x) & 255)
#define VBID ((int)blockIdx.x + HALF_ * (int)gridDim.x)
#define NVB ((int)gridDim.x * (int)(blockDim.x >> 8))
#define FOR_PAIRED(N, U) for (int _b = (int)blockIdx.x, _g = (int)gridDim.x, _st = _g * (int)(blockDim.x >> 8); _b < (N); _b += _st) { \
    int U = _b + HALF_ * _g; if (U >= (N)) U = _b;
template <int CTRL>
__device__ __forceinline__ float dpp_mov(float v) {
  return __builtin_bit_cast(float, __builtin_amdgcn_mov_dpp(__builtin_bit_cast(int, v), CTRL, 0xF, 0xF, true));
}
template <int CTRL>
__device__ __forceinline__ int dpp_movi(int v) { return __builtin_amdgcn_mov_dpp(v, CTRL, 0xF, 0xF, true); }
typedef unsigned u32x2_ __attribute__((ext_vector_type(2)));
__device__ __forceinline__ float row_sum16(float v) {
  v += dpp_mov<0xB1>(v);
  v += dpp_mov<0x4E>(v);
  v += dpp_mov<0x141>(v);
  v += dpp_mov<0x140>(v);
  return v;
}
__device__ __forceinline__ float half_sum(float v) {
  v = row_sum16(v);
  const u32x2_ r = __builtin_amdgcn_permlane16_swap(__float_as_uint(v), __float_as_uint(v), false, false);
  return __uint_as_float(r.x) + __uint_as_float(r.y);
}
__device__ __forceinline__ float wave_sum(float v) {
#pragma unroll
  for (int o = 32; o > 0; o >>= 1) v += __shfl_xor(v, o);
  return v;
}
__device__ __forceinline__ float sigmoidf_(float x) { return __builtin_amdgcn_rcpf(1.f + __expf(-x)); }
__device__ __forceinline__ float siluf_(float x) { return x * __builtin_amdgcn_rcpf(1.f + __expf(-x)); }
__device__ __forceinline__ float gelu_tanh(float x) {
  float u = 0.7978845608028654f * (x + 0.044715f * x * x * x);
  float t = 1.f - 2.f * __builtin_amdgcn_rcpf(1.f + __expf(2.f * u));
  return 0.5f * x * (1.f + t);
}
__device__ __forceinline__ int row_mod(int r) { return r < TLAT ? (r >> 12) : 8; }

#define SMEM_BYTES 73728
#define LDS_SMALL 73728
#define LDS_BIG 147456
#define LDT 72

#define LAS3 __attribute__((address_space(3)))
__device__ __forceinline__ void glds16(const u16* g, char* lds_wave_base) {
  __builtin_amdgcn_global_load_lds((const unsigned*)g, (LAS3 unsigned*)lds_wave_base, 16, 0, 0);
}
__device__ __forceinline__ void gemm128x(const u16* __restrict__ A, int lda, const u16* __restrict__ Bt, int ldb, int bs1, int bs2, int K,
                                         f32x16 (&acc)[2][2], char* smem) {
  char* As = smem;
  char* Bs = smem + 32768;
  const int tid = TIDS, lane = tid & 63, w = tid >> 6, wr = w >> 1, wc = w & 1;
  const int nk = K >> 6;
  const int srow = w * 8 + (lane >> 3);
  const int schunk = (lane & 7) ^ ((srow >> 1) & 7);
  const int aoff = srow * lda + schunk * 8, boff = srow * ldb + schunk * 8;
  const int a32 = 32 * lda;
  __syncthreads();
#pragma unroll
  for (int i = 0; i < 4; i++) {
    glds16(A + (aoff + i * a32), As + (i * 4 + w) * 1024);
    glds16(Bt + (boff + (i & 1) * bs1 + (i >> 1) * bs2), Bs + (i * 4 + w) * 1024);
  }
  __syncthreads();
  const int fr = lane & 31, hh = lane >> 5;
  const int sw = (fr >> 1) & 7;
  for (int kt = 0; kt < nk; kt++) {
    const int cur = kt & 1;
    if (kt + 1 < nk) {
      const int ko = (kt + 1) * 64;
      char* An = As + (cur ^ 1) * 16384;
      char* Bn = Bs + (cur ^ 1) * 16384;
#pragma unroll
      for (int i = 0; i < 4; i++) {
        glds16(A + (aoff + i * a32 + ko), An + (i * 4 + w) * 1024);
        glds16(Bt + (boff + (i & 1) * bs1 + (i >> 1) * bs2 + ko), Bn + (i * 4 + w) * 1024);
      }
    }
    const char* Ac = As + cur * 16384 + (wr * 64 + fr) * 128;
    const char* Bc = Bs + cur * 16384 + (wc * 64 + fr) * 128;
#pragma unroll
    for (int kk = 0; kk < 4; kk++) {
      const int so = ((2 * kk + hh) ^ sw) << 4;
      uint4 a0 = *(const uint4*)(Ac + so);
      uint4 a1 = *(const uint4*)(Ac + 32 * 128 + so);
      uint4 b0 = *(const uint4*)(Bc + so);
      uint4 b1 = *(const uint4*)(Bc + 32 * 128 + so);
      acc[0][0] = mfma32(a0, b0, acc[0][0]);
      acc[0][1] = mfma32(a0, b1, acc[0][1]);
      acc[1][0] = mfma32(a1, b0, acc[1][0]);
      acc[1][1] = mfma32(a1, b1, acc[1][1]);
    }
    __syncthreads();
  }
}
__device__ __forceinline__ void gemm128(const u16* __restrict__ A, int lda, const u16* __restrict__ Bt, int ldb, int K,
                                        f32x16 (&acc)[2][2], char* smem) {
  gemm128x(A, lda, Bt, ldb, 32 * ldb, 64 * ldb, K, acc, smem);
}
__device__ __forceinline__ void gemm128h(const u16* __restrict__ A, int lda, const u16* __restrict__ Bt, int ldb, int K, int jh,
                                         f32x16 (&acc)[2], char* smem) {
  char* As = smem;
  char* Bs = smem + 32768;
  const int tid = TIDS, lane = tid & 63, w = tid >> 6, wr = w >> 1, wc = w & 1;
  const int nk = K >> 6;
  const int srow = w * 8 + (lane >> 3);
  const int schunk = (lane & 7) ^ ((srow >> 1) & 7);
  const int aoff = srow * lda + schunk * 8;
  const int a32 = 32 * lda;
  const int boff = (jh * 32 + srow) * ldb + schunk * 8, b64 = 64 * ldb;
  __syncthreads();
#pragma unroll
  for (int i = 0; i < 4; i++) glds16(A + (aoff + i * a32), As + (i * 4 + w) * 1024);
#pragma unroll
  for (int i = 0; i < 2; i++) glds16(Bt + (boff + i * b64), Bs + (i * 4 + w) * 1024);
  __syncthreads();
  const int fr = lane & 31, hh = lane >> 5;
  const int sw = (fr >> 1) & 7;
  for (int kt = 0; kt < nk; kt++) {
    const int cur = kt & 1;
    if (kt + 1 < nk) {
      const int ko = (kt + 1) * 64;
      char* An = As + (cur ^ 1) * 16384;
      char* Bn = Bs + (cur ^ 1) * 8192;
#pragma unroll
      for (int i = 0; i < 4; i++) glds16(A + (aoff + i * a32 + ko), An + (i * 4 + w) * 1024);
#pragma unroll
      for (int i = 0; i < 2; i++) glds16(Bt + (boff + i * b64 + ko), Bn + (i * 4 + w) * 1024);
    }
    const char* Ac = As + cur * 16384 + (wr * 64 + fr) * 128;
    const char* Bc = Bs + cur * 8192 + (wc * 32 + fr) * 128;
#pragma unroll
    for (int kk = 0; kk < 4; kk++) {
      const int so = ((2 * kk + hh) ^ sw) << 4;
      uint4 a0 = *(const uint4*)(Ac + so);
      uint4 a1 = *(const uint4*)(Ac + 32 * 128 + so);
      uint4 b0 = *(const uint4*)(Bc + so);
      acc[0] = mfma32(a0, b0, acc[0]);
      acc[1] = mfma32(a1, b0, acc[1]);
    }
    __syncthreads();
  }
}
#define WAIT_VM(n) asm volatile("s_waitcnt vmcnt(%0)" ::"n"(n) : "memory")
#define G256_STAGE 49152
__device__ __forceinline__ void gemm256(const u16* __restrict__ A, int lda, const u16* __restrict__ Bt, int ldb, int K,
                                        f32x16 (&acc)[2][2], char* smem) {
  const int tid = TIDX, lane = tid & 63, w = tid >> 6, wr = w >> 1, wc = w & 1;
  const int nk = K >> 6;
  const int srow = w * 8 + (lane >> 3);
  const int schunk = (lane & 7) ^ ((srow >> 1) & 7);
  const int aoff = srow * lda + schunk * 8, boff = srow * ldb + schunk * 8;
  const int a64 = 64 * lda, b64 = 64 * ldb;
  auto issue = [&](int kt) __attribute__((always_inline)) {
    char* As = smem + (kt % 3) * G256_STAGE;
    char* Bs = As + 32768;
    const int ko = kt * 64;
#pragma unroll
    for (int i = 0; i < 4; i++) glds16((const u16*)((const char*)A + (unsigned)((aoff + i * a64 + ko) * 2)), As + (w + 8 * i) * 1024);
#pragma unroll
    for (int i = 0; i < 2; i++) glds16((const u16*)((const char*)Bt + (unsigned)((boff + i * b64 + ko) * 2)), Bs + (w + 8 * i) * 1024);
  };
  WAIT_VM(0);
  __syncthreads();
  issue(0);
  if (nk > 1) issue(1);
  const int fr = lane & 31, hh = lane >> 5;
  const int sw = (fr >> 1) & 7;
  const int rdA = (wr * 64 + fr) * 128, rdB = 32768 + (wc * 64 + fr) * 128;
  for (int kt = 0; kt < nk; kt++) {
    if (kt + 1 < nk) WAIT_VM(6); else WAIT_VM(0);
    __builtin_amdgcn_s_barrier();
    if (kt + 2 < nk) issue(kt + 2);
    const char* Sb = smem + (kt % 3) * G256_STAGE;
#pragma unroll
    for (int kk = 0; kk < 4; kk++) {
      const int so = ((2 * kk + hh) ^ sw) << 4;
      uint4 a0 = *(const uint4*)(Sb + rdA + so);
      uint4 a1 = *(const uint4*)(Sb + rdA + 32 * 128 + so);
      uint4 b0 = *(const uint4*)(Sb + rdB + so);
      uint4 b1 = *(const uint4*)(Sb + rdB + 32 * 128 + so);
      acc[0][0] = mfma32(a0, b0, acc[0][0]);
      acc[0][1] = mfma32(a0, b1, acc[0][1]);
      acc[1][0] = mfma32(a1, b0, acc[1][0]);
      acc[1][1] = mfma32(a1, b1, acc[1][1]);
    }
  }
  __syncthreads();
}
__device__ __forceinline__ void gemm256h(const u16* __restrict__ A, int lda, const u16* __restrict__ Bt, int ldb, int K, int jh,
                                         f32x16 (&acc)[2], char* smem) {
  const int tid = TIDX, lane = tid & 63, w = tid >> 6, wr = w >> 1, wc = w & 1;
  const int nk = K >> 6;
  const int srow = w * 8 + (lane >> 3);
  const int schunk = (lane & 7) ^ ((srow >> 1) & 7);
  const int aoff = srow * lda + schunk * 8;
  const int a64 = 64 * lda;
  const int boff = ((srow >> 5) * 64 + jh * 32 + (srow & 31)) * ldb + schunk * 8;
  auto issue = [&](int kt) __attribute__((always_inline)) {
    char* As = smem + (kt % 3) * G256_STAGE;
    char* Bs = As + 32768;
    const int ko = kt * 64;
#pragma unroll
    for (int i = 0; i < 4; i++) glds16(A + (aoff + i * a64 + ko), As + (w + 8 * i) * 1024);
    glds16(Bt + (boff + ko), Bs + w * 1024);
  };
  WAIT_VM(0);
  __syncthreads();
  issue(0);
  if (nk > 1) issue(1);
  const int fr = lane & 31, hh = lane >> 5;
  const int sw = (fr >> 1) & 7;
  const int rdA = (wr * 64 + fr) * 128, rdB = 32768 + (wc * 32 + fr) * 128;
  for (int kt = 0; kt < nk; kt++) {
    if (kt + 1 < nk) WAIT_VM(5); else WAIT_VM(0);
    __builtin_amdgcn_s_barrier();
    if (kt + 2 < nk) issue(kt + 2);
    const char* Sb = smem + (kt % 3) * G256_STAGE;
#pragma unroll
    for (int kk = 0; kk < 4; kk++) {
      const int so = ((2 * kk + hh) ^ sw) << 4;
      uint4 a0 = *(const uint4*)(Sb + rdA + so);
      uint4 a1 = *(const uint4*)(Sb + rdA + 32 * 128 + so);
      uint4 b0 = *(const uint4*)(Sb + rdB + so);
      acc[0] = mfma32(a0, b0, acc[0]);
      acc[1] = mfma32(a1, b0, acc[1]);
    }
  }
  __syncthreads();
}
#define FOR_UNITS_XCD(NRT, NCT, RT, CT) \
  for (int _s = (int)(blockIdx.x >> 3), _per = (NRT) >> 3, _n = _per * (NCT); _s < _n; _s += (int)(gridDim.x >> 3)) { \
    const int RT = (int)(blockIdx.x & 7) * _per + _s / (NCT), CT = _s % (NCT);
#define ZERO_ACC(acc) { _Pragma("unroll") for (int _i = 0; _i < 2; _i++) _Pragma("unroll") for (int _j = 0; _j < 2; _j++) _Pragma("unroll") for (int _r = 0; _r < 16; _r++) acc[_i][_j][_r] = 0.f; }
#define ACC_ROW(wr, i, r, lane) ((wr) * 64 + (i) * 32 + ((r) & 3) + 8 * ((r) >> 2) + 4 * ((lane) >> 5))
#define ACC_COL(wc, j, lane) ((wc) * 64 + (j) * 32 + ((lane) & 31))

__device__ __forceinline__ void job_mods(const Params& p, int job, char* smem) {
  float* s = (float*)smem;
  float* red = s + 9 * 1024;
  const int L = job / 96, nt = job % 96;
  const int tid = TIDS, lane = tid & 63, w = tid >> 6;
  __syncthreads();
  for (int i = tid; i < 9 * 1024; i += 256) {
    const int j = i >> 10, k = i & 1023;
    const float cv = (j < 8) ? p.c[j * 1024 + k] : p.c_ctx[k];
    s[i] = siluf_(cv);
  }
  __syncthreads();
  const int n = nt * 64 + lane;
  float acc[9];
#pragma unroll
  for (int j = 0; j < 9; j++) acc[j] = 0.f;
  const float* wp = p.w_mod + (long)L * 1024 * 6144 + (long)(w * 256) * 6144 + n;
#pragma unroll 8
  for (int k = 0; k < 256; k++) {
    const float wv = wp[(long)k * 6144];
#pragma unroll
    for (int j = 0; j < 9; j++) acc[j] += s[j * 1024 + w * 256 + k] * wv;
  }
#pragma unroll
  for (int j = 0; j < 9; j++) red[(w * 9 + j) * 64 + lane] = acc[j];
  __syncthreads();
  for (int i = tid; i < 9 * 64; i += 256) {
    const int j = i >> 6, l = i & 63;
    const float v = ((red[(0 * 9 + j) * 64 + l] + red[(1 * 9 + j) * 64 + l]) + red[(2 * 9 + j) * 64 + l]) + red[(3 * 9 + j) * 64 + l];
    p.mods[(L * 9 + j) * 6144 + nt * 64 + l] = v + p.b_mod[L * 6144 + nt * 64 + l];
  }
}

__device__ __forceinline__ void job_convT(const float* src, int ldsrc, int c0, int k0, u16* dst, int K, int n0, const float* scale, char* smem) {
  float* t = (float*)smem;
  const int tid = TIDS;
  __syncthreads();
  const int nc = tid & 31, kr = tid >> 5;
#pragma unroll 4
  for (int kk = kr; kk < 128; kk += 8) {
    float v = 0.f;
    if (src) { v = src[(long)(k0 + kk) * ldsrc + c0 + nc]; if (scale) v *= scale[k0 + kk]; }
    t[nc * 129 + kk] = v;
  }
  __syncthreads();
  const int nr = tid >> 3, kc = (tid & 7) * 16;
  unsigned o[8];
#pragma unroll
  for (int q = 0; q < 8; q++) o[q] = pack2(t[nr * 129 + kc + 2 * q], t[nr * 129 + kc + 2 * q + 1]);
  uint4* dp = (uint4*)(dst + (long)(n0 + nr) * K + k0 + kc);
  dp[0] = make_uint4(o[0], o[1], o[2], o[3]);
  dp[1] = make_uint4(o[4], o[5], o[6], o[7]);
}

#define NJ_W2 (40 * 8)
#define NJ_WG (96 * 8)
#define NJ_UKV (32 * 1)
#define NJ_UQ (24 * 2)
#define NJ_BA (32 * 4)
#define NJ_BF (32 * 2)
#define NJ_BC (32 * 2)
#define NJ_OUT (32 * 8)
#define NJ_WQ (32 * 8)
#define NJ_CONV_LAYER (NJ_W2 + NJ_WG + NJ_UKV + NJ_UQ + NJ_BA + NJ_BF + NJ_BC + NJ_OUT + NJ_WQ)

__device__ __forceinline__ void job_conv_weights(const Params& p, int job, char* smem) {
  const int L = job / NJ_CONV_LAYER;
  int j = job % NJ_CONV_LAYER;
  const float* src; int ldsrc, c0, k0, K, n0; u16* dst; const float* scale = nullptr;
  if (j < NJ_W2) {
    const int nt = j >> 3, kt = j & 7; n0 = nt * 32;
    bool valid = true;
    if (n0 < 256) c0 = 160 + n0;
    else if (n0 < 512) c0 = 416 + (n0 - 256);
    else if (n0 < 1024) { const int q = (n0 - 512) >> 5; c0 = 672 + (q & 1) * 256 + (q >> 1) * 32; }
    else if (n0 < 1152) c0 = n0 - 1024;
    else if (n0 < 1184) c0 = 128 + (n0 - 1152);
    else { c0 = 0; valid = false; }
    src = valid ? p.w_in + (long)L * 1024 * 4256 : nullptr; ldsrc = 4256; k0 = kt * 128; dst = p.W2T + (long)L * W2T_SZ; K = 1024;
  } else if ((j -= NJ_W2) < NJ_WG) {
    const int nt = j >> 3, kt = j & 7;
    src = p.w_in + (long)L * 1024 * 4256; ldsrc = 4256; c0 = 1184 + nt * 32; k0 = kt * 128; dst = p.WgT + (long)L * WGT_SZ; K = 1024; n0 = nt * 32;
  } else if ((j -= NJ_WG) < NJ_UKV) {
    src = p.w_ukv + (long)L * 128 * 1024; ldsrc = 1024; c0 = j * 32; k0 = 0; dst = p.WukvT + (long)L * WUKV_SZ; K = 128; n0 = j * 32; scale = p.g_ckv + L * 128;
  } else if ((j -= NJ_UKV) < NJ_UQ) {
    const int nt = j >> 1, kt = j & 1;
    src = p.w_uq + (long)L * 256 * 768; ldsrc = 768; c0 = nt * 32; k0 = kt * 128; dst = p.WuqT + (long)L * WUQ_SZ; K = 256; n0 = nt * 32; scale = p.g_cq + L * 256;
  } else if ((j -= NJ_UQ) < NJ_BA) {
    const int nt = j >> 2, kt = j & 3;
    src = p.wb_attn + (long)L * 512 * 1024; ldsrc = 1024; c0 = nt * 32; k0 = kt * 128; dst = p.WbaT + (long)L * WBA_SZ; K = 512; n0 = nt * 32;
  } else if ((j -= NJ_BA) < NJ_BF) {
    const int nt = j >> 1, kt = j & 1;
    src = p.wb_fnet + (long)L * 256 * 1024; ldsrc = 1024; c0 = nt * 32; k0 = kt * 128; dst = p.WbfT + (long)L * WBF_SZ; K = 256; n0 = nt * 32;
  } else if ((j -= NJ_BF) < NJ_BC) {
    const int nt = j >> 1, kt = j & 1;
    src = p.wb_conv + (long)L * 256 * 1024; ldsrc = 1024; c0 = nt * 32; k0 = kt * 128; dst = p.WbcT + (long)L * WBC_SZ; K = 256; n0 = nt * 32;
  } else if ((j -= NJ_BC) < NJ_OUT) {
    const int nt = j >> 3, kt = j & 7;
    src = p.w_out + (long)L * 1024 * 1024; ldsrc = 1024; c0 = nt * 32; k0 = kt * 128; dst = p.WoutT + (long)L * WOUT_SZ; K = 1024; n0 = nt * 32;
  } else {
    j -= NJ_OUT;
    const int nt = j >> 3, kt = j & 7;
    src = p.w_query + (long)L * 1024 * 1024; ldsrc = 1024; c0 = nt * 32; k0 = kt * 128; dst = p.WqT + (long)L * WQ_SZ; K = 1024; n0 = nt * 32;
  }
  job_convT(src, ldsrc, c0, k0, dst, K, n0, scale, smem);
}

__device__ __forceinline__ void job_cvt_straight(const float* src, u16* dst, long job) {
  const long base = job * 8192 + TIDS * 8;
#pragma unroll
  for (int i = 0; i < 4; i++) {
    const long o = base + i * 2048;
    float4 a = *(const float4*)(src + o), b = *(const float4*)(src + o + 4);
    *(uint4*)(dst + o) = make_uint4(pack2(a.x, a.y), pack2(a.z, a.w), pack2(b.x, b.y), pack2(b.z, b.w));
  }
}

#define NJ_MISC 87
__device__ __forceinline__ void job_misc(const Params& p, int job) {
  const int tid = TIDS;
#pragma unroll 1
  for (int q = 0; q < 8; q++) {
    const int e = tid + 256 * q;
    if (job < 64) {
      const int i = job * 2048 + e;
      const int k = i >> 9, ee = i & 511, part = ee >> 8, t = ee & 255;
      const float a = (float)((k * t) & 255) * (1.0f / 128.0f);
      p.Dctx[i] = tobf((part == 0 ? cospif(a) : -sinpif(a)) * (1.0f / 16.0f));
    } else if (job < 72) {
      const int i = (job - 64) * 2048 + e;
      const int R = i >> 7, kk = i & 127, k1 = (R >> 6) * 32 + (R & 31), pr = (R >> 5) & 1, part = kk >> 6, t1 = kk & 63;
      const float a = (float)((k1 * t1) & 63) * (1.0f / 32.0f);
      const float cs = cospif(a), sn = sinpif(a);
      const float v = (pr == 0) ? (part == 0 ? cs : -sn) : (part == 0 ? -sn : -cs);
      p.WA[i] = tobf(v * 0.125f);
    } else if (job < 80) {
      const int i = (job - 72) * 2048 + e;
      const int k2 = i >> 7, kk = i & 127, part = kk >> 6, t2 = kk & 63;
      const float a = (float)((k2 * t2) & 63) * (1.0f / 32.0f);
      p.WC[i] = (k2 < 64) ? tobf((part == 0 ? cospif(a) : sinpif(a)) * 0.125f) : (u16)0;
    } else if (job < 84) {
      const int i = (job - 80) * 2048 + e;
      const int n = i >> 6, d = i & 63, pp = n >> 6, en = n & 63;
      const float a = (float)((en * d) & 63) * (1.0f / 32.0f);
      p.Wcs[i] = tobf((pp == 0 ? cospif(a) : sinpif(a)) * 0.125f);
    } else if (job < 86) {
      const int i = (job - 84) * 2048 + e;
      const float a = (float)i * (1.0f / 2048.0f);
      p.tw[2 * i] = cospif(a); p.tw[2 * i + 1] = sinpif(a);
    } else if (e < 512) {
      const int pos = e >> 3, mm = e & 7;
      const float inv = powf(10000.0f, -(float)(2 * mm) / 16.0f);
      const float ang = (float)pos * inv;
      p.ropetab[e * 2] = cosf(ang);
      p.ropetab[e * 2 + 1] = sinf(ang);
    }
  }
}

#define NJ_MODS 192
#define NJ_CONVW (2 * NJ_CONV_LAYER)
#define NJ_SUBK 32
#define NJ_PREP (NJ_MODS + NJ_CONVW + NJ_SUBK + NJ_MISC)

__device__ __forceinline__ void phase_prep(const Params& p, char* smem) {
  char* sm = smem + HALF_ * LDS_SMALL;
  FOR_PAIRED(NJ_MODS, j) job_mods(p, j, sm); }
  FOR_PAIRED(NJ_CONVW, j) job_conv_weights(p, j, sm); }
  for (int j = VBID; j < NJ_SUBK; j += NVB) job_cvt_straight(p.sub_keys, p.SubK, j);
  for (int j = NVB - 1 - VBID; j < NJ_MISC; j += NVB) job_misc(p, j);
}

__device__ __forceinline__ unsigned pack_i8x4(float4 v, float inv) {
  const int q0 = (int)rintf(v.x * inv), q1 = (int)rintf(v.y * inv), q2 = (int)rintf(v.z * inv), q3 = (int)rintf(v.w * inv);
  return ((unsigned)q0 & 0xffu) | (((unsigned)q1 & 0xffu) << 8) | (((unsigned)q2 & 0xffu) << 16) | ((unsigned)q3 << 24);
}
__device__ __forceinline__ void phase_norm(const Params& p, int L, int which, int nrows) {
  const int lane = TIDS & 63;
  const int gw = VBID * 4 + (TIDS >> 6), nw = NVB * 4;
  const float* g = (which == 0 ? p.g_norm1 : p.g_norm2) + L * 1024;
  const int rpw = (nrows + nw - 1) / nw;
  const int rb = gw * rpw, re = (rb + rpw < nrows) ? rb + rpw : nrows;
  int curmod = -1;
  float4 G[4], SH[4];
#pragma unroll
  for (int i = 0; i < 4; i++) { G[i] = make_float4(0.f, 0.f, 0.f, 0.f); SH[i] = G[i]; }
  for (int r0 = rb; r0 < re; r0 += 2) {
    float4 v[2][4];
    int rr[2]; bool ok[2];
#pragma unroll
    for (int u = 0; u < 2; u++) {
      const int r = r0 + u;
      ok[u] = r < re; rr[u] = ok[u] ? r : r0;
      const float* src;
      if (which == 0 && L == 0) src = (rr[u] < TLAT) ? p.x + (long)rr[u] * 1024 : p.ctx + (long)(rr[u] - TLAT) * 1024;
      else src = (rr[u] < TLAT) ? p.out + (long)rr[u] * 1024 : p.ctx1 + (long)(rr[u] - TLAT) * 1024;
#pragma unroll
      for (int i = 0; i < 4; i++) v[u][i] = *(const float4*)(src + i * 256 + lane * 4);
    }
#pragma unroll
    for (int u = 0; u < 2; u++) {
      const int r = rr[u];
      const int mr = row_mod(r);
      if (mr != curmod) {
        curmod = mr;
        const float* md = p.mods + (long)(L * 9 + mr) * 6144 + (which == 0 ? 0 : 3072);
#pragma unroll
        for (int i = 0; i < 4; i++) {
          const int c = i * 256 + lane * 4;
          const float4 gg = *(const float4*)(g + c);
          const float4 sc = *(const float4*)(md + 1024 + c);
          SH[i] = *(const float4*)(md + c);
          G[i] = make_float4(gg.x * (1.f + sc.x), gg.y * (1.f + sc.y), gg.z * (1.f + sc.z), gg.w * (1.f + sc.w));
        }
      }
      float ss = 0.f;
#pragma unroll
      for (int i = 0; i < 4; i++) ss += v[u][i].x * v[u][i].x + v[u][i].y * v[u][i].y + v[u][i].z * v[u][i].z + v[u][i].w * v[u][i].w;
      ss = wave_sum(ss);
      const float rs = __builtin_amdgcn_rsqf(ss * (1.0f / 1024.0f) + EPSV);
      if (!ok[u]) continue;
#pragma unroll
      for (int i = 0; i < 4; i++) {
        const int c = i * 256 + lane * 4;
        const float o0 = v[u][i].x * rs * G[i].x + SH[i].x;
        const float o1 = v[u][i].y * rs * G[i].y + SH[i].y;
        const float o2 = v[u][i].z * rs * G[i].z + SH[i].z;
        const float o3 = v[u][i].w * rs * G[i].w + SH[i].w;
        *(uint2*)(p.hx + (long)r * 1024 + c) = make_uint2(pack2(o0, o1), pack2(o2, o3));
        if (which == 1) {
          float am = fmaxf(fmaxf(fabsf(o0), fabsf(o1)), fmaxf(fabsf(o2), fabsf(o3)));
#pragma unroll
          for (int sx = 16; sx > 0; sx >>= 1) am = fmaxf(am, __shfl_xor(am, sx));
          const float inv = am > 0.f ? 127.0f / am : 0.f;
          ((unsigned*)p.hq8)[(long)r * 256 + i * 64 + lane] = pack_i8x4(make_float4(o0, o1, o2, o3), inv);
          if ((lane & 31) == 0) p.hs[(long)r * 8 + 2 * i + (lane >> 5)] = am * (1.0f / 127.0f);
        }
      }
    }
  }
}
#define U8_SCALE 32.0f
#define V8_SCALE 4.0f
__device__ __forceinline__ unsigned pack_fp8x4(float4 v, float s) {
  int w = 0;
  w = __builtin_amdgcn_cvt_pk_fp8_f32(v.x * s, v.y * s, w, false);
  w = __builtin_amdgcn_cvt_pk_fp8_f32(v.z * s, v.w * s, w, true);
  return (unsigned)w;
}
__device__ __forceinline__ void phase_tables(const Params& p, int L, int wrank = -1, int nworkers = 0) {
  const int tid = TIDS;
  if (wrank < 0) { wrank = VBID; nworkers = NVB; }
  for (int job = wrank; job < 4096; job += nworkers) {
    const bool isu = job < 2048;
    const float* src = (isu ? p.u_tab : p.v_tab) + (long)L * NEXP * 1024;
    unsigned char* dst = isu ? p.UT8 : p.VT8;
    const float s = isu ? U8_SCALE : V8_SCALE;
    const long base = (long)(isu ? job : job - 2048) * 8192 + tid * 16;
#pragma unroll
    for (int i = 0; i < 2; i++) {
      const long o = base + i * 4096;
      const float4 a = *(const float4*)(src + o), b = *(const float4*)(src + o + 4);
      const float4 c = *(const float4*)(src + o + 8), d = *(const float4*)(src + o + 12);
      const long e = o >> 10; const int col = (int)(o & 1023), sl = col >> 7, cc = col & 127;
      if (isu) {
        float am = fmaxf(fmaxf(fmaxf(fabsf(a.x), fabsf(a.y)), fmaxf(fabsf(a.z), fabsf(a.w))), fmaxf(fmaxf(fabsf(b.x), fabsf(b.y)), fmaxf(fabsf(b.z), fabsf(b.w))));
        am = fmaxf(am, fmaxf(fmaxf(fmaxf(fabsf(c.x), fabsf(c.y)), fmaxf(fabsf(c.z), fabsf(c.w))), fmaxf(fmaxf(fabsf(d.x), fabsf(d.y)), fmaxf(fabsf(d.z), fabsf(d.w)))));
#pragma unroll
        for (int sx = 32; sx > 0; sx >>= 1) am = fmaxf(am, __shfl_xor(am, sx));
        const float inv = am > 0.f ? 127.0f / am : 0.f;
        *(uint4*)(dst + ((long)sl * NEXP + e) * 128 + cc) = make_uint4(pack_i8x4(a, inv), pack_i8x4(b, inv), pack_i8x4(c, inv), pack_i8x4(d, inv));
        if ((tid & 63) == 0) p.su[e] = am * (1.0f / 127.0f);
      } else
      *(uint4*)(dst + ((long)sl * NEXP + e) * 128 + cc) = make_uint4(pack_fp8x4(a, s), pack_fp8x4(b, s), pack_fp8x4(c, s), pack_fp8x4(d, s));
    }
  }
}

template <bool BIG>
__device__ __forceinline__ void phase_s2(const Params& p, int L, char* smem) {
  constexpr int TM = BIG ? 256 : 128;
  const int lane = TIDX & 63, w = TIDX >> 6, wr = w >> 1, wc = w & 1;
  for (int pass = 0; pass < (L == 0 ? 1 : 2); pass++) {
  const int g_nrt = (L == 0) ? RTOT / TM : (pass == 0 ? TLAT / TM : TCTX / TM), g_nct = (L == 0 || pass == 0) ? 10 : 2;
  FOR_UNITS_XCD(g_nrt, g_nct, rt_, ct_)
    const int rt = (L == 1 && pass == 1) ? TLAT / TM + rt_ : rt_, ct = (L == 1 && pass == 1) ? 8 + ct_ : ct_;
    f32x16 acc[2][2];
    ZERO_ACC(acc);
    if constexpr (BIG) gemm256(p.hx + (long)rt * TM * 1024, 1024, p.W2T + (long)L * W2T_SZ + (long)ct * 128 * 1024, 1024, 1024, acc, smem);
    else gemm128(p.hx + (long)rt * TM * 1024, 1024, p.W2T + (long)L * W2T_SZ + (long)ct * 128 * 1024, 1024, 1024, acc, smem);
    const int row0 = rt * TM;
#define S2_STORE(DST, LDD, C0) { u16* dp = (DST) + (long)row0 * (LDD) + (C0); \
      const int tb = opaque((wr * 64 + 4 * (lane >> 5)) * (LDD) + wc * 64 + (lane & 31)); \
      _Pragma("unroll") for (int i = 0; i < 2; i++) _Pragma("unroll") for (int j = 0; j < 2; j++) _Pragma("unroll") for (int r = 0; r < 16; r++) \
        dp[tb + (i * 32 + (r & 3) + 8 * (r >> 2)) * (LDD) + j * 32] = tobf(acc[i][j][r]); }
    if (ct < 2) S2_STORE(p.cq, 256, ct * 128)
    else if (ct < 4) S2_STORE(p.zf, 256, (ct - 2) * 128)
    else if (ct < 8) {
      u16* dp = p.zc + (long)row0 * 256 + (ct - 4) * 64;
      const int tb = opaque((wr * 64 + 4 * (lane >> 5)) * 256 + wc * 32 + (lane & 31));
#pragma unroll
      for (int i = 0; i < 2; i++)
#pragma unroll
        for (int r = 0; r < 16; r++)
          dp[tb + (i * 32 + (r & 3) + 8 * (r >> 2)) * 256] = tobf(acc[i][0][r] * sigmoidf_(acc[i][1][r]));
    }
    else if (ct == 8) S2_STORE(p.ckv, 128, 0)
#undef S2_STORE
    else if (wc == 0) {
      float* dp = p.kr + (long)row0 * 32;
      const int tb = opaque((wr * 64 + 4 * (lane >> 5)) * 32 + (lane & 31));
#pragma unroll
      for (int i = 0; i < 2; i++)
#pragma unroll
        for (int r = 0; r < 16; r++)
          dp[tb + (i * 32 + (r & 3) + 8 * (r >> 2)) * 32] = acc[i][0][r];
    }
  }
  }
}

__device__ __forceinline__ void unit_kv(const Params& p, int L, int rt, int h, char* smem) {
  u16* As = (u16*)smem;
  u16* Ws = (u16*)(smem + 128 * 136 * 2);
  float* rrs = (float*)(smem + 2 * 128 * 136 * 2);
  const int tid = TIDS, lane = tid & 63, w = tid >> 6, hh = lane >> 5, c = lane & 31;
  const int row0 = rt * 128;
  __syncthreads();
  {
    const u16* ap = p.ckv + (long)row0 * 128;
    const u16* wp = p.WukvT + (long)L * WUKV_SZ + (long)h * 128 * 128;
#pragma unroll
    for (int i = 0; i < 8; i++) {
      const int idx = tid + 256 * i, rw = idx >> 4, ch = idx & 15;
      *(uint4*)(As + rw * 136 + ch * 8) = ldg16(ap + rw * 128 + ch * 8);
      *(uint4*)(Ws + rw * 136 + ch * 8) = ldg16(wp + rw * 128 + ch * 8);
    }
  }
  __syncthreads();
  {
    const int rw = tid >> 1, hf = tid & 1;
    float ss = 0.f;
#pragma unroll
    for (int q = 0; q < 8; q++) {
      uint4 v = *(const uint4*)(As + rw * 136 + hf * 64 + q * 8);
      float a;
      a = bf_lo(v.x); ss += a * a; a = bf_hi(v.x); ss += a * a;
      a = bf_lo(v.y); ss += a * a; a = bf_hi(v.y); ss += a * a;
      a = bf_lo(v.z); ss += a * a; a = bf_hi(v.z); ss += a * a;
      a = bf_lo(v.w); ss += a * a; a = bf_hi(v.w); ss += a * a;
    }
    ss += dpp_mov<0xB1>(ss);
    if (hf == 0) rrs[rw] = __builtin_amdgcn_rsqf(ss * (1.0f / 128.0f) + EPSV);
  }
  __syncthreads();
  f32x16 aK[2], aV[2];
#pragma unroll
  for (int r = 0; r < 16; r++) { aK[0][r] = 0.f; aK[1][r] = 0.f; aV[0][r] = 0.f; aV[1][r] = 0.f; }
#pragma unroll
  for (int s = 0; s < 8; s++) {
    const int ko = s * 16 + hh * 8;
    uint4 tk = *(const uint4*)(As + (32 * w + c) * 136 + ko);
    uint4 w0 = *(const uint4*)(Ws + (c) * 136 + ko);
    uint4 w1 = *(const uint4*)(Ws + (32 + c) * 136 + ko);
    uint4 w2 = *(const uint4*)(Ws + (64 + c) * 136 + ko);
    uint4 w3 = *(const uint4*)(Ws + (96 + c) * 136 + ko);
    aK[0] = mfma32(tk, w0, aK[0]);
    aK[1] = mfma32(tk, w1, aK[1]);
    aV[0] = mfma32(w2, tk, aV[0]);
    aV[1] = mfma32(w3, tk, aV[1]);
  }
  const bool lat = row0 < TLAT;
  const int b = lat ? (row0 >> 12) : ((row0 - TLAT) >> 8);
  const int s0 = lat ? (row0 & 4095) : ((row0 - TLAT) & 255);
  const int kpos0 = lat ? (CTXL + s0) : s0;
  const float* gkn = p.g_kn + L * 96;
  const float gk0 = gkn[c], gk1 = gkn[32 + c], gk2 = gkn[64 + c];
  u16* Kdst = p.Kb + ((long)(b * 8 + h) * SKEYS + kpos0) * 96;
#pragma unroll
  for (int r = 0; r < 16; r++) {
    const int tl = 32 * w + (r & 3) + 8 * (r >> 2) + 4 * hh;
    const float rc = rrs[tl];
    const float v0 = aK[0][r] * rc, v1 = aK[1][r] * rc;
    const float kv = p.kr[(long)(row0 + tl) * 32 + c];
    const float ss = half_sum(v0 * v0 + v1 * v1 + kv * kv);
    const float rk = __builtin_amdgcn_rsqf(ss * (1.0f / 96.0f) + EPSV);
    const float krn = kv * rk * gk2;
    const float partner = dpp_mov<0x128>(krn);
    float o2 = krn;
    if (lat) {
      const int s = s0 + tl;
      const int pos = (c < 16) ? (s >> 6) : (s & 63);
      const float2 cs = *(const float2*)(p.ropetab + (pos * 8 + (c & 7)) * 2);
      const float rot = (c & 8) ? partner : -partner;
      o2 = krn * cs.x + rot * cs.y;
    }
    u16* kd = Kdst + (long)tl * 96;
    kd[c] = tobf(v0 * rk * gk0);
    kd[32 + c] = tobf(v1 * rk * gk1);
    kd[64 + c] = tobf(o2);
  }
  u16* Vdst = p.Vtb + (long)(b * 8 + h) * 64 * SKEYS + kpos0;
  const float rcv = rrs[32 * w + c];
#pragma unroll
  for (int i = 0; i < 2; i++)
#pragma unroll
    for (int r = 0; r < 16; r++) {
      const int d = 32 * i + (r & 3) + 8 * (r >> 2) + 4 * hh;
      Vdst[(long)d * SKEYS + 32 * w + c] = tobf(aV[i][r] * rcv);
    }
}

__device__ __forceinline__ void unit_chdft(const Params& p, int ut, int g, bool lat, char* smem) {
  const int lane = TIDS & 63, w = TIDS >> 6, wr = w >> 1, wc = w & 1;
  f32x16 acc[2][2];
  ZERO_ACC(acc);
  if (lat) {
    const int b = ut >> 5, j = ut & 31;
    gemm128x(p.Wcs, 64, p.zf + ((long)(b * SEQ + 2 * j) * 256 + g * 64), 64 * 256, 32 * 64 * 256, 256, 64, acc, smem);
    u16* dst = p.Ytl + ((long)(b * 256 + g * 64) * 64 + 2 * j) * 128;
#pragma unroll
    for (int i = 0; i < 2; i++)
#pragma unroll
      for (int jj = 0; jj < 2; jj++)
#pragma unroll
        for (int r = 0; r < 16; r++) {
          const int e = i * 32 + (r & 3) + 8 * (r >> 2) + 4 * (lane >> 5);
          dst[((long)e * 64 + wc) * 128 + wr * 64 + jj * 32 + (lane & 31)] = tobf(acc[i][jj][r]);
        }
  } else {
    const int row0 = TLAT + ut * 128;
    gemm128(p.Wcs, 64, p.zf + (long)row0 * 256 + g * 64, 256, 64, acc, smem);
    const int b = (row0 - TLAT) >> 8, s0 = (row0 - TLAT) & 255;
#pragma unroll
    for (int i = 0; i < 2; i++)
#pragma unroll
      for (int jj = 0; jj < 2; jj++)
#pragma unroll
        for (int r = 0; r < 16; r++) {
          const int n = ACC_ROW(wr, i, r, lane);
          const int t = s0 + ACC_COL(wc, jj, lane);
          p.Ytc[((long)(b * 256 + g * 64 + (n & 63))) * 512 + (n >> 6) * 256 + t] = tobf(acc[i][jj][r]);
        }
  }
}

__device__ __forceinline__ void unit_conv(const Params& p, int L, int ut, char* smem) {
  float* U = (float*)smem;
  const int tid = TIDS, lane = tid & 63, w = tid >> 6;
  const int row0 = ut * 32;
  const bool lat = row0 < TLAT;
  const int seqlen = lat ? SEQ : CTXL;
  const int s0 = lat ? (row0 & 4095) : ((row0 - TLAT) & 255);
  float wv[31];
#pragma unroll
  for (int j = 0; j < 31; j++) wv[j] = p.w_dw[(long)L * 31 * 256 + j * 256 + tid];
  const float bias = p.b_dw[L * 256 + tid];
  __syncthreads();
  {
    uint4 cu[8];
#pragma unroll
    for (int q = 0; q < 8; q++) {
      const int id = tid + 256 * q, i = id >> 5, k = id & 31;
      const int s = s0 - 15 + i;
      cu[q] = make_uint4(0u, 0u, 0u, 0u);
      if (i < 62 && s >= 0 && s < seqlen) cu[q] = ldg16(p.zc + (long)(row0 - 15 + i) * 256 + k * 8);
    }
#pragma unroll
    for (int q = 0; q < 8; q++) {
      const int id = tid + 256 * q, i = id >> 5, k = id & 31;
      if (i < 62) {
        *(float4*)(U + i * 256 + k * 8) = make_float4(bf_lo(cu[q].x), bf_hi(cu[q].x), bf_lo(cu[q].y), bf_hi(cu[q].y));
        *(float4*)(U + i * 256 + k * 8 + 4) = make_float4(bf_lo(cu[q].z), bf_hi(cu[q].z), bf_lo(cu[q].w), bf_hi(cu[q].w));
      }
    }
  }
  __syncthreads();
  {
    float win[31];
#pragma unroll
    for (int j = 0; j < 30; j++) win[j] = U[j * 256 + tid];
#pragma unroll
    for (int t = 0; t < 32; t++) {
      win[(t + 30) % 31] = U[(t + 30) * 256 + tid];
      float a0 = bias, a1 = 0.f;
#pragma unroll
      for (int j = 0; j < 30; j += 2) { a0 += win[(t + j) % 31] * wv[j]; a1 += win[(t + j + 1) % 31] * wv[j + 1]; }
      a0 += win[(t + 30) % 31] * wv[30];
      U[t * 256 + tid] = a0 + a1;
    }
  }
  __syncthreads();
  const float4 gg = *(const float4*)(p.g_cln + L * 256 + lane * 4);
  const float4 bb = *(const float4*)(p.b_cln + L * 256 + lane * 4);
#pragma unroll
  for (int q = 0; q < 8; q++) {
    const int t = w * 8 + q;
    const float4 v = *(const float4*)(U + t * 256 + lane * 4);
    const float mu = wave_sum(v.x + v.y + v.z + v.w) * (1.0f / 256.0f);
    const float d0 = v.x - mu, d1 = v.y - mu, d2 = v.z - mu, d3 = v.w - mu;
    const float var = wave_sum(d0 * d0 + d1 * d1 + d2 * d2 + d3 * d3) * (1.0f / 256.0f);
    const float rs = __builtin_amdgcn_rsqf(var + EPSV);
    const float y0 = siluf_(d0 * rs * gg.x + bb.x), y1 = siluf_(d1 * rs * gg.y + bb.y);
    const float y2 = siluf_(d2 * rs * gg.z + bb.z), y3 = siluf_(d3 * rs * gg.w + bb.w);
    *(uint2*)(p.cv + (long)(row0 + t) * 256 + lane * 4) = make_uint2(pack2(y0, y1), pack2(y2, y3));
  }
}

#ifndef S3_REP_MASK
#define S3_REP_MASK 7
#endif
__device__ __forceinline__ void phase_s3(const Params& p, int L, char* smem, bool rep = false) {
  const int msk = rep ? S3_REP_MASK : 7;
  char* sm = smem + HALF_ * LDS_SMALL;
  const int nrt_all = (L == 0) ? 272 : 256;
  const int sh = (int)(blockDim.x >> 9);
  const int nkv = (msk & 1) ? (272 * 8) >> sh : 0, nch = (msk & 2) ? (nrt_all * 4) >> sh : 0, ncv = (msk & 4) ? (nrt_all * 4) >> sh : 0;
  const int q0 = (int)(blockIdx.x & 7) * (int)(gridDim.x >> 3) + (int)(blockIdx.x >> 3);
#pragma unroll 1
  for (int q = q0; q < nkv + nch + ncv; q += (int)gridDim.x) {
    if (q < nkv) { const int u = (q << sh) + HALF_; unit_kv(p, L, u >> 3, u & 7, sm); }
    else if (q < nkv + nch) { const int v = ((q - nkv) << sh) + HALF_, ut = v >> 2; unit_chdft(p, ut < 256 ? ut : ut - 256, v & 3, ut < 256, sm); }
    else { const int v = ((q - nkv - nch) << sh) + HALF_; unit_conv(p, L, v, sm); }
  }
}

#define KLD 104
__device__ __forceinline__ void unit_attn(const Params& p, int L, int b, int h, int qt, bool isctx, char* smem) {
  const int tf = TIDX, NT = (int)blockDim.x, nh = NT >> 8, half = tf >> 8, wf = tf >> 6;
  const int tid = tf & 255, lane = tid & 63, w = tid >> 6, hh = lane >> 5, c = lane & 31;
  const int qtile = qt * nh + half;
  const int qrow0 = isctx ? (TLAT + b * CTXL + qtile * 128) : (b * SEQ + qtile * 128);
  const int nkt = isctx ? (CTXL / 64) : (SKEYS / 64);
  char* smh = smem + half * LDS_SMALL;
  u16* As = (u16*)smh;
  u16* Bs = (u16*)(smh + 128 * LDT * 2);
  u16* Qs = (u16*)(smh + (128 + 96) * LDT * 2);
  f32x16 aq[3];
#pragma unroll
  for (int r = 0; r < 16; r++) { aq[0][r] = 0.f; aq[1][r] = 0.f; aq[2][r] = 0.f; }
  float ssq = 0.f;
  const u16* cqp = p.cq + (long)qrow0 * 256;
  const u16* wqp = p.WuqT + (long)L * WUQ_SZ + (long)h * 96 * 256;
  uint4 pa[4][4], pb[4][3];
#pragma unroll
  for (int kc = 0; kc < 4; kc++) {
#pragma unroll
    for (int i = 0; i < 4; i++) { const int idx = tid + 256 * i; pa[kc][i] = ldg16(cqp + (idx >> 3) * 256 + kc * 64 + (idx & 7) * 8); }
#pragma unroll
    for (int i = 0; i < 3; i++) { const int idx = tid + 256 * i; pb[kc][i] = ldg16(wqp + (idx >> 3) * 256 + kc * 64 + (idx & 7) * 8); }
  }
  __builtin_amdgcn_sched_barrier(0);
#pragma unroll
  for (int kc = 0; kc < 4; kc++) {
    __syncthreads();
#pragma unroll
    for (int i = 0; i < 4; i++) {
      const int idx = tid + 256 * i, rw = idx >> 3, ch = idx & 7;
      *(uint4*)(As + rw * LDT + ch * 8) = pa[kc][i];
    }
#pragma unroll
    for (int i = 0; i < 3; i++) {
      const int idx = tid + 256 * i, rw = idx >> 3, ch = idx & 7;
      *(uint4*)(Bs + rw * LDT + ch * 8) = pb[kc][i];
    }
    __syncthreads();
#pragma unroll
    for (int q = 0; q < 4; q++) {
      uint4 v = *(const uint4*)(As + (32 * w + c) * LDT + hh * 32 + q * 8);
      float a;
      a = bf_lo(v.x); ssq += a * a; a = bf_hi(v.x); ssq += a * a;
      a = bf_lo(v.y); ssq += a * a; a = bf_hi(v.y); ssq += a * a;
      a = bf_lo(v.z); ssq += a * a; a = bf_hi(v.z); ssq += a * a;
      a = bf_lo(v.w); ssq += a * a; a = bf_hi(v.w); ssq += a * a;
    }
#pragma unroll
    for (int kk = 0; kk < 4; kk++) {
      uint4 a = *(const uint4*)(As + (32 * w + c) * LDT + kk * 16 + hh * 8);
#pragma unroll
      for (int j = 0; j < 3; j++) {
        uint4 bq = *(const uint4*)(Bs + (32 * j + c) * LDT + kk * 16 + hh * 8);
        aq[j] = mfma32(a, bq, aq[j]);
      }
    }
  }
  ssq += __shfl_xor(ssq, 32);
  const float rr_lane = __builtin_amdgcn_rsqf(ssq * (1.0f / 256.0f) + EPSV);
  {
    const float* gqn = p.g_qn + L * 96;
    const float g0 = gqn[c], g1 = gqn[32 + c], g2 = gqn[64 + c];
    const float qscale = 0.10206207261596577f * 1.4426950408889634f;
    u16* Qw = Qs + w * 32 * KLD;
#pragma unroll
    for (int r = 0; r < 16; r++) {
      const int rl = (r & 3) + 8 * (r >> 2) + 4 * hh;
      const float rc = __shfl(rr_lane, rl);
      const float q0 = aq[0][r] * rc, q1 = aq[1][r] * rc, q2 = aq[2][r] * rc;
      const float ss = half_sum(q0 * q0 + q1 * q1 + q2 * q2);
      const float rq = __builtin_amdgcn_rsqf(ss * (1.0f / 96.0f) + EPSV);
      const float qn2 = q2 * rq * g2;
      const float partner = dpp_mov<0x128>(qn2);
      float o2 = qn2;
      if (!isctx) {
        const int s = qtile * 128 + 32 * w + rl;
        const int pos = (c < 16) ? (s >> 6) : (s & 63);
        const float2 cs = *(const float2*)(p.ropetab + (pos * 8 + (c & 7)) * 2);
        const float rot = (c & 8) ? partner : -partner;
        o2 = qn2 * cs.x + rot * cs.y;
      }
      Qw[rl * KLD + c] = tobf(q0 * rq * g0 * qscale);
      Qw[rl * KLD + 32 + c] = tobf(q1 * rq * g1 * qscale);
      Qw[rl * KLD + 64 + c] = tobf(o2 * qscale);
    }
  }
  __syncthreads();
  uint4 qf[6];
#pragma unroll
  for (int s = 0; s < 6; s++) qf[s] = *(const uint4*)(Qs + (w * 32 + c) * KLD + s * 16 + hh * 8);
  __syncthreads();
  u16* Ks = (u16*)smem;
  u16* Vs = (u16*)(smem + 2 * 64 * KLD * 2);
  const u16* kg = p.Kb + (long)(b * 8 + h) * SKEYS * 96;
  const u16* vg = p.Vtb + (long)(b * 8 + h) * 64 * SKEYS;
  uint4 rk[3], rv[2];
  int krow[3], kch[3], vrw[2], vch[2];
#pragma unroll
  for (int i = 0; i < 3; i++) { const int idx = tf + NT * i; krow[i] = idx / 12; kch[i] = idx % 12; }
#pragma unroll
  for (int i = 0; i < 2; i++) { const int idx = tf + NT * i; vrw[i] = idx >> 3; vch[i] = idx & 7; }
#pragma unroll
  for (int i = 0; i < 3; i++) if (tf + NT * i < 768) rk[i] = ldg16(kg + (long)(tf + NT * i) * 8);
#pragma unroll
  for (int i = 0; i < 2; i++) if (tf + NT * i < 512) rv[i] = ldg16(vg + (long)vrw[i] * SKEYS + vch[i] * 8);
#pragma unroll
  for (int i = 0; i < 3; i++) if (tf + NT * i < 768) *(uint4*)(Ks + krow[i] * KLD + kch[i] * 8) = rk[i];
#pragma unroll
  for (int i = 0; i < 2; i++) if (tf + NT * i < 512) *(uint4*)(Vs + vrw[i] * LDT + vch[i] * 8) = rv[i];
  __syncthreads();
  f32x16 aO[2];
#pragma unroll
  for (int r = 0; r < 16; r++) { aO[0][r] = 0.f; aO[1][r] = 0.f; }
  float mref = 0.f;
  float ls0 = 0.f, ls1 = 0.f, ls2 = 0.f, ls3 = 0.f;
  const int kperm = (c & ~12) | ((c & 4) << 1) | ((c & 8) >> 1);
  for (int kt = 0; kt < nkt; kt++) {
    const int cur = kt & 1;
    if (kt + 1 < nkt) {
#pragma unroll
      for (int i = 0; i < 3; i++) if (tf + NT * i < 768) rk[i] = ldg16(kg + (long)(kt + 1) * 64 * 96 + (long)(tf + NT * i) * 8);
#pragma unroll
      for (int i = 0; i < 2; i++) if (tf + NT * i < 512) rv[i] = ldg16(vg + (long)vrw[i] * SKEYS + (kt + 1) * 64 + vch[i] * 8);
    }
    __builtin_amdgcn_sched_barrier(0);
    const u16* Kc = Ks + cur * 64 * KLD;
    const u16* Vc = Vs + cur * 64 * LDT;
    f32x16 aS[2];
    {
      const float nm = -mref;
#pragma unroll
      for (int r = 0; r < 16; r++) { aS[0][r] = nm; aS[1][r] = nm; }
    }
#pragma unroll
    for (int s = 0; s < 6; s++) {
      uint4 k0 = *(const uint4*)(Kc + (kperm) * KLD + s * 16 + hh * 8);
      uint4 k1 = *(const uint4*)(Kc + (32 + kperm) * KLD + s * 16 + hh * 8);
      aS[0] = mfma32(k0, qf[s], aS[0]);
      aS[1] = mfma32(k1, qf[s], aS[1]);
    }
    float mx = fmaxf(aS[0][0], aS[1][0]);
#pragma unroll
    for (int r = 1; r < 16; r++) mx = fmaxf(fmaxf(mx, aS[0][r]), aS[1][r]);
    if (__any(mx > 8.0f)) {
      const float mo = fmaxf(mx, __shfl_xor(mx, 32));
      const float delta = (mo > 8.0f) ? mo : 0.f;
      const float alpha = __builtin_amdgcn_exp2f(-delta);
      mref += delta;
      ls0 *= alpha; ls1 *= alpha; ls2 *= alpha; ls3 *= alpha;
#pragma unroll
      for (int r = 0; r < 16; r++) {
        aO[0][r] *= alpha; aO[1][r] *= alpha;
        aS[0][r] -= delta; aS[1][r] -= delta;
      }
    }
#pragma unroll
    for (int r = 0; r < 16; r += 2) {
      aS[0][r] = __builtin_amdgcn_exp2f(aS[0][r]); aS[0][r + 1] = __builtin_amdgcn_exp2f(aS[0][r + 1]);
      aS[1][r] = __builtin_amdgcn_exp2f(aS[1][r]); aS[1][r + 1] = __builtin_amdgcn_exp2f(aS[1][r + 1]);
    }
#pragma unroll
    for (int i = 0; i < 2; i++)
#pragma unroll
      for (int s2 = 0; s2 < 2; s2++) {
        uint4 pf = make_uint4(pack2(aS[i][8 * s2 + 0], aS[i][8 * s2 + 1]), pack2(aS[i][8 * s2 + 2], aS[i][8 * s2 + 3]),
                              pack2(aS[i][8 * s2 + 4], aS[i][8 * s2 + 5]), pack2(aS[i][8 * s2 + 6], aS[i][8 * s2 + 7]));
        uint4 v0 = *(const uint4*)(Vc + (c) * LDT + 32 * i + 16 * s2 + 8 * hh);
        uint4 v1 = *(const uint4*)(Vc + (32 + c) * LDT + 32 * i + 16 * s2 + 8 * hh);
        aO[0] = mfma32(v0, pf, aO[0]);
        aO[1] = mfma32(v1, pf, aO[1]);
        {
          typedef __bf16 bf16x2q_ __attribute__((ext_vector_type(2)));
          const bf16x2q_ one2 = __builtin_bit_cast(bf16x2q_, 0x3f803f80u);
          ls0 = __builtin_amdgcn_fdot2_f32_bf16(__builtin_bit_cast(bf16x2q_, pf.x), one2, ls0, false);
          ls1 = __builtin_amdgcn_fdot2_f32_bf16(__builtin_bit_cast(bf16x2q_, pf.y), one2, ls1, false);
          ls2 = __builtin_amdgcn_fdot2_f32_bf16(__builtin_bit_cast(bf16x2q_, pf.z), one2, ls2, false);
          ls3 = __builtin_amdgcn_fdot2_f32_bf16(__builtin_bit_cast(bf16x2q_, pf.w), one2, ls3, false);
        }
      }
    if (kt + 1 < nkt) {
      const int nx = cur ^ 1;
#pragma unroll
      for (int i = 0; i < 3; i++) if (tf + NT * i < 768) *(uint4*)(Ks + nx * 64 * KLD + krow[i] * KLD + kch[i] * 8) = rk[i];
#pragma unroll
      for (int i = 0; i < 2; i++) if (tf + NT * i < 512) *(uint4*)(Vs + nx * 64 * LDT + vrw[i] * LDT + vch[i] * 8) = rv[i];
    }
    __syncthreads();
  }
  float lsum = (ls0 + ls1) + (ls2 + ls3);
  lsum += __shfl_xor(lsum, 32);
  const float inv = 1.0f / lsum;
  u16* Os = (u16*)smem + wf * 32 * LDT;
#pragma unroll
  for (int i = 0; i < 2; i++)
#pragma unroll
    for (int r = 0; r < 16; r++) {
      const int d = 32 * i + (r & 3) + 8 * (r >> 2) + 4 * hh;
      Os[c * LDT + d] = tobf(aO[i][r] * inv);
    }
  __syncthreads();
#pragma unroll
  for (int i = 0; i < 4; i++) {
    const int idx = lane + 64 * i, q = idx >> 3, ch = idx & 7;
    *(uint4*)(p.Ob + (long)(qrow0 + 32 * w + q) * 512 + h * 64 + ch * 8) = *(const uint4*)(Os + q * LDT + ch * 8);
  }
}

__device__ __forceinline__ void unit_dftA(const Params& p, int b, int np, char* smem) {
  const int lane = TIDS & 63, w = TIDS >> 6, wr = w >> 1, wc = w & 1, hh = lane >> 5, c = lane & 31;
  f32x16 acc[2][2];
  ZERO_ACC(acc);
  gemm128(p.WA, 128, p.Ytl + (long)(b * 256 + 2 * np) * 64 * 128, 128, 128, acc, smem);
  const int n = 2 * np + wc;
#pragma unroll
  for (int jj = 0; jj < 2; jj++) {
    const int t2 = jj * 32 + c;
#pragma unroll
    for (int r = 0; r < 16; r++) {
      const int k1 = wr * 32 + (r & 3) + 8 * (r >> 2) + 4 * hh;
      const float2 t = *(const float2*)(p.tw + 2 * ((k1 * t2) & 4095));
      const float gr = acc[0][jj][r], gi = acc[1][jj][r];
      u16* dst = p.GB + ((long)((b * 64 + k1) * 256 + n)) * 128 + t2;
      dst[0] = tobf(gr * t.x + gi * t.y);
      dst[64] = tobf(gi * t.x - gr * t.y);
    }
  }
}
__device__ __forceinline__ void unit_dftC(const Params& p, int b, int k1, int nt, char* smem) {
  const int lane = TIDS & 63, w = TIDS >> 6, wr = w >> 1, wc = w & 1, hh = lane >> 5, c = lane & 31;
  f32x16 acc[2][2];
  ZERO_ACC(acc);
  gemm128(p.WC, 128, p.GB + ((long)((b * 64 + k1) * 256 + nt * 128)) * 128, 128, 128, acc, smem);
  if (wr == 0) {
#pragma unroll
    for (int i = 0; i < 2; i++)
#pragma unroll
      for (int jj = 0; jj < 2; jj++)
#pragma unroll
        for (int r = 0; r < 16; r++) {
          const int k2 = i * 32 + (r & 3) + 8 * (r >> 2) + 4 * hh;
          p.Fb[((long)b * SEQ + k1 + 64 * k2) * 256 + nt * 128 + wc * 64 + jj * 32 + c] = tobf(acc[i][jj][r]);
        }
  }
}
__device__ __forceinline__ void unit_seqdft_ctx(const Params& p, int b, int mt, int nt, char* smem) {
  const int lane = TIDS & 63, w = TIDS >> 6, wr = w >> 1, wc = w & 1;
  f32x16 acc[2][2];
  ZERO_ACC(acc);
  gemm128(p.Dctx + (long)mt * 128 * 512, 512, p.Ytc + (long)(b * 256 + nt * 128) * 512, 512, 512, acc, smem);
  const long orow0 = (long)TLAT + b * CTXL + mt * 128;
#pragma unroll
  for (int i = 0; i < 2; i++)
#pragma unroll
    for (int j = 0; j < 2; j++)
#pragma unroll
      for (int r = 0; r < 16; r++)
        p.Fb[(orow0 + ACC_ROW(wr, i, r, lane)) * 256 + nt * 128 + ACC_COL(wc, j, lane)] = tobf(acc[i][j][r]);
}
__device__ __forceinline__ void phase_dftC(const Params& p, char* smem) {
  char* sm = smem + HALF_ * LDS_SMALL;
  FOR_PAIRED(8 * 64 * 2, u) unit_dftC(p, u >> 7, (u >> 1) & 63, u & 1, sm); }
}

__device__ __forceinline__ void phase_s4(const Params& p, int L, char* smem) {
  char* sm = smem + HALF_ * LDS_SMALL;
  const int nh = (int)(blockDim.x >> 8), tpp = 32 / nh;
  {
    const int x = blockIdx.x & 7, l = blockIdx.x >> 3, nl = gridDim.x >> 3;
    for (int s = l; s < 8 * tpp; s += nl) {
      const int bh = x * 8 + s / tpp;
      unit_attn(p, L, bh >> 3, bh & 7, s % tpp, false, smem);
    }
  }
  FOR_PAIRED(8 * 128, v) unit_dftA(p, v >> 7, v & 127, sm); }
  if (L == 0) {
    FOR_PAIRED(8 * 2 * 2, v) unit_seqdft_ctx(p, v >> 2, (v >> 1) & 1, v & 1, sm); }
    const int tpc = 2 / nh;
    for (int v = blockIdx.x; v < 64 * tpc; v += gridDim.x) unit_attn(p, L, (v / tpc) >> 3, (v / tpc) & 7, v % tpc, true, smem);
  }
}

template <bool BIG>
__device__ __forceinline__ void phase_s7(const Params& p, int L, char* smem) {
  constexpr int TM = BIG ? 256 : 128;
  const int nrt = ((L == 0) ? RTOT : TLAT) / TM;
  FOR_UNITS_XCD(nrt, 8, rt, ct)
    const int row0 = rt * TM;
    f32x16 macc[2][2];
    ZERO_ACC(macc);
#pragma unroll 1
    for (int br = 0; br < 3; br++) {
      unsigned gp[2][2][8];
      {
      f32x16 acc[2][2];
      ZERO_ACC(acc);
      if constexpr (BIG) gemm256(p.hx + (long)row0 * 1024, 1024, p.WgT + (long)L * WGT_SZ + (long)(br * 1024 + ct * 128) * 1024, 1024, 1024, acc, smem);
      else gemm128(p.hx + (long)row0 * 1024, 1024, p.WgT + (long)L * WGT_SZ + (long)(br * 1024 + ct * 128) * 1024, 1024, 1024, acc, smem);
#pragma unroll
      for (int i = 0; i < 2; i++)
#pragma unroll
        for (int j = 0; j < 2; j++)
#pragma unroll
          for (int r = 0; r < 8; r++) gp[i][j][r] = pack2(sigmoidf_(acc[i][j][2 * r]), sigmoidf_(acc[i][j][2 * r + 1]));
      }
      const u16* A2; const u16* B2; int K2;
      if (br == 0) { A2 = p.Ob + (long)row0 * 512; B2 = p.WbaT + (long)L * WBA_SZ + (long)ct * 128 * 512; K2 = 512; }
      else if (br == 1) { A2 = p.Fb + (long)row0 * 256; B2 = p.WbfT + (long)L * WBF_SZ + (long)ct * 128 * 256; K2 = 256; }
      else { A2 = p.cv + (long)row0 * 256; B2 = p.WbcT + (long)L * WBC_SZ + (long)ct * 128 * 256; K2 = 256; }
      {
        f32x16 ab[2][2];
        ZERO_ACC(ab);
        if constexpr (BIG) gemm256(A2, K2, B2, K2, K2, ab, smem); else gemm128(A2, K2, B2, K2, K2, ab, smem);
#pragma unroll
        for (int i = 0; i < 2; i++)
#pragma unroll
          for (int j = 0; j < 2; j++)
#pragma unroll
            for (int r = 0; r < 8; r++) {
              if ((ABL_BR >> br) & 1) {
              macc[i][j][2 * r] += bf_lo(gp[i][j][r]) * ab[i][j][2 * r];
              macc[i][j][2 * r + 1] += bf_hi(gp[i][j][r]) * ab[i][j][2 * r + 1];
              }
            }
      }
    }
    u16* mp = p.m + (long)row0 * 1024 + ct * 128;
    const int tid = TIDX, lane = tid & 63, w = tid >> 6, wr = w >> 1, wc = w & 1;
    const int tb = (wr * 64 + 4 * (lane >> 5)) * 1024 + wc * 64 + (lane & 31);
#pragma unroll
    for (int i = 0; i < 2; i++)
#pragma unroll
      for (int j = 0; j < 2; j++)
#pragma unroll
        for (int r = 0; r < 16; r++)
          mp[tb + (i * 32 + (r & 3) + 8 * (r >> 2)) * 1024 + j * 32] = tobf(macc[i][j][r]);
  }
  if (L == 0) {
    const int per_xcd = (int)(gridDim.x >> 3), l = (int)(blockIdx.x >> 3), x = (int)(blockIdx.x & 7);
    const int n5 = (nrt >> 3) * 8 - 4 * per_xcd;
    if (n5 >= 0 && n5 < per_xcd) {
      const int nidle = per_xcd - n5, nh = (int)(blockDim.x >> 8);
      if (l >= n5) phase_tables(p, L, (x * nidle + (l - n5)) * nh + HALF_, 8 * nidle * nh);
    } else phase_tables(p, L);
  }
}

template <bool BIG>
__device__ __forceinline__ void phase_s8(const Params& p, int L, char* smem, bool dry = false) {
  constexpr int TM = BIG ? 256 : 128;
  const int lane = TIDX & 63, w = TIDX >> 6, wr = w >> 1, wc = w & 1;
  const int nrt = ((L == 0) ? RTOT : TLAT) / TM;
  FOR_UNITS_XCD(nrt, 8, rt, ct)
    const long row0 = (long)rt * TM;
    f32x16 acc[2][2];
    ZERO_ACC(acc);
    if constexpr (BIG) gemm256(p.m + row0 * 1024, 1024, p.WoutT + (long)L * WOUT_SZ + (long)ct * 128 * 1024, 1024, 1024, acc, smem);
    else gemm128(p.m + row0 * 1024, 1024, p.WoutT + (long)L * WOUT_SZ + (long)ct * 128 * 1024, 1024, 1024, acc, smem);
    const int mr = row_mod((int)row0);
    const float* gt = p.mods + (long)(L * 9 + mr) * 6144 + 2048 + ct * 128;
    const float* src; float* dst;
    if (row0 < TLAT) { src = (L == 0 ? p.x : p.out) + row0 * 1024; dst = p.out + row0 * 1024; }
    else { src = (L == 0 ? p.ctx : p.ctx1) + (row0 - TLAT) * 1024; dst = p.ctx1 + (row0 - TLAT) * 1024; }
    src += ct * 128; dst += ct * 128;
    const int tb = opaque((wr * 64 + 4 * (lane >> 5)) * 1024 + wc * 64 + (lane & 31));
#pragma unroll
    for (int j = 0; j < 2; j++) {
      const float gv = gt[ACC_COL(wc, j, lane)];
#pragma unroll
      for (int i = 0; i < 2; i++)
#pragma unroll
        for (int r = 0; r < 16; r++) {
          const int o = tb + (i * 32 + (r & 3) + 8 * (r >> 2)) * 1024 + j * 32;
          const float nv = src[o] + gv * acc[i][j][r];
          if (!dry) dst[o] = nv;
        }
    }
  }
}

#define CE_DESC(a, b) { const float _x = fmaxf(a, b); const float _y = fminf(a, b); a = _x; b = _y; }
template <int N>
__device__ __forceinline__ void bitonic_sort_desc(float (&v)[N]) {
#pragma unroll
  for (int k = 2; k <= N; k <<= 1)
#pragma unroll
    for (int j = k >> 1; j > 0; j >>= 1)
#pragma unroll
      for (int i = 0; i < N; i++) {
        const int l = i ^ j;
        if (l > i) {
          if ((i & k) == 0) { CE_DESC(v[i], v[l]); } else { CE_DESC(v[l], v[i]); }
        }
      }
}
__device__ __forceinline__ void sort16_desc(float (&v)[16]) {
  CE_DESC(v[0], v[1]) CE_DESC(v[2], v[3]) CE_DESC(v[4], v[5]) CE_DESC(v[6], v[7]) CE_DESC(v[8], v[9]) CE_DESC(v[10], v[11]) CE_DESC(v[12], v[13]) CE_DESC(v[14], v[15])
  CE_DESC(v[0], v[2]) CE_DESC(v[1], v[3]) CE_DESC(v[4], v[6]) CE_DESC(v[5], v[7]) CE_DESC(v[8], v[10]) CE_DESC(v[9], v[11]) CE_DESC(v[12], v[14]) CE_DESC(v[13], v[15])
  CE_DESC(v[1], v[2]) CE_DESC(v[5], v[6]) CE_DESC(v[9], v[10]) CE_DESC(v[13], v[14]) CE_DESC(v[0], v[4]) CE_DESC(v[1], v[5]) CE_DESC(v[2], v[6]) CE_DESC(v[3], v[7])
  CE_DESC(v[8], v[12]) CE_DESC(v[9], v[13]) CE_DESC(v[10], v[14]) CE_DESC(v[11], v[15]) CE_DESC(v[2], v[4]) CE_DESC(v[3], v[5]) CE_DESC(v[10], v[12]) CE_DESC(v[11], v[13])
  CE_DESC(v[1], v[2]) CE_DESC(v[3], v[4]) CE_DESC(v[5], v[6]) CE_DESC(v[9], v[10]) CE_DESC(v[11], v[12]) CE_DESC(v[13], v[14]) CE_DESC(v[0], v[8]) CE_DESC(v[1], v[9])
  CE_DESC(v[2], v[10]) CE_DESC(v[3], v[11]) CE_DESC(v[4], v[12]) CE_DESC(v[5], v[13]) CE_DESC(v[6], v[14]) CE_DESC(v[7], v[15]) CE_DESC(v[4], v[8]) CE_DESC(v[5], v[9])
  CE_DESC(v[6], v[10]) CE_DESC(v[7], v[11]) CE_DESC(v[2], v[4]) CE_DESC(v[3], v[5]) CE_DESC(v[6], v[8]) CE_DESC(v[7], v[9]) CE_DESC(v[10], v[12]) CE_DESC(v[11], v[13])
  CE_DESC(v[1], v[2]) CE_DESC(v[3], v[4]) CE_DESC(v[5], v[6]) CE_DESC(v[7], v[8]) CE_DESC(v[9], v[10]) CE_DESC(v[11], v[12]) CE_DESC(v[13], v[14])
}
template <int N>
__device__ __forceinline__ void bitonic_merge_desc(float (&v)[N]) {
#pragma unroll
  for (int j = N >> 1; j > 0; j >>= 1)
#pragma unroll
    for (int i = 0; i < N; i++) {
      const int l = i ^ j;
      if (l > i) { CE_DESC(v[i], v[l]); }
    }
}
__device__ __forceinline__ void merge_top16(float (&a)[16], const float (&b)[16]) {
#pragma unroll
  for (int i = 0; i < 16; i++) a[i] = fmaxf(a[i], b[15 - i]);
  bitonic_merge_desc<16>(a);
}
__device__ __forceinline__ void xhalf_merge_top16(float (&g)[16]) {
#pragma unroll
  for (int i = 0; i < 8; i++) {
    const int j = 15 - i;
    const u32x2_ ri = __builtin_amdgcn_permlane32_swap(__float_as_uint(g[i]), __float_as_uint(g[i]), false, false);
    const u32x2_ rj = __builtin_amdgcn_permlane32_swap(__float_as_uint(g[j]), __float_as_uint(g[j]), false, false);
    g[i] = fmaxf(__uint_as_float(ri.x), __uint_as_float(rj.y));
    g[j] = fmaxf(__uint_as_float(rj.x), __uint_as_float(ri.y));
  }
  bitonic_merge_desc<16>(g);
}
__device__ __forceinline__ void top16_of_tiles(const f32x16 (&s)[4], int hh, float (&res)[16]) {
  float g[4][16];
#pragma unroll
  for (int t = 0; t < 4; t++) {
#pragma unroll
    for (int r = 0; r < 16; r++) {
      const unsigned key = (unsigned)(32 * t + (r & 3) + 8 * (r >> 2)) + (unsigned)(4 * hh);
      g[t][r] = __uint_as_float((__float_as_uint(s[t][r]) & 0xffffff80u) | key);
    }
    sort16_desc(g[t]);
  }
  merge_top16(g[0], g[1]);
  merge_top16(g[2], g[3]);
  merge_top16(g[0], g[2]);
  xhalf_merge_top16(g[0]);
#pragma unroll
  for (int i = 0; i < 16; i++) res[i] = g[0][i];
}

template <bool BIG>
__device__ __forceinline__ void unit_peer_query(const Params& p, int L, int rt, int h, char* smem) {
  constexpr int TM = BIG ? 256 : 128, NT = BIG ? 512 : 256;
  const int tid = TIDX, lane = tid & 63, w = tid >> 6, wr = w >> 1, wc = w & 1, hh = lane >> 5, c = lane & 31;
  const long row0 = (long)rt * TM;
  u16* Qs = (u16*)smem;
  u16* Ss = (u16*)(smem + TM * 136 * 2);
  {
    f32x16 acc[2][2];
    ZERO_ACC(acc);
    if constexpr (BIG) gemm256(p.hx + row0 * 1024, 1024, p.WqT + (long)L * WQ_SZ + (long)h * 128 * 1024, 1024, 1024, acc, smem);
    else gemm128(p.hx + row0 * 1024, 1024, p.WqT + (long)L * WQ_SZ + (long)h * 128 * 1024, 1024, 1024, acc, smem);
#pragma unroll
    for (int i = 0; i < 2; i++)
#pragma unroll
      for (int j = 0; j < 2; j++)
#pragma unroll
        for (int r = 0; r < 16; r++) Qs[ACC_ROW(wr, i, r, lane) * 136 + ACC_COL(wc, j, lane)] = tobf(acc[i][j][r]);
    const u16* sk = p.SubK + (long)L * SUBK_SZ + (long)h * 2 * 128 * 64;
#pragma unroll
    for (int i = 0; i < 2048 / NT; i++) {
      const int idx = tid + NT * i, rw = idx >> 3, ch = idx & 7;
      *(uint4*)(Ss + rw * LDT + ch * 8) = ldg16(sk + rw * 64 + ch * 8);
    }
  }
  __syncthreads();
  float top[2][16];
#pragma unroll
  for (int pp = 0; pp < 2; pp++) {
    f32x16 s[4];
#pragma unroll
    for (int t = 0; t < 4; t++)
#pragma unroll
      for (int r = 0; r < 16; r++) s[t][r] = 0.f;
#pragma unroll
    for (int kk = 0; kk < 4; kk++) {
      uint4 bq = *(const uint4*)(Qs + (32 * w + c) * 136 + pp * 64 + kk * 16 + hh * 8);
#pragma unroll
      for (int t = 0; t < 4; t++) {
        uint4 ak = *(const uint4*)(Ss + (pp * 128 + 32 * t + c) * LDT + kk * 16 + hh * 8);
        s[t] = mfma32(ak, bq, s[t]);
      }
    }
    top16_of_tiles(s, hh, top[pp]);
  }
  float cand[32];
#define CAND2(q, a0, b0, a1, b1) { const float ta_ = hh ? top[0][a1] : top[0][a0]; const float tb_ = hh ? top[1][b1] : top[1][b0]; \
    cand[q] = __uint_as_float((__float_as_uint(ta_ + tb_) & 0xffffff00u) | (hh ? (unsigned)((a1) * 16 + (b1)) : (unsigned)((a0) * 16 + (b0)))); }
  CAND2(0, 0, 0, 0, 1)
  CAND2(1, 0, 2, 0, 3)
  CAND2(2, 0, 4, 0, 5)
  CAND2(3, 0, 6, 0, 7)
  CAND2(4, 0, 8, 0, 9)
  CAND2(5, 0, 10, 0, 11)
  CAND2(6, 0, 12, 0, 13)
  CAND2(7, 0, 14, 0, 15)
  CAND2(8, 1, 0, 1, 1)
  CAND2(9, 1, 2, 1, 3)
  CAND2(10, 1, 4, 1, 5)
  CAND2(11, 1, 6, 1, 7)
  CAND2(12, 2, 0, 2, 1)
  CAND2(13, 2, 2, 2, 3)
  CAND2(14, 2, 4, 3, 0)
  CAND2(15, 3, 1, 3, 2)
  CAND2(16, 3, 3, 4, 0)
  CAND2(17, 4, 1, 4, 2)
  CAND2(18, 5, 0, 5, 1)
  CAND2(19, 6, 0, 6, 1)
  CAND2(20, 7, 0, 7, 1)
  CAND2(21, 8, 0, 9, 0)
  CAND2(22, 10, 0, 11, 0)
  CAND2(23, 12, 0, 13, 0)
  CAND2(24, 14, 0, 15, 0)
#undef CAND2
#pragma unroll
  for (int q = 25; q < 32; q++) cand[q] = -3.0e38f;
  float best[16];
  {
    float g[2][16];
#pragma unroll
    for (int t = 0; t < 2; t++) {
#pragma unroll
      for (int r = 0; r < 16; r++) g[t][r] = cand[t * 16 + r];
      sort16_desc(g[t]);
    }
    merge_top16(g[0], g[1]);
    xhalf_merge_top16(g[0]);
#pragma unroll
    for (int i = 0; i < 16; i++) best[i] = g[0][i];
  }
  float e[16], es = 0.f;
#pragma unroll
  for (int i = 0; i < 16; i++) { e[i] = __expf(best[i] - best[0]); es += e[i]; }
  const float einv = 1.0f / es;
  __syncthreads();
  int* Ix = (int*)smem + w * 32 * 33;
  if (hh == 0) {
#pragma unroll
    for (int i = 0; i < 16; i++) {
      Ix[c * 33 + i] = (int)(__float_as_uint(top[0][i]) & 127u);
      Ix[c * 33 + 16 + i] = (int)(__float_as_uint(top[1][i]) & 127u);
    }
  }
  __syncthreads();
  const long orow = row0 + 32 * w + c;
  u16* ed = p.eid + orow * 128 + h * 16 + hh * 8;
  float* gd = p.gate + orow * 128 + h * 16 + hh * 8;
  int ev[8]; float gv[8];
#pragma unroll
  for (int i = 0; i < 8; i++) {
    const unsigned hm = 0u - (unsigned)hh;
    const unsigned bselu = (__float_as_uint(best[8 + i]) & hm) | (__float_as_uint(best[i]) & ~hm);
    const float esel = __uint_as_float((__float_as_uint(e[8 + i]) & hm) | (__float_as_uint(e[i]) & ~hm));
    const unsigned id = bselu & 255u;
    const int ia = Ix[c * 33 + (id >> 4)], ib = Ix[c * 33 + 16 + (id & 15)];
    ev[i] = ia * 128 + ib;
    gv[i] = esel * einv;
  }
  *(uint4*)(ed) = make_uint4((unsigned)ev[0] | ((unsigned)ev[1] << 16), (unsigned)ev[2] | ((unsigned)ev[3] << 16),
                             (unsigned)ev[4] | ((unsigned)ev[5] << 16), (unsigned)ev[6] | ((unsigned)ev[7] << 16));
  *(float4*)(gd) = make_float4(gv[0], gv[1], gv[2], gv[3]);
  *(float4*)(gd + 4) = make_float4(gv[4], gv[5], gv[6], gv[7]);
}

template <bool BIG>
__device__ __forceinline__ void phase_s10(const Params& p, int L, char* smem) {
  const int nrt = ((L == 0) ? RTOT : TLAT) / (BIG ? 256 : 128);
  FOR_UNITS_XCD(nrt, 8, rt, hd) unit_peer_query<BIG>(p, L, rt, hd, smem); }
}

#define CVT8(w, lo2, hi2) { lo2 = __builtin_amdgcn_cvt_pk_f32_fp8((int)(w), false); hi2 = __builtin_amdgcn_cvt_pk_f32_fp8((int)(w), true); }
#if CHECK_ATTN
#define NB11 1
#else
#define NB11 2
#endif
__device__ __forceinline__ void phase_s11a(const Params& p, int L) {
  const int lane = TIDS & 63, j = lane >> 3, cch = lane & 7;
  const int sl = VBID & 7;
  const int lw = (VBID >> 3) * 4 + (TIDS >> 6), nlw = (NVB >> 3) * 4;
  const int nrows = (L == 0) ? RTOT : TLAT;
  const unsigned char* Ub = p.UT8 + (long)(blockIdx.x & 7) * NEXP * 128;
  const unsigned uoff = (unsigned)cch * 16u;
  int rrN[NB11]; bool okN[NB11];
  uint4 hqN[NB11]; float shN[NB11]; int e_loN[NB11], e_hiN[NB11];
  auto load_idx = [&](int r0) __attribute__((always_inline)) {
#pragma unroll
    for (int u = 0; u < NB11; u++) {
      const int r = r0 + u * nlw;
      okN[u] = r < nrows; rrN[u] = okN[u] ? r : lw;
      hqN[u] = ldg16(p.hq8 + (long)rrN[u] * 1024 + sl * 128 + cch * 16);
      shN[u] = p.hs[(long)rrN[u] * 8 + sl];
      e_loN[u] = (int)p.eid[(long)rrN[u] * 128 + lane]; e_hiN[u] = (int)p.eid[(long)rrN[u] * 128 + 64 + lane];
    }
  };
  if (lw < nrows) load_idx(lw);
  for (int r0 = lw; r0 < nrows; r0 += NB11 * nlw) {
    int rr[NB11]; bool ok[NB11];
    uint4 hq[NB11]; float sh[NB11]; int e_lo[NB11], e_hi[NB11];
#pragma unroll
    for (int u = 0; u < NB11; u++) { rr[u] = rrN[u]; ok[u] = okN[u]; hq[u] = hqN[u]; sh[u] = shN[u]; e_lo[u] = e_loN[u]; e_hi[u] = e_hiN[u]; }
    uint4 uu[NB11][16];
#pragma unroll
    for (int u = 0; u < NB11; u++)
#pragma unroll
      for (int i = 0; i < 16; i++) {
        const int e = __shfl(i < 8 ? e_lo[u] : e_hi[u], 8 * (i & 7) + j);
        uu[u][i] = ldg16(Ub + (((unsigned)e << 7) + uoff));
      }
    if (r0 + NB11 * nlw < nrows) load_idx(r0 + NB11 * nlw);
    __builtin_amdgcn_sched_barrier(0);
#pragma unroll
    for (int u = 0; u < NB11; u++) {
      int d[16];
#pragma unroll
      for (int i = 0; i < 16; i++) {
        int acc = 0;
        acc = __builtin_amdgcn_sdot4((int)uu[u][i].x, (int)hq[u].x, acc, false);
        acc = __builtin_amdgcn_sdot4((int)uu[u][i].y, (int)hq[u].y, acc, false);
        acc = __builtin_amdgcn_sdot4((int)uu[u][i].z, (int)hq[u].z, acc, false);
        acc = __builtin_amdgcn_sdot4((int)uu[u][i].w, (int)hq[u].w, acc, false);
        d[i] = acc;
      }
      int t8[8], t4[4], t2[2];
      { const bool up = (lane & 4) != 0;
#pragma unroll
        for (int k = 0; k < 8; k++) { const int send = up ? d[k] : d[k + 8], keep = up ? d[k + 8] : d[k]; t8[k] = keep + dpp_movi<0x1B>(dpp_movi<0x141>(send)); } }
      { const bool up = (lane & 2) != 0;
#pragma unroll
        for (int k = 0; k < 4; k++) { const int send = up ? t8[k] : t8[k + 4], keep = up ? t8[k + 4] : t8[k]; t4[k] = keep + dpp_movi<0x4E>(send); } }
      { const bool up = (lane & 1) != 0;
#pragma unroll
        for (int k = 0; k < 2; k++) { const int send = up ? t4[k] : t4[k + 2], keep = up ? t4[k + 2] : t4[k]; t2[k] = keep + dpp_movi<0xB1>(send); } }
      if (ok[u]) p.PD[((long)sl * RTOT + rr[u]) * 64 + cch * 8 + j] = pack2((float)t2[0] * sh[u], (float)t2[1] * sh[u]);
    }
  }
}
__device__ __forceinline__ void phase_s11r(const Params& p, int L) {
  const int lane = TIDS & 63;
  const int gw = VBID * 4 + (TIDS >> 6), nw = NVB * 4;
  const int nrows = (L == 0) ? RTOT : TLAT;
  const int P0 = 16 * (lane >> 3) + (lane & 7);
  for (int r0 = gw; r0 < nrows; r0 += 2 * nw) {
    unsigned pw[2][8]; float g0[2], g1[2]; unsigned e0[2], e1[2]; int rr[2]; bool ok[2];
#pragma unroll
    for (int u = 0; u < 2; u++) {
      const int r = r0 + u * nw;
      ok[u] = r < nrows; rr[u] = ok[u] ? r : r0;
#pragma unroll
      for (int s2 = 0; s2 < 8; s2++) pw[u][s2] = p.PD[((long)s2 * RTOT + rr[u]) * 64 + lane];
      g0[u] = p.gate[(long)rr[u] * 128 + P0]; g1[u] = p.gate[(long)rr[u] * 128 + P0 + 8];
      e0[u] = p.eid[(long)rr[u] * 128 + P0]; e1[u] = p.eid[(long)rr[u] * 128 + P0 + 8];
    }
#pragma unroll
    for (int u = 0; u < 2; u++) {
      float d0 = 0.f, d1 = 0.f;
#pragma unroll
      for (int s2 = 0; s2 < 8; s2++) { d0 += bf_lo(pw[u][s2]); d1 += bf_hi(pw[u][s2]); }
      const float act0 = gelu_tanh(d0 * p.su[e0[u]]) * g0[u] * (1.0f / V8_SCALE);
      const float act1 = gelu_tanh(d1 * p.su[e1[u]]) * g1[u] * (1.0f / V8_SCALE);
      if (ok[u]) {
        p.REC[(long)rr[u] * 128 + P0] = ((unsigned)tobf(act0) << 16) | e0[u];
        p.REC[(long)rr[u] * 128 + P0 + 8] = ((unsigned)tobf(act1) << 16) | e1[u];
      }
    }
  }
}
__device__ __forceinline__ void phase_s11b(const Params& p, int L, bool dry = false) {
  const int lane = TIDS & 63, j = lane >> 3, cch = lane & 7;
  const int sl = VBID & 7;
  const int lw = (VBID >> 3) * 4 + (TIDS >> 6), nlw = (NVB >> 3) * 4;
  const int nrows = (L == 0) ? RTOT : TLAT;
  const unsigned char* Vb = p.VT8 + (long)(blockIdx.x & 7) * NEXP * 128;
  const unsigned voff0 = (unsigned)cch * 16u;
  const int P0 = 16 * (lane >> 3) + (lane & 7);
  const int col = sl * 128 + cch * 16 + 2 * j;
  int rrN[NB11]; bool okN[NB11];
  unsigned c_loN[NB11], c_hiN[NB11];
  auto load_idx = [&](int r0) __attribute__((always_inline)) {
#pragma unroll
    for (int u = 0; u < NB11; u++) {
      const int r = r0 + u * nlw;
      okN[u] = r < nrows; rrN[u] = okN[u] ? r : lw;
      c_loN[u] = p.REC[(long)rrN[u] * 128 + lane]; c_hiN[u] = p.REC[(long)rrN[u] * 128 + 64 + lane];
    }
  };
  if (lw < nrows) load_idx(lw);
  for (int r0 = lw; r0 < nrows; r0 += NB11 * nlw) {
    int rr[NB11]; bool ok[NB11];
    unsigned c_lo[NB11], c_hi[NB11];
#pragma unroll
    for (int u = 0; u < NB11; u++) { rr[u] = rrN[u]; ok[u] = okN[u]; c_lo[u] = c_loN[u]; c_hi[u] = c_hiN[u]; }
    uint4 vv[NB11][16];
    float av[NB11][16];
#pragma unroll
    for (int u = 0; u < NB11; u++)
#pragma unroll
      for (int i = 0; i < 16; i++) {
        const unsigned wrec = (unsigned)__shfl((int)(i < 8 ? c_lo[u] : c_hi[u]), 8 * (i & 7) + j);
        av[u][i] = __uint_as_float(wrec & 0xffff0000u);
        vv[u][i] = ldg16(Vb + (((wrec & 0xffffu) << 7) + voff0));
      }
    if (r0 + NB11 * nlw < nrows) load_idx(r0 + NB11 * nlw);
    __builtin_amdgcn_sched_barrier(0);
#pragma unroll
    for (int u = 0; u < NB11; u++) {
      f32x2 o2[8];
#pragma unroll
      for (int q = 0; q < 8; q++) o2[q] = f32x2{0.f, 0.f};
#pragma unroll
      for (int i = 0; i < 16; i++) {
        const float a = av[u][i];
        const f32x2 aa = {a, a};
        f32x2 a0, a1;
        CVT8(vv[u][i].x, a0, a1); o2[0] += aa * a0; o2[1] += aa * a1;
        CVT8(vv[u][i].y, a0, a1); o2[2] += aa * a0; o2[3] += aa * a1;
        CVT8(vv[u][i].z, a0, a1); o2[4] += aa * a0; o2[5] += aa * a1;
        CVT8(vv[u][i].w, a0, a1); o2[6] += aa * a0; o2[7] += aa * a1;
      }
      float o[16];
#pragma unroll
      for (int q = 0; q < 8; q++) { o[2 * q] = o2[q].x; o[2 * q + 1] = o2[q].y; }
      float t8[8], t4[4], t2[2];
#pragma unroll
      for (int k = 0; k < 8; k++) {
        const u32x2_ q = __builtin_amdgcn_permlane32_swap(__float_as_uint(o[k]), __float_as_uint(o[k + 8]), false, false);
        t8[k] = __uint_as_float(q.x) + __uint_as_float(q.y);
      }
#pragma unroll
      for (int k = 0; k < 4; k++) {
        const u32x2_ q = __builtin_amdgcn_permlane16_swap(__float_as_uint(t8[k]), __float_as_uint(t8[k + 4]), false, false);
        t4[k] = __uint_as_float(q.x) + __uint_as_float(q.y);
      }
      { const bool up = (lane & 8) != 0;
#pragma unroll
        for (int k = 0; k < 2; k++) { const float send = up ? t4[k] : t4[k + 2], keep = up ? t4[k + 2] : t4[k]; t2[k] = keep + dpp_mov<0x128>(send); } }
      if (!ABL_PEER || !ok[u]) continue;
      const int r = rr[u];
      float* xr = ((r < TLAT) ? p.out + (long)r * 1024 : p.ctx1 + (long)(r - TLAT) * 1024) + col;
      const float2 gt = *(const float2*)(p.mods + (long)(L * 9 + row_mod(r)) * 6144 + 5120 + col);
      float2 xv = *(const float2*)xr;
      xv.x += gt.x * t2[0]; xv.y += gt.y * t2[1];
      if (!dry) *(float2*)xr = xv;
    }
  }
}


#if CHECK_ATTN
__device__ __forceinline__ float blk_sum(float v, float* red) {
  v = wave_sum(v);
  __syncthreads();
  if ((TIDS & 63) == 0) red[TIDS >> 6] = v;
  __syncthreads();
  return red[0] + red[1] + red[2] + red[3];
}
__device__ __forceinline__ float blk_max(float v, float* red) {
#pragma unroll
  for (int o = 32; o > 0; o >>= 1) v = fmaxf(v, __shfl_xor(v, o));
  __syncthreads();
  if ((TIDS & 63) == 0) red[TIDS >> 6] = v;
  __syncthreads();
  return fmaxf(fmaxf(red[0], red[1]), fmaxf(red[2], red[3]));
}
__device__ __forceinline__ bool far(float got, float ref, float rel, float ab) { return !(fabsf(got - ref) <= rel * fabsf(ref) + ab); }
__device__ __forceinline__ void rope_ref(const float* z, float* o, int s) {
  for (int c = 0; c < 32; c++) {
    const int pos = (c < 16) ? (s / 64) : (s % 64);
    const float inv = powf(10000.0f, -(float)(2 * (c % 8)) / 16.0f);
    const float ang = (float)pos * inv;
    const int cb = c & 16, cc = c & 15;
    const float rot = (cc < 8) ? -z[cb + cc + 8] : z[cb + cc - 8];
    o[c] = z[c] * cosf(ang) + rot * sinf(ang);
  }
}
__device__ __forceinline__ void check_proj(const Params& p, int L, int r, char* smem) {
  float* hrow = (float*)smem;
  float* z = hrow + 1024;
  float* kvr = z + 416;
  float* red = kvr + 1024;
  float* kk = red + 8;
  const int tid = TIDS;
  __syncthreads();
  for (int k = tid; k < 1024; k += 256) hrow[k] = bf1(p.hx[(long)r * 1024 + k]);
  __syncthreads();
  for (int n = tid; n < 416; n += 256) {
    float a = 0.f;
    for (int k = 0; k < 1024; k++) a += hrow[k] * p.w_in[((long)L * 1024 + k) * 4256 + n];
    z[n] = a;
  }
  __syncthreads();
  unsigned bad = 0;
  if (L == 0 || r < TLAT)
  for (int n = tid; n < 256; n += 256) if (far(bf1(p.cq[(long)r * 256 + n]), z[160 + n], 0.02f, 0.03f)) bad |= 1u;
  for (int n = tid; n < 32; n += 256) if (far(p.kr[(long)r * 32 + n], z[128 + n], 0.02f, 0.03f)) bad |= 1u;
  const float ssc = blk_sum(tid < 128 ? z[tid] * z[tid] : 0.f, red);
  const float rc = __builtin_amdgcn_rsqf(ssc / 128.0f + EPSV);
  for (int n = tid; n < 1024; n += 256) {
    float a = 0.f;
    for (int k = 0; k < 128; k++) a += z[k] * rc * p.g_ckv[L * 128 + k] * p.w_ukv[((long)L * 128 + k) * 1024 + n];
    kvr[n] = a;
  }
  __syncthreads();
  const bool lat = r < TLAT;
  const int b = lat ? (r >> 12) : ((r - TLAT) >> 8), s = lat ? (r & 4095) : ((r - TLAT) & 255), kpos = lat ? CTXL + s : s;
  for (int h = 0; h < 8; h++) {
    float sq = 0.f;
    if (tid < 64) sq = kvr[h * 128 + tid] * kvr[h * 128 + tid]; else if (tid < 96) sq = z[128 + tid - 64] * z[128 + tid - 64];
    const float ssk = blk_sum(sq, red);
    const float rk = __builtin_amdgcn_rsqf(ssk / 96.0f + EPSV);
    if (tid == 0) {
      float* zr = kk + 96; float* zo = zr + 32;
      for (int c = 0; c < 32; c++) zr[c] = z[128 + c] * rk * p.g_kn[L * 96 + 64 + c];
      if (lat) rope_ref(zr, zo, s); else for (int c = 0; c < 32; c++) zo[c] = zr[c];
      for (int c = 0; c < 32; c++) kk[64 + c] = zo[c];
    }
    if (tid < 64) kk[tid] = kvr[h * 128 + tid] * rk * p.g_kn[L * 96 + tid];
    __syncthreads();
    if (tid < 96 && far(bf1(p.Kb[((long)(b * 8 + h) * SKEYS + kpos) * 96 + tid]), kk[tid], 0.03f, 0.03f)) bad |= 2u;
    if (tid < 64 && far(bf1(p.Vtb[((long)(b * 8 + h) * 64 + tid) * SKEYS + kpos]), kvr[h * 128 + 64 + tid], 0.03f, 0.03f)) bad |= 4u;
    __syncthreads();
  }
  if (bad & CHECK_MASK) atomicOr(&p.bar[0], bad & CHECK_MASK);
}
__device__ __forceinline__ void check_attn(const Params& p, int L, int r, int h, char* smem) {
  float* cqr = (float*)smem;
  float* q = cqr + 256;
  float* sc = q + 96;
  float* red = sc + 4352;
  const int tid = TIDS;
  const bool lat = r < TLAT;
  const int b = lat ? (r >> 12) : ((r - TLAT) >> 8), s = lat ? (r & 4095) : ((r - TLAT) & 255);
  const int nkeys = lat ? SKEYS : CTXL;
  __syncthreads();
  cqr[tid] = bf1(p.cq[(long)r * 256 + tid]);
  __syncthreads();
  const float rc = __builtin_amdgcn_rsqf(blk_sum(cqr[tid] * cqr[tid], red) / 256.0f + EPSV);
  float qr = 0.f;
  if (tid < 96) for (int k = 0; k < 256; k++) qr += cqr[k] * rc * p.g_cq[L * 256 + k] * p.w_uq[((long)L * 256 + k) * 768 + h * 96 + tid];
  const float rq = __builtin_amdgcn_rsqf(blk_sum(tid < 96 ? qr * qr : 0.f, red) / 96.0f + EPSV);
  if (tid < 96) q[tid] = qr * rq * p.g_qn[L * 96 + tid];
  __syncthreads();
  if (tid == 0 && lat) {
    float* zr = red + 8; float* zo = zr + 32;
    for (int c = 0; c < 32; c++) zr[c] = q[64 + c];
    rope_ref(zr, zo, s);
    for (int c = 0; c < 32; c++) q[64 + c] = zo[c];
  }
  __syncthreads();
  float mx = -1e30f;
  for (int key = tid; key < nkeys; key += 256) {
    float a = 0.f;
    for (int d = 0; d < 96; d++) a += q[d] * bf1(p.Kb[((long)(b * 8 + h) * SKEYS + key) * 96 + d]);
    a *= 0.10206207261596577f;
    sc[key] = a; mx = fmaxf(mx, a);
  }
  mx = blk_max(mx, red);
  float ps = 0.f;
  for (int key = tid; key < nkeys; key += 256) { const float e = expf(sc[key] - mx); sc[key] = e; ps += e; }
  const float tot = blk_sum(ps, red);
  unsigned bad = 0;
  if (tid < 64) {
    float a = 0.f;
    for (int key = 0; key < nkeys; key++) a += sc[key] * bf1(p.Vtb[((long)(b * 8 + h) * 64 + tid) * SKEYS + key]);
    a /= tot;
    if (far(bf1(p.Ob[(long)r * 512 + h * 64 + tid]), a, 0.04f, 1.5e-3f)) bad |= 8u;
  }
  if (bad & CHECK_MASK) atomicOr(&p.bar[0], bad & CHECK_MASK);
}
__device__ __forceinline__ void phase_check(const Params& p, int L, char* smem) {
  const int nq = (L == 0) ? 12 : 8;
  char* sm = smem + HALF_ * LDS_SMALL;
  for (int pass = 0; pass < 2; pass++) {
  FOR_PAIRED(pass == 0 ? 12 : nq * 8, uu)
    const int u = (pass == 0) ? uu : uu + 12;
    const int si = (u < 12) ? u : ((u - 12) >> 3);
    int r;
    switch (si) {
      case 0: r = 0; break; case 1: r = 63; break; case 2: r = 64; break; case 3: r = 4095; break;
      case 4: r = 4096 + 777; break; case 5: r = 12345; break; case 6: r = 20000; break; case 7: r = 32767; break;
      case 8: r = TLAT; break; case 9: r = TLAT + 255; break; case 10: r = TLAT + 256 + 100; break; default: r = TLAT + 2047; break;
    }
    if (u < 12) check_proj(p, L, r, sm);
    else check_attn(p, L, r, (u - 12) & 7, sm);
  }
  }
}
#endif

#define XB_TMO      128
#define XB_XCNT(j)  (256  + 64 * (j))
#define XB_XSUB(j)  (1280 + 64 * (j))
#define XB_XGEN(j)  (2304 + 64 * (j))
#define XB_TOP      3328
#define XB_TOPGEN   3392
#define XCD_BAR_WORDS 3456
#define XB_SPIN_CAP (1u << 22)
#define LAS __attribute__((address_space(3)))
__device__ __forceinline__ unsigned xb_ld(unsigned* p)              { return __hip_atomic_load(p, __ATOMIC_RELAXED, __HIP_MEMORY_SCOPE_AGENT); }
__device__ __forceinline__ unsigned xb_add(unsigned* p, unsigned v) { return __hip_atomic_fetch_add(p, v, __ATOMIC_RELAXED, __HIP_MEMORY_SCOPE_AGENT); }
__device__ __forceinline__ unsigned xb_xcc_id() { return (unsigned)__builtin_amdgcn_s_getreg((3 << 11) | 20) & 0xFu; }
#define XB_SPIN(cond, bar) do { unsigned _sp = 0; while (cond) { __builtin_amdgcn_s_sleep(1); \
    if ((++_sp & 255u) == 0u) { if (xb_ld(&(bar)[XB_TMO])) break; if (_sp > XB_SPIN_CAP) { atomicAdd(&(bar)[XB_TMO], 1u); break; } } } } while (0)
struct XcdBarrier { unsigned* bar; unsigned x; volatile LAS unsigned* st; };
__device__ __forceinline__ XcdBarrier xcd_barrier_post(unsigned* bar, volatile LAS unsigned* st) {
  XcdBarrier b; b.bar = bar; b.x = xb_xcc_id(); b.st = st;
  if (threadIdx.x == 0) (void)xb_add(&bar[XB_XCNT(b.x)], 1u);
  return b;
}
__device__ __forceinline__ void xcd_barrier_complete(unsigned* bar, unsigned x, unsigned& nloc, unsigned& nx) {
  const unsigned G = gridDim.x * gridDim.y * gridDim.z;
  unsigned sum, cnt, mine, sp = 0u;
  for (;;) {
    sum = 0u; cnt = 0u; mine = 0u;
#pragma unroll
    for (unsigned j = 0; j < 16; ++j) { const unsigned c = xb_ld(&bar[XB_XCNT(j)]); sum += c; cnt += (c > 0u) ? 1u : 0u; mine = (j == x) ? c : mine; }
    if (sum == G) break;
    __builtin_amdgcn_s_sleep(1);
    if ((++sp & 255u) == 0u) { if (xb_ld(&bar[XB_TMO])) break; if (sp > XB_SPIN_CAP) { atomicAdd(&bar[XB_TMO], 1u); break; } }
  }
  nloc = mine > 0u ? mine : 1u; nx = cnt > 0u ? cnt : 1u;
}
__device__ __forceinline__ void xcd_barrier(const XcdBarrier& b) {
  asm volatile("s_waitcnt vmcnt(0)" ::: "memory");
  __syncthreads();
  if (threadIdx.x == 0) {
    unsigned* bar = b.bar;
    asm volatile("" : "+s"(bar));
    __builtin_amdgcn_s_waitcnt(0);
    unsigned nloc = b.st[0], nx = b.st[1];
    if (nloc == 0u) { xcd_barrier_complete(bar, b.x, nloc, nx); b.st[0] = nloc; b.st[1] = nx; }
    const unsigned old = xb_add(&bar[XB_XSUB(b.x)], 1u);
    const unsigned gen = old / nloc;
    if (old + 1u == (gen + 1u) * nloc) {
      __builtin_amdgcn_fence(__ATOMIC_RELEASE, "agent");
      asm volatile("s_waitcnt vmcnt(0)" ::: "memory");
      const unsigned og = xb_add(&bar[XB_TOP], 1u);
      const unsigned tg = og / nx;
      if (og + 1u == (tg + 1u) * nx) xb_add(&bar[XB_TOPGEN], 1u);
      else XB_SPIN(xb_ld(&bar[XB_TOPGEN]) == tg, bar);
      __builtin_amdgcn_fence(__ATOMIC_ACQUIRE, "agent");
      xb_add(&bar[XB_XGEN(b.x)], 1u);
      asm volatile("s_waitcnt vmcnt(0)" ::: "memory");
    } else {
      XB_SPIN(xb_ld(&bar[XB_XGEN(b.x)]) == gen, bar);
      __builtin_amdgcn_fence(__ATOMIC_ACQUIRE, "agent");
      asm volatile("s_waitcnt vmcnt(0)" ::: "memory");
    }
  }
  __syncthreads();
}

#define PPL 12
#define NPHASE (1 + 2 * PPL + CHECK_ATTN)
#ifndef PH_LIMIT
#define PH_LIMIT NPHASE
#endif
__device__ __forceinline__ void run_phase(const Params& p, int ph, char* smem, bool dry = false, bool big = false) {
  if (ph == 0) { phase_prep(p, smem); return; }
#if CHECK_ATTN
  if (ph == 1 + 2 * PPL) {
    if (blockIdx.x == 0 && threadIdx.x == 0 && __hip_atomic_load(&p.bar[0], __ATOMIC_RELAXED, __HIP_MEMORY_SCOPE_AGENT) != 0u) p.out[0] = __uint_as_float(0x7fc00000u);
    return;
  }
#endif
  const int L = (ph - 1) / PPL, s = (ph - 1) % PPL;
  if (s == 0 || s == 7) {
    phase_norm(p, L, s == 0 ? 0 : 1, (s == 0 || L == 0) ? RTOT : TLAT);
    if (s == 0 && L == 1) phase_tables(p, L);
    return;
  }
  switch (s) {
    case 1: phase_s2<true>(p, L, smem); break;
    case 2: phase_s3(p, L, smem, dry); break;
    case 3: phase_s4(p, L, smem); break;
    case 4: phase_dftC(p, smem);
#if CHECK_ATTN
      phase_check(p, L, smem);
#endif
      break;
    case 5: phase_s7<true>(p, L, smem); break;
    case 6: phase_s8<true>(p, L, smem, dry); break;
    case 8: phase_s10<true>(p, L, smem); break;
    case 9: phase_s11a(p, L); break;
    case 10: phase_s11r(p, L); break;
    case 11: phase_s11b(p, L, dry); break;
  }
}

__global__ void __launch_bounds__(512, 2) mega(Params p, int ph0, int ph1) {
  extern __shared__ __attribute__((aligned(16))) char smem[];
  __shared__ uint4 xb_words;
  cg::grid_group grid = cg::this_grid();
  const bool multi = (ph1 - ph0) > 1;
  const bool big = blockDim.x == 512;
  XcdBarrier xb;
  if (multi) {
    if (threadIdx.x == 0) xb_words = make_uint4(0u, 0u, 0u, 0u);
    __syncthreads();
    xb = xcd_barrier_post(p.bar, (volatile LAS unsigned*)&xb_words);
  }
  for (int ph = ph0; ph < ph1; ph++) {
    if (ph > ph0) {
      if (ph == ph0 + 1) grid.sync();
      else xcd_barrier(xb);
    }
#if PROBE_S >= 0
    {
      const int kind = (ph == 0) ? 100 : (ph - 1) % PPL;
      const int reps = (kind == PROBE_S) ? PROBE_REPS * p.one : 0;
      for (int rep = 0; rep <= reps; rep++) {
        if (rep > 0) xcd_barrier(xb);
        const bool dry = (rep < reps);
        if (kind == PROBE_S && (kind == 6 || kind == 11 || kind == 2)) run_phase(p, ph, smem, dry, big);
        else run_phase(p, ph, smem, false, big);
      }
    }
#else
    run_phase(p, ph, smem, false, big);
#endif
  }
}

static inline size_t al256(size_t x) { return (x + 255) & ~(size_t)255; }
extern "C" void kernel_launch(void* const* d_in, const int* in_sizes, int n_in, void* d_out, int out_size, void* d_ws,
                              size_t ws_size, hipStream_t stream) {
  Params p{};
  const float* const* in = (const float* const*)d_in;
  p.x = in[0]; p.c = in[1]; p.ctx = in[2]; p.c_ctx = in[3]; p.w_mod = in[4]; p.b_mod = in[5]; p.g_norm1 = in[6];
  p.w_in = in[7]; p.g_ckv = in[8]; p.w_ukv = in[9]; p.g_cq = in[10]; p.w_uq = in[11]; p.g_qn = in[12]; p.g_kn = in[13];
  p.w_dw = in[14]; p.b_dw = in[15]; p.g_cln = in[16]; p.b_cln = in[17]; p.wb_attn = in[18]; p.wb_fnet = in[19];
  p.wb_conv = in[20]; p.w_out = in[21]; p.g_norm2 = in[22]; p.w_query = in[23]; p.sub_keys = in[24]; p.u_tab = in[25];
  p.v_tab = in[26];
  p.out = (float*)d_out;
  p.one = 1; p.pad_ = 0;
  char* ws = (char*)d_ws;
  size_t off = 0;
  auto take = [&](size_t bytes) { char* q = ws + off; off += al256(bytes); return q; };
  p.bar = (unsigned*)take(XCD_BAR_WORDS * 4);
  const size_t mods_bytes = 2 * 9 * 6144 * 4;
  p.mods = (float*)take(mods_bytes);
  p.ropetab = (float*)take(64 * 8 * 2 * 4);
  p.W2T = (u16*)take(2ull * W2T_SZ * 2);
  p.WgT = (u16*)take(2ull * WGT_SZ * 2);
  p.WukvT = (u16*)take(2ull * WUKV_SZ * 2);
  p.WuqT = (u16*)take(2ull * WUQ_SZ * 2);
  p.WbaT = (u16*)take(2ull * WBA_SZ * 2);
  p.WbfT = (u16*)take(2ull * WBF_SZ * 2);
  p.WbcT = (u16*)take(2ull * WBC_SZ * 2);
  p.WoutT = (u16*)take(2ull * WOUT_SZ * 2);
  p.WqT = (u16*)take(2ull * WQ_SZ * 2);
  p.SubK = (u16*)take(2ull * SUBK_SZ * 2);
  p.WA = (u16*)take(128 * 128 * 2);
  p.WC = (u16*)take(128 * 128 * 2);
  p.tw = (float*)take(4096 * 2 * 4);
  p.GB = (u16*)take((size_t)NB * 256 * 8192 * 2);
  p.Dctx = (u16*)take(256ull * 512 * 2);
  p.Wcs = (u16*)take(128ull * 64 * 2);
  p.UT8 = (unsigned char*)take((size_t)NEXP * 1024);
  p.VT8 = (unsigned char*)take((size_t)NEXP * 1024);
  p.su = (float*)take((size_t)NEXP * 4);
  p.hq8 = (unsigned char*)take((size_t)RTOT * 1024);
  p.hs = (float*)take((size_t)RTOT * 8 * 4);
  p.hx = (u16*)take((size_t)RTOT * 1024 * 2);
  p.REC = (unsigned*)p.hx;
  {
    const size_t b0 = off;
    p.cq = (u16*)take((size_t)RTOT * 256 * 2);
    p.zf = (u16*)take((size_t)RTOT * 256 * 2);
    p.zc = (u16*)take((size_t)RTOT * 512 * 2);
    p.ckv = (u16*)take((size_t)RTOT * 128 * 2);
    p.kr = (float*)take((size_t)RTOT * 32 * 4);
    p.m = (u16*)(ws + b0);
    p.PD = (unsigned*)(ws + b0);
  }
  {
    const size_t c0 = off;
    p.Kb = (u16*)take((size_t)NB * NH * SKEYS * 96 * 2);
    p.Vtb = (u16*)take((size_t)NB * NH * 64 * SKEYS * 2);
    p.eid = (u16*)(ws + c0);
    p.gate = (float*)(ws + c0 + al256((size_t)RTOT * 128 * 4));
  }
  p.Ytl = (u16*)take((size_t)NB * 256 * 8192 * 2);
  p.Ytc = (u16*)take((size_t)NB * 256 * 512 * 2);
  p.Ob = (u16*)take((size_t)RTOT * 512 * 2);
  p.Fb = (u16*)take((size_t)RTOT * 256 * 2);
  p.cv = (u16*)take((size_t)RTOT * 256 * 2);
  p.ctx1 = (float*)take((size_t)TCTX * 1024 * 4);
  if (off > ws_size) { fprintf(stderr, "workspace too small: need %zu have %zu\n", off, ws_size); return; }

  (void)hipMemsetAsync(p.bar, 0, XCD_BAR_WORDS * 4, stream);
  static int cus = 0;
  if (!cus) {
    int dev = 0;
    (void)hipGetDevice(&dev);
    (void)hipDeviceGetAttribute(&cus, hipDeviceAttributeMultiprocessorCount, dev);
    (void)hipFuncSetAttribute((const void*)mega, hipFuncAttributeMaxDynamicSharedMemorySize, LDS_BIG);
  }
#if ONE_LAUNCH
  int ph0 = 0, ph1 = NPHASE;
  void* args[] = {&p, &ph0, &ph1};
  hipError_t e = hipLaunchCooperativeKernel((void*)mega, dim3(cus), dim3(512), args, LDS_BIG, stream);
  if (e != hipSuccess) fprintf(stderr, "cooperative launch failed: %s (grid %d)\n", hipGetErrorString(e), cus);
#else
  for (int ph = 0; ph < PH_LIMIT; ph++) {
    const int kind = (ph == 0) ? 100 : (ph - 1) % PPL;
    const bool bigp = (kind == 1 || kind == 5 || kind == 6 || kind == 8);
    if (bigp) mega<<<cus, 512, LDS_BIG, stream>>>(p, ph, ph + 1);
    else mega<<<cus * 2, 256, LDS_SMALL, stream>>>(p, ph, ph + 1);
  }
#endif
}
```
